# Optimizing an MI355X kernel written in HIP

```python
import math
import jax, jax.numpy as jnp
from jax import lax
import numpy as np

D_MODEL = 1024
BATCH = 8
SEQ = 4096
DEPTH = 4

CHUNK = 64
Q_BLOCK = 2 * CHUNK

ATT_HEAD_DIM = 64
ATT_WIDTH = D_MODEL // 2
ATT_HEADS = ATT_WIDTH // ATT_HEAD_DIM
POOL_WINDOWS = (2, 4, 8, 16)
POOL_GROUPS = 4
POOL_WIDTH = D_MODEL // 4
POOL_GROUP_DIM = POOL_WIDTH // POOL_GROUPS
SSM_WIDTH = D_MODEL // 4
SSM_GROUP_DIM = 16
SSM_GROUPS = SSM_WIDTH // SSM_GROUP_DIM
SSM_STATE = 64
DT_MIN = 1e-3
DT_MAX = 1e-1
N_BRANCH = 3
N_EXPERTS = 32
TOP_K = 4
D_FF = D_MODEL
SWIGLU_LIMIT = 7.0
SWIGLU_ALPHA = 1.702
MOE_BLOCK = 256
LN_EPS = 1e-5
DEEPNORM_ALPHA = (2.0 * DEPTH) ** 0.25
DEEPNORM_BETA = (8.0 * DEPTH) ** -0.25

IN_SPLIT_SIZES = (ATT_WIDTH, ATT_WIDTH, ATT_WIDTH, ATT_HEADS, POOL_WIDTH, SSM_WIDTH, N_BRANCH * D_MODEL)
N_IN = 3 * ATT_WIDTH + ATT_HEADS + POOL_WIDTH + SSM_WIDTH + N_BRANCH * D_MODEL

kernel_name = "hybrid_fox_pool_s5_moe_deepnorm"


def _split_points():
    pts, acc = [], 0
    for s in IN_SPLIT_SIZES[:-1]:
        acc += s
        pts.append(acc)
    return pts


def _layer_norm(x, g, b):
    xf = x.astype(jnp.float32)
    mu = xf.mean(-1, keepdims=True)
    var = jnp.square(xf - mu).mean(-1, keepdims=True)
    y = (xf - mu) * lax.rsqrt(var + LN_EPS) * g.astype(jnp.float32) + b.astype(jnp.float32)
    return y.astype(x.dtype)


def _forgetting_attention(q, k, v, f_logit, b_f):
    B_, S_, H, Dh = q.shape
    log_f = jax.nn.log_sigmoid(f_logit.astype(jnp.float32) + b_f.astype(jnp.float32))
    cum = jnp.cumsum(log_f, axis=1)
    cum_k = cum.transpose(0, 2, 1)
    nb = S_ // Q_BLOCK
    scale = Dh ** -0.5
    kf = k.astype(jnp.float32)
    qb = q.reshape(B_, nb, Q_BLOCK, H, Dh).transpose(1, 0, 2, 3, 4)
    cb = cum.reshape(B_, nb, Q_BLOCK, H).transpose(1, 0, 3, 2)
    key_pos = jnp.arange(S_)

    def block(args):
        i, q_i, c_i = args
        s = jnp.einsum('bqhd,bkhd->bhqk', q_i.astype(jnp.float32), kf) * scale
        s = s + (c_i[..., :, None] - cum_k[..., None, :])
        q_pos = i * Q_BLOCK + jnp.arange(Q_BLOCK)
        s = jnp.where(key_pos[None, :] <= q_pos[:, None], s, -jnp.inf)
        p = jax.nn.softmax(s, axis=-1)
        return jnp.einsum('bhqk,bkhd->bqhd', p.astype(v.dtype), v)

    out = lax.map(block, (jnp.arange(nb), qb, cb))
    return out.transpose(1, 0, 2, 3, 4).reshape(B_, S_, H * Dh)


def _multiscale_pool(u, w_pool, pool_scale):
    B_, S_, _ = u.shape
    ug = u.reshape(B_, S_, POOL_GROUPS, POOL_GROUP_DIM).astype(jnp.float32)
    cs = jnp.cumsum(ug, axis=1)
    cs0 = jnp.pad(cs, ((0, 0), (1, 0), (0, 0), (0, 0)))
    win = jnp.array(POOL_WINDOWS, jnp.int32)
    t = jnp.arange(S_, dtype=jnp.int32)[:, None]
    start = jnp.maximum(t + 1 - win[None, :], 0)
    g_idx = jnp.arange(POOL_GROUPS)[None, :]
    lower = cs0[:, start, g_idx]
    count = jnp.minimum(t + 1, win[None, :]).astype(jnp.float32)
    pooled = (cs - lower) / count[None, :, :, None]
    mixed = (pooled - ug).astype(u.dtype)
    y = jnp.einsum('bsgc,gcd->bsgd', mixed, w_pool).reshape(B_, S_, POOL_WIDTH)
    return y * pool_scale


def _s5(u, lam_re, lam_im, log_dt, b_re, b_im, c_re, c_im, d_skip, w_glu, b_glu):
    f32 = jnp.float32
    B_, S_, _ = u.shape
    uf = u.reshape(B_, S_, SSM_GROUPS, SSM_GROUP_DIM).astype(f32)
    dt = jnp.exp(log_dt.astype(f32))[:, None]
    lr = lam_re.astype(f32)
    li = lam_im.astype(f32)
    mag = jnp.exp(lr * dt)
    ar = mag * jnp.cos(li * dt)
    ai = mag * jnp.sin(li * dt)
    den = lr * lr + li * li
    nr = ar - 1.0
    zr = (nr * lr + ai * li) / den
    zi = (ai * lr - nr * li) / den
    br = b_re.astype(f32)
    bi = b_im.astype(f32)
    bbr = zr[..., None] * br - zi[..., None] * bi
    bbi = zr[..., None] * bi + zi[..., None] * br
    xr = jnp.einsum('bsgh,gph->bsgp', uf, bbr)
    xi = jnp.einsum('bsgh,gph->bsgp', uf, bbi)
    a_r = jnp.broadcast_to(ar[None, None], (1, S_) + ar.shape)
    a_i = jnp.broadcast_to(ai[None, None], (1, S_) + ai.shape)

    def combine(e1, e2):
        a1r, a1i, b1r, b1i = e1
        a2r, a2i, b2r, b2i = e2
        return (a2r * a1r - a2i * a1i,
                a2r * a1i + a2i * a1r,
                a2r * b1r - a2i * b1i + b2r,
                a2r * b1i + a2i * b1r + b2i)

    _, _, hr, hi = lax.associative_scan(combine, (a_r, a_i, xr, xi), axis=1)
    y = (jnp.einsum('bsgp,ghp->bsgh', hr, c_re.astype(f32))
         - jnp.einsum('bsgp,ghp->bsgh', hi, c_im.astype(f32))
         + d_skip.astype(f32) * uf)
    y = jax.nn.gelu(y.reshape(B_, S_, SSM_WIDTH).astype(u.dtype))
    return y * jax.nn.sigmoid(y @ w_glu + b_glu)


def _moe(h, w_router, b_router, w_up, b_up, w_down, b_down):
    f32 = jnp.float32
    B_, S_, D = h.shape
    xt = h.reshape(-1, D)
    N = xt.shape[0]
    logits = (xt @ w_router).astype(f32) + b_router.astype(f32)
    top_val, top_idx = lax.top_k(logits, TOP_K)
    gate = jax.nn.softmax(top_val, axis=-1)
    M = N * TOP_K
    flat_e = top_idx.reshape(-1)
    order = jnp.argsort(flat_e)
    sorted_e = flat_e[order]
    counts = jnp.bincount(flat_e, length=N_EXPERTS)
    padded = (counts + MOE_BLOCK - 1) // MOE_BLOCK * MOE_BLOCK
    start = jnp.cumsum(counts) - counts
    pend = jnp.cumsum(padded)
    pstart = pend - padded
    dest = pstart[sorted_e] + jnp.arange(M, dtype=counts.dtype) - start[sorted_e]
    P = M + N_EXPERTS * MOE_BLOCK
    nblk = P // MOE_BLOCK
    row_tok = jnp.zeros((P,), jnp.int32).at[dest].set((order // TOP_K).astype(jnp.int32))
    row_w = jnp.zeros((P,), f32).at[dest].set(gate.reshape(-1)[order])
    blk_e = jnp.minimum(jnp.searchsorted(pend, jnp.arange(nblk) * MOE_BLOCK, side='right'), N_EXPERTS - 1)
    xb = xt[row_tok].reshape(nblk, MOE_BLOCK, D)

    def expert_block(args):
        x_b, e = args
        hu = x_b @ w_up[e] + b_up[e]
        x_glu = jnp.minimum(hu[:, ::2], SWIGLU_LIMIT)
        x_lin = jnp.clip(hu[:, 1::2], -SWIGLU_LIMIT, SWIGLU_LIMIT)
        act = x_glu * jax.nn.sigmoid(SWIGLU_ALPHA * x_glu) * (x_lin + 1.0)
        return act @ w_down[e] + b_down[e]

    yb = lax.map(expert_block, (xb, blk_e)).reshape(P, D)
    y = jnp.zeros((N, D), h.dtype).at[row_tok].add(yb * row_w[:, None].astype(h.dtype))
    return y.reshape(B_, S_, D)


def setup_inputs(seed: int = 0) -> dict:
    key = jax.random.key(seed)
    ks = jax.random.split(key, 32)
    L, D = DEPTH, D_MODEL
    G, H, P = SSM_GROUPS, SSM_GROUP_DIM, SSM_STATE

    def nrm(k, shape, scale):
        return jax.random.normal(k, shape, jnp.float32) * scale

    x = nrm(ks[0], (BATCH, SEQ, D), 1.0)
    col_scale = jnp.concatenate([
        jnp.ones((2 * ATT_WIDTH,), jnp.float32),
        jnp.full((ATT_WIDTH,), DEEPNORM_BETA, jnp.float32),
        jnp.ones((N_IN - 3 * ATT_WIDTH,), jnp.float32)])
    w_in = nrm(ks[1], (L, D, N_IN), D ** -0.5) * col_scale
    b_forget = jnp.linspace(1.0, 6.0, ATT_HEADS, dtype=jnp.float32)[None, :] + nrm(ks[2], (L, ATT_HEADS), 0.1)
    w_pool = nrm(ks[3], (L, POOL_GROUPS, POOL_GROUP_DIM, POOL_GROUP_DIM), POOL_GROUP_DIM ** -0.5)
    pool_scale = 1.0 + nrm(ks[4], (L, POOL_WIDTH), 0.1)
    ssm_lambda_re = -0.5 + nrm(ks[5], (L, G, P), 0.01)
    ssm_lambda_im = jnp.broadcast_to(math.pi * jnp.arange(P, dtype=jnp.float32), (L, G, P))
    ssm_log_dt = jax.random.uniform(ks[6], (L, G), jnp.float32, math.log(DT_MIN), math.log(DT_MAX))
    ssm_b_re = nrm(ks[7], (L, G, P, H), (2.0 * H) ** -0.5)
    ssm_b_im = nrm(ks[8], (L, G, P, H), (2.0 * H) ** -0.5)
    ssm_c_re = nrm(ks[9], (L, G, H, P), P ** -0.5)
    ssm_c_im = nrm(ks[10], (L, G, H, P), P ** -0.5)
    ssm_d = nrm(ks[11], (L, G, H), 1.0)
    w_glu = nrm(ks[12], (L, SSM_WIDTH, SSM_WIDTH), SSM_WIDTH ** -0.5)
    b_glu = nrm(ks[13], (L, SSM_WIDTH), 0.01)
    w_branch_a = nrm(ks[14], (L, ATT_WIDTH, D), ATT_WIDTH ** -0.5 * DEEPNORM_BETA)
    w_branch_b = nrm(ks[15], (L, POOL_WIDTH, D), POOL_WIDTH ** -0.5 * DEEPNORM_BETA)
    w_branch_c = nrm(ks[16], (L, SSM_WIDTH, D), SSM_WIDTH ** -0.5 * DEEPNORM_BETA)
    w_out = nrm(ks[17], (L, D, D), D ** -0.5 * DEEPNORM_BETA)
    ln1_g = 1.0 + nrm(ks[18], (L, D), 0.02)
    ln1_b = nrm(ks[19], (L, D), 0.02)
    w_router = nrm(ks[20], (L, D, N_EXPERTS), D ** -0.5)
    b_router = nrm(ks[21], (L, N_EXPERTS), 0.01)
    w_up = nrm(ks[22], (L, N_EXPERTS, D, 2 * D_FF), D ** -0.5)
    b_up = nrm(ks[23], (L, N_EXPERTS, 2 * D_FF), 0.01)
    w_down = nrm(ks[24], (L, N_EXPERTS, D_FF, D), D_FF ** -0.5 * DEEPNORM_BETA)
    b_down = nrm(ks[25], (L, N_EXPERTS, D), 0.01)
    ln2_g = 1.0 + nrm(ks[26], (L, D), 0.02)
    ln2_b = nrm(ks[27], (L, D), 0.02)
    return {"x": x, "w_in": w_in, "b_forget": b_forget, "w_pool": w_pool, "pool_scale": pool_scale,
            "ssm_lambda_re": ssm_lambda_re, "ssm_lambda_im": ssm_lambda_im, "ssm_log_dt": ssm_log_dt,
            "ssm_b_re": ssm_b_re, "ssm_b_im": ssm_b_im, "ssm_c_re": ssm_c_re, "ssm_c_im": ssm_c_im,
            "ssm_d": ssm_d, "w_glu": w_glu, "b_glu": b_glu, "w_branch_a": w_branch_a,
            "w_branch_b": w_branch_b, "w_branch_c": w_branch_c, "w_out": w_out,
            "ln1_g": ln1_g, "ln1_b": ln1_b, "w_router": w_router, "b_router": b_router,
            "w_up": w_up, "b_up": b_up, "w_down": w_down, "b_down": b_down,
            "ln2_g": ln2_g, "ln2_b": ln2_b}


def reference(x, w_in, b_forget, w_pool, pool_scale, ssm_lambda_re, ssm_lambda_im, ssm_log_dt,
              ssm_b_re, ssm_b_im, ssm_c_re, ssm_c_im, ssm_d, w_glu, b_glu, w_branch_a,
              w_branch_b, w_branch_c, w_out, ln1_g, ln1_b, w_router, b_router,
              w_up, b_up, w_down, b_down, ln2_g, ln2_b):
    B_, S_, D = x.shape
    split_pts = _split_points()
    for l in range(DEPTH):
        h = x @ w_in[l]
        q, k, v, f_logit, u_pool, u_ssm, g = jnp.split(h, split_pts, axis=-1)
        shp = (B_, S_, ATT_HEADS, ATT_HEAD_DIM)
        y_a = _forgetting_attention(q.reshape(shp), k.reshape(shp), v.reshape(shp), f_logit, b_forget[l])
        y_b = _multiscale_pool(u_pool, w_pool[l], pool_scale[l])
        y_c = _s5(u_ssm, ssm_lambda_re[l], ssm_lambda_im[l], ssm_log_dt[l], ssm_b_re[l], ssm_b_im[l],
                  ssm_c_re[l], ssm_c_im[l], ssm_d[l], w_glu[l], b_glu[l])
        gates = jax.nn.sigmoid(g.reshape(B_, S_, N_BRANCH, D))
        merged = (gates[:, :, 0] * (y_a @ w_branch_a[l])
                  + gates[:, :, 1] * (y_b @ w_branch_b[l])
                  + gates[:, :, 2] * (y_c @ w_branch_c[l]))
        mix = merged @ w_out[l]
        x = _layer_norm(DEEPNORM_ALPHA * x + mix, ln1_g[l], ln1_b[l])
        ffn = _moe(x, w_router[l], b_router[l], w_up[l], b_up[l], w_down[l], b_down[l])
        x = _layer_norm(DEEPNORM_ALPHA * x + ffn, ln2_g[l], ln2_b[l])
    return x
```

```cpp
#include <hip/hip_runtime.h>
#include <cstdint>
#include <cstdio>
#include <cmath>

typedef unsigned short bf16_t;
typedef short bf16x8 __attribute__((ext_vector_type(8)));
typedef float f32x4 __attribute__((ext_vector_type(4)));
typedef unsigned u32x4 __attribute__((ext_vector_type(4)));
typedef unsigned u32x2 __attribute__((ext_vector_type(2)));

constexpr int D = 1024, NB = 8, SEQ = 4096, NTOK = NB * SEQ, NL = 4;
constexpr int NIN = 5128, HP = 5120;
constexpr int NE = 32, TOPK = 4;
constexpr int MOE_ROWS = 139264;
constexpr float C2 = 0.125f * 1.4426950408889634f;
constexpr float L2E = 1.4426950408889634f;
constexpr float ALPHA = 1.681792830507429f;
constexpr float LN_EPS = 1e-5f;
constexpr int HC_Q = 0, HC_K = 512, HC_V = 1024, HC_POOL = 1536, HC_SSM = 1792, HC_G = 2048;

constexpr size_t MiB = 1u << 20;
constexpr size_t WS_CTL = 0;
constexpr size_t WS_WIN = 1 * MiB;
constexpr size_t WS_WBA = 41 * MiB;
constexpr size_t WS_WBB = 45 * MiB;
constexpr size_t WS_WBC = 47 * MiB;
constexpr size_t WS_WOUT = 49 * MiB;
constexpr size_t WS_WGLU = 57 * MiB;
constexpr size_t WS_WUP = 80 * MiB;
constexpr size_t WS_WDN = 592 * MiB;
constexpr size_t WS_XA = 848 * MiB;
constexpr size_t WS_X1 = 976 * MiB;
constexpr size_t WS_XB = 1104 * MiB;
constexpr size_t WS_X1B = 1168 * MiB;
constexpr size_t WS_H = 1232 * MiB;
constexpr size_t WS_A3 = 1552 * MiB;
constexpr size_t WS_MERGED = 1576 * MiB;
constexpr size_t WS_MIX = 1640 * MiB;
constexpr size_t WS_YB = 1704 * MiB;
constexpr size_t WS_YCP = 1720 * MiB;
constexpr size_t WS_YC = 1736 * MiB;
constexpr size_t WS_LOGF = 1752 * MiB;
constexpr size_t WS_CUM = 1753 * MiB;
constexpr size_t WS_TOK = 1754 * MiB;
constexpr size_t WS_RE = 1758 * MiB;
constexpr size_t WS_RR = WS_RE + 512 * 1024;
constexpr size_t WS_RG = WS_RR + 512 * 1024;
constexpr size_t WS_ACT = 1760 * MiB;
constexpr size_t WS_YM = 2032 * MiB;
constexpr size_t WS_END = 2304 * MiB;
constexpr int CW_CNT = 1024;

__device__ __forceinline__ float bf2f(bf16_t b) { return __uint_as_float((unsigned)b << 16); }
__device__ __forceinline__ bf16_t f2bf(float f) { unsigned u = __float_as_uint(f); return (bf16_t)((u + 0x7fffu + ((u >> 16) & 1u)) >> 16); }
__device__ __forceinline__ unsigned pk2(float lo, float hi) { return (unsigned)f2bf(lo) | ((unsigned)f2bf(hi) << 16); }
__device__ __forceinline__ float sigmoidf_(float x) { return 1.0f / (1.0f + __expf(-x)); }
__device__ __forceinline__ float wave_sum(float v) {
#pragma unroll
    for (int o = 1; o < 64; o <<= 1) v += __shfl_xor(v, o);
    return v;
}
template <int N> __device__ __forceinline__ void reduce_scatter(float (&v)[N], int lane) {
    int s = 32;
#pragma unroll
    for (int n = N / 2; n >= 1; n >>= 1) {
        const bool up = (lane & s) != 0;
#pragma unroll
        for (int i = 0; i < n; ++i) { const float keep = up ? v[i + n] : v[i], send = up ? v[i] : v[i + n]; v[i] = keep + __shfl_xor(send, s); }
        s >>= 1;
    }
    for (; s >= 1; s >>= 1) v[0] += __shfl_xor(v[0], s);
}

__device__ __forceinline__ int src_col(int mode, int n) {
    if (mode == 1) return n + (n >= 1536 ? 8 : 0);
    if (mode == 2) { const int pn = n >> 8, r = n & 255, bj = r >> 7, jj = r & 127; return 2 * (128 * pn + jj) + bj; }
    return n;
}
__device__ __forceinline__ void transpose_item(const float* W, int Nsrc, int K, int Ndst, bf16_t* WT, int mode, float* scr, int item, int lane) {
    const int nblk = Ndst / 32, kb = item / nblk, nb = item % nblk, k0 = 64 * kb, n0 = 32 * nb;
    const int sc = src_col(mode, n0 + (lane & 31));
#pragma unroll 8
    for (int i = 0; i < 32; ++i) { const int kk = 2 * i + (lane >> 5); scr[kk * 33 + (lane & 31)] = W[(size_t)(k0 + kk) * Nsrc + sc]; }
    asm volatile("s_waitcnt lgkmcnt(0)" ::: "memory");
    const int c = lane & 7;
#pragma unroll
    for (int j = 0; j < 4; ++j) { const int n = (lane >> 3) + 8 * j; const float* s = scr + (8 * c) * 33 + n;
        u32x4 o; o.x = pk2(s[0 * 33], s[1 * 33]); o.y = pk2(s[2 * 33], s[3 * 33]); o.z = pk2(s[4 * 33], s[5 * 33]); o.w = pk2(s[6 * 33], s[7 * 33]);
        *(u32x4*)(WT + (size_t)(n0 + n) * K + k0 + 8 * c) = o; }
    asm volatile("s_waitcnt lgkmcnt(0)" ::: "memory");
}
struct PrepArgs { const float *w_in, *w_ba, *w_bb, *w_bc, *w_out, *w_glu, *w_up, *w_dn; unsigned char* ws; };
__global__ void __launch_bounds__(256) k_prep(PrepArgs a) {
    __shared__ float scr_all[4][64 * 33];
    const int lane = threadIdx.x & 63, wv = threadIdx.x >> 6;
    float* scr = scr_all[wv];
    const long gw = (long)blockIdx.x * 4 + wv, NGW = (long)gridDim.x * 4;
    constexpr long I_IN = (1024 / 64) * (5120 / 32), I_BA = (512 / 64) * (1024 / 32), I_BB = (256 / 64) * (1024 / 32), I_OUT = (1024 / 64) * (1024 / 32), I_GLU = (256 / 64) * (256 / 32);
    constexpr long I_UP = (1024 / 64) * (2048 / 32), I_DN = (1024 / 64) * (1024 / 32);
    constexpr long T_IN = NL * I_IN, T_BA = NL * I_BA, T_BB = NL * I_BB, T_OUT = NL * I_OUT, T_GLU = NL * I_GLU, T_UP = (long)NL * NE * I_UP, T_DN = (long)NL * NE * I_DN;
    constexpr long TOTAL = T_IN + T_BA + 2 * T_BB + T_OUT + T_GLU + T_UP + T_DN;
    for (long it = gw; it < TOTAL; it += NGW) {
        long r = it;
        if (r < T_UP) { const int inst = (int)(r / I_UP), item = (int)(r % I_UP); transpose_item(a.w_up + (size_t)inst * 1024 * 2048, 2048, 1024, 2048, (bf16_t*)(a.ws + WS_WUP) + (size_t)inst * 2048 * 1024, 2, scr, item, lane); continue; } r -= T_UP;
        if (r < T_DN) { const int inst = (int)(r / I_DN), item = (int)(r % I_DN); transpose_item(a.w_dn + (size_t)inst * 1024 * 1024, 1024, 1024, 1024, (bf16_t*)(a.ws + WS_WDN) + (size_t)inst * 1024 * 1024, 0, scr, item, lane); continue; } r -= T_DN;
        if (r < T_IN) { const int inst = (int)(r / I_IN), item = (int)(r % I_IN); transpose_item(a.w_in + (size_t)inst * 1024 * NIN, NIN, 1024, 5120, (bf16_t*)(a.ws + WS_WIN) + (size_t)inst * 5120 * 1024, 1, scr, item, lane); continue; } r -= T_IN;
        if (r < T_BA) { const int inst = (int)(r / I_BA), item = (int)(r % I_BA); transpose_item(a.w_ba + (size_t)inst * 512 * 1024, 1024, 512, 1024, (bf16_t*)(a.ws + WS_WBA) + (size_t)inst * 1024 * 512, 0, scr, item, lane); continue; } r -= T_BA;
        if (r < T_BB) { const int inst = (int)(r / I_BB), item = (int)(r % I_BB); transpose_item(a.w_bb + (size_t)inst * 256 * 1024, 1024, 256, 1024, (bf16_t*)(a.ws + WS_WBB) + (size_t)inst * 1024 * 256, 0, scr, item, lane); continue; } r -= T_BB;
        if (r < T_BB) { const int inst = (int)(r / I_BB), item = (int)(r % I_BB); transpose_item(a.w_bc + (size_t)inst * 256 * 1024, 1024, 256, 1024, (bf16_t*)(a.ws + WS_WBC) + (size_t)inst * 1024 * 256, 0, scr, item, lane); continue; } r -= T_BB;
        if (r < T_OUT) { const int inst = (int)(r / I_OUT), item = (int)(r % I_OUT); transpose_item(a.w_out + (size_t)inst * 1024 * 1024, 1024, 1024, 1024, (bf16_t*)(a.ws + WS_WOUT) + (size_t)inst * 1024 * 1024, 0, scr, item, lane); continue; } r -= T_OUT;
        { const int inst = (int)(r / I_GLU), item = (int)(r % I_GLU); transpose_item(a.w_glu + (size_t)inst * 256 * 256, 256, 256, 256, (bf16_t*)(a.ws + WS_WGLU) + (size_t)inst * 256 * 256, 0, scr, item, lane); }
    }
}

template <bool DUAL, class AF, class BF, class EF>
__device__ __forceinline__ void ngemm_tile(int m0, int n0, int K, AF arow, BF brow, EF epi) {
    const int tid = threadIdx.x, lane = tid & 63, w = tid >> 6, wm = w >> 1, wn = w & 1, fr = lane & 15, fq = lane >> 4;
    const bf16_t* ap[2]; const bf16_t* bp[2]; const bf16_t* bq[2];
#pragma unroll
    for (int i = 0; i < 2; ++i) { ap[i] = arow(m0 + wm * 32 + i * 16 + fr) + 8 * fq; bp[i] = brow(n0 + wn * 32 + i * 16 + fr, 0) + 8 * fq; bq[i] = DUAL ? brow(n0 + wn * 32 + i * 16 + fr, 1) + 8 * fq : bp[i]; }
    f32x4 acc[2][2], acc2[2][2];
#pragma unroll
    for (int i = 0; i < 2; ++i)
#pragma unroll
        for (int j = 0; j < 2; ++j) { acc[i][j] = (f32x4){0.f, 0.f, 0.f, 0.f}; acc2[i][j] = (f32x4){0.f, 0.f, 0.f, 0.f}; }
    for (int k0 = 0; k0 < K; k0 += 32) {
        bf16x8 a[2], b[2], b2[2];
#pragma unroll
        for (int i = 0; i < 2; ++i) { a[i] = *(const bf16x8*)(ap[i] + k0); b[i] = *(const bf16x8*)(bp[i] + k0); if (DUAL) b2[i] = *(const bf16x8*)(bq[i] + k0); }
#pragma unroll
        for (int i = 0; i < 2; ++i)
#pragma unroll
            for (int j = 0; j < 2; ++j) { acc[i][j] = __builtin_amdgcn_mfma_f32_16x16x32_bf16(a[i], b[j], acc[i][j], 0, 0, 0);
                if (DUAL) acc2[i][j] = __builtin_amdgcn_mfma_f32_16x16x32_bf16(a[i], b2[j], acc2[i][j], 0, 0, 0); }
    }
#pragma unroll
    for (int i = 0; i < 2; ++i)
#pragma unroll
        for (int j = 0; j < 2; ++j)
#pragma unroll
            for (int r = 0; r < 4; ++r) epi(m0 + wm * 32 + i * 16 + 4 * fq + r, n0 + wn * 32 + j * 16 + fr, acc[i][j][r], acc2[i][j][r]);
}

__global__ void __launch_bounds__(256) k_gemm_in(const bf16_t* xb, const bf16_t* Wt, bf16_t* H, bf16_t* A3) {
    const int n0 = blockIdx.x * 64, m0 = blockIdx.y * 64;
    ngemm_tile<false>(m0, n0, 1024,
        [&](int m) { return xb + (size_t)m * 1024; },
        [&](int n, int) { return Wt + (size_t)n * 1024; },
        [&](int m, int n, float v, float) {
            if (n < 512) H[(size_t)m * HP + n] = f2bf(v * C2);
            else if (n < HC_SSM) H[(size_t)m * HP + n] = f2bf(v);
            else if (n < HC_G) { const int c = n - HC_SSM, g = c >> 4, h = c & 15; A3[((size_t)g * 2048 + (m >> 4)) * 384 + (m & 15) * 16 + h] = f2bf(v); }
            else H[(size_t)m * HP + n] = f2bf(sigmoidf_(v));
        });
}
__global__ void __launch_bounds__(256) k_gemm_glu(const bf16_t* ycp, const bf16_t* Wt, const float* bglu, bf16_t* yc) {
    const int n0 = blockIdx.x * 64, m0 = blockIdx.y * 64;
    ngemm_tile<false>(m0, n0, 256,
        [&](int m) { return ycp + (size_t)m * 256; },
        [&](int n, int) { return Wt + (size_t)n * 256; },
        [&](int m, int n, float v, float) { const float y = bf2f(ycp[(size_t)m * 256 + n]); yc[(size_t)m * 256 + n] = f2bf(y * sigmoidf_(v + bglu[n])); });
}
__global__ void __launch_bounds__(256) k_gemm_branch(const bf16_t* A, int lda, int K, const bf16_t* Wt, const bf16_t* H, int br, bf16_t* merged) {
    const int n0 = blockIdx.x * 64, m0 = blockIdx.y * 64;
    ngemm_tile<false>(m0, n0, K,
        [&](int m) { return A + (size_t)m * lda; },
        [&](int n, int) { return Wt + (size_t)n * K; },
        [&](int m, int n, float v, float) { float r = bf2f(H[(size_t)m * HP + HC_G + br * 1024 + n]) * v; if (br > 0) r += bf2f(merged[(size_t)m * 1024 + n]); merged[(size_t)m * 1024 + n] = f2bf(r); });
}
__global__ void __launch_bounds__(256) k_gemm_out(const bf16_t* merged, const bf16_t* Wt, bf16_t* mix) {
    const int n0 = blockIdx.x * 64, m0 = blockIdx.y * 64;
    ngemm_tile<false>(m0, n0, 1024,
        [&](int m) { return merged + (size_t)m * 1024; },
        [&](int n, int) { return Wt + (size_t)n * 1024; },
        [&](int m, int n, float v, float) { mix[(size_t)m * 1024 + n] = f2bf(v); });
}
__device__ __forceinline__ bool moe_locate(const unsigned* cnt, int row0, int& e, int& eoff, int& ecnt) {
    int off = 0;
    for (int i = 0; i < NE; ++i) { const int c = (int)cnt[i], pc = (c + 255) & ~255; if (row0 < off + pc) { e = i; eoff = off; ecnt = c; return true; } off += pc; }
    return false;
}
__global__ void __launch_bounds__(256) k_moe_up(const bf16_t* x1b, const bf16_t* Wup  , const float* bup  , const unsigned* cnt, const int* tok, bf16_t* act) {
    const int j0 = blockIdx.x * 64, m0 = blockIdx.y * 64;
    int e, eoff, ecnt; if (!moe_locate(cnt, m0, e, eoff, ecnt)) return;
    const bf16_t* We = Wup + (size_t)e * 2048 * 1024; const float* be = bup + (size_t)e * 2048;
    ngemm_tile<true>(m0, j0, 1024,
        [&](int m) { const int r = m - eoff; const int t = r < ecnt ? tok[(size_t)e * NTOK + r] : 0; return x1b + (size_t)t * 1024; },
        [&](int j, int which) { return We + (size_t)((j >> 7) * 256 + (j & 127) + which * 128) * 1024; },
        [&](int m, int j, float vg, float vl) {
            float g = vg + be[2 * j], l = vl + be[2 * j + 1];
            g = fminf(g, 7.0f); l = fminf(fmaxf(l, -7.0f), 7.0f);
            act[(size_t)m * 1024 + j] = f2bf(g * sigmoidf_(1.702f * g) * (l + 1.0f)); });
}
__global__ void __launch_bounds__(256) k_moe_down(const bf16_t* act, const bf16_t* Wdn  , const float* bdn  , const unsigned* cnt, bf16_t* ym) {
    const int n0 = blockIdx.x * 64, m0 = blockIdx.y * 64;
    int e, eoff, ecnt; if (!moe_locate(cnt, m0, e, eoff, ecnt)) return;
    const bf16_t* We = Wdn + (size_t)e * 1024 * 1024; const float* be = bdn + (size_t)e * 1024;
    ngemm_tile<false>(m0, n0, 1024,
        [&](int m) { return act + (size_t)m * 1024; },
        [&](int n, int) { return We + (size_t)n * 1024; },
        [&](int m, int n, float v, float) { ym[(size_t)m * 1024 + n] = f2bf(v + be[n]); });
}

__global__ void __launch_bounds__(256) k_cumsum(const float* logf, float* cum) {
    __shared__ float wsum[4];
    const int tid = threadIdx.x, lane = tid & 63, wv = tid >> 6;
    const float* src = logf + (size_t)blockIdx.x * SEQ + tid * 16; float* dst = cum + (size_t)blockIdx.x * SEQ + tid * 16;
    float v[16]; float s = 0.f;
#pragma unroll
    for (int i = 0; i < 16; ++i) { s += src[i]; v[i] = s; }
    float inc = s;
#pragma unroll
    for (int o = 1; o < 64; o <<= 1) { const float t = __shfl_up(inc, o); if (lane >= o) inc += t; }
    if (lane == 63) wsum[wv] = inc;
    __syncthreads();
    float base = inc - s;
    for (int i = 0; i < wv; ++i) base += wsum[i];
#pragma unroll
    for (int i = 0; i < 16; ++i) dst[i] = v[i] + base;
}

__global__ void __launch_bounds__(128) k_attn(bf16_t* H, const float* cum) {
    __shared__ float Ks[32][64], Vs[32][64], Bs[32];
    const int qb = blockIdx.x, h = blockIdx.y, b = blockIdx.z, tid = threadIdx.x;
    const int i = qb * 128 + tid; const size_t row = (size_t)b * SEQ + i;
    float q[64], o[64];
    { const bf16_t* qp = H + row * HP + HC_Q + h * 64;
#pragma unroll
      for (int c = 0; c < 8; ++c) { const u32x4 w = *(const u32x4*)(qp + c * 8);
#pragma unroll
          for (int e = 0; e < 4; ++e) { q[c * 8 + 2 * e] = __uint_as_float(w[e] << 16); q[c * 8 + 2 * e + 1] = __uint_as_float(w[e] & 0xffff0000u); } } }
#pragma unroll
    for (int d = 0; d < 64; ++d) o[d] = 0.f;
    float m = -INFINITY, l = 0.f;
    const float* cb = cum + (size_t)(b * 8 + h) * SEQ;
    const int nkt = (qb * 128 + 128) / 32;
    for (int kt = 0; kt < nkt; ++kt) {
        __syncthreads();
        { const int key = tid >> 2, d0 = (tid & 3) * 16; const bf16_t* kp = H + ((size_t)b * SEQ + kt * 32 + key) * HP + h * 64 + d0;
#pragma unroll
          for (int c = 0; c < 2; ++c) { const u32x4 wk = *(const u32x4*)(kp + HC_K + c * 8), wvv = *(const u32x4*)(kp + HC_V + c * 8);
#pragma unroll
              for (int e = 0; e < 4; ++e) { Ks[key][d0 + c * 8 + 2 * e] = __uint_as_float(wk[e] << 16); Ks[key][d0 + c * 8 + 2 * e + 1] = __uint_as_float(wk[e] & 0xffff0000u);
                                            Vs[key][d0 + c * 8 + 2 * e] = __uint_as_float(wvv[e] << 16); Vs[key][d0 + c * 8 + 2 * e + 1] = __uint_as_float(wvv[e] & 0xffff0000u); } } }
        if (tid < 32) Bs[tid] = -L2E * cb[kt * 32 + tid];
        __syncthreads();
        for (int jj = 0; jj < 32; ++jj) {
            const int j = kt * 32 + jj;
            if (j <= i) {
                float s = Bs[jj];
#pragma unroll
                for (int d = 0; d < 64; ++d) s += q[d] * Ks[jj][d];
                const float mn = fmaxf(m, s), al = exp2f(m - mn), p = exp2f(s - mn);
                l = l * al + p; m = mn;
#pragma unroll
                for (int d = 0; d < 64; ++d) o[d] = o[d] * al + p * Vs[jj][d];
            }
        }
    }
    const float rl = 1.0f / l;
    bf16_t* op = H + row * HP + HC_Q + h * 64;
#pragma unroll
    for (int c = 0; c < 8; ++c) { u32x4 w;
#pragma unroll
        for (int e = 0; e < 4; ++e) w[e] = pk2(o[c * 8 + 2 * e] * rl, o[c * 8 + 2 * e + 1] * rl);
        *(u32x4*)(op + c * 8) = w; }
}

__global__ void __launch_bounds__(256) k_pool(const bf16_t* H, const float* wpool  , const float* pscale  , bf16_t* yb) {
    __shared__ float mx[16][256];
    const int tid = threadIdx.x, tok0 = blockIdx.x * 16;
    { const int ch = tid, g = ch >> 6, w = 2 << g;
      for (int tt = 0; tt < 16; ++tt) { const int tok = tok0 + tt, t = tok & (SEQ - 1); const int n = (t + 1 < w) ? t + 1 : w; float s = 0.f;
          for (int k = 0; k < n; ++k) s += bf2f(H[(size_t)(tok - k) * HP + HC_POOL + ch]);
          mx[tt][ch] = s / (float)n - bf2f(H[(size_t)tok * HP + HC_POOL + ch]); } }
    __syncthreads();
    const int g = tid >> 6, dd = tid & 63; float acc[16];
#pragma unroll
    for (int tt = 0; tt < 16; ++tt) acc[tt] = 0.f;
    for (int c = 0; c < 64; ++c) { const float wv = wpool[(g * 64 + c) * 64 + dd];
#pragma unroll
        for (int tt = 0; tt < 16; ++tt) acc[tt] += mx[tt][g * 64 + c] * wv; }
    const float ps = pscale[tid];
#pragma unroll
    for (int tt = 0; tt < 16; ++tt) yb[(size_t)(tok0 + tt) * 256 + tid] = f2bf(acc[tt] * ps);
}

__global__ void __launch_bounds__(64) k_s5(const bf16_t* A3, const float* lam_re, const float* lam_im, const float* log_dt, const float* b_re, const float* b_im,
                                            const float* c_re, const float* c_im, const float* dsk, bf16_t* ycp) {
    const int b = blockIdx.x >> 4, g = blockIdx.x & 15, p = threadIdx.x, lane = p;
    const float dt = expf(log_dt[g]), lr = lam_re[g * 64 + p], li = lam_im[g * 64 + p];
    const float mag = expf(lr * dt), ar = mag * cosf(li * dt), ai = mag * sinf(li * dt), den = lr * lr + li * li, nr = ar - 1.0f;
    const float zr = (nr * lr + ai * li) / den, zi = (ai * lr - nr * li) / den;
    float bbr[16], bbi[16], cre[16], cim[16];
#pragma unroll
    for (int h = 0; h < 16; ++h) { const float br = b_re[(g * 64 + p) * 16 + h], bi = b_im[(g * 64 + p) * 16 + h]; bbr[h] = zr * br - zi * bi; bbi[h] = zr * bi + zi * br;
        cre[h] = c_re[(g * 16 + h) * 64 + p]; cim[h] = c_im[(g * 16 + h) * 64 + p]; }
    const int hq = (lane >> 2) & 15; const float dq = dsk[g * 16 + hq];
    float hr = 0.f, hi = 0.f;
    for (int t = 0; t < SEQ; ++t) {
        const size_t tok = (size_t)b * SEQ + t;
        const bf16_t* up = A3 + ((size_t)g * 2048 + (tok >> 4)) * 384 + (tok & 15) * 16;
        const u32x4 w0 = *(const u32x4*)up, w1 = *(const u32x4*)(up + 8);
        float u[16];
#pragma unroll
        for (int e = 0; e < 4; ++e) { u[2 * e] = __uint_as_float(w0[e] << 16); u[2 * e + 1] = __uint_as_float(w0[e] & 0xffff0000u); u[8 + 2 * e] = __uint_as_float(w1[e] << 16); u[8 + 2 * e + 1] = __uint_as_float(w1[e] & 0xffff0000u); }
        float xr = 0.f, xi = 0.f;
#pragma unroll
        for (int h = 0; h < 16; ++h) { xr += bbr[h] * u[h]; xi += bbi[h] * u[h]; }
        const float nhr = ar * hr - ai * hi + xr, nhi = ar * hi + ai * hr + xi; hr = nhr; hi = nhi;
        float v[16];
#pragma unroll
        for (int h = 0; h < 16; ++h) v[h] = cre[h] * hr - cim[h] * hi;
        reduce_scatter<16>(v, lane);
        if ((lane & 3) == 0) {
            float y = v[0] + dq * bf2f(up[hq]);
            const float t3 = 0.7978845608028654f * (y + 0.044715f * y * y * y);
            y = 0.5f * y * (1.0f + tanhf(t3));
            ycp[tok * 256 + g * 16 + hq] = f2bf(y);
        }
    }
}

__device__ __forceinline__ void row_ln(f32x4 (&v)[4], const float* g, const float* bta, int lane) {
    float s = 0.f;
#pragma unroll
    for (int j = 0; j < 4; ++j) s += (v[j].x + v[j].y) + (v[j].z + v[j].w);
    const float mean = wave_sum(s) * (1.f / D); float s2 = 0.f;
#pragma unroll
    for (int j = 0; j < 4; ++j) { v[j] = v[j] - mean; s2 += (v[j].x * v[j].x + v[j].y * v[j].y) + (v[j].z * v[j].z + v[j].w * v[j].w); }
    const float rstd = 1.0f / sqrtf(wave_sum(s2) * (1.f / D) + LN_EPS);
#pragma unroll
    for (int j = 0; j < 4; ++j) { const f32x4 gg = *(const f32x4*)(g + 4 * (lane + 64 * j)), bb = *(const f32x4*)(bta + 4 * (lane + 64 * j)); v[j] = v[j] * rstd * gg + bb; }
}
__device__ __forceinline__ void row_store_bf16(const f32x4 (&v)[4], bf16_t* orow, int lane) {
#pragma unroll
    for (int j = 0; j < 4; ++j) { u32x2 w; w.x = pk2(v[j].x, v[j].y); w.y = pk2(v[j].z, v[j].w); *(u32x2*)(orow + 4 * (lane + 64 * j)) = w; }
}
__device__ __forceinline__ void row_logf(const f32x4 (&v)[4], const float* w_in_l, const float* bf_l, float* logf, int m, int lane) {
    float a[8];
#pragma unroll
    for (int e = 0; e < 8; ++e) a[e] = 0.f;
#pragma unroll
    for (int j = 0; j < 4; ++j)
#pragma unroll
        for (int i = 0; i < 4; ++i) { const int k = 4 * (lane + 64 * j) + i; const float xv = v[j][i]; const float* wr = w_in_l + (size_t)k * NIN + 1536;
            const f32x4 w0 = *(const f32x4*)wr, w1 = *(const f32x4*)(wr + 4);
            a[0] += xv * w0.x; a[1] += xv * w0.y; a[2] += xv * w0.z; a[3] += xv * w0.w; a[4] += xv * w1.x; a[5] += xv * w1.y; a[6] += xv * w1.z; a[7] += xv * w1.w; }
    reduce_scatter<8>(a, lane);
    if ((lane & 7) == 0) { const int h = lane >> 3; const float z = a[0] + bf_l[h]; const float ls = fminf(z, 0.f) - log1pf(expf(-fabsf(z)));
        const int b = m / SEQ, t = m % SEQ; logf[((size_t)b * 8 + h) * SEQ + t] = ls; }
}
__global__ void __launch_bounds__(256) k_row0(const float* x, const float* w_in0, const float* bf0, bf16_t* xb, float* logf) {
    const int lane = threadIdx.x & 63; const int gw = blockIdx.x * 4 + (threadIdx.x >> 6), NGW = gridDim.x * 4;
    for (int m = gw; m < NTOK; m += NGW) {
        f32x4 v[4];
#pragma unroll
        for (int j = 0; j < 4; ++j) v[j] = *(const f32x4*)(x + (size_t)m * D + 4 * (lane + 64 * j));
        row_store_bf16(v, xb + (size_t)m * D, lane);
        row_logf(v, w_in0, bf0, logf, m, lane);
    }
}
__global__ void __launch_bounds__(256) k_row1(const float* xin, const bf16_t* mix, const float* g1, const float* b1, const float* wr  , const float* br,
                                               float* x1, bf16_t* x1b, unsigned* cnt, int* tok, int* re, int* rr, float* rg) {
    const int lane = threadIdx.x & 63; const int gw = blockIdx.x * 4 + (threadIdx.x >> 6), NGW = gridDim.x * 4;
    for (int m = gw; m < NTOK; m += NGW) {
        f32x4 v[4];
#pragma unroll
        for (int j = 0; j < 4; ++j) { const f32x4 xv = *(const f32x4*)(xin + (size_t)m * D + 4 * (lane + 64 * j)); const u32x2 mw = *(const u32x2*)(mix + (size_t)m * D + 4 * (lane + 64 * j));
            v[j].x = ALPHA * xv.x + __uint_as_float(mw.x << 16); v[j].y = ALPHA * xv.y + __uint_as_float(mw.x & 0xffff0000u); v[j].z = ALPHA * xv.z + __uint_as_float(mw.y << 16); v[j].w = ALPHA * xv.w + __uint_as_float(mw.y & 0xffff0000u); }
        row_ln(v, g1, b1, lane);
#pragma unroll
        for (int j = 0; j < 4; ++j) *(f32x4*)(x1 + (size_t)m * D + 4 * (lane + 64 * j)) = v[j];
        row_store_bf16(v, x1b + (size_t)m * D, lane);
        float a[32];
#pragma unroll
        for (int e = 0; e < 32; ++e) a[e] = 0.f;
#pragma unroll
        for (int j = 0; j < 4; ++j)
#pragma unroll
            for (int i = 0; i < 4; ++i) { const int k = 4 * (lane + 64 * j) + i; const float xv = v[j][i]; const float* wp = wr + (size_t)k * 32;
#pragma unroll
                for (int c = 0; c < 8; ++c) { const f32x4 w = *(const f32x4*)(wp + 4 * c); a[4 * c] += xv * w.x; a[4 * c + 1] += xv * w.y; a[4 * c + 2] += xv * w.z; a[4 * c + 3] += xv * w.w; } }
        reduce_scatter<32>(a, lane);
        const float mine = a[0] + br[(lane >> 1) & 31];
        float lg[32];
#pragma unroll
        for (int e = 0; e < 32; ++e) lg[e] = __shfl(mine, 2 * e);
        int ti[4]; float tv[4];
#pragma unroll
        for (int k = 0; k < 4; ++k) { float bv = -INFINITY; int bi = 0;
#pragma unroll
            for (int e = 0; e < 32; ++e) { const bool taken = (k > 0 && ti[0] == e) || (k > 1 && ti[1] == e) || (k > 2 && ti[2] == e); if (!taken && lg[e] > bv) { bv = lg[e]; bi = e; } }
            ti[k] = bi; tv[k] = bv; }
        const float e0 = 1.0f, e1 = expf(tv[1] - tv[0]), e2 = expf(tv[2] - tv[0]), e3 = expf(tv[3] - tv[0]); const float inv = 1.0f / (e0 + e1 + e2 + e3);
        if (lane < 4) {
            const int e = lane == 0 ? ti[0] : lane == 1 ? ti[1] : lane == 2 ? ti[2] : ti[3];
            const float gt = (lane == 0 ? e0 : lane == 1 ? e1 : lane == 2 ? e2 : e3) * inv;
            const unsigned rank = atomicAdd(cnt + e, 1u);
            tok[(size_t)e * NTOK + rank] = m; re[(size_t)m * 4 + lane] = e; rr[(size_t)m * 4 + lane] = (int)rank; rg[(size_t)m * 4 + lane] = gt;
        }
    }
}
__global__ void __launch_bounds__(256) k_row2(const float* x1, const bf16_t* ym, const unsigned* cnt, const int* re, const int* rr, const float* rg, const float* g2, const float* b2,
                                               float* xout, bf16_t* xb, const float* w_in_next, const float* bf_next, float* logf) {
    const int lane = threadIdx.x & 63; const int gw = blockIdx.x * 4 + (threadIdx.x >> 6), NGW = gridDim.x * 4;
    int pc = lane < 32 ? (int)((cnt[lane & 31] + 255u) & ~255u) : 0; int inc = pc;
#pragma unroll
    for (int o = 1; o < 32; o <<= 1) { const int t = __shfl_up(inc, o); if (lane >= o) inc += t; }
    const int poff = inc - pc;
    for (int m = gw; m < NTOK; m += NGW) {
        f32x4 v[4];
#pragma unroll
        for (int j = 0; j < 4; ++j) { const f32x4 xv = *(const f32x4*)(x1 + (size_t)m * D + 4 * (lane + 64 * j)); v[j] = xv * ALPHA; }
#pragma unroll
        for (int k = 0; k < 4; ++k) { const int e = re[(size_t)m * 4 + k], rk = rr[(size_t)m * 4 + k]; const float gt = rg[(size_t)m * 4 + k];
            const int row = __shfl(poff, e) + rk; const bf16_t* yr = ym + (size_t)row * 1024;
#pragma unroll
            for (int j = 0; j < 4; ++j) { const u32x2 w = *(const u32x2*)(yr + 4 * (lane + 64 * j));
                v[j].x += gt * __uint_as_float(w.x << 16); v[j].y += gt * __uint_as_float(w.x & 0xffff0000u); v[j].z += gt * __uint_as_float(w.y << 16); v[j].w += gt * __uint_as_float(w.y & 0xffff0000u); } }
        row_ln(v, g2, b2, lane);
#pragma unroll
        for (int j = 0; j < 4; ++j) *(f32x4*)(xout + (size_t)m * D + 4 * (lane + 64 * j)) = v[j];
        if (w_in_next) { row_store_bf16(v, xb + (size_t)m * D, lane); row_logf(v, w_in_next, bf_next, logf, m, lane); }
    }
}

extern "C" void kernel_launch(void* const* d_in, const int* in_sizes, int n_in, void* d_out, int out_size, void* d_ws, size_t ws_size, hipStream_t stream) {
    if (n_in != 29 || out_size != NTOK * D || ws_size < WS_END) { fprintf(stderr, "kernel_launch: unexpected shapes (n_in %d out %d ws %zu)\n", n_in, out_size, ws_size); return; }
    unsigned char* ws = (unsigned char*)d_ws;
    const float* x = (const float*)d_in[0]; const float* w_in = (const float*)d_in[1]; const float* b_forget = (const float*)d_in[2];
    const float* w_pool = (const float*)d_in[3]; const float* pool_scale = (const float*)d_in[4];
    const float* lam_re = (const float*)d_in[5]; const float* lam_im = (const float*)d_in[6]; const float* log_dt = (const float*)d_in[7];
    const float* sb_re = (const float*)d_in[8]; const float* sb_im = (const float*)d_in[9]; const float* sc_re = (const float*)d_in[10]; const float* sc_im = (const float*)d_in[11];
    const float* ssm_d = (const float*)d_in[12]; const float* w_glu = (const float*)d_in[13]; const float* b_glu = (const float*)d_in[14];
    const float* w_ba = (const float*)d_in[15]; const float* w_bb = (const float*)d_in[16]; const float* w_bc = (const float*)d_in[17]; const float* w_out = (const float*)d_in[18];
    const float* ln1_g = (const float*)d_in[19]; const float* ln1_b = (const float*)d_in[20]; const float* w_router = (const float*)d_in[21]; const float* b_router = (const float*)d_in[22];
    const float* w_up = (const float*)d_in[23]; const float* b_up = (const float*)d_in[24]; const float* w_down = (const float*)d_in[25]; const float* b_down = (const float*)d_in[26];
    const float* ln2_g = (const float*)d_in[27]; const float* ln2_b = (const float*)d_in[28];

    hipMemsetAsync(ws + WS_CTL, 0, 1 * MiB, stream);
    bf16_t* Win = (bf16_t*)(ws + WS_WIN); bf16_t* Wba = (bf16_t*)(ws + WS_WBA); bf16_t* Wbb = (bf16_t*)(ws + WS_WBB); bf16_t* Wbc = (bf16_t*)(ws + WS_WBC);
    bf16_t* Wout = (bf16_t*)(ws + WS_WOUT); bf16_t* Wglu = (bf16_t*)(ws + WS_WGLU); bf16_t* Wup = (bf16_t*)(ws + WS_WUP); bf16_t* Wdn = (bf16_t*)(ws + WS_WDN);
    float* XA = (float*)(ws + WS_XA); float* X1 = (float*)(ws + WS_X1); bf16_t* XB = (bf16_t*)(ws + WS_XB); bf16_t* X1B = (bf16_t*)(ws + WS_X1B);
    bf16_t* H = (bf16_t*)(ws + WS_H); bf16_t* A3 = (bf16_t*)(ws + WS_A3); bf16_t* MERGED = (bf16_t*)(ws + WS_MERGED); bf16_t* MIX = (bf16_t*)(ws + WS_MIX);
    bf16_t* YB = (bf16_t*)(ws + WS_YB); bf16_t* YCP = (bf16_t*)(ws + WS_YCP); bf16_t* YC = (bf16_t*)(ws + WS_YC);
    float* LOGF = (float*)(ws + WS_LOGF); float* CUM = (float*)(ws + WS_CUM);
    int* TOK = (int*)(ws + WS_TOK); int* RE = (int*)(ws + WS_RE); int* RR = (int*)(ws + WS_RR); float* RG = (float*)(ws + WS_RG);
    bf16_t* ACT = (bf16_t*)(ws + WS_ACT); bf16_t* YM = (bf16_t*)(ws + WS_YM);
    unsigned* CTL = (unsigned*)(ws + WS_CTL);

    PrepArgs pa{}; pa.w_in = w_in; pa.w_ba = w_ba; pa.w_bb = w_bb; pa.w_bc = w_bc; pa.w_out = w_out; pa.w_glu = w_glu; pa.w_up = w_up; pa.w_dn = w_down; pa.ws = ws;
    hipLaunchKernelGGL(k_prep, dim3(2048), dim3(256), 0, stream, pa);
    hipLaunchKernelGGL(k_row0, dim3(1024), dim3(256), 0, stream, x, w_in, b_forget, XB, LOGF);
    for (int l = 0; l < NL; ++l) {
        const float* xin = l == 0 ? x : XA;
        unsigned* cnt = CTL + CW_CNT + 64 * l;
        hipLaunchKernelGGL(k_cumsum, dim3(64), dim3(256), 0, stream, LOGF, CUM);
        hipLaunchKernelGGL(k_gemm_in, dim3(HP / 64, NTOK / 64), dim3(256), 0, stream, XB, Win + (size_t)l * 5120 * 1024, H, A3);
        hipLaunchKernelGGL(k_attn, dim3(SEQ / 128, 8, NB), dim3(128), 0, stream, H, CUM);
        hipLaunchKernelGGL(k_pool, dim3(NTOK / 16), dim3(256), 0, stream, H, w_pool + (size_t)l * 4 * 64 * 64, pool_scale + (size_t)l * 256, YB);
        hipLaunchKernelGGL(k_s5, dim3(NB * 16), dim3(64), 0, stream, A3, lam_re + (size_t)l * 1024, lam_im + (size_t)l * 1024, log_dt + (size_t)l * 16, sb_re + (size_t)l * 16384, sb_im + (size_t)l * 16384,
                           sc_re + (size_t)l * 16384, sc_im + (size_t)l * 16384, ssm_d + (size_t)l * 256, YCP);
        hipLaunchKernelGGL(k_gemm_glu, dim3(256 / 64, NTOK / 64), dim3(256), 0, stream, YCP, Wglu + (size_t)l * 65536, b_glu + (size_t)l * 256, YC);
        hipLaunchKernelGGL(k_gemm_branch, dim3(D / 64, NTOK / 64), dim3(256), 0, stream, H, HP, 512, Wba + (size_t)l * 1024 * 512, H, 0, MERGED);
        hipLaunchKernelGGL(k_gemm_branch, dim3(D / 64, NTOK / 64), dim3(256), 0, stream, YB, 256, 256, Wbb + (size_t)l * 1024 * 256, H, 1, MERGED);
        hipLaunchKernelGGL(k_gemm_branch, dim3(D / 64, NTOK / 64), dim3(256), 0, stream, YC, 256, 256, Wbc + (size_t)l * 1024 * 256, H, 2, MERGED);
        hipLaunchKernelGGL(k_gemm_out, dim3(D / 64, NTOK / 64), dim3(256), 0, stream, MERGED, Wout + (size_t)l * 1024 * 1024, MIX);
        hipLaunchKernelGGL(k_row1, dim3(1024), dim3(256), 0, stream, xin, MIX, ln1_g + (size_t)l * D, ln1_b + (size_t)l * D, w_router + (size_t)l * D * NE, b_router + (size_t)l * NE,
                           X1, X1B, cnt, TOK, RE, RR, RG);
        hipLaunchKernelGGL(k_moe_up, dim3(1024 / 64, MOE_ROWS / 64), dim3(256), 0, stream, X1B, Wup + (size_t)l * NE * 2048 * 1024, b_up + (size_t)l * NE * 2048, cnt, TOK, ACT);
        hipLaunchKernelGGL(k_moe_down, dim3(1024 / 64, MOE_ROWS / 64), dim3(256), 0, stream, ACT, Wdn + (size_t)l * NE * 1024 * 1024, b_down + (size_t)l * NE * 1024, cnt, YM);
        const bool last = (l == NL - 1);
        hipLaunchKernelGGL(k_row2, dim3(1024), dim3(256), 0, stream, X1, YM, cnt, RE, RR, RG, ln2_g + (size_t)l * D, ln2_b + (size_t)l * D,
                           last ? (float*)d_out : XA, XB, last ? (const float*)nullptr : w_in + (size_t)(l + 1) * D * NIN, last ? (const float*)nullptr : b_forget + (size_t)(l + 1) * 8, LOGF);
    }
}
```

```cpp
#include <hip/hip_runtime.h>
#include <cstdint>
#include <cstdio>
#include <cmath>

typedef unsigned short bf16_t;
typedef short bf16x8 __attribute__((ext_vector_type(8)));
typedef float f32x4 __attribute__((ext_vector_type(4)));
typedef float f32x2 __attribute__((ext_vector_type(2)));
typedef unsigned u32x4 __attribute__((ext_vector_type(4)));
typedef unsigned u32x2 __attribute__((ext_vector_type(2)));

constexpr int D = 1024, NB = 8, SEQ = 4096, NTOK = NB * SEQ, NL = 4;
constexpr int NIN = 5128, HP = 5120;
constexpr int NE = 32, TOPK = 4;
constexpr int MOE_ROWS = 139264;
constexpr float C2 = 0.125f * 1.4426950408889634f;
constexpr float L2E = 1.4426950408889634f;
constexpr float ALPHA = 1.681792830507429f;
constexpr float LN_EPS = 1e-5f;
constexpr int HC_Q = 0, HC_K = 512, HC_V = 1024, HC_POOL = 1536, HC_SSM = 1792, HC_G = 2048;

constexpr size_t MiB = 1u << 20;
constexpr size_t WS_CTL = 0;
constexpr size_t WS_WIN = 1 * MiB;
constexpr size_t WS_WBA = 41 * MiB;
constexpr size_t WS_WBB = 45 * MiB;
constexpr size_t WS_WBC = 47 * MiB;
constexpr size_t WS_WOUT = 49 * MiB;
constexpr size_t WS_WGLU = 57 * MiB;
constexpr size_t WS_WUP = 80 * MiB;
constexpr size_t WS_WDN = 592 * MiB;
constexpr size_t WS_XA = 848 * MiB;
constexpr size_t WS_X1 = 976 * MiB;
constexpr size_t WS_XB = 1104 * MiB;
constexpr size_t WS_X1B = 1168 * MiB;
constexpr size_t WS_H = 1232 * MiB;
constexpr size_t WS_A3 = 1552 * MiB;
constexpr size_t WS_MERGED = 1576 * MiB;
constexpr size_t WS_MIX = 1640 * MiB;
constexpr size_t WS_YB = 1704 * MiB;
constexpr size_t WS_YCP = 1720 * MiB;
constexpr size_t WS_YC = 1736 * MiB;
constexpr size_t WS_LOGF = 1752 * MiB;
constexpr size_t WS_CUM = 1753 * MiB;
constexpr size_t WS_TOK = 1754 * MiB;
constexpr size_t WS_RE = 1758 * MiB;
constexpr size_t WS_RR = WS_RE + 512 * 1024;
constexpr size_t WS_RG = WS_RR + 512 * 1024;
constexpr size_t WS_ACT = 1760 * MiB;
constexpr size_t WS_YM = 2032 * MiB;
constexpr size_t WS_END = 2304 * MiB;
constexpr int CW_MOEF = 238592;
constexpr int CW_S5C = 237568;
constexpr int CW_ATTQ = 229376;
constexpr int CW_CNT = 200704, CNT_STRIDE = 32;

__device__ __forceinline__ float bf2f(bf16_t b) { return __uint_as_float((unsigned)b << 16); }
__device__ __forceinline__ bf16_t f2bf(float f) { unsigned u = __float_as_uint(f); return (bf16_t)((u + 0x7fffu + ((u >> 16) & 1u)) >> 16); }
__device__ __forceinline__ unsigned pk2(float lo, float hi) { unsigned r; asm("v_cvt_pk_bf16_f32 %0, %1, %2" : "=v"(r) : "v"(lo), "v"(hi)); return r; }
__device__ __forceinline__ float sigmoidf_(float x) { return 1.0f / (1.0f + __expf(-x)); }
__device__ __forceinline__ float wave_sum(float v) {
#pragma unroll
    for (int o = 1; o < 64; o <<= 1) v += __shfl_xor(v, o);
    return v;
}
__device__ __forceinline__ float wave_max_f(float v) {
#pragma unroll
    for (int o = 32; o >= 1; o >>= 1) v = fmaxf(v, __shfl_xor(v, o));
    return v; }
__device__ __forceinline__ int wave_min_i(int v) {
#pragma unroll
    for (int o = 32; o >= 1; o >>= 1) { const int t = __shfl_xor(v, o); v = t < v ? t : v; }
    return v; }
template <int N> __device__ __forceinline__ void reduce_scatter(float (&v)[N], int lane) {
    int s = 32;
#pragma unroll
    for (int n = N / 2; n >= 1; n >>= 1) {
        const bool up = (lane & s) != 0;
#pragma unroll
        for (int i = 0; i < n; ++i) { float hi = v[i + n], lo = v[i]; asm volatile("" : "+v"(hi), "+v"(lo));
            const float keep = up ? hi : lo, send = up ? lo : hi; v[i] = keep + __shfl_xor(send, s); }
        s >>= 1;
    }
    for (; s >= 1; s >>= 1) v[0] += __shfl_xor(v[0], s);
}

__device__ __forceinline__ int dst_row(int mode, int c) {
    if (mode == 1) return c < 1536 ? c : (c < 1544 ? -1 : c - 8);
    if (mode == 2) { const int j = c >> 1, bj = c & 1; return (j >> 7) * 256 + bj * 128 + (j & 127); }
    return c;
}
__device__ __forceinline__ void transpose_item(const float* W, int Nsrc, int K, int Ndst, bf16_t* WT, int mode, float* scr, int item, int lane) {
    (void)Ndst;
    const int nkb = K / 64, nb = item / nkb, kb = item % nkb, k0 = 64 * kb, c0 = 64 * nb;
    const bool cin = (c0 + lane) < Nsrc;
    const float* src = W + (size_t)k0 * Nsrc + c0 + (cin ? lane : 0);
#pragma unroll 16
    for (int kk = 0; kk < 64; ++kk) scr[kk * 65 + lane] = __builtin_nontemporal_load(src + (size_t)kk * Nsrc);
    asm volatile("s_waitcnt lgkmcnt(0)" ::: "memory");
    const int c8 = lane & 7;
#pragma unroll
    for (int i = 0; i < 8; ++i) { const int col = (lane >> 3) + 8 * i; const int n = (c0 + col) < Nsrc ? dst_row(mode, c0 + col) : -1; const float* s = scr + (8 * c8) * 65 + col;
        const float sc = (mode == 1 && n >= 2048) ? -L2E : 1.0f;
        u32x4 o; o.x = pk2(s[0 * 65] * sc, s[1 * 65] * sc); o.y = pk2(s[2 * 65] * sc, s[3 * 65] * sc); o.z = pk2(s[4 * 65] * sc, s[5 * 65] * sc); o.w = pk2(s[6 * 65] * sc, s[7 * 65] * sc);
        if (n >= 0) __builtin_nontemporal_store(o, (u32x4*)(WT + (size_t)n * K + k0 + 8 * c8)); }
    asm volatile("s_waitcnt lgkmcnt(0)" ::: "memory");
}
struct PrepArgs { const float *w_in, *w_ba, *w_bb, *w_bc, *w_out, *w_glu, *w_up, *w_dn; unsigned char* ws; };
__device__ __forceinline__ void prep_items(const PrepArgs& a, float* scr, long gw, long NGW, int lane) {
    constexpr long I_IN = (1024 / 64) * ((NIN + 63) / 64), I_BA = (512 / 64) * (1024 / 64), I_BB = (256 / 64) * (1024 / 64), I_OUT = (1024 / 64) * (1024 / 64), I_GLU = (256 / 64) * (256 / 64);
    constexpr long I_UP = (1024 / 64) * (2048 / 64), I_DN = (1024 / 64) * (1024 / 64);
    constexpr long T_IN = NL * I_IN, T_BA = NL * I_BA, T_BB = NL * I_BB, T_OUT = NL * I_OUT, T_GLU = NL * I_GLU, T_UP = (long)NL * NE * I_UP, T_DN = (long)NL * NE * I_DN;
    constexpr long TOTAL = T_IN + T_BA + 2 * T_BB + T_OUT + T_GLU + T_UP + T_DN;
    for (long it = gw; it < TOTAL; it += NGW) {
        long r = it;
        if (r < T_UP) { const int inst = (int)(r / I_UP), item = (int)(r % I_UP); transpose_item(a.w_up + (size_t)inst * 1024 * 2048, 2048, 1024, 2048, (bf16_t*)(a.ws + WS_WUP) + (size_t)inst * 2048 * 1024, 2, scr, item, lane); continue; } r -= T_UP;
        if (r < T_DN) { const int inst = (int)(r / I_DN), item = (int)(r % I_DN); transpose_item(a.w_dn + (size_t)inst * 1024 * 1024, 1024, 1024, 1024, (bf16_t*)(a.ws + WS_WDN) + (size_t)inst * 1024 * 1024, 0, scr, item, lane); continue; } r -= T_DN;
        if (r < T_IN) { const int inst = (int)(r / I_IN), item = (int)(r % I_IN); transpose_item(a.w_in + (size_t)inst * 1024 * NIN, NIN, 1024, 5120, (bf16_t*)(a.ws + WS_WIN) + (size_t)inst * 5120 * 1024, 1, scr, item, lane); continue; } r -= T_IN;
        if (r < T_BA) { const int inst = (int)(r / I_BA), item = (int)(r % I_BA); transpose_item(a.w_ba + (size_t)inst * 512 * 1024, 1024, 512, 1024, (bf16_t*)(a.ws + WS_WBA) + (size_t)inst * 1024 * 512, 0, scr, item, lane); continue; } r -= T_BA;
        if (r < T_BB) { const int inst = (int)(r / I_BB), item = (int)(r % I_BB); transpose_item(a.w_bb + (size_t)inst * 256 * 1024, 1024, 256, 1024, (bf16_t*)(a.ws + WS_WBB) + (size_t)inst * 1024 * 256, 0, scr, item, lane); continue; } r -= T_BB;
        if (r < T_BB) { const int inst = (int)(r / I_BB), item = (int)(r % I_BB); transpose_item(a.w_bc + (size_t)inst * 256 * 1024, 1024, 256, 1024, (bf16_t*)(a.ws + WS_WBC) + (size_t)inst * 1024 * 256, 0, scr, item, lane); continue; } r -= T_BB;
        if (r < T_OUT) { const int inst = (int)(r / I_OUT), item = (int)(r % I_OUT); transpose_item(a.w_out + (size_t)inst * 1024 * 1024, 1024, 1024, 1024, (bf16_t*)(a.ws + WS_WOUT) + (size_t)inst * 1024 * 1024, 0, scr, item, lane); continue; } r -= T_OUT;
        { const int inst = (int)(r / I_GLU), item = (int)(r % I_GLU); transpose_item(a.w_glu + (size_t)inst * 256 * 256, 256, 256, 256, (bf16_t*)(a.ws + WS_WGLU) + (size_t)inst * 256 * 256, 0, scr, item, lane); }
    }
}

__device__ __forceinline__ void row_ln(f32x4 (&v)[4], const float* g, const float* bta, int lane) {
    float s = 0.f;
#pragma unroll
    for (int j = 0; j < 4; ++j) s += (v[j].x + v[j].y) + (v[j].z + v[j].w);
    const float mean = wave_sum(s) * (1.f / D); float s2 = 0.f;
#pragma unroll
    for (int j = 0; j < 4; ++j) { v[j] = v[j] - mean; s2 += (v[j].x * v[j].x + v[j].y * v[j].y) + (v[j].z * v[j].z + v[j].w * v[j].w); }
    const float rstd = 1.0f / sqrtf(wave_sum(s2) * (1.f / D) + LN_EPS);
#pragma unroll
    for (int j = 0; j < 4; ++j) { const f32x4 gg = *(const f32x4*)(g + 4 * (lane + 64 * j)), bb = *(const f32x4*)(bta + 4 * (lane + 64 * j)); v[j] = v[j] * rstd * gg + bb; }
}
#define GAS __attribute__((address_space(1)))
__device__ __forceinline__ void row_store_bf16(const f32x4 (&v)[4], bf16_t* orow, int lane) {
#pragma unroll
    for (int j = 0; j < 4; ++j) { u32x2 w; asm("v_cvt_pk_bf16_f32 %0, %1, %2" : "=v"(w.x) : "v"(v[j].x), "v"(v[j].y)); asm("v_cvt_pk_bf16_f32 %0, %1, %2" : "=v"(w.y) : "v"(v[j].z), "v"(v[j].w)); *(GAS u32x2*)((GAS bf16_t*)orow + 4 * (lane + 64 * j)) = w; }
}
#define LAS __attribute__((address_space(3)))
namespace pg8 {
constexpr int BM = 256, BK = 64, HALF = 128, HTB = HALF * BK * 2, STAGE_BYTES = 8 * HTB;
__device__ __forceinline__ int lds_byte(int r, int c) { const int st = (r >> 4) * 2 + (c >> 5), rr = r & 15, cc = c & 31, ob = rr * 64 + cc * 2; return st * 1024 + (ob ^ (((ob >> 9) & 1) << 5)); }
__device__ __forceinline__ void stage_rc(int b, int& R, int& C) { const int st = b / 1024, sb = b % 1024, swz = sb ^ (((sb >> 9) & 1) << 5); R = (st >> 1) * 16 + swz / 64; C = (st & 1) * 32 + (swz % 64) / 2; }
__device__ __forceinline__ int perm32(int rho) { const int n = rho >> 4, i = rho & 15; return 8 * (i >> 2) + 4 * n + (i & 3); }

struct Unit { const char* A; const char* B; int pm, pn, e, valid, lt; int lda, ldb, nt, seg; };

typedef f32x4 Acc[2][2][4][2];

template <bool GATHER, class Epi, class Sched>
__device__ __forceinline__ void gemm_phase(LAS unsigned char* lds, const Sched& S, const Epi& E) {
    int tid_ = threadIdx.x; asm volatile("" : "+v"(tid_));
    const int tid = tid_, wid = __builtin_amdgcn_readfirstlane(tid >> 6), lane = tid & 63, wr = wid >> 2, wc = wid & 3, fr = lane & 15, fq = lane >> 4;
    int R0, C0; stage_rc(tid * 16, R0, C0);
    const int Rb0 = (R0 & ~31) + perm32(R0 & 31);
    unsigned vB, vBn, vA = 0, vAn = 0; size_t sB, sBn, sA = 0, sAn = 0;
    unsigned offA[2][2], offN[2][2];
    const size_t kstep = (size_t)(BK * 2);
    const unsigned ldsw = (unsigned)wid * 1024u;
    const int aoff = lds_byte(wr * 64 + fr, fq * 8), boff = lds_byte(wc * 32 + fr, fq * 8);
#define PG8_SA(b, h) (((b) * 2 + (h)) * HTB)
#define PG8_SB(b, h) ((4 + (b) * 2 + (h)) * HTB)
#define PG8_STAGE_B(bufoff, gbase, h, vb, sb) do { _Pragma("unroll") for (int _i = 0; _i < 2; ++_i) \
        __builtin_amdgcn_global_load_lds((const unsigned*)((const char*)(gbase) + (size_t)(2 * (h) + _i) * (sb) + (vb)), (LAS unsigned*)(lds + (bufoff) + ldsw + _i * 8192), 16, 0, 0); } while (0)
#define PG8_STAGE_A(bufoff, gbase, h, va, sa, offs) do { _Pragma("unroll") for (int _i = 0; _i < 2; ++_i) { \
        const char* _p = GATHER ? (const char*)(gbase) + (offs)[h][_i] : (const char*)(gbase) + (size_t)(2 * (h) + _i) * (sa) + (va); \
        __builtin_amdgcn_global_load_lds((const unsigned*)_p, (LAS unsigned*)(lds + (bufoff) + ldsw + _i * 8192), 16, 0, 0); } } while (0)
#define PG8_LDA(dst, b, h) do { _Pragma("unroll") for (int m = 0; m < 4; ++m) _Pragma("unroll") for (int k = 0; k < 2; ++k) dst[m][k] = *(const LAS bf16x8*)(lds + PG8_SA(b, h) + aoff + m * 2048 + k * 1024); } while (0)
#define PG8_LDB(dst, b, h) do { _Pragma("unroll") for (int n = 0; n < 2; ++n) _Pragma("unroll") for (int k = 0; k < 2; ++k) dst[n][k] = *(const LAS bf16x8*)(lds + PG8_SB(b, h) + boff + n * 2048 + k * 1024); } while (0)
#define PG8_MMA(ai, bj, At, Bt) do { __builtin_amdgcn_s_setprio(1); _Pragma("unroll") for (int m = 0; m < 4; ++m) _Pragma("unroll") for (int n = 0; n < 2; ++n) _Pragma("unroll") for (int k = 0; k < 2; ++k) \
        acc[ai][bj][m][n] = __builtin_amdgcn_mfma_f32_16x16x32_bf16(Bt[n][k], At[m][k], acc[ai][bj][m][n], 0, 0, 0); __builtin_amdgcn_s_setprio(0); } while (0)
#define PG8_WAIT_V(n) asm volatile("s_waitcnt vmcnt(" #n ")" ::: "memory")
#define PG8_WAIT_L(n) asm volatile("s_waitcnt lgkmcnt(" #n ")" ::: "memory")
#define PG8_BAR __builtin_amdgcn_s_barrier()
#define PG8_SCHED __builtin_amdgcn_sched_barrier(0)
#define PG8_GEOM(u, oA, va, sa, vb, sb) do { if constexpr (GATHER) S.goff(u, R0, C0, oA); else { va = (unsigned)(R0 * (u).lda + C0) * 2u; sa = (size_t)64 * (u).lda * 2; } \
        vb = (unsigned)(Rb0 * (u).ldb + C0) * 2u; sb = (size_t)64 * (u).ldb * 2; } while (0)
    Unit cur, nxt; int ui = 0;
    if (!S.next(0, cur)) return;
    PG8_GEOM(cur, offA, vA, sA, vB, sB);
#pragma unroll
    for (int h = 0; h < 2; ++h)
#pragma unroll
        for (int i = 0; i < 2; ++i) offN[h][i] = offA[h][i];
    vAn = vA; sAn = sA; vBn = vB; sBn = sB; int nt = cur.nt;
    Acc acc;
#pragma unroll
    for (int a = 0; a < 2; ++a)
#pragma unroll
        for (int b = 0; b < 2; ++b)
#pragma unroll
            for (int m = 0; m < 4; ++m)
#pragma unroll
                for (int n = 0; n < 2; ++n) acc[a][b][m][n] = (f32x4){0.f, 0.f, 0.f, 0.f};
    bf16x8 At[4][2], B0[2][2], B1[2][2];
    const char* cA = cur.A; const char* cB = cur.B;
    E.pre(cur, wr, wc, fr, fq);
    PG8_STAGE_B(PG8_SB(0, 0), cB, 0, vB, sB); PG8_STAGE_B(PG8_SB(0, 1), cB, 1, vB, sB); PG8_STAGE_A(PG8_SA(0, 0), cA, 0, vA, sA, offA); PG8_STAGE_A(PG8_SA(0, 1), cA, 1, vA, sA, offA);
    if (wr == 1) PG8_BAR;
    PG8_WAIT_V(2); PG8_BAR;
    PG8_STAGE_B(PG8_SB(1, 0), cB + kstep, 0, vB, sB); PG8_STAGE_A(PG8_SA(1, 0), cA + kstep, 0, vA, sA, offA); PG8_STAGE_B(PG8_SB(1, 1), cB + kstep, 1, vB, sB);
    PG8_WAIT_V(6); PG8_BAR;
    for (;;) {
        const bool has_next = S.next(ui + 1, nxt);
        const char* nA = has_next ? nxt.A : cA; const char* nB = has_next ? nxt.B : cB;
        if (has_next) PG8_GEOM(nxt, offN, vAn, sAn, vBn, sBn);
#pragma unroll 1
        for (int t = 0; t < nt; t += 2) {
            const bool last = (t == nt - 2);
            const char* a1 = cA + (size_t)(t + 1) * kstep;
            const char* a2 = last ? nA : cA + (size_t)(t + 2) * kstep; const char* b2 = last ? nB : cB + (size_t)(t + 2) * kstep;
            const char* a3 = a2 + kstep; const char* b3 = b2 + kstep;
            unsigned o2[2][2];
            if constexpr (GATHER) {
#pragma unroll
                for (int h = 0; h < 2; ++h)
#pragma unroll
                    for (int i = 0; i < 2; ++i) o2[h][i] = last ? offN[h][i] : offA[h][i];
            }
            const unsigned va2 = last ? vAn : vA, vb2 = last ? vBn : vB; const size_t sa2 = last ? sAn : sA, sb2 = last ? sBn : sB;
            PG8_LDB(B0, 0, 0); PG8_LDB(B1, 0, 1); PG8_SCHED; PG8_LDA(At, 0, 0); PG8_STAGE_A(PG8_SA(1, 1), a1, 1, vA, sA, offA);
            PG8_WAIT_V(8); PG8_WAIT_L(0); PG8_BAR; PG8_MMA(0, 0, At, B0); PG8_MMA(0, 1, At, B1); PG8_BAR; PG8_SCHED;
            PG8_LDA(At, 0, 1); PG8_STAGE_B(PG8_SB(0, 0), b2, 0, vb2, sb2); PG8_STAGE_B(PG8_SB(0, 1), b2, 1, vb2, sb2); PG8_STAGE_A(PG8_SA(0, 0), a2, 0, va2, sa2, o2);
            PG8_WAIT_V(8); PG8_WAIT_L(0); PG8_BAR; PG8_MMA(1, 0, At, B0); PG8_MMA(1, 1, At, B1); PG8_BAR; PG8_SCHED;
            PG8_LDB(B0, 1, 0); PG8_LDB(B1, 1, 1); PG8_SCHED; PG8_LDA(At, 1, 0); PG8_STAGE_A(PG8_SA(0, 1), a2, 1, va2, sa2, o2);
            PG8_WAIT_V(8); PG8_WAIT_L(0); PG8_BAR; PG8_MMA(0, 0, At, B0); PG8_MMA(0, 1, At, B1); PG8_BAR; PG8_SCHED;
            PG8_LDA(At, 1, 1); PG8_STAGE_B(PG8_SB(1, 0), b3, 0, vb2, sb2); PG8_STAGE_B(PG8_SB(1, 1), b3, 1, vb2, sb2); PG8_STAGE_A(PG8_SA(1, 0), a3, 0, va2, sa2, o2);
            PG8_WAIT_V(8); PG8_WAIT_L(0); PG8_BAR; PG8_MMA(1, 0, At, B0); PG8_MMA(1, 1, At, B1); PG8_BAR; PG8_SCHED;
        }
        if (wr == 0) PG8_BAR;
        if constexpr (!Epi::AFTER_DRAIN) E(acc, cur, wr, wc, fr, fq);
        if (!has_next) break;
        if (!E.keep_acc(cur)) {
#pragma unroll
            for (int a = 0; a < 2; ++a)
#pragma unroll
                for (int b = 0; b < 2; ++b)
#pragma unroll
                    for (int m = 0; m < 4; ++m)
#pragma unroll
                        for (int n = 0; n < 2; ++n) acc[a][b][m][n] = (f32x4){0.f, 0.f, 0.f, 0.f};
        }
        cur = nxt; cA = nA; cB = nB; ++ui; nt = cur.nt; vA = vAn; sA = sAn; vB = vBn; sB = sBn;
        if constexpr (GATHER) {
#pragma unroll
            for (int h = 0; h < 2; ++h)
#pragma unroll
                for (int i = 0; i < 2; ++i) offA[h][i] = offN[h][i];
        }
        E.pre(cur, wr, wc, fr, fq);
        if (wr == 1) PG8_BAR;
    }
    PG8_WAIT_V(0);
    PG8_BAR;
    if constexpr (Epi::AFTER_DRAIN) E.after(acc, cur, wr, wc, fr, fq, lds);
#undef PG8_GEOM
#undef PG8_SA
#undef PG8_SB
#undef PG8_STAGE_A
#undef PG8_STAGE_B
#undef PG8_LDA
#undef PG8_LDB
#undef PG8_MMA
#undef PG8_WAIT_V
#undef PG8_WAIT_L
#undef PG8_BAR
#undef PG8_SCHED
}

struct StaticOrder {
    const char* A; const char* B; size_t tstepA, tstepB; int nM, nN, nwg, G, c, lda, ldb, nt;
    __device__ __forceinline__ void init(const void* A_, int lda_, const void* B_, int ldb_, int K, int M, int N, int G_, int c_) {
        A = (const char*)A_; B = (const char*)B_; lda = lda_; ldb = ldb_; nt = K / BK; tstepA = (size_t)BM * lda * 2; tstepB = (size_t)BM * ldb * 2; nM = M / BM; nN = N / BM; nwg = nM * nN; G = G_; c = c_; }
    __device__ __forceinline__ bool next(int i, Unit& u) const {
        const long L = (long)i * G + c; if (L >= nwg) return false;
        int wgid = (int)L; { const int q = nwg / 8, r = nwg % 8, xcd = wgid % 8, off = wgid / 8; wgid = (xcd < r ? xcd * (q + 1) : r * (q + 1) + (xcd - r) * q) + off; }
        const int nig = 8 * nN, gid = wgid / nig, fm = gid * 8, gsz = (nM - fm) < 8 ? (nM - fm) : 8;
        u.pm = fm + ((wgid % nig) % gsz); u.pn = (wgid % nig) / gsz; u.e = 0; u.valid = 256; u.lt = 0; u.lda = lda; u.ldb = ldb; u.nt = nt; u.seg = 0;
        u.A = A + (size_t)u.pm * tstepA; u.B = B + (size_t)u.pn * tstepB; return true;
    }
};
}
namespace pg8 {
__device__ __forceinline__ unsigned cvt_pk_bf16(float lo, float hi) { unsigned r; asm volatile("v_cvt_pk_bf16_f32 %0, %1, %2" : "=v"(r) : "v"(lo), "v"(hi)); return r; }
__device__ __forceinline__ float fsig(float x) { return __builtin_amdgcn_rcpf(1.0f + __builtin_amdgcn_exp2f(-L2E * x)); }
__device__ __forceinline__ u32x4 pack8(const f32x4 v0, const f32x4 v1) { u32x4 w; w.x = cvt_pk_bf16(v0[0], v0[1]); w.y = cvt_pk_bf16(v0[2], v0[3]); w.z = cvt_pk_bf16(v1[0], v1[1]); w.w = cvt_pk_bf16(v1[2], v1[3]); return w; }
__device__ __forceinline__ void unpack8(const u32x4 w, f32x4& v0, f32x4& v1) {
    v0[0] = __uint_as_float(w.x << 16); v0[1] = __uint_as_float(w.x & 0xffff0000u); v0[2] = __uint_as_float(w.y << 16); v0[3] = __uint_as_float(w.y & 0xffff0000u);
    v1[0] = __uint_as_float(w.z << 16); v1[1] = __uint_as_float(w.z & 0xffff0000u); v1[2] = __uint_as_float(w.w << 16); v1[3] = __uint_as_float(w.w & 0xffff0000u); }
__device__ __forceinline__ u32x4 ld16(const void* ubase, unsigned voff) { return *(const GAS u32x4*)((const GAS char*)ubase + voff); }
__device__ __forceinline__ void st16(void* ubase, unsigned voff, u32x4 v) { *(GAS u32x4*)((GAS char*)ubase + voff) = v; }
__device__ __forceinline__ f32x4 ldf4(const void* ubase, unsigned voff) { return *(const GAS f32x4*)((const GAS char*)ubase + voff); }

struct EpiIn { bf16_t* H; bf16_t* A3; unsigned char* GQ;
    static constexpr bool AFTER_DRAIN = false; __device__ __forceinline__ void pre(const Unit&, int, int, int, int) const {} __device__ __forceinline__ bool keep_acc(const Unit&) const { return false; }
    __device__ __forceinline__ void operator()(const Acc& acc, const Unit& u, int wr, int wc, int fr, int fq) const {
        const int pn = u.pn;
        const unsigned vH = (unsigned)(fr * HP + 8 * fq) * 2u, vS = (unsigned)((fq >> 1) * 2048 * 384 + fr * 16 + (fq & 1) * 8) * 2u, vG = (unsigned)(fr * 3072 + 8 * fq);
#pragma unroll
        for (int ai = 0; ai < 2; ++ai)
#pragma unroll
            for (int m = 0; m < 4; ++m) {
#pragma unroll
                for (int bj = 0; bj < 2; ++bj) { f32x4 v0 = acc[ai][bj][m][0], v1 = acc[ai][bj][m][1];
                    if (pn < 2) { v0 = v0 * C2; v1 = v1 * C2; }
                    if (pn >= 8) { unsigned q[8];
#pragma unroll
                        for (int i = 0; i < 4; i += 2) {
                            f32x2 ta = (f32x2){__builtin_amdgcn_exp2f(v0[i]), __builtin_amdgcn_exp2f(v0[i + 1])} + (f32x2){1.0f, 1.0f}, tb = (f32x2){__builtin_amdgcn_exp2f(v1[i]), __builtin_amdgcn_exp2f(v1[i + 1])} + (f32x2){1.0f, 1.0f};
                            f32x2 ya = (f32x2){__builtin_amdgcn_rcpf(ta.x), __builtin_amdgcn_rcpf(ta.y)} * (f32x2){255.0f, 255.0f} + (f32x2){0.5f, 0.5f}, yb = (f32x2){__builtin_amdgcn_rcpf(tb.x), __builtin_amdgcn_rcpf(tb.y)} * (f32x2){255.0f, 255.0f} + (f32x2){0.5f, 0.5f};
                            q[i] = (unsigned)fmaxf(ya.x, 1.0f); q[i + 1] = (unsigned)fmaxf(ya.y, 1.0f); q[4 + i] = (unsigned)fmaxf(yb.x, 1.0f); q[5 + i] = (unsigned)fmaxf(yb.y, 1.0f); }
                        u32x2 w; w.x = q[0] | (q[1] << 8) | (q[2] << 16) | (q[3] << 24); w.y = q[4] | (q[5] << 8) | (q[6] << 16) | (q[7] << 24);
                        *(GAS u32x2*)((GAS unsigned char*)GQ + (size_t)(u.pm * 256 + ai * 128 + wr * 64 + m * 16) * 3072 + (pn - 8) * 256 + bj * 128 + wc * 32 + vG) = w; }
                    else if (pn == 7) st16(A3 + ((size_t)(bj * 8 + wc * 2) * 2048 + u.pm * 16 + ai * 8 + wr * 4 + m) * 384, vS, pack8(v0, v1));
                    else st16(H + (size_t)(u.pm * 256 + ai * 128 + wr * 64 + m * 16) * HP + pn * 256 + bj * 128 + wc * 32, vH, pack8(v0, v1)); } }
    }
};
struct EpiGlu { const bf16_t* ycp; const float* bias; bf16_t* yc;
    static constexpr bool AFTER_DRAIN = false; __device__ __forceinline__ void pre(const Unit&, int, int, int, int) const {} __device__ __forceinline__ bool keep_acc(const Unit&) const { return false; }
    __device__ __forceinline__ void operator()(const Acc& acc, const Unit& u, int wr, int wc, int fr, int fq) const {
        const unsigned vo = (unsigned)(fr * 256 + 8 * fq) * 2u;
        f32x4 bv[2][2];
#pragma unroll
        for (int bj = 0; bj < 2; ++bj)
#pragma unroll
            for (int n = 0; n < 2; ++n) bv[bj][n] = ldf4(bias + bj * 128 + wc * 32 + 4 * n, (unsigned)fq * 32u);
#define GL_UB(it) ((size_t)(u.pm * 256 + ((it) >> 3) * 128 + wr * 64 + (((it) >> 1) & 3) * 16) * 256 + ((it) & 1) * 128 + wc * 32)
        u32x4 yn = ld16(ycp + GL_UB(0), vo);
#pragma unroll
        for (int it = 0; it < 16; ++it) { const int ai = it >> 3, m = (it >> 1) & 3, bj = it & 1; const size_t ub = GL_UB(it); f32x4 y0, y1; unpack8(yn, y0, y1);
            if (it + 1 < 16) yn = ld16(ycp + GL_UB(it + 1), vo);
            f32x4 v0 = acc[ai][bj][m][0] + bv[bj][0], v1 = acc[ai][bj][m][1] + bv[bj][1];
#pragma unroll
            for (int i = 0; i < 4; ++i) { v0[i] = y0[i] * fsig(v0[i]); v1[i] = y1[i] * fsig(v1[i]); }
            st16(yc + ub, vo, pack8(v0, v1));
            asm volatile("" ::: "memory"); }
#undef GL_UB
    }
};
struct EpiBranch { const bf16_t* H; bf16_t* merged; int br;
    static constexpr bool AFTER_DRAIN = false; __device__ __forceinline__ void pre(const Unit&, int, int, int, int) const {} __device__ __forceinline__ bool keep_acc(const Unit&) const { return false; }
    __device__ __forceinline__ void operator()(const Acc& acc, const Unit& u, int wr, int wc, int fr, int fq) const {
        const unsigned vH = (unsigned)(fr * HP + 8 * fq) * 2u, vM = (unsigned)(fr * 1024 + 8 * fq) * 2u;
#pragma unroll
        for (int ai = 0; ai < 2; ++ai)
#pragma unroll
            for (int m = 0; m < 4; ++m) { const int rowu = u.pm * 256 + ai * 128 + wr * 64 + m * 16;
#pragma unroll
                for (int bj = 0; bj < 2; ++bj) { const int cu = u.pn * 256 + bj * 128 + wc * 32; f32x4 g0, g1; unpack8(ld16(H + (size_t)rowu * HP + HC_G + br * 1024 + cu, vH), g0, g1);
                    f32x4 v0 = acc[ai][bj][m][0] * g0, v1 = acc[ai][bj][m][1] * g1;
                    if (br > 0) { f32x4 p0, p1; unpack8(ld16(merged + (size_t)rowu * 1024 + cu, vM), p0, p1); v0 = v0 + p0; v1 = v1 + p1; }
                    st16(merged + (size_t)rowu * 1024 + cu, vM, pack8(v0, v1)); }
                asm volatile("" ::: "memory"); }
    }
};
struct EpiBranchF { const unsigned char* GQ; bf16_t* merged;
    static constexpr bool AFTER_DRAIN = false; __device__ __forceinline__ void pre(const Unit&, int, int, int, int) const {} __device__ __forceinline__ bool keep_acc(const Unit& u) const { return u.seg < 2; }
    __device__ __forceinline__ void operator()(Acc& acc, const Unit& u, int wr, int wc, int fr, int fq) const {
        const unsigned vG = (unsigned)(fr * 3072 + 8 * fq), vM = (unsigned)(fr * 1024 + 8 * fq) * 2u; const int seg = u.seg;
        const unsigned char* gbase = GQ + (size_t)(u.pm * 256 + wr * 64) * 3072 + seg * 1024 + u.pn * 256 + wc * 32;
        bf16_t* mbase = merged + (size_t)(u.pm * 256 + wr * 64) * 1024 + u.pn * 256 + wc * 32;
#define BF_LOAD(it, G, Hh) do { const size_t ro_ = (size_t)(((it) >> 3) * 128 + (((it) >> 1) & 3) * 16); const int bj_ = (it) & 1; \
            G = *(const GAS u32x2*)((const GAS unsigned char*)gbase + ro_ * 3072 + bj_ * 128 + vG); Hh = (u32x2){0xffffffffu, 0xffffffffu}; if (seg < 2) Hh = *(const GAS u32x2*)((const GAS unsigned char*)gbase + ro_ * 3072 + 1024 + bj_ * 128 + vG); } while (0)
        u32x2 gn, hn; BF_LOAD(0, gn, hn);
#pragma unroll
        for (int it = 0; it < 16; ++it) { const int ai = it >> 3, m = (it >> 1) & 3, bj = it & 1; const size_t ro = (size_t)(ai * 128 + m * 16);
            const u32x2 gw = gn, hw = hn;
            if (it + 1 < 16) BF_LOAD(it + 1, gn, hn);
            f32x4 g0, g1;
#pragma unroll
            for (int i = 0; i < 4; ++i) { g0[i] = (float)((gw.x >> (8 * i)) & 255u) * __builtin_amdgcn_rcpf((float)((hw.x >> (8 * i)) & 255u));
                                          g1[i] = (float)((gw.y >> (8 * i)) & 255u) * __builtin_amdgcn_rcpf((float)((hw.y >> (8 * i)) & 255u)); }
            acc[ai][bj][m][0] = acc[ai][bj][m][0] * g0; acc[ai][bj][m][1] = acc[ai][bj][m][1] * g1;
            if (seg == 2) st16(mbase + ro * 1024 + bj * 128, vM, pack8(acc[ai][bj][m][0], acc[ai][bj][m][1]));
            asm volatile("" ::: "memory"); }
#undef BF_LOAD
    }
};
struct EpiPlain { bf16_t* O; const float* bias; int bias_estride;
    static constexpr bool AFTER_DRAIN = false; __device__ __forceinline__ void pre(const Unit&, int, int, int, int) const {} __device__ __forceinline__ bool keep_acc(const Unit&) const { return false; }
    __device__ __forceinline__ void operator()(const Acc& acc, const Unit& u, int wr, int wc, int fr, int fq) const {
        const unsigned vo = (unsigned)(fr * 1024 + 8 * fq) * 2u;
        f32x4 bv[2][2];
#pragma unroll
        for (int bj = 0; bj < 2; ++bj)
#pragma unroll
            for (int n = 0; n < 2; ++n) bv[bj][n] = bias ? ldf4(bias + (size_t)u.e * bias_estride + u.pn * 256 + bj * 128 + wc * 32 + 4 * n, (unsigned)fq * 32u) : (f32x4){0.f, 0.f, 0.f, 0.f};
#pragma unroll
        for (int ai = 0; ai < 2; ++ai)
#pragma unroll
            for (int m = 0; m < 4; ++m) { const int rowu = u.pm * 256 + ai * 128 + wr * 64 + m * 16;
#pragma unroll
                for (int bj = 0; bj < 2; ++bj) st16(O + (size_t)rowu * 1024 + u.pn * 256 + bj * 128 + wc * 32, vo, pack8(acc[ai][bj][m][0] + bv[bj][0], acc[ai][bj][m][1] + bv[bj][1])); }
    }
};
struct EpiUp { bf16_t* act; const float* bup;
    static constexpr bool AFTER_DRAIN = false; __device__ __forceinline__ void pre(const Unit&, int, int, int, int) const {} __device__ __forceinline__ bool keep_acc(const Unit&) const { return false; }
    __device__ __forceinline__ void operator()(const Acc& acc, const Unit& u, int wr, int wc, int fr, int fq) const {
        const unsigned vo = (unsigned)(fr * 1024 + 8 * fq) * 2u;
        const int ju = u.pn * 128 + wc * 32;
        f32x4 bb[4];
#pragma unroll
        for (int q = 0; q < 4; ++q) { bb[q] = ldf4(bup + (size_t)u.e * 2048 + 2 * ju + 4 * q, (unsigned)fq * 64u); bb[q][1] += 1.0f; bb[q][3] += 1.0f; }
#pragma unroll
        for (int ai = 0; ai < 2; ++ai)
#pragma unroll
            for (int m = 0; m < 4; ++m) { const int rowu = u.pm * 256 + ai * 128 + wr * 64 + m * 16; f32x4 o[2];
#pragma unroll
                for (int n = 0; n < 2; ++n)
#pragma unroll
                    for (int i2 = 0; i2 < 2; ++i2) { const int q = 4 * n + 2 * i2;
                        f32x2 g = (f32x2){acc[ai][0][m][n][2 * i2], acc[ai][0][m][n][2 * i2 + 1]} + (f32x2){bb[q >> 1][0], bb[(q >> 1)][2]};
                        f32x2 l = (f32x2){acc[ai][1][m][n][2 * i2], acc[ai][1][m][n][2 * i2 + 1]} + (f32x2){bb[q >> 1][1], bb[(q >> 1)][3]};
                        g = __builtin_elementwise_min(g, (f32x2){7.0f, 7.0f}); l.x = __builtin_amdgcn_fmed3f(l.x, -6.0f, 8.0f); l.y = __builtin_amdgcn_fmed3f(l.y, -6.0f, 8.0f);
                        const f32x2 t = g * (-1.702f * L2E); const f32x2 d = (f32x2){__builtin_amdgcn_exp2f(t.x), __builtin_amdgcn_exp2f(t.y)} + (f32x2){1.0f, 1.0f};
                        const f32x2 s = (f32x2){__builtin_amdgcn_rcpf(d.x), __builtin_amdgcn_rcpf(d.y)};
                        const f32x2 r = (g * s) * l; o[n][2 * i2] = r.x; o[n][2 * i2 + 1] = r.y; }
                st16(act + (size_t)rowu * 1024 + ju, vo, pack8(o[0], o[1])); }
    }
};
struct EpiYm8 { unsigned char* O; const float* bias;
    mutable f32x4 bv[2][2];
    static constexpr bool AFTER_DRAIN = false;
    __device__ __forceinline__ void pre(const Unit& u, int, int wc, int, int fq) const {
#pragma unroll
        for (int bj = 0; bj < 2; ++bj)
#pragma unroll
            for (int n = 0; n < 2; ++n) bv[bj][n] = ldf4(bias + (size_t)u.e * 1024 + u.pn * 256 + bj * 128 + wc * 32 + 4 * n, (unsigned)fq * 32u); } __device__ __forceinline__ bool keep_acc(const Unit&) const { return false; }
    __device__ __forceinline__ void operator()(const Acc& acc, const Unit& u, int wr, int wc, int fr, int fq) const {
        const unsigned vo = (unsigned)(fr * 1024 + 8 * fq);
#pragma unroll
        for (int ai = 0; ai < 2; ++ai)
#pragma unroll
            for (int m = 0; m < 4; ++m) { const int rowu = u.pm * 256 + ai * 128 + wr * 64 + m * 16;
#pragma unroll
                for (int bj = 0; bj < 2; ++bj) { const f32x4 a = acc[ai][bj][m][0] + bv[bj][0], b = acc[ai][bj][m][1] + bv[bj][1]; u32x2 w;
                    int t = __builtin_amdgcn_cvt_pk_fp8_f32(a[0], a[1], 0, false); t = __builtin_amdgcn_cvt_pk_fp8_f32(a[2], a[3], t, true); w.x = (unsigned)t;
                    t = __builtin_amdgcn_cvt_pk_fp8_f32(b[0], b[1], 0, false); t = __builtin_amdgcn_cvt_pk_fp8_f32(b[2], b[3], t, true); w.y = (unsigned)t;
                    *(GAS u32x2*)((GAS unsigned char*)O + (size_t)rowu * 1024 + u.pn * 256 + bj * 128 + wc * 32 + vo) = w; } }
    }
};
}
#include <hip/hip_bf16.h>
#include <cmath>
namespace attn_body {
using bf16=__hip_bfloat16;
using bf16x8=__attribute__((ext_vector_type(8)))short;
using s16x4=__attribute__((ext_vector_type(4)))short;
using f32x16=__attribute__((ext_vector_type(16)))float;
using u32x4=__attribute__((ext_vector_type(4)))unsigned;
constexpr int BATCH=8,NHEAD=8,SEQ=4096,D=64,DM=5120;
constexpr int NW=8,QBLK=32,QB=QBLK*NW,KVBLK=64,NQB=SEQ/QB;
constexpr int ATTN_PITCH=DM, ATTN_UNIT_ROWS=QB;
__device__ __forceinline__ int crow(int r,int hi){return (r&3)+8*(r>>2)+4*hi;}
#define SBAR() __builtin_amdgcn_sched_barrier(0)
__device__ __forceinline__ void cmask(f32x16&p0,f32x16&p1,int jb,int qrel,int hi){
  const float NEG=-INFINITY; int kb=64*jb+4*hi;
  #pragma unroll
  for(int r=0;r<16;++r){int kv=kb+(r&3)+8*(r>>2); if(kv>qrel)p0[r]=NEG; if(kv+32>qrel)p1[r]=NEG;}
}

constexpr int NSLOT=3, SLOTB=8192;
constexpr int LDS_K=0, LDS_V=NSLOT*SLOTB, LDS_WS=2*NSLOT*SLOTB, LDS_OST=LDS_WS+NW*64*4, LDS_BIAS=LDS_OST+NW*4096, LDS_BYTES=LDS_BIAS+SEQ*4;
constexpr float C2=0.125f*1.4426950408889634f;
__device__ __forceinline__ void glds16(const void*gsrc,unsigned lds_dst){unsigned keep;
  asm volatile("s_mov_b32 %0, m0\n\ts_mov_b32 m0, %2\n\ts_nop 0\n\tglobal_load_lds_dwordx4 %1, off\n\ts_mov_b32 m0, %0":"=&s"(keep):"v"(gsrc),"s"(lds_dst):"memory");}
__device__ __forceinline__ float max3f(float a,float b,float c){float r;asm("v_max3_f32 %0, %1, %2, %3":"=v"(r):"v"(a),"v"(b),"v"(c));return r;}
__device__ __forceinline__ float max2f(float a,float b){float r;asm("v_max_f32_e32 %0, %1, %2":"=v"(r):"v"(a),"v"(b));return r;}
__device__ __forceinline__ float fadd_s(float a,float b){float r;asm("v_add_f32_e32 %0, %1, %2":"=v"(r):"v"(a),"v"(b));return r;}
__device__ __forceinline__ float fsub_s(float a,float b){float r;asm("v_sub_f32_e32 %0, %1, %2":"=v"(r):"v"(a),"v"(b));return r;}
typedef float f32x2_t __attribute__((ext_vector_type(2))); typedef __bf16 bf16x2_t __attribute__((ext_vector_type(2)));
__device__ __forceinline__ unsigned cvtpk_s(float lo,float hi){f32x2_t v={lo,hi};bf16x2_t b=__builtin_convertvector(v,bf16x2_t);return __builtin_bit_cast(unsigned,b);}
#define WAIT_BAR(N) asm volatile("s_waitcnt vmcnt(" #N ") lgkmcnt(0)\n\ts_barrier":::"memory")

__device__ __forceinline__ void qkt(f32x16&p0,f32x16&p1,const char*Kslot,const bf16x8*qr,const f32x16&c0in,const f32x16&c1in,int r32,int hi){
  const char*kb=Kslot+hi*1024+r32*16;
  #pragma unroll
  for(int d0=0;d0<4;++d0){
    const bf16x8 b0=*reinterpret_cast<const bf16x8*>(kb+d0*2048);
    const bf16x8 b1=*reinterpret_cast<const bf16x8*>(kb+d0*2048+512);
    if(d0==0){p0=__builtin_amdgcn_mfma_f32_32x32x16_bf16(b0,qr[0],c0in,0,0,0);p1=__builtin_amdgcn_mfma_f32_32x32x16_bf16(b1,qr[0],c1in,0,0,0);}
    else{p0=__builtin_amdgcn_mfma_f32_32x32x16_bf16(b0,qr[d0],p0,0,0,0);p1=__builtin_amdgcn_mfma_f32_32x32x16_bf16(b1,qr[d0],p1,0,0,0);}}
}
typedef __attribute__((address_space(3))) const char* lds_cptr;
typedef short v4i16_t __attribute__((ext_vector_type(4)));
__device__ __forceinline__ void kload8(bf16x8*kf,lds_cptr kp){
  kf[0]=*(const __attribute__((address_space(3))) bf16x8*)(kp);      kf[1]=*(const __attribute__((address_space(3))) bf16x8*)(kp+512);
  kf[2]=*(const __attribute__((address_space(3))) bf16x8*)(kp+2048); kf[3]=*(const __attribute__((address_space(3))) bf16x8*)(kp+2560);
  kf[4]=*(const __attribute__((address_space(3))) bf16x8*)(kp+4096); kf[5]=*(const __attribute__((address_space(3))) bf16x8*)(kp+4608);
  kf[6]=*(const __attribute__((address_space(3))) bf16x8*)(kp+6144); kf[7]=*(const __attribute__((address_space(3))) bf16x8*)(kp+6656);
}
__device__ __forceinline__ void kload2(bf16x8*kf,lds_cptr kp,int j){ kf[2*j]=*(const __attribute__((address_space(3))) bf16x8*)(kp+j*2048); kf[2*j+1]=*(const __attribute__((address_space(3))) bf16x8*)(kp+j*2048+512); }
__device__ __forceinline__ s16x4 vtr(lds_cptr p){ return __builtin_bit_cast(s16x4,__builtin_amdgcn_ds_read_tr16_b64_v4i16((__attribute__((address_space(3))) v4i16_t*)p)); }
__device__ __forceinline__ float rowmax(const f32x16&p0,const f32x16&p1){
  float a=max3f(p0[0],p0[1],p1[0]),b=max3f(p0[2],p0[3],p1[1]);a=max3f(a,p1[2],p1[3]);
  #pragma unroll
  for(int r=4;r<16;r+=4){a=max3f(a,p0[r],p0[r+1]);b=max3f(b,p0[r+2],p0[r+3]);a=max3f(a,p1[r],p1[r+1]);b=max3f(b,p1[r+2],p1[r+3]);}
  const float m=max2f(a,b);
  auto rr=__builtin_amdgcn_permlane32_swap(__float_as_uint(m),__float_as_uint(m),false,false);
  return max2f(__uint_as_float(rr[0]),__uint_as_float(rr[1]));
}
__device__ __forceinline__ void pv(f32x16*o,int vb,bf16x8 pa0,bf16x8 pa1,bf16x8 pa2,bf16x8 pa3){
  #pragma unroll
  for(int d0=0;d0<2;++d0){s16x4 lo[4],hi[4];
    #pragma unroll
    for(int ks=0;ks<4;++ks){
      asm volatile("ds_read_b64_tr_b16 %0,%1 offset:%c2":"=&v"(lo[ks]):"v"(vb),"i"(d0*4096+ks*1024):"memory");
      asm volatile("ds_read_b64_tr_b16 %0,%1 offset:%c2":"=&v"(hi[ks]):"v"(vb),"i"(d0*4096+ks*1024+512):"memory");}
    asm volatile("s_waitcnt lgkmcnt(0)":::"memory");SBAR();
    #define PK(k) (bf16x8){lo[k][0],lo[k][1],lo[k][2],lo[k][3],hi[k][0],hi[k][1],hi[k][2],hi[k][3]}
    o[d0]=__builtin_amdgcn_mfma_f32_32x32x16_bf16(pa0,PK(0),o[d0],0,0,0);
    o[d0]=__builtin_amdgcn_mfma_f32_32x32x16_bf16(pa1,PK(1),o[d0],0,0,0);
    o[d0]=__builtin_amdgcn_mfma_f32_32x32x16_bf16(pa2,PK(2),o[d0],0,0,0);
    o[d0]=__builtin_amdgcn_mfma_f32_32x32x16_bf16(pa3,PK(3),o[d0],0,0,0);
    #undef PK
  }
}

#ifndef ATTN_STORE16
#define ATTN_STORE16(p,v) (*(u32x4*)(p)=(v))
#endif
typedef __attribute__((address_space(3))) const float* lds_fptr; typedef float f32x4_t __attribute__((ext_vector_type(4)));
__device__ __forceinline__ void bias_tuple(f32x16&c0,f32x16&c1,lds_fptr bp,float mhat){
  #pragma unroll
  for(int g=0;g<4;++g){ const f32x4_t x=*(const __attribute__((address_space(3))) f32x4_t*)(bp+8*g), y=*(const __attribute__((address_space(3))) f32x4_t*)(bp+32+8*g);
    #pragma unroll
    for(int i=0;i<4;++i){ c0[4*g+i]=x[i]-mhat; c1[4*g+i]=y[i]-mhat; } }
}
template<int THRL> __device__ __forceinline__ void attn_unit(int b,int h,int qb,const bf16*Q,const bf16*__restrict__ K,const bf16*__restrict__ V,bf16*O,const float*__restrict__ cum,char*shm){
  int tid_=threadIdx.x; asm volatile("":"+v"(tid_));
  const int tid=tid_,lane=tid&63,r32=lane&31,hi=lane>>5; const int wid=__builtin_amdgcn_readfirstlane(tid>>6);
  const long rowbase=(long)b*SEQ; const int q0=qb*QB;
  const bf16*Qw=Q+(rowbase+q0+wid*QBLK)*DM+h*D;
  const bf16*Kh=K+rowbase*DM+h*D,*Vh=V+rowbase*DM+h*D;
  const unsigned lds0=(unsigned)(uintptr_t)shm;
  float*wsf=(float*)(shm+LDS_WS)+wid*64;
  { const float*cb=cum+(long)(b*NHEAD+h)*SEQ; const float cref=cb[q0]; float*bt=(float*)(shm+LDS_BIAS);
    float cv[8];
    _Pragma("unroll") for(int u=0;u<8;++u){const int j=tid+u*NW*64; cv[u]=(j<q0+QB)?cb[j]:0.f;}
    _Pragma("unroll") for(int u=0;u<8;++u){const int j=tid+u*NW*64; if(j<q0+QB)bt[j]=-1.4426950408889634f*(cv[u]-cref);} }
  asm volatile("s_waitcnt lgkmcnt(0)\n\ts_barrier":::"memory");
  int tskip=0;
  { const int NT0=(q0+QB)/KVBLK; const lds_fptr bt0=(lds_fptr)((lds_cptr)shm+LDS_BIAS);
    const float bv=(lane<NT0)?bt0[64*lane+63]:0.f;
    const unsigned long long mk=__ballot(lane<NT0&&bv<-64.f);
    tskip=__builtin_amdgcn_readfirstlane((int)__popcll(mk))&~1; if(tskip>NT0-4)tskip=NT0-4; }
  const lds_fptr btl=(lds_fptr)((lds_cptr)shm+LDS_BIAS)+4*hi+64*tskip;
  const bf16*Khs=Kh+(long)tskip*KVBLK*DM,*Vhs=Vh+(long)tskip*KVBLK*DM;
  const bf16*ksrc=Khs+(long)lane*DM+wid*8;
  const bf16*vsrc=Vhs+(long)(16*(wid&3)+(lane>>2))*DM+(wid>>2)*32+(lane&3)*8;
  const unsigned kdst=lds0+LDS_K+wid*1024, vdst=lds0+LDS_V+wid*1024;
  #define DMA_K(t,slot) glds16(ksrc+(long)(t)*KVBLK*DM,(unsigned)__builtin_amdgcn_readfirstlane(kdst+(slot)))
  #define DMA_V(t,slot) glds16(vsrc+(long)(t)*KVBLK*DM,(unsigned)__builtin_amdgcn_readfirstlane(vdst+(slot)))
  const int vb0=(int)(lds0+LDS_V)+((lane>>4)&1)*32+(lane&3)*8+(4*hi+((lane&15)>>2))*64;
  const char*Kbase=shm+LDS_K; bf16x8 kf[8];
  const lds_cptr shm3=(lds_cptr)shm; const lds_cptr kp0=shm3+LDS_K+hi*1024+r32*16; const lds_cptr vp0=shm3+LDS_V+((lane>>4)&1)*32+(lane&3)*8+(4*hi+((lane&15)>>2))*64;
  const int NT=(q0+QB)/KVBLK-tskip;
  DMA_K(0,0);DMA_V(0,0);DMA_K(1,SLOTB);
  bf16x8 qr[4];
  #pragma unroll
  for(int d0=0;d0<4;++d0)qr[d0]=*reinterpret_cast<const bf16x8*>(&Qw[(long)r32*DM+d0*16+hi*8]);
  float mhat=0.f,l_reg=0.f;f32x16 o[2];o[0]=f32x16{};o[1]=f32x16{};
  const int qrel=wid*QBLK+r32;
  #define CMASK(P0,P1,t) do{int jb_=(t)-(NT-4); if(jb_>=0)cmask(P0,P1,jb_,qrel,hi);}while(0)
  bool resc=false;
  #define START(P0,P1) do{ const float rm=rowmax(P0,P1); resc=false; \
    { const float dl=rm; mhat=fadd_s(mhat,dl); \
      _Pragma("unroll") for(int r=0;r<16;++r){P0[r]=fsub_s(P0[r],dl);P1[r]=fsub_s(P1[r],dl);} \
      } \
    _Pragma("unroll") for(int r=0;r<16;++r)P0[r]=__builtin_amdgcn_exp2f(P0[r]); }while(0)
  #define RESC() do{ if(resc){ asm volatile("s_waitcnt lgkmcnt(0)":::"memory"); \
      _Pragma("unroll") for(int d_=0;d_<2;++d_) _Pragma("unroll") for(int r=0;r<16;++r)o[d_][r]*=wsf[crow(r,hi)]; } }while(0)
  f32x16 pA0,pA1,pB0,pB1;
  int sl_prev=0,sl_cur=0,sl_next=SLOTB;
  #define ROT() do{sl_prev=sl_cur;sl_cur=sl_next;sl_next=(sl_next==(NSLOT-1)*SLOTB)?0:sl_next+SLOTB;}while(0)
  DMA_K(2,2*SLOTB);
  WAIT_BAR(3);
  { f32x16 c0in,c1in; bias_tuple(c0in,c1in,btl,0.f); qkt(pA0,pA1,Kbase,qr,c0in,c1in,r32,hi); } asm volatile("s_nop 15\n\ts_nop 7":"+v"(pA0),"+v"(pA1));CMASK(pA0,pA1,0);
  START(pA0,pA1);
  _Pragma("unroll") for(int r=0;r<16;++r)pA1[r]=__builtin_amdgcn_exp2f(pA1[r]);
  WAIT_BAR(0);
  DMA_K(3,0);DMA_V(1,SLOTB);
  ROT();
  kload8(kf,kp0+sl_cur);
  WAIT_BAR(2);
  s16x4 vlo[8],vhi[8]; u32x4 pw0,pw1,pw2,pw3;
  #define PKW(P,B) cvtpk_s(P[B],P[B+1])
  #define PAF(k) __builtin_bit_cast(bf16x8,pw##k)
  #define VFR(i) (bf16x8){vlo[i][0],vlo[i][1],vlo[i][2],vlo[i][3],vhi[i][0],vhi[i][1],vhi[i][2],vhi[i][3]}
  #define PIN(x) asm volatile("":"+v"(x))
  #define MX3(a,b,c) __builtin_fmaxf(__builtin_fmaxf((a),(b)),(c))
  #define GAPA(MF,A0,A1,A2,A3,W0,W1,PW) do{ MF; sacc+=A0; sacc+=A1; sacc+=A2; sacc+=A3; PIN(sacc); W0; W1; PIN(PW); SBAR(); }while(0)
  #define EX(v) __builtin_amdgcn_exp2f(v)
  #define GAPB(MF,X,B) do{ MF; X[B]=EX(X[B]); X[B+1]=EX(X[B+1]); X[B+2]=EX(X[B+2]); X[B+3]=EX(X[B+3]); PIN(X); SBAR(); }while(0)
  #define VRD(i) do{ vlo[i]=vtr(vp_+(((i)>>2)*4096+((i)&3)*1024)); vhi[i]=vtr(vp_+(((i)>>2)*4096+((i)&3)*1024+512)); }while(0)
  #define KRD(G,j) do{ if(G){ kload2(kf,kp0+sl_next,j); SBAR(); } }while(0)
  #define STEP(C0,C1,P0,P1,t,GK,GV,GL) do{ SBAR(); \
    const lds_cptr vp_=vp0+sl_prev; bias_tuple(C0,C1,btl+(t)*64,mhat); SBAR(); \
    VRD(0); SBAR(); float sacc=(P0[0]+P0[1]); \
    GAPA(C0=__builtin_amdgcn_mfma_f32_32x32x16_bf16(kf[0],qr[0],C0,0,0,0), P0[2],P0[3],P0[4],P0[5],     pw0[0]=PKW(P0,0), pw0[1]=PKW(P0,2), pw0); \
    VRD(4); SBAR(); GAPA(C1=__builtin_amdgcn_mfma_f32_32x32x16_bf16(kf[1],qr[0],C1,0,0,0), P0[6],P0[7],P0[8],P0[9],     pw0[2]=PKW(P0,4), pw0[3]=PKW(P0,6), pw0); \
    VRD(1); SBAR(); GAPA(C0=__builtin_amdgcn_mfma_f32_32x32x16_bf16(kf[2],qr[1],C0,0,0,0),   P0[10],P0[11],P0[12],P0[13], pw1[0]=PKW(P0,8), pw1[1]=PKW(P0,10), pw1); \
    VRD(5); SBAR(); GAPA(C1=__builtin_amdgcn_mfma_f32_32x32x16_bf16(kf[3],qr[1],C1,0,0,0),   P0[14],P0[15],P1[0],P1[1],   pw1[2]=PKW(P0,12),pw1[3]=PKW(P0,14), pw1); \
    VRD(2); SBAR(); GAPA(C0=__builtin_amdgcn_mfma_f32_32x32x16_bf16(kf[4],qr[2],C0,0,0,0),   P1[2],P1[3],P1[4],P1[5],     pw2[0]=PKW(P1,0), pw2[1]=PKW(P1,2), pw2); \
    VRD(6); SBAR(); GAPA(C1=__builtin_amdgcn_mfma_f32_32x32x16_bf16(kf[5],qr[2],C1,0,0,0),   P1[6],P1[7],P1[8],P1[9],     pw2[2]=PKW(P1,4), pw2[3]=PKW(P1,6), pw2); \
    VRD(3); SBAR(); GAPA(C0=__builtin_amdgcn_mfma_f32_32x32x16_bf16(kf[6],qr[3],C0,0,0,0),   P1[10],P1[11],P1[12],P1[13], pw3[0]=PKW(P1,8), pw3[1]=PKW(P1,10), pw3); \
    VRD(7); SBAR(); GAPA(C1=__builtin_amdgcn_mfma_f32_32x32x16_bf16(kf[7],qr[3],C1,0,0,0),   P1[14],P1[15],0.f,0.f,       pw3[2]=PKW(P1,12),pw3[3]=PKW(P1,14), pw3); \
    l_reg+=sacc; \
    if(GK){DMA_K((t)+3,sl_cur);} if(GV){DMA_V((t)+1,sl_next);} \
    CMASK(C0,C1,t); \
    { float a=MX3(C0[0],C0[1],C1[0]),b=MX3(C0[2],C0[3],C1[1]); a=MX3(a,C1[2],C1[3]); \
      _Pragma("unroll") for(int r=4;r<16;r+=4){a=MX3(a,C0[r],C0[r+1]);b=MX3(b,C0[r+2],C0[r+3]);a=MX3(a,C1[r],C1[r+1]);b=MX3(b,C1[r+2],C1[r+3]);} \
      float rm=__builtin_fmaxf(a,b); { auto rr=__builtin_amdgcn_permlane32_swap(__float_as_uint(rm),__float_as_uint(rm),false,false); rm=__builtin_fmaxf(__uint_as_float(rr[0]),__uint_as_float(rr[1])); } \
      resc=false; \
      if(__builtin_expect(__any(rm>(float)THRL),0)){ const float dl=__builtin_fmaxf(rm,0.f); mhat+=dl; \
        _Pragma("unroll") for(int r=0;r<16;++r){C0[r]-=dl;C1[r]-=dl;} \
        const float f=__builtin_amdgcn_exp2f(-dl); l_reg*=f; if(hi==0)wsf[r32]=f; resc=true; } } \
    SBAR(); \
    GAPB(o[0]=__builtin_amdgcn_mfma_f32_32x32x16_bf16(PAF(0),VFR(0),o[0],0,0,0), C0,0); \
    GAPB(o[1]=__builtin_amdgcn_mfma_f32_32x32x16_bf16(PAF(0),VFR(4),o[1],0,0,0), C0,4); \
    KRD(GL,0); GAPB(o[0]=__builtin_amdgcn_mfma_f32_32x32x16_bf16(PAF(1),VFR(1),o[0],0,0,0), C0,8); \
    KRD(GL,1); GAPB(o[1]=__builtin_amdgcn_mfma_f32_32x32x16_bf16(PAF(1),VFR(5),o[1],0,0,0), C0,12); \
    KRD(GL,2); GAPB(o[0]=__builtin_amdgcn_mfma_f32_32x32x16_bf16(PAF(2),VFR(2),o[0],0,0,0), C1,0); \
    KRD(GL,3); GAPB(o[1]=__builtin_amdgcn_mfma_f32_32x32x16_bf16(PAF(2),VFR(6),o[1],0,0,0), C1,4); \
    GAPB(o[0]=__builtin_amdgcn_mfma_f32_32x32x16_bf16(PAF(3),VFR(3),o[0],0,0,0), C1,8); \
    GAPB(o[1]=__builtin_amdgcn_mfma_f32_32x32x16_bf16(PAF(3),VFR(7),o[1],0,0,0), C1,12); \
    }while(0)
  int t=1;
  #undef CMASK
  #define CMASK(P0,P1,t) do{}while(0)
  for(;t+5<NT;t+=2){
    STEP(pB0,pB1,pA0,pA1,t,true,true,true);     WAIT_BAR(2); RESC(); ROT();
    STEP(pA0,pA1,pB0,pB1,t+1,true,true,true);   WAIT_BAR(2); RESC(); ROT();
  }
  #undef CMASK
  #define CMASK(P0,P1,t) do{int jb_=(t)-(NT-4); if(jb_>=0)cmask(P0,P1,jb_,qrel,hi);}while(0)
  #define ENDW(tt) do{ if((tt)+3<NT){WAIT_BAR(2);} else if((tt)+2<NT){WAIT_BAR(1);} else {WAIT_BAR(0);} }while(0)
  for(;t+1<NT;t+=2){
    STEP(pB0,pB1,pA0,pA1,t,(t+3<NT),(t+1<NT),(t+1<NT));       ENDW(t);   RESC(); ROT();
    STEP(pA0,pA1,pB0,pB1,t+1,(t+4<NT),(t+2<NT),(t+2<NT));     ENDW(t+1); RESC(); ROT();
  }
  STEP(pB0,pB1,pA0,pA1,NT-1,false,false,false); RESC();
  { float sacc=pB0[0]+pB0[1]; _Pragma("unroll") for(int r=2;r<16;++r)sacc+=pB0[r]; _Pragma("unroll") for(int r=0;r<16;++r)sacc+=pB1[r]; l_reg+=sacc;
    pw0=(u32x4){PKW(pB0,0),PKW(pB0,2),PKW(pB0,4),PKW(pB0,6)};pw1=(u32x4){PKW(pB0,8),PKW(pB0,10),PKW(pB0,12),PKW(pB0,14)};pw2=(u32x4){PKW(pB1,0),PKW(pB1,2),PKW(pB1,4),PKW(pB1,6)};pw3=(u32x4){PKW(pB1,8),PKW(pB1,10),PKW(pB1,12),PKW(pB1,14)};
    SBAR(); pv(o,vb0+sl_cur,PAF(0),PAF(1),PAF(2),PAF(3)); }
  #undef PKW
  #undef PAF
  #undef VFR
  #undef PIN
  #undef MX3
  #undef GAPA
  #undef GAPB
  #undef EX
  #undef VRD
  #undef KRD
  #undef STEP
  #undef ENDW
  {auto rr=__builtin_amdgcn_permlane32_swap(__float_as_uint(l_reg),__float_as_uint(l_reg),false,false);l_reg=__uint_as_float(rr[0])+__uint_as_float(rr[1]);}
  if(hi==0)wsf[32+r32]=l_reg;asm volatile("s_waitcnt lgkmcnt(0)":::"memory");
  float rli[16];
  #pragma unroll
  for(int r=0;r<16;++r)rli[r]=__builtin_amdgcn_rcpf(wsf[32+crow(r,hi)]);
  bf16*Ow=O+(rowbase+q0+wid*QBLK)*DM+h*D;
  { bf16*stg=(bf16*)(shm+LDS_OST)+wid*2048;
    #pragma unroll
    for(int r=0;r<16;++r){const int orow=crow(r,hi);
      #pragma unroll
      for(int d0=0;d0<2;++d0)stg[orow*64+d0*32+r32]=__float2bfloat16(o[d0][r]*rli[r]);}
    asm volatile("s_waitcnt lgkmcnt(0)":::"memory");
    #pragma unroll
    for(int i=0;i<4;++i){const int row=i*8+(lane>>3),ch=lane&7; const u32x4 v=*(const u32x4*)(stg+row*64+ch*8); ATTN_STORE16(Ow+(long)row*DM+ch*8,v);} }
  asm volatile("s_waitcnt lgkmcnt(0)\n\ts_barrier":::"memory");
  #undef DMA_K
  #undef DMA_V
  #undef CMASK
  #undef START
  #undef RESC
  #undef ROT
}
constexpr int ATTN_LDS_BYTES=LDS_BYTES;
struct AttnTensors { const bf16* Q; const bf16* K; const bf16* V; bf16* O; const float* cum; };
struct AttnUnit { int bh; int qb; };
struct StaticOrder {
  int vcu;
  __device__ __forceinline__ explicit StaticOrder(int grid,int block):vcu((block%8)*(grid/8)+block/8){}
  __device__ __forceinline__ bool next(int i,AttnUnit&u)const{ if(i>=4||vcu>=256)return false; const int s=vcu&3; u.bh=(vcu>>5)*NHEAD+((((vcu>>2)&7)+2*i)&7); u.qb=(i==0)?s:(i==1)?7-s:(i==2)?8+s:15-s; return true; }
  __device__ __forceinline__ void a_ready(const AttnUnit&)const{}
  __device__ __forceinline__ void done(const AttnUnit&)const{}
};
struct QueueOrder {
  unsigned* q; volatile __attribute__((address_space(3))) int* slot;
  __device__ __forceinline__ bool next(int,AttnUnit&u)const{
    if(threadIdx.x==0)slot[0]=(int)__hip_atomic_fetch_add(q,1u,__ATOMIC_RELAXED,__HIP_MEMORY_SCOPE_AGENT);
    asm volatile("s_waitcnt vmcnt(0) lgkmcnt(0)\n\ts_barrier":::"memory");
    const int v=__builtin_amdgcn_readfirstlane(slot[0]);
    asm volatile("s_waitcnt lgkmcnt(0)\n\ts_barrier":::"memory");
    if(v>=128)return false; u.qb=15-(v>>3); u.bh=7-(v&7); return true; }
  __device__ __forceinline__ void a_ready(const AttnUnit&)const{}
  __device__ __forceinline__ void done(const AttnUnit&)const{}
};
template<class Sched,int THRL=8> __device__ __forceinline__ void attn_phase(char*lds,const AttnTensors&T,const Sched&S){
  AttnUnit u;
  for(int i=0;S.next(i,u);++i){ S.a_ready(u); attn_unit<THRL>(u.bh/NHEAD,u.bh%NHEAD,u.qb,T.Q,T.K,T.V,T.O,T.cum,lds); S.done(u); }
}
#undef SBAR
#undef WAIT_BAR
}
constexpr int NWAVES = 8;
constexpr int RING_BYTES = 131072;
constexpr int LDSCTL_BYTES = 4096, RING_OFF = LDSCTL_BYTES;
constexpr int LDS_BYTES = 147456;
constexpr int CW_BAR = 4096;
typedef __attribute__((address_space(1))) unsigned gu32;

#define XB_TMO      128
#define XB_XCNT(j)  (256  + 64 * (j))
#define XB_XSUB(j)  (1280 + 64 * (j))
#define XB_XGEN(j)  (2304 + 64 * (j))
#define XB_TOP      3328
#define XB_TOPGEN   3392
#define XCD_BAR_WORDS 3456
#define XB_SPIN_CAP (1u << 18)
__device__ __forceinline__ unsigned xb_ld(unsigned* p)              { return __hip_atomic_load(p, __ATOMIC_RELAXED, __HIP_MEMORY_SCOPE_AGENT); }
__device__ __forceinline__ unsigned xb_add(unsigned* p, unsigned v) { return __hip_atomic_fetch_add(p, v, __ATOMIC_RELAXED, __HIP_MEMORY_SCOPE_AGENT); }
__device__ __forceinline__ unsigned xb_xcc_id() { return (unsigned)__builtin_amdgcn_s_getreg((3 << 11) | 20) & 0xFu; }
#define XB_SPIN(cond, bar) do { unsigned _sp = 0; while (cond) { __builtin_amdgcn_s_sleep(1); \
    if ((++_sp & 255u) == 0u) { if (xb_ld(&(bar)[XB_TMO])) break; if (_sp > XB_SPIN_CAP) { atomicAdd(&(bar)[XB_TMO], 1u); break; } } } } while (0)
struct XcdBarrier { unsigned* bar; unsigned x; volatile LAS unsigned* st; };
__device__ __forceinline__ XcdBarrier xcd_barrier_post(unsigned* bar, volatile LAS unsigned* st) {
    XcdBarrier b; b.bar = bar; b.x = xb_xcc_id(); b.st = st;
    if (threadIdx.x == 0) (void)xb_add(&bar[XB_XCNT(b.x)], 1u);
    return b;
}
__device__ __forceinline__ void xcd_barrier_complete(unsigned* bar, unsigned x, unsigned& nloc, unsigned& nx) {
    const unsigned G = gridDim.x * gridDim.y * gridDim.z;
    unsigned sum, cnt, mine, sp = 0u;
    for (;;) {
        sum = 0u; cnt = 0u; mine = 0u;
#pragma unroll
        for (unsigned j = 0; j < 16; ++j) { const unsigned c = xb_ld(&bar[XB_XCNT(j)]); sum += c; cnt += (c > 0u) ? 1u : 0u; mine = (j == x) ? c : mine; }
        if (sum == G) break;
        __builtin_amdgcn_s_sleep(1);
        if ((++sp & 255u) == 0u) { if (xb_ld(&bar[XB_TMO])) break; if (sp > XB_SPIN_CAP) { atomicAdd(&bar[XB_TMO], 1u); break; } }
    }
    nloc = mine > 0u ? mine : 1u; nx = cnt > 0u ? cnt : 1u;
}
__device__ __forceinline__ void xcd_barrier(const XcdBarrier& b) {
    asm volatile("s_waitcnt vmcnt(0)" ::: "memory");
    __syncthreads();
    if (threadIdx.x == 0) {
        unsigned* bar = b.bar;
        __builtin_amdgcn_s_waitcnt(0);
        unsigned nloc = b.st[0], nx = b.st[1];
        if (nloc == 0u) { xcd_barrier_complete(bar, b.x, nloc, nx); b.st[0] = nloc; b.st[1] = nx; }
        const unsigned old = xb_add(&bar[XB_XSUB(b.x)], 1u);
        const unsigned gen = old / nloc;
        if (old + 1u == (gen + 1u) * nloc) {
            __builtin_amdgcn_fence(__ATOMIC_RELEASE, "agent");
            asm volatile("s_waitcnt vmcnt(0)" ::: "memory");
            const unsigned og = xb_add(&bar[XB_TOP], 1u);
            const unsigned tg = og / nx;
            if (og + 1u == (tg + 1u) * nx) xb_add(&bar[XB_TOPGEN], 1u);
            else XB_SPIN(xb_ld(&bar[XB_TOPGEN]) == tg, bar);
            __builtin_amdgcn_fence(__ATOMIC_ACQUIRE, "agent");
            xb_add(&bar[XB_XGEN(b.x)], 1u);
            asm volatile("s_waitcnt vmcnt(0)" ::: "memory");
        } else {
            XB_SPIN(xb_ld(&bar[XB_XGEN(b.x)]) == gen, bar);
            __builtin_amdgcn_fence(__ATOMIC_ACQUIRE, "agent");
            asm volatile("s_waitcnt vmcnt(0)" ::: "memory");
        }
    }
    __syncthreads();
}

struct MoeOrder {
    const volatile LAS int* tpre; const unsigned* cnt; const int* tok; const char* A; const char* B; size_t estepB, tstepB, tstepA; int nN, G, c, lda; bool gather;
    int r0x;
    __device__ __forceinline__ bool unit_at(int mt, int pn, pg8::Unit& u) const {
        if (mt >= tpre[32]) return false;
        const int e = __builtin_amdgcn_readfirstlane((int)((volatile LAS unsigned char*)(tpre + 96))[mt]);
        const int lt = __builtin_amdgcn_readfirstlane(mt - tpre[e]);
        const int rem = tpre[33 + e] - lt * 256;
        u.e = e; u.pm = mt; u.pn = pn; u.valid = rem < 256 ? rem : 256; u.lt = lt; u.lda = 1024; u.ldb = 1024; u.nt = 16; u.seg = 0;
        u.B = B + (size_t)e * estepB + (size_t)pn * tstepB;
        u.A = gather ? A : A + (size_t)mt * tstepA;
        return true;
    }
    __device__ __forceinline__ bool next(int i, pg8::Unit& u) const {
        const int x = c & 7, j = c >> 3, per = (G >> 3) / nN, pn = j % nN; int mt = (i * 8 + x) * per + j / nN;
        if (r0x >= 0) { const int k = r0x + 1; mt = mt < k ? mt : (mt < 2 * k ? 32 + (mt - k) : 64 + (mt - 2 * k)); }
        return unit_at(mt, pn, u);
    }
    __device__ __forceinline__ void goff(const pg8::Unit& u, int R0, int C0, unsigned (&off)[2][2]) const {
#pragma unroll
        for (int h = 0; h < 2; ++h)
#pragma unroll
            for (int i = 0; i < 2; ++i) { const int r = h * 128 + R0 + 64 * i; const int t = r < u.valid ? tok[(size_t)u.e * NTOK + u.lt * 256 + r] : 0; off[h][i] = (unsigned)(t * lda + C0) * 2u; }
    }
};
struct MoeOne { MoeOrder M; int mt, pn;
    __device__ __forceinline__ bool next(int i, pg8::Unit& u) const { if (i) return false; return M.unit_at(mt, pn, u); }
    __device__ __forceinline__ void goff(const pg8::Unit& u, int R0, int C0, unsigned (&off)[2][2]) const { M.goff(u, R0, C0, off); }
};
__device__ __forceinline__ void moe_prefix(const unsigned* cnt, volatile LAS int* tpre) {
    int tid = threadIdx.x; asm volatile("" : "+v"(tid));
    if (tid < 64) { const int c = tid < 32 ? (int)cnt[tid * CNT_STRIDE] : 0; const int tl = (c + 255) >> 8; int inc = tl;
#pragma unroll
        for (int o = 1; o < 32; o <<= 1) { const int t = __shfl_up(inc, o); if (tid >= o) inc += t; }
        if (tid < 32) { tpre[tid] = inc - tl; tpre[33 + tid] = c; if (tid == 31) tpre[32] = inc; } }
    __syncthreads();
    { volatile LAS unsigned char* tmap = (volatile LAS unsigned char*)(tpre + 96);
      const int tot = tpre[32];
      for (int mt = tid; mt < tot; mt += NWAVES * 64) { int e = 0;
#pragma unroll
          for (int k = 1; k < 32; ++k) e += (tpre[k] <= mt) ? 1 : 0;
          tmap[mt] = (unsigned char)e; } }
    __syncthreads();
}

constexpr size_t WS_S5W1 = 58 * MiB;
constexpr size_t WS_S5W3 = 66 * MiB;
constexpr size_t WS_S5A16 = 78 * MiB;
constexpr size_t WS_S5S = 2304 * MiB;
constexpr size_t WS_OB = 2320 * MiB;
constexpr size_t WS_GQ = 2640 * MiB;
constexpr size_t WS_END2 = 2736 * MiB;

struct S5Disc { float lr, li, dt, zr, zi; };
__device__ __forceinline__ S5Disc s5_disc(const float* lam_re, const float* lam_im, const float* log_dt, int g, int p) {
    S5Disc d; d.dt = expf(log_dt[g]); d.lr = lam_re[g * 64 + p]; d.li = lam_im[g * 64 + p];
    const float mag = expf(d.lr * d.dt), ar = mag * cosf(d.li * d.dt), ai = mag * sinf(d.li * d.dt), den = d.lr * d.lr + d.li * d.li, nr = ar - 1.0f;
    d.zr = (nr * d.lr + ai * d.li) / den; d.zi = (ai * d.lr - nr * d.li) / den; return d;
}
__device__ __forceinline__ void s5_apow(const S5Disc& d, float n, float& pr, float& pi) { const float mag = expf(d.lr * d.dt * n); pr = mag * cosf(d.li * d.dt * n); pi = mag * sinf(d.li * d.dt * n); }

struct S5In { const float *lam_re, *lam_im, *log_dt, *b_re, *b_im, *c_re, *c_im, *dsk; };
__device__ __forceinline__ void s5_prep_item(const S5In& in, unsigned char* ws, int l, int g, int kind, int q, int lane) {
    const float* lam_re = in.lam_re + (size_t)l * 1024; const float* lam_im = in.lam_im + (size_t)l * 1024; const float* log_dt = in.log_dt + (size_t)l * 16;
    const float* b_re = in.b_re + (size_t)l * 16384; const float* b_im = in.b_im + (size_t)l * 16384; const float* c_re = in.c_re + (size_t)l * 16384; const float* c_im = in.c_im + (size_t)l * 16384;
    const float* dsk = in.dsk + (size_t)l * 256;
    bf16_t* W1 = (bf16_t*)(ws + WS_S5W1) + ((size_t)l * 16 + g) * 256 * 256;
    bf16_t* W3 = (bf16_t*)(ws + WS_S5W3) + ((size_t)l * 16 + g) * 256 * 384;
    const int p = lane;
    const S5Disc d = s5_disc(lam_re, lam_im, log_dt, g, p);
    if (kind == 0) {
        float pr, pi; s5_apow(d, (float)q, pr, pi);
        float mr[16], mi[16];
#pragma unroll
        for (int h = 0; h < 16; ++h) { const float br = b_re[(g * 64 + p) * 16 + h], bi = b_im[(g * 64 + p) * 16 + h]; const float bbr = d.zr * br - d.zi * bi, bbi = d.zr * bi + d.zi * br;
            mr[h] = pr * bbr - pi * bbi; mi[h] = pr * bbi + pi * bbr; }
        float crv[16], civ[16];
#pragma unroll
        for (int hp = 0; hp < 16; ++hp) { crv[hp] = c_re[(g * 16 + hp) * 64 + p]; civ[hp] = c_im[(g * 16 + hp) * 64 + p]; }
#pragma unroll
        for (int hp = 0; hp < 16; ++hp) {
            const float cr = crv[hp], ci = civ[hp];
            float v[16];
#pragma unroll
            for (int h = 0; h < 16; ++h) v[h] = cr * mr[h] - ci * mi[h];
            reduce_scatter<16>(v, lane);
            const int h = (lane >> 2) & 15;
            float kv = v[0]; if (q == 0 && h == hp) kv += dsk[g * 16 + hp];
            const bf16_t kb = f2bf(kv);
            for (int s = (lane & 3); s + q < 16; s += 4) { const int t = s + q;
                W3[(size_t)(t * 16 + hp) * 384 + s * 16 + h] = kb;
                if (q > 0) W3[(size_t)(s * 16 + hp) * 384 + t * 16 + h] = 0; }
        }
    } else if (kind == 1) {
        float pr, pi; s5_apow(d, (float)(15 - q), pr, pi);
        u32x4 wr0, wr1, wi0, wi1; unsigned wr_[8], wi_[8];
#pragma unroll
        for (int h2 = 0; h2 < 8; ++h2) { float re[2], im[2];
#pragma unroll
            for (int e = 0; e < 2; ++e) { const int h = 2 * h2 + e; const float br = b_re[(g * 64 + p) * 16 + h], bi = b_im[(g * 64 + p) * 16 + h]; const float bbr = d.zr * br - d.zi * bi, bbi = d.zr * bi + d.zi * br;
                re[e] = pr * bbr - pi * bbi; im[e] = pr * bbi + pi * bbr; }
            wr_[h2] = pk2(re[0], re[1]); wi_[h2] = pk2(im[0], im[1]); }
        wr0 = (u32x4){wr_[0], wr_[1], wr_[2], wr_[3]}; wr1 = (u32x4){wr_[4], wr_[5], wr_[6], wr_[7]}; wi0 = (u32x4){wi_[0], wi_[1], wi_[2], wi_[3]}; wi1 = (u32x4){wi_[4], wi_[5], wi_[6], wi_[7]};
        *(u32x4*)(W1 + (size_t)p * 256 + q * 16) = wr0; *(u32x4*)(W1 + (size_t)p * 256 + q * 16 + 8) = wr1;
        *(u32x4*)(W1 + (size_t)(64 + p) * 256 + q * 16) = wi0; *(u32x4*)(W1 + (size_t)(64 + p) * 256 + q * 16 + 8) = wi1;
        const u32x4 z = (u32x4){0u, 0u, 0u, 0u};
        *(u32x4*)(W1 + (size_t)(128 + p) * 256 + q * 16) = z; *(u32x4*)(W1 + (size_t)(128 + p) * 256 + q * 16 + 8) = z;
        *(u32x4*)(W1 + (size_t)(192 + p) * 256 + q * 16) = z; *(u32x4*)(W1 + (size_t)(192 + p) * 256 + q * 16 + 8) = z;
    } else {
        float pr, pi; s5_apow(d, (float)(q + 1), pr, pi);
#pragma unroll
        for (int hp = 0; hp < 16; ++hp) { const float cr = c_re[(g * 16 + hp) * 64 + p], ci = c_im[(g * 16 + hp) * 64 + p];
            W3[(size_t)(q * 16 + hp) * 384 + 256 + p] = f2bf(cr * pr - ci * pi);
            W3[(size_t)(q * 16 + hp) * 384 + 320 + p] = f2bf(-(cr * pi + ci * pr)); }
        if (q == 0) { float ar, ai; s5_apow(d, 16.0f, ar, ai); float* A16 = (float*)(ws + WS_S5A16) + (((size_t)l * 16 + g) * 64 + p) * 2; A16[0] = ar; A16[1] = ai; }
    }
}

__device__ __forceinline__ void s5_scan_wg(const float* S, const float* a16, bf16_t* A3, int b, int g, LAS float* sl) {
    int tid = threadIdx.x; asm volatile("" : "+v"(tid));
    const f32x4* src = (const f32x4*)(S + ((size_t)g * 2048 + b * 256) * 128);
#pragma unroll 1
    for (int i0 = tid; i0 < 8192; i0 += 8 * NWAVES * 64) { f32x4 w[8];
#pragma unroll
        for (int u = 0; u < 8; ++u) w[u] = src[i0 + u * NWAVES * 64];
#pragma unroll
        for (int u = 0; u < 8; ++u) *(LAS f32x4*)(sl + 4 * (i0 + u * NWAVES * 64)) = w[u]; }
    __syncthreads();
    if (tid < 64) {
        const int lane = tid; const float ar = a16[(g * 64 + lane) * 2], ai = a16[(g * 64 + lane) * 2 + 1];
        bf16_t* hp = A3 + ((size_t)g * 2048 + b * 256) * 384 + 256 + lane;
        float hr = 0.f, hi = 0.f;
#pragma unroll 8
        for (int c = 0; c < 256; ++c) { const float sr = sl[c * 128 + lane], si = sl[c * 128 + 64 + lane];
            hp[(size_t)c * 384] = f2bf(hr); hp[(size_t)c * 384 + 64] = f2bf(hi);
            const float nr = ar * hr - ai * hi + sr, ni = ar * hi + ai * hr + si; hr = nr; hi = ni; }
        asm volatile("s_waitcnt vmcnt(0)" ::: "memory");
        __builtin_amdgcn_fence(__ATOMIC_ACQUIRE, "agent");
        asm volatile("s_waitcnt vmcnt(0)" ::: "memory");
    }
    __syncthreads();
}

typedef float f32x16p __attribute__((ext_vector_type(16)));
__device__ __forceinline__ void pool_phase(const bf16_t* H, const float* wpool, const float* pscale, bf16_t* yb, int bx, int G, LAS unsigned char* lds) {
    int tid = threadIdx.x; asm volatile("" : "+v"(tid));
    const int lane = tid & 63, w8 = tid >> 6, g = w8 >> 1, tb = (w8 & 1) * 32, r = lane & 31, hi = lane >> 5;
    LAS bf16_t* ut = (LAS bf16_t*)lds; LAS bf16_t* mxb = (LAS bf16_t*)(lds + 79 * 512);
    bf16x8 wf[4][2]; float ps[2];
#pragma unroll
    for (int ks = 0; ks < 4; ++ks)
#pragma unroll
        for (int cb = 0; cb < 2; ++cb) { unsigned pk[4];
#pragma unroll
            for (int j2 = 0; j2 < 4; ++j2) { const float a = wpool[(g * 64 + 16 * ks + 8 * hi + 2 * j2) * 64 + 32 * cb + r], b = wpool[(g * 64 + 16 * ks + 8 * hi + 2 * j2 + 1) * 64 + 32 * cb + r]; pk[j2] = pk2(a, b); }
            wf[ks][cb] = __builtin_bit_cast(bf16x8, (u32x4){pk[0], pk[1], pk[2], pk[3]}); }
    ps[0] = pscale[g * 64 + r]; ps[1] = pscale[g * 64 + 32 + r];
    u32x4 wn[5];
#pragma unroll
    for (int u = 0; u < 5; ++u) { const int c = tid + u * NWAVES * 64; const int rr = c >> 5, ch8 = (c & 31) * 8; const int tok = bx * 64 - 15 + rr; wn[u] = (u32x4){0u, 0u, 0u, 0u}; if (bx < NTOK / 64 && c < 79 * 32 && tok >= 0) wn[u] = *(const GAS u32x4*)((const GAS bf16_t*)H + (size_t)tok * HP + HC_POOL + ch8); }
    for (int item = bx; item < NTOK / 64; item += G) {
        const int t0 = item * 64;
        {
#pragma unroll
          for (int u = 0; u < 5; ++u) { const int c = tid + u * NWAVES * 64; if (c < 79 * 32) *(LAS u32x4*)(ut + (c >> 5) * 256 + (c & 31) * 8) = wn[u]; }
          const int t1 = (item + G) * 64;
#pragma unroll
          for (int u = 0; u < 5; ++u) { const int c = tid + u * NWAVES * 64; const int rr = c >> 5, ch8 = (c & 31) * 8; const int tok = t1 - 15 + rr; wn[u] = (u32x4){0u, 0u, 0u, 0u}; if (item + G < NTOK / 64 && c < 79 * 32 && tok >= 0) wn[u] = *(const GAS u32x4*)((const GAS bf16_t*)H + (size_t)tok * HP + HC_POOL + ch8); } }
        __syncthreads();
        { const int ch = tid & 255, half = tid >> 8, gg = ch >> 6, w = 2 << gg, l0 = half * 32, tf = (t0 + l0) & (SEQ - 1);
          float s = 0.f;
          for (int k = 1; k < w; ++k) if (tf - k >= 0) s += bf2f(ut[(15 + l0 - k) * 256 + ch]);
#pragma unroll 4
          for (int q = 0; q < 32; ++q) { const int lt = l0 + q, t = tf + q; const float u = bf2f(ut[(15 + lt) * 256 + ch]);
              s += u; if (q > 0 && t >= w) s -= bf2f(ut[(15 + lt - w) * 256 + ch]);
              const int cnt = (t + 1 < w) ? t + 1 : w;
              mxb[lt * 264 + ch] = f2bf(s * __builtin_amdgcn_rcpf((float)cnt) - u); } }
        __syncthreads();
        f32x16p acc[2];
#pragma unroll
        for (int cb = 0; cb < 2; ++cb)
#pragma unroll
            for (int q = 0; q < 16; ++q) acc[cb][q] = 0.f;
#pragma unroll
        for (int ks = 0; ks < 4; ++ks) { const bf16x8 a = *(const LAS bf16x8*)(mxb + (tb + r) * 264 + g * 64 + 16 * ks + 8 * hi);
            acc[0] = __builtin_amdgcn_mfma_f32_32x32x16_bf16(a, wf[ks][0], acc[0], 0, 0, 0); acc[1] = __builtin_amdgcn_mfma_f32_32x32x16_bf16(a, wf[ks][1], acc[1], 0, 0, 0); }
#pragma unroll
        for (int cb = 0; cb < 2; ++cb)
#pragma unroll
            for (int q = 0; q < 16; ++q) { const int tok = t0 + tb + (q & 3) + 8 * (q >> 2) + 4 * hi; yb[(size_t)tok * 256 + g * 64 + 32 * cb + r] = f2bf(acc[cb][q] * ps[cb]); }
        __syncthreads();
    }
}

constexpr int WT_PITCH = 1028;
__device__ __forceinline__ void load_wt_lds(const float* W, int ldw, int ne, volatile LAS float* Tv) {
    int tid0 = threadIdx.x; asm volatile("" : "+v"(tid0));
    LAS float* T = (LAS float*)Tv; const int q = ne >> 2, tot = 1024 * q;
    for (int base = tid0; base < tot; base += 8 * NWAVES * 64) {
        f32x4 w[8];
#pragma unroll
        for (int u = 0; u < 8; ++u) { const int idx = base + u * NWAVES * 64; if (idx < tot) { const int k = idx / q, e4 = (idx - k * q) * 4; w[u] = *(const f32x4*)(W + (size_t)k * ldw + e4); } }
#pragma unroll
        for (int u = 0; u < 8; ++u) { const int idx = base + u * NWAVES * 64; if (idx < tot) { const int k = idx / q, e4 = (idx - k * q) * 4;
            T[(e4 + 0) * WT_PITCH + k] = w[u].x; T[(e4 + 1) * WT_PITCH + k] = w[u].y; T[(e4 + 2) * WT_PITCH + k] = w[u].z; T[(e4 + 3) * WT_PITCH + k] = w[u].w; } }
    }
    __syncthreads();
}
__device__ __forceinline__ void wave_sum2(float& a, float& b) {
#pragma unroll
    for (int o = 1; o < 64; o <<= 1) { const float ta = __shfl_xor(a, o), tb = __shfl_xor(b, o); a += ta; b += tb; } }
__device__ __forceinline__ void wave_max2(float a, float b, float& ra, float& rb) {
#pragma unroll
    for (int o = 32; o >= 1; o >>= 1) { const float ta = __shfl_xor(a, o), tb = __shfl_xor(b, o); a = fmaxf(a, ta); b = fmaxf(b, tb); }
    ra = a; rb = b; }
__device__ __forceinline__ void wave_min2(int a, int b, int& ra, int& rb) {
#pragma unroll
    for (int o = 32; o >= 1; o >>= 1) { const int ta = __shfl_xor(a, o), tb = __shfl_xor(b, o); a = ta < a ? ta : a; b = tb < b ? tb : b; }
    ra = a; rb = b; }
__device__ __forceinline__ void row_ln2(f32x4 (&v)[4], f32x4 (&w)[4], const float* g, const float* bta, int lane) {
    f32x4 gg[4], bb[4];
#pragma unroll
    for (int j = 0; j < 4; ++j) { gg[j] = *(const GAS f32x4*)((const GAS float*)g + 4 * (lane + 64 * j)); bb[j] = *(const GAS f32x4*)((const GAS float*)bta + 4 * (lane + 64 * j)); }
    float s = 0.f, t = 0.f;
#pragma unroll
    for (int j = 0; j < 4; ++j) { s += (v[j].x + v[j].y) + (v[j].z + v[j].w); t += (w[j].x + w[j].y) + (w[j].z + w[j].w); }
    wave_sum2(s, t); const float mv = s * (1.f / D), mw = t * (1.f / D); float s2 = 0.f, t2 = 0.f;
#pragma unroll
    for (int j = 0; j < 4; ++j) { v[j] = v[j] - mv; w[j] = w[j] - mw; s2 += (v[j].x * v[j].x + v[j].y * v[j].y) + (v[j].z * v[j].z + v[j].w * v[j].w); t2 += (w[j].x * w[j].x + w[j].y * w[j].y) + (w[j].z * w[j].z + w[j].w * w[j].w); }
    wave_sum2(s2, t2); const float rv = __builtin_amdgcn_rsqf(s2 * (1.f / D) + LN_EPS), rw = __builtin_amdgcn_rsqf(t2 * (1.f / D) + LN_EPS);
#pragma unroll
    for (int j = 0; j < 4; ++j) { v[j] = v[j] * rv * gg[j] + bb[j]; w[j] = w[j] * rw * gg[j] + bb[j]; }
}
__device__ __forceinline__ void row_ln2s(f32x4 (&v)[4], f32x4 (&w)[4], const float* g, const float* bta, int lane, float& mv, float& rv, float& mw, float& rw) {
    f32x4 gg[4], bb[4];
#pragma unroll
    for (int j = 0; j < 4; ++j) { gg[j] = *(const GAS f32x4*)((const GAS float*)g + 4 * (lane + 64 * j)); bb[j] = *(const GAS f32x4*)((const GAS float*)bta + 4 * (lane + 64 * j)); }
    float s = 0.f, t = 0.f;
#pragma unroll
    for (int j = 0; j < 4; ++j) { s += (v[j].x + v[j].y) + (v[j].z + v[j].w); t += (w[j].x + w[j].y) + (w[j].z + w[j].w); }
    wave_sum2(s, t); mv = s * (1.f / D); mw = t * (1.f / D); float s2 = 0.f, t2 = 0.f;
#pragma unroll
    for (int j = 0; j < 4; ++j) { v[j] = v[j] - mv; w[j] = w[j] - mw; s2 += (v[j].x * v[j].x + v[j].y * v[j].y) + (v[j].z * v[j].z + v[j].w * v[j].w); t2 += (w[j].x * w[j].x + w[j].y * w[j].y) + (w[j].z * w[j].z + w[j].w * w[j].w); }
    wave_sum2(s2, t2); rv = __builtin_amdgcn_rsqf(s2 * (1.f / D) + LN_EPS); rw = __builtin_amdgcn_rsqf(t2 * (1.f / D) + LN_EPS);
#pragma unroll
    for (int j = 0; j < 4; ++j) { v[j] = v[j] * rv * gg[j] + bb[j]; w[j] = w[j] * rw * gg[j] + bb[j]; }
}
template <int N> __device__ __forceinline__ void reduce_scatter2(float (&v)[N], float (&w)[N], int lane) {
    int s = 32;
#pragma unroll
    for (int n = N / 2; n >= 1; n >>= 1) {
        const bool up = (lane & s) != 0;
#pragma unroll
        for (int i = 0; i < n; ++i) { float hi = v[i + n], lo = v[i], hj = w[i + n], lj = w[i]; asm volatile("" : "+v"(hi), "+v"(lo), "+v"(hj), "+v"(lj));
            const float kv = up ? hi : lo, sv = up ? lo : hi, kw = up ? hj : lj, sw = up ? lj : hj; v[i] = kv + __shfl_xor(sv, s); w[i] = kw + __shfl_xor(sw, s); }
        s >>= 1;
    }
    for (; s >= 1; s >>= 1) { const float ta = __shfl_xor(v[0], s), tb = __shfl_xor(w[0], s); v[0] += ta; w[0] += tb; }
}
template <int NEX> __device__ __forceinline__ void row_dot2_lds(const f32x4 (&v0)[4], const f32x4 (&v1)[4], const LAS float* T, float (&a0)[NEX], float (&a1)[NEX], int lane) {
#pragma unroll
    for (int e = 0; e < NEX; ++e) { f32x2 p0 = (f32x2){0.f, 0.f}, p1 = (f32x2){0.f, 0.f};
#pragma unroll
        for (int j = 0; j < 4; ++j) { const f32x4 w = *(const LAS f32x4*)(T + e * WT_PITCH + 4 * (lane + 64 * j));
            p0 = __builtin_elementwise_fma((f32x2){v0[j].x, v0[j].y}, (f32x2){w.x, w.y}, p0); p0 = __builtin_elementwise_fma((f32x2){v0[j].z, v0[j].w}, (f32x2){w.z, w.w}, p0);
            p1 = __builtin_elementwise_fma((f32x2){v1[j].x, v1[j].y}, (f32x2){w.x, w.y}, p1); p1 = __builtin_elementwise_fma((f32x2){v1[j].z, v1[j].w}, (f32x2){w.z, w.w}, p1); }
        a0[e] = p0.x + p0.y; a1[e] = p1.x + p1.y;
        if ((e & 3) == 3) { asm volatile("" ::: "memory"); __builtin_amdgcn_sched_barrier(0); } }
}
__device__ __forceinline__ void row_logf_fin(float (&a)[8], const float* bf_l, float* logf, int m, int lane) {
    reduce_scatter<8>(a, lane);
    if ((lane & 7) == 0) { const int h = lane >> 3; const float z = a[0] + ((const GAS float*)bf_l)[h]; const float ls = fminf(z, 0.f) - 0.6931471805599453f * __builtin_amdgcn_logf(1.0f + __builtin_amdgcn_exp2f(-L2E * fabsf(z)));
        const int b = m / SEQ, t = m % SEQ; ((GAS float*)logf)[((size_t)b * 8 + h) * SEQ + t] = ls; }
}
__device__ __forceinline__ void rows0_phase(const float* x, const float* w_in0, const float* bf0, bf16_t* xb, float* logf, volatile LAS float* T, int gw, int NGW, int lane) {
    asm volatile("" : "+v"(lane));
    load_wt_lds(w_in0 + 1536, NIN, 8, T);
    f32x4 n0[4], n1[4];
    if (2 * gw < NTOK) {
#pragma unroll
        for (int j = 0; j < 4; ++j) { n0[j] = *(const GAS f32x4*)((const GAS float*)x + (size_t)(2 * gw) * D + 4 * (lane + 64 * j)); n1[j] = *(const GAS f32x4*)((const GAS float*)x + (size_t)(2 * gw + 1) * D + 4 * (lane + 64 * j)); } }
    for (int m = 2 * gw; m < NTOK; m += 2 * NGW) {
        f32x4 v0[4], v1[4];
#pragma unroll
        for (int j = 0; j < 4; ++j) { v0[j] = n0[j]; v1[j] = n1[j]; }
        { const int mn = m + 2 * NGW; if (mn < NTOK) {
#pragma unroll
            for (int j = 0; j < 4; ++j) { n0[j] = *(const GAS f32x4*)((const GAS float*)x + (size_t)mn * D + 4 * (lane + 64 * j)); n1[j] = *(const GAS f32x4*)((const GAS float*)x + (size_t)(mn + 1) * D + 4 * (lane + 64 * j)); } } }
        float a0[8], a1[8]; row_dot2_lds<8>(v0, v1, (const LAS float*)T, a0, a1, lane);
        row_store_bf16(v0, xb + (size_t)m * D, lane); row_logf_fin(a0, bf0, logf, m, lane);
        row_store_bf16(v1, xb + (size_t)(m + 1) * D, lane); row_logf_fin(a1, bf0, logf, m + 1, lane);
    }
    __syncthreads();
}
__device__ __forceinline__ void rows1_phase(const bf16_t* xinb, const bf16_t* mix, const float* g1, const float* b1, const float* wr, const float* br, bf16_t* x1b, unsigned* cnt, int* tok, int* re, int* rr, float* rg,
                                            volatile LAS float* T, volatile LAS unsigned* lcnt, volatile LAS unsigned* lbase, volatile LAS float* wscr_all, int bx, int G, int wave, int lane) {
    asm volatile("" : "+v"(lane));
    volatile LAS float* wscr = wscr_all + wave * 32;
    const int tid = wave * 64 + lane;
    if (tid < 32) lcnt[tid] = 0u;
    load_wt_lds(wr, 32, 32, T);
    for (int blk = bx; blk < NTOK / 128; blk += G) {
        const int row0 = blk * 128 + wave * 16;
        int my_e = 0; float my_g = 0.f;
#pragma unroll 1
        for (int i = 0; i < 16; i += 2) {
            const int m = row0 + i; f32x4 v0[4], v1[4];
#pragma unroll
            for (int j = 0; j < 4; ++j) { f32x4 xa, xb_; { const u32x2 wa = *(const u32x2*)(xinb + (size_t)m * D + 4 * (lane + 64 * j)), wb = *(const u32x2*)(xinb + (size_t)(m + 1) * D + 4 * (lane + 64 * j));
                    xa.x = __uint_as_float(wa.x << 16); xa.y = __uint_as_float(wa.x & 0xffff0000u); xa.z = __uint_as_float(wa.y << 16); xa.w = __uint_as_float(wa.y & 0xffff0000u); xb_.x = __uint_as_float(wb.x << 16); xb_.y = __uint_as_float(wb.x & 0xffff0000u); xb_.z = __uint_as_float(wb.y << 16); xb_.w = __uint_as_float(wb.y & 0xffff0000u); }
                const u32x2 ma = *(const u32x2*)(mix + (size_t)m * D + 4 * (lane + 64 * j)), mb = *(const u32x2*)(mix + (size_t)(m + 1) * D + 4 * (lane + 64 * j));
                v0[j].x = ALPHA * xa.x + __uint_as_float(ma.x << 16); v0[j].y = ALPHA * xa.y + __uint_as_float(ma.x & 0xffff0000u); v0[j].z = ALPHA * xa.z + __uint_as_float(ma.y << 16); v0[j].w = ALPHA * xa.w + __uint_as_float(ma.y & 0xffff0000u);
                v1[j].x = ALPHA * xb_.x + __uint_as_float(mb.x << 16); v1[j].y = ALPHA * xb_.y + __uint_as_float(mb.x & 0xffff0000u); v1[j].z = ALPHA * xb_.z + __uint_as_float(mb.y << 16); v1[j].w = ALPHA * xb_.w + __uint_as_float(mb.y & 0xffff0000u); }
            row_ln2(v0, v1, g1, b1, lane);
            row_store_bf16(v0, x1b + (size_t)m * D, lane); row_store_bf16(v1, x1b + (size_t)(m + 1) * D, lane);
            float a0[32], a1[32]; row_dot2_lds<32>(v0, v1, (const LAS float*)T, a0, a1, lane);
            reduce_scatter2<32>(a0, a1, lane);
            const int myexp = (lane >> 1) & 31; const float bre = br[myexp]; const float va = a0[0] + bre, vb = a1[0] + bre;
            int ra = 0, rb = 0;
#pragma unroll
            for (int k = 1; k < 32; ++k) { const int oe = (myexp + k) & 31; const float oa = __shfl(va, 2 * oe), ob = __shfl(vb, 2 * oe);
                ra += (oa > va || (oa == va && oe < myexp)) ? 1 : 0; rb += (ob > vb || (ob == vb && oe < myexp)) ? 1 : 0; }
            float ua[4], ub[4]; int ta[4], tb[4];
#pragma unroll
            for (int k = 0; k < 4; ++k) { const unsigned long long ma = __ballot(ra == k), mb = __ballot(rb == k); const int la = __ffsll((long long)ma) - 1, lb = __ffsll((long long)mb) - 1;
                ta[k] = la >> 1; tb[k] = lb >> 1; ua[k] = __shfl(va, la); ub[k] = __shfl(vb, lb); }
            { const float e1 = __builtin_amdgcn_exp2f(L2E * (ua[1] - ua[0])), e2 = __builtin_amdgcn_exp2f(L2E * (ua[2] - ua[0])), e3 = __builtin_amdgcn_exp2f(L2E * (ua[3] - ua[0])); const float inv = 1.0f / (1.0f + e1 + e2 + e3);
              if ((lane >> 2) == i) { const int k = lane & 3; my_e = k == 0 ? ta[0] : k == 1 ? ta[1] : k == 2 ? ta[2] : ta[3]; my_g = (k == 0 ? 1.0f : k == 1 ? e1 : k == 2 ? e2 : e3) * inv; } }
            { const float e1 = __builtin_amdgcn_exp2f(L2E * (ub[1] - ub[0])), e2 = __builtin_amdgcn_exp2f(L2E * (ub[2] - ub[0])), e3 = __builtin_amdgcn_exp2f(L2E * (ub[3] - ub[0])); const float inv = 1.0f / (1.0f + e1 + e2 + e3);
              if ((lane >> 2) == i + 1) { const int k = lane & 3; my_e = k == 0 ? tb[0] : k == 1 ? tb[1] : k == 2 ? tb[2] : tb[3]; my_g = (k == 0 ? 1.0f : k == 1 ? e1 : k == 2 ? e2 : e3) * inv; } }
        }
        const unsigned lrank = __hip_atomic_fetch_add((LAS unsigned*)lcnt + my_e, 1u, __ATOMIC_RELAXED, __HIP_MEMORY_SCOPE_WORKGROUP);
        __syncthreads();
        if (tid < 32) { const unsigned c = lcnt[tid]; lbase[tid] = c ? atomicAdd(cnt + tid * CNT_STRIDE, c) : 0u; }
        __syncthreads();
        { const unsigned rank = lbase[my_e] + lrank; const int m = row0 + (lane >> 2);
          tok[(size_t)my_e * NTOK + rank] = m; re[(size_t)row0 * 4 + lane] = my_e; rr[(size_t)row0 * 4 + lane] = (int)rank; rg[(size_t)row0 * 4 + lane] = my_g; }
        __syncthreads();
        if (tid < 32) lcnt[tid] = 0u;
        __syncthreads();
    }
}
constexpr size_t WS_WRT = 79 * MiB;
constexpr int PW1 = 1032;
__device__ __forceinline__ void router_prep_item(const float* g1, const float* b1, const float* wr, const float* br, unsigned char* ws, int l, int e, int lane) {
    bf16_t* WT = (bf16_t*)(ws + WS_WRT) + (size_t)l * 64 * PW1; float* GB = (float*)(ws + WS_WRT + 768 * 1024) + l * 64;
    float sg = 0.f, sb = 0.f;
#pragma unroll
    for (int j = 0; j < 16; ++j) { const int k = lane + 64 * j; const float w0 = wr[(size_t)l * 1024 * 32 + k * 32 + e], gk = g1[l * 1024 + k], bk = b1[l * 1024 + k]; const float w = w0 * gk;
        const bf16_t hi = f2bf(w); WT[e * PW1 + k] = hi; WT[(32 + e) * PW1 + k] = f2bf(w - bf2f(hi)); sg += w; sb += bk * w0; }
    sg = wave_sum(sg); sb = wave_sum(sb);
    if (lane == 0) { GB[e] = sg; GB[32 + e] = sb + br[l * 32 + e]; }
}
__device__ __forceinline__ void rows1m_phase(const bf16_t* xinb, const bf16_t* mix, const float* g1, const float* b1, const bf16_t* wtg, const float* gbg, bf16_t* x1b, unsigned* cnt, int* tok, int* re, int* rr, float* rg,
                                             LAS unsigned char* ring, volatile LAS unsigned* lcnt, volatile LAS unsigned* lbase, volatile LAS float* gb  , int bx, int G, int wave, int lane) {
    asm volatile("" : "+v"(lane));
    const int tid = wave * 64 + lane;
    LAS bf16_t* WT = (LAS bf16_t*)ring;
    if (tid < 32) lcnt[tid] = 0u;
    { const GAS u32x4* src = (const GAS u32x4*)wtg; constexpr int NV = 64 * PW1 * 2 / 16;
#pragma unroll 1
      for (int i0 = tid; i0 < NV; i0 += 8 * NWAVES * 64) { u32x4 w[8];
#pragma unroll
          for (int u = 0; u < 8; ++u) { const int i = i0 + u * NWAVES * 64; if (i < NV) w[u] = src[i]; }
#pragma unroll
          for (int u = 0; u < 8; ++u) { const int i = i0 + u * NWAVES * 64; if (i < NV) *(LAS u32x4*)(ring + 16 * i) = w[u]; } }
      if (tid < 64) gb[tid] = ((const GAS float*)gbg)[tid]; }
    __syncthreads();
    const int rrow = lane & 15, grp = lane >> 4;
    for (int blk = bx; blk < NTOK / 128; blk += G) {
        const int row0 = blk * 128 + wave * 16;
        float mu_l = 0.f, rs_l = 0.f;
        u32x2 nxa[4], nxb[4], nma[4], nmb[4];
#pragma unroll
        for (int j = 0; j < 4; ++j) { nxa[j] = *(const GAS u32x2*)((const GAS bf16_t*)xinb + (size_t)row0 * D + 4 * (lane + 64 * j)); nxb[j] = *(const GAS u32x2*)((const GAS bf16_t*)xinb + (size_t)(row0 + 1) * D + 4 * (lane + 64 * j));
                                      nma[j] = *(const GAS u32x2*)((const GAS bf16_t*)mix + (size_t)row0 * D + 4 * (lane + 64 * j)); nmb[j] = *(const GAS u32x2*)((const GAS bf16_t*)mix + (size_t)(row0 + 1) * D + 4 * (lane + 64 * j)); }
#pragma unroll 1
        for (int i = 0; i < 16; i += 2) {
            const int m = row0 + i; f32x4 v0[4], v1[4];
            u32x2 cxa[4], cxb[4], cma[4], cmb[4];
#pragma unroll
            for (int j = 0; j < 4; ++j) { cxa[j] = nxa[j]; cxb[j] = nxb[j]; cma[j] = nma[j]; cmb[j] = nmb[j]; }
            if (i + 2 < 16) {
#pragma unroll
                for (int j = 0; j < 4; ++j) { nxa[j] = *(const GAS u32x2*)((const GAS bf16_t*)xinb + (size_t)(m + 2) * D + 4 * (lane + 64 * j)); nxb[j] = *(const GAS u32x2*)((const GAS bf16_t*)xinb + (size_t)(m + 3) * D + 4 * (lane + 64 * j));
                                              nma[j] = *(const GAS u32x2*)((const GAS bf16_t*)mix + (size_t)(m + 2) * D + 4 * (lane + 64 * j)); nmb[j] = *(const GAS u32x2*)((const GAS bf16_t*)mix + (size_t)(m + 3) * D + 4 * (lane + 64 * j)); }
            }
#pragma unroll
            for (int j = 0; j < 4; ++j) { f32x4 xa, xb_; { const u32x2 wa = cxa[j], wb = cxb[j];
                    xa.x = __uint_as_float(wa.x << 16); xa.y = __uint_as_float(wa.x & 0xffff0000u); xa.z = __uint_as_float(wa.y << 16); xa.w = __uint_as_float(wa.y & 0xffff0000u); xb_.x = __uint_as_float(wb.x << 16); xb_.y = __uint_as_float(wb.x & 0xffff0000u); xb_.z = __uint_as_float(wb.y << 16); xb_.w = __uint_as_float(wb.y & 0xffff0000u); }
                const u32x2 ma = cma[j], mb = cmb[j];
                v0[j].x = ALPHA * xa.x + __uint_as_float(ma.x << 16); v0[j].y = ALPHA * xa.y + __uint_as_float(ma.x & 0xffff0000u); v0[j].z = ALPHA * xa.z + __uint_as_float(ma.y << 16); v0[j].w = ALPHA * xa.w + __uint_as_float(ma.y & 0xffff0000u);
                v1[j].x = ALPHA * xb_.x + __uint_as_float(mb.x << 16); v1[j].y = ALPHA * xb_.y + __uint_as_float(mb.x & 0xffff0000u); v1[j].z = ALPHA * xb_.z + __uint_as_float(mb.y << 16); v1[j].w = ALPHA * xb_.w + __uint_as_float(mb.y & 0xffff0000u); }
            float ma_, ra_, mb_, rb_; row_ln2s(v0, v1, g1, b1, lane, ma_, ra_, mb_, rb_);
            row_store_bf16(v0, x1b + (size_t)m * D, lane); row_store_bf16(v1, x1b + (size_t)(m + 1) * D, lane);
            if (rrow == i) { mu_l = ma_; rs_l = ra_; } if (rrow == i + 1) { mu_l = mb_; rs_l = rb_; }
        }
        f32x4 ax[4], am[4];
#pragma unroll
        for (int t = 0; t < 4; ++t) { ax[t] = (f32x4){0.f, 0.f, 0.f, 0.f}; am[t] = (f32x4){0.f, 0.f, 0.f, 0.f}; }
        { const GAS bf16_t* xp = (const GAS bf16_t*)xinb + (size_t)(row0 + rrow) * D + 8 * grp; const GAS bf16_t* mp = (const GAS bf16_t*)mix + (size_t)(row0 + rrow) * D + 8 * grp; const LAS bf16_t* wp = WT + rrow * PW1 + 8 * grp;
#pragma unroll 8
          for (int ks = 0; ks < 32; ++ks) { const bf16x8 fx = *(const GAS bf16x8*)(xp + 32 * ks), fm = *(const GAS bf16x8*)(mp + 32 * ks);
#pragma unroll
              for (int t = 0; t < 4; ++t) { const bf16x8 fw = *(const LAS bf16x8*)(wp + 16 * t * PW1 + 32 * ks);
                  ax[t] = __builtin_amdgcn_mfma_f32_16x16x32_bf16(fw, fx, ax[t], 0, 0, 0); am[t] = __builtin_amdgcn_mfma_f32_16x16x32_bf16(fw, fm, am[t], 0, 0, 0); } } }
        float v[8]; int ev[8];
#pragma unroll
        for (int t = 0; t < 2; ++t)
#pragma unroll
            for (int r = 0; r < 4; ++r) { const int e = 16 * t + 4 * grp + r; const float P = ALPHA * (ax[t][r] + ax[t + 2][r]) + (am[t][r] + am[t + 2][r]);
                v[4 * t + r] = rs_l * (P - mu_l * gb[e]) + gb[32 + e]; ev[4 * t + r] = e; }
        int kk[8], rk[8];
#pragma unroll
        for (int a = 0; a < 8; ++a) { const int bits = (int)__float_as_uint(v[a]); const int mono = bits ^ ((bits >> 31) & 0x7fffffff); kk[a] = (mono & ~31) | (31 - ev[a]); rk[a] = 0; }
#pragma unroll
        for (int a = 0; a < 8; ++a)
#pragma unroll
            for (int b = 0; b < 8; ++b) if (b != a) rk[a] += (kk[b] > kk[a]) ? 1 : 0;
#pragma unroll
        for (int sg = 1; sg < 4; ++sg) {
#pragma unroll
            for (int b = 0; b < 8; ++b) { const int o = __shfl_xor(kk[b], 16 * sg);
#pragma unroll
                for (int a = 0; a < 8; ++a) rk[a] += (o > kk[a]) ? 1 : 0; } }
        float u[4]; int tsel[4];
#pragma unroll
        for (int k = 0; k < 4; ++k) { unsigned se = 0u, sv = 0u;
#pragma unroll
            for (int a = 0; a < 8; ++a) { const bool hit = rk[a] == k; se |= hit ? (unsigned)(ev[a] + 1) : 0u; sv |= hit ? __float_as_uint(v[a]) : 0u; }
            se |= (unsigned)__shfl_xor((int)se, 16); sv |= (unsigned)__shfl_xor((int)sv, 16); se |= (unsigned)__shfl_xor((int)se, 32); sv |= (unsigned)__shfl_xor((int)sv, 32);
            tsel[k] = (int)se - 1; u[k] = __uint_as_float(sv); }
        const float e1 = __builtin_amdgcn_exp2f(L2E * (u[1] - u[0])), e2 = __builtin_amdgcn_exp2f(L2E * (u[2] - u[0])), e3 = __builtin_amdgcn_exp2f(L2E * (u[3] - u[0])); const float inv = 1.0f / (1.0f + e1 + e2 + e3);
        const int my_e = grp == 0 ? tsel[0] : grp == 1 ? tsel[1] : grp == 2 ? tsel[2] : tsel[3]; const float my_g = (grp == 0 ? 1.0f : grp == 1 ? e1 : grp == 2 ? e2 : e3) * inv;
        const unsigned lrank = __hip_atomic_fetch_add((LAS unsigned*)lcnt + my_e, 1u, __ATOMIC_RELAXED, __HIP_MEMORY_SCOPE_WORKGROUP);
        __syncthreads();
        if (tid < 32) { const unsigned c = lcnt[tid]; lbase[tid] = c ? atomicAdd(cnt + tid * CNT_STRIDE, c) : 0u; }
        __syncthreads();
        { const unsigned rank = lbase[my_e] + lrank; const int m = row0 + rrow;
          tok[(size_t)my_e * NTOK + rank] = m; re[(size_t)m * 4 + grp] = my_e; rr[(size_t)m * 4 + grp] = (int)rank; rg[(size_t)m * 4 + grp] = my_g; }
        __syncthreads();
        if (tid < 32) lcnt[tid] = 0u;
        __syncthreads();
    }
}
__device__ __forceinline__ void rows2_phase(const bf16_t* x1b, const unsigned char* ym, const unsigned* cnt, const int* re, const int* rr, const float* rg, const float* g2, const float* b2,
                                            float* xout, bf16_t* xb, const float* w_in_next, const float* bf_next, float* logf, volatile LAS float* T, int gw, int NGW, int lane) {
    asm volatile("" : "+v"(lane));
    if (w_in_next) load_wt_lds(w_in_next + 1536, NIN, 8, T);
    int pc = lane < 32 ? (int)((((const GAS unsigned*)cnt)[(lane & 31) * CNT_STRIDE] + 255u) & ~255u) : 0; int inc = pc;
#pragma unroll
    for (int o = 1; o < 32; o <<= 1) { const int t = __shfl_up(inc, o); if (lane >= o) inc += t; }
    const int poff = inc - pc;
    typedef int i32x4 __attribute__((ext_vector_type(4)));
    u32x2 nxa[4], nxb[4]; i32x4 ne0, nr0, ne1, nr1; f32x4 ng0, ng1;
#define R2_FETCH(M) do { _Pragma("unroll") for (int j = 0; j < 4; ++j) { nxa[j] = *(const GAS u32x2*)((const GAS bf16_t*)x1b + (size_t)(M) * D + 4 * (lane + 64 * j)); nxb[j] = *(const GAS u32x2*)((const GAS bf16_t*)x1b + (size_t)((M) + 1) * D + 4 * (lane + 64 * j)); } \
        ne0 = *(const GAS i32x4*)((const GAS int*)re + (size_t)(M) * 4); nr0 = *(const GAS i32x4*)((const GAS int*)rr + (size_t)(M) * 4); ng0 = *(const GAS f32x4*)((const GAS float*)rg + (size_t)(M) * 4); \
        ne1 = *(const GAS i32x4*)((const GAS int*)re + (size_t)((M) + 1) * 4); nr1 = *(const GAS i32x4*)((const GAS int*)rr + (size_t)((M) + 1) * 4); ng1 = *(const GAS f32x4*)((const GAS float*)rg + (size_t)((M) + 1) * 4); } while (0)
    if (2 * gw < NTOK) R2_FETCH(2 * gw);
    for (int m = 2 * gw; m < NTOK; m += 2 * NGW) {
        f32x4 v0[4], v1[4]; const i32x4 e0 = ne0, r0 = nr0, e1 = ne1, r1 = nr1; const f32x4 g0 = ng0, g1 = ng1;
#pragma unroll
        for (int j = 0; j < 4; ++j) { const u32x2 wa = nxa[j], wb = nxb[j];
            v0[j].x = ALPHA * __uint_as_float(wa.x << 16); v0[j].y = ALPHA * __uint_as_float(wa.x & 0xffff0000u); v0[j].z = ALPHA * __uint_as_float(wa.y << 16); v0[j].w = ALPHA * __uint_as_float(wa.y & 0xffff0000u);
            v1[j].x = ALPHA * __uint_as_float(wb.x << 16); v1[j].y = ALPHA * __uint_as_float(wb.x & 0xffff0000u); v1[j].z = ALPHA * __uint_as_float(wb.y << 16); v1[j].w = ALPHA * __uint_as_float(wb.y & 0xffff0000u); }
        unsigned y0[4][4], y1[4][4];
#pragma unroll
        for (int k = 0; k < 4; ++k) { const int ra = __shfl(poff, e0[k]) + r0[k], rb = __shfl(poff, e1[k]) + r1[k]; const GAS unsigned char* ya = (const GAS unsigned char*)ym + (size_t)ra * 1024; const GAS unsigned char* yb_ = (const GAS unsigned char*)ym + (size_t)rb * 1024;
#pragma unroll
            for (int j = 0; j < 4; ++j) { y0[k][j] = *(const GAS unsigned*)(ya + 4 * (lane + 64 * j)); y1[k][j] = *(const GAS unsigned*)(yb_ + 4 * (lane + 64 * j)); } }
        { const int mn = m + 2 * NGW; if (mn < NTOK) R2_FETCH(mn); }
#pragma unroll
        for (int k = 0; k < 4; ++k)
#pragma unroll
            for (int j = 0; j < 4; ++j) { const int w = (int)y0[k][j], x = (int)y1[k][j]; const f32x2 ga = (f32x2){g0[k], g0[k]}, gb = (f32x2){g1[k], g1[k]};
                const f32x2 a01 = __builtin_elementwise_fma(__builtin_amdgcn_cvt_pk_f32_fp8(w, false), ga, (f32x2){v0[j].x, v0[j].y}), a23 = __builtin_elementwise_fma(__builtin_amdgcn_cvt_pk_f32_fp8(w, true), ga, (f32x2){v0[j].z, v0[j].w});
                const f32x2 b01 = __builtin_elementwise_fma(__builtin_amdgcn_cvt_pk_f32_fp8(x, false), gb, (f32x2){v1[j].x, v1[j].y}), b23 = __builtin_elementwise_fma(__builtin_amdgcn_cvt_pk_f32_fp8(x, true), gb, (f32x2){v1[j].z, v1[j].w});
                v0[j] = (f32x4){a01.x, a01.y, a23.x, a23.y}; v1[j] = (f32x4){b01.x, b01.y, b23.x, b23.y}; }
        row_ln2(v0, v1, g2, b2, lane);
        if (xout) { _Pragma("unroll") for (int j = 0; j < 4; ++j) { *(GAS f32x4*)((GAS float*)xout + (size_t)m * D + 4 * (lane + 64 * j)) = v0[j]; *(GAS f32x4*)((GAS float*)xout + (size_t)(m + 1) * D + 4 * (lane + 64 * j)) = v1[j]; } }
        if (w_in_next) { float a0[8], a1[8]; row_dot2_lds<8>(v0, v1, (const LAS float*)T, a0, a1, lane);
            row_store_bf16(v0, xb + (size_t)m * D, lane); row_logf_fin(a0, bf_next, logf, m, lane);
            row_store_bf16(v1, xb + (size_t)(m + 1) * D, lane); row_logf_fin(a1, bf_next, logf, m + 1, lane); }
    }
#undef R2_FETCH
    __syncthreads();
}
__device__ __forceinline__ void cumsum_block(const float* logf, float* cum, int bh, volatile LAS float* scr) {
    int tid = threadIdx.x; asm volatile("" : "+v"(tid)); const int lane = tid & 63, wv = tid >> 6;
    const float* src = logf + (size_t)bh * SEQ + tid * 8; float* dst = cum + (size_t)bh * SEQ + tid * 8;
    const f32x4 a = *(const f32x4*)src, b = *(const f32x4*)(src + 4);
    float v[8]; v[0] = a.x; v[1] = v[0] + a.y; v[2] = v[1] + a.z; v[3] = v[2] + a.w; v[4] = v[3] + b.x; v[5] = v[4] + b.y; v[6] = v[5] + b.z; v[7] = v[6] + b.w;
    const float s = v[7]; float inc = s;
#pragma unroll
    for (int o = 1; o < 64; o <<= 1) { const float t = __shfl_up(inc, o); if (lane >= o) inc += t; }
    if (lane == 63) scr[wv] = inc;
    __syncthreads();
    float base = inc - s;
    for (int i = 0; i < wv; ++i) base += scr[i];
    f32x4 o0, o1; o0.x = v[0] + base; o0.y = v[1] + base; o0.z = v[2] + base; o0.w = v[3] + base; o1.x = v[4] + base; o1.y = v[5] + base; o1.z = v[6] + base; o1.w = v[7] + base;
    *(f32x4*)dst = o0; *(f32x4*)(dst + 4) = o1;
    __syncthreads();
}

struct S5Order { const char* A; const char* B; size_t bstep; int G, c, ldb, nt;
    __device__ __forceinline__ bool next(int i, pg8::Unit& u) const {
        const int L = i * G + c; if (L >= 128) return false;
        const int g = L >> 3, pm = L & 7;
        u.A = A + ((size_t)g * 2048 + pm * 256) * 384 * 2; u.B = B + (size_t)g * bstep; u.e = g; u.pm = pm; u.pn = 0; u.valid = 256; u.lt = 0; u.lda = 384; u.ldb = ldb; u.nt = nt; u.seg = 0; return true; }
};
struct BranchOrder { pg8::StaticOrder T; const char *A0, *A1, *A2, *B0, *B1, *B2;
    __device__ __forceinline__ bool next(int i, pg8::Unit& u) const {
        const int ti = i / 3, seg = i - 3 * ti;
        if (!T.next(ti, u)) return false;
        u.seg = seg; u.lda = seg == 0 ? HP : 256; u.ldb = seg == 0 ? 512 : 256; u.nt = seg == 0 ? 8 : 4;
        const char *a0 = A0, *a1 = A1, *a2 = A2, *b0 = B0, *b1 = B1, *b2 = B2; asm volatile("" : "+s"(a0), "+s"(a1), "+s"(a2), "+s"(b0), "+s"(b1), "+s"(b2));
        u.A = (seg == 0 ? a0 : seg == 1 ? a1 : a2) + (size_t)u.pm * 256 * u.lda * 2; u.B = (seg == 0 ? b0 : seg == 1 ? b1 : b2) + (size_t)u.pn * 256 * u.ldb * 2; return true; }
};
namespace pg8 {
struct EpiS1 { float* S;
    static constexpr bool AFTER_DRAIN = false; __device__ __forceinline__ void pre(const Unit&, int, int, int, int) const {} __device__ __forceinline__ bool keep_acc(const Unit&) const { return false; }
    __device__ __forceinline__ void operator()(const Acc& acc, const Unit& u, int wr, int wc, int fr, int fq) const {
        const unsigned vo = (unsigned)(fr * 128 + 8 * fq) * 4u;
#pragma unroll
        for (int ai = 0; ai < 2; ++ai)
#pragma unroll
            for (int m = 0; m < 4; ++m) { float* ub = S + ((size_t)u.e * 2048 + u.pm * 256 + ai * 128 + wr * 64 + m * 16) * 128 + wc * 32;
                *(GAS f32x4*)((GAS char*)ub + vo) = acc[ai][0][m][0]; *(GAS f32x4*)((GAS char*)ub + vo + 16) = acc[ai][0][m][1]; }
    }
};
struct EpiS3 { bf16_t* ycp;
    static constexpr bool AFTER_DRAIN = false; __device__ __forceinline__ void pre(const Unit&, int, int, int, int) const {} __device__ __forceinline__ bool keep_acc(const Unit&) const { return false; }
    __device__ __forceinline__ void operator()(const Acc& acc, const Unit& u, int wr, int wc, int fr, int fq) const {
        const unsigned vo = (unsigned)((fr * 16 + (fq >> 1)) * 256 + (fq & 1) * 8) * 2u;
#pragma unroll
        for (int ai = 0; ai < 2; ++ai)
#pragma unroll
            for (int m = 0; m < 4; ++m)
#pragma unroll
                for (int bj = 0; bj < 2; ++bj) { f32x4 v[2] = {acc[ai][bj][m][0], acc[ai][bj][m][1]};
#pragma unroll
                    for (int n = 0; n < 2; ++n)
#pragma unroll
                        for (int i = 0; i < 4; ++i) { const float y = v[n][i]; v[n][i] = y * fsig(1.5957691216057308f * (y + 0.044715f * y * y * y)); }
                    st16(ycp + ((size_t)(u.pm * 256 + ai * 128 + wr * 64 + m * 16) * 16 + bj * 8 + wc * 2) * 256 + u.e * 16, vo, pack8(v[0], v[1])); }
    }
};
}

struct OneUnit { const char* A; const char* B; int pm, lda, ldb, nt;
    __device__ __forceinline__ bool next(int i, pg8::Unit& u) const {
        if (i) return false;
        u.A = A + (size_t)pm * 256 * lda * 2; u.B = B; u.e = 0; u.pm = pm; u.pn = 0; u.valid = 256; u.lt = 0; u.lda = lda; u.ldb = ldb; u.nt = nt; u.seg = 0; return true; }
};
__device__ __forceinline__ void wg_mem_sync() {
    asm volatile("s_waitcnt vmcnt(0)" ::: "memory");
    __syncthreads();
    if (threadIdx.x == 0) { __builtin_amdgcn_fence(__ATOMIC_ACQUIRE, "agent"); asm volatile("s_waitcnt vmcnt(0)" ::: "memory"); }
    __syncthreads();
}
__device__ __forceinline__ void count_in_and_wait(unsigned* ctr, unsigned n, unsigned* bar) {
    asm volatile("s_waitcnt vmcnt(0)" ::: "memory");
    __syncthreads();
    if (threadIdx.x == 0) {
        __builtin_amdgcn_fence(__ATOMIC_RELEASE, "agent");
        asm volatile("s_waitcnt vmcnt(0)" ::: "memory");
        (void)xb_add(ctr, 1u);
        XB_SPIN(xb_ld(ctr) < n, bar);
        __builtin_amdgcn_fence(__ATOMIC_ACQUIRE, "agent");
        asm volatile("s_waitcnt vmcnt(0)" ::: "memory");
    }
    __syncthreads();
}

#ifndef STEP_MASK
#define STEP_MASK 0x1fff
#endif
struct Args {
    const float* in[29]; float* out; unsigned char* ws;
    int step_lo, step_hi;
    int bar_region, pad;
};
constexpr int STEPS_PER_LAYER = 12, N_STEPS = 1 + NL * STEPS_PER_LAYER;

__global__ void __launch_bounds__(NWAVES * 64, 2) mk_fwd(Args a) {
    extern __shared__ __attribute__((aligned(16))) unsigned char lds_raw[];
    LAS unsigned char* lds0 = (LAS unsigned char*)lds_raw;
    LAS unsigned char* lds = lds0 + RING_OFF;
    volatile LAS unsigned* MISC = (volatile LAS unsigned*)lds0;
    const int tid = threadIdx.x, lane = tid & 63, wave = __builtin_amdgcn_readfirstlane(tid >> 6);
    const int G = gridDim.x;
    const int gw = (int)blockIdx.x * NWAVES + wave, NGW = G * NWAVES;
    unsigned char* ws = a.ws;
    for (int u = tid; u < LDSCTL_BYTES / 4; u += NWAVES * 64) ((LAS unsigned*)lds0)[u] = 0u;
    __syncthreads();
    XcdBarrier bar = xcd_barrier_post((unsigned*)(ws + WS_CTL) + CW_BAR + a.bar_region * XCD_BAR_WORDS, MISC + 8);
    const int lo = a.step_lo, hi = a.step_hi;
#define IN(k) (lo <= (k) && (k) < hi)
#define SEAM(k) do { if (IN(k) && IN((k) + 1)) xcd_barrier(bar); } while (0)
#define BX() ({ int b_ = (int)blockIdx.x; asm volatile("" : "+s"(b_)); b_; })
#define GWL() (BX() * NWAVES + wave)
#define WSP(T, off) ({ unsigned char* w_ = ws; asm volatile("" : "+s"(w_)); (T*)(__attribute__((address_space(1))) T*)(w_ + (off)); })
#define ARG_IN(i) ({ const __attribute__((address_space(4))) char* k_ = (const __attribute__((address_space(4))) char*)__builtin_amdgcn_kernarg_segment_ptr(); asm volatile("" : "+s"(k_)); (const float*)(const __attribute__((address_space(1))) float*)*(const float* const __attribute__((address_space(4)))*)(k_ + 8 * (i)); })

    if (IN(0) && (STEP_MASK & 1)) {
        PrepArgs pa; pa.w_in = ARG_IN(1); pa.w_ba = ARG_IN(15); pa.w_bb = ARG_IN(16); pa.w_bc = ARG_IN(17); pa.w_out = ARG_IN(18); pa.w_glu = ARG_IN(13); pa.w_up = ARG_IN(23); pa.w_dn = ARG_IN(25); pa.ws = ws;
        prep_items(pa, (float*)(lds_raw + RING_OFF + wave * 16640), (long)gw, (long)NGW, lane);
        S5In si; si.lam_re = ARG_IN(5); si.lam_im = ARG_IN(6); si.log_dt = ARG_IN(7); si.b_re = ARG_IN(8); si.b_im = ARG_IN(9); si.c_re = ARG_IN(10); si.c_im = ARG_IN(11); si.dsk = ARG_IN(12);
        for (int it = gw; it < NL * 16 * 48; it += NGW) { const int lg = it / 48, r = it % 48; s5_prep_item(si, ws, lg >> 4, lg & 15, r >> 4, r & 15, lane); }
        for (int it = gw; it < NL * 32; it += NGW) router_prep_item(ARG_IN(19), ARG_IN(20), ARG_IN(21), ARG_IN(22), ws, it >> 5, it & 31, lane);
        __syncthreads();
        rows0_phase(ARG_IN(0), ARG_IN(1), ARG_IN(2), WSP(bf16_t, WS_XB), WSP(float, WS_LOGF), (volatile LAS float*)lds, gw, NGW, lane);
    }
    SEAM(0);

    for (int l = 0; l < NL; ++l) {
        const int s0 = 1 + STEPS_PER_LAYER * l;
        unsigned* cnt = (unsigned*)(ws + WS_CTL) + CW_CNT + NE * CNT_STRIDE * l;
        if (IN(s0 + 0) && (STEP_MASK & (2 << 0))) {
            if (BX() < 64) cumsum_block(WSP(float, WS_LOGF), WSP(float, WS_CUM), BX(), (volatile LAS float*)lds);
            bf16_t* H = WSP(bf16_t, WS_H); bf16_t* A3 = WSP(bf16_t, WS_A3);
            pg8::StaticOrder S; S.init(WSP(bf16_t, WS_XB), 1024, WSP(bf16_t, WS_WIN) + (size_t)l * 5120 * 1024, 1024, 1024, NTOK, 5120, G, BX());
            pg8::EpiIn E{H, A3, WSP(unsigned char, WS_GQ)};
            pg8::gemm_phase<false>(lds, S, E);
        }
        SEAM(s0 + 0);
        if (IN(s0 + 1) && (STEP_MASK & (2 << 1))) {
            if (BX() < 128) {
                const int c = BX();
                { S5Order S{(const char*)WSP(bf16_t, WS_A3), (const char*)(WSP(bf16_t, WS_S5W1) + (size_t)l * 16 * 256 * 256), (size_t)256 * 256 * 2, G, c, 256, 4};
                  pg8::EpiS1 E{WSP(float, WS_S5S)};
                  pg8::gemm_phase<false>(lds, S, E); }
                wg_mem_sync();
                s5_scan_wg(WSP(float, WS_S5S), WSP(float, WS_S5A16) + (size_t)l * 16 * 64 * 2, WSP(bf16_t, WS_A3), c & 7, c >> 3, (LAS float*)lds);
                { S5Order S{(const char*)WSP(bf16_t, WS_A3), (const char*)(WSP(bf16_t, WS_S5W3) + (size_t)l * 16 * 256 * 384), (size_t)256 * 384 * 2, G, c, 384, 6};
                  pg8::EpiS3 E{WSP(bf16_t, WS_YCP)};
                  pg8::gemm_phase<false>(lds, S, E); }
                count_in_and_wait((unsigned*)(ws + WS_CTL) + CW_S5C + (l * 8 + (c & 7)) * 32, 16u, bar.bar);
                { bf16_t* YCP = WSP(bf16_t, WS_YCP); bf16_t* YC = WSP(bf16_t, WS_YC);
                  OneUnit S{(const char*)YCP, (const char*)(WSP(bf16_t, WS_WGLU) + (size_t)l * 65536), (c & 7) * 16 + (c >> 3), 256, 256, 4};
                  pg8::EpiGlu E{YCP, ARG_IN(14) + (size_t)l * 256, YC};
                  pg8::gemm_phase<false>(lds, S, E); }
                __syncthreads();
            }
            {
                bf16_t* H = WSP(bf16_t, WS_H); const float* CUM = WSP(float, WS_CUM);
                const attn_body::AttnTensors AT{(const attn_body::bf16*)(H + HC_Q), (const attn_body::bf16*)(H + HC_K), (const attn_body::bf16*)(H + HC_V), (attn_body::bf16*)WSP(bf16_t, WS_OB), CUM};
                const int vcu = (G % 8 == 0) ? (BX() % 8) * (G / 8) + BX() / 8 : BX(); const int batch = (vcu * 8 / G) & 7;
                attn_body::QueueOrder S{(unsigned*)(ws + WS_CTL) + CW_ATTQ + a.pad * 1024 + (l * 8 + batch) * 32, (volatile LAS int*)(MISC + 60)};
                attn_body::AttnTensors ATb = AT; ATb.Q += (size_t)batch * SEQ * HP; ATb.K += (size_t)batch * SEQ * HP; ATb.V += (size_t)batch * SEQ * HP; ATb.O += (size_t)batch * SEQ * HP; ATb.cum += (size_t)batch * 8 * SEQ;
                attn_body::attn_phase<attn_body::QueueOrder>((char*)lds_raw + RING_OFF, ATb, S);
            }
            __syncthreads();
            {
                const bf16_t* H = WSP(bf16_t, WS_H); const float* wpool = ARG_IN(3) + (size_t)l * 4 * 64 * 64; const float* pscale = ARG_IN(4) + (size_t)l * 256; bf16_t* YB = WSP(bf16_t, WS_YB);
                pool_phase(H, wpool, pscale, YB, BX(), G, lds);
            }
        }
        SEAM(s0 + 5);
        if (IN(s0 + 6) && (STEP_MASK & (2 << 6))) {
            bf16_t* H = WSP(bf16_t, WS_H); bf16_t* MERGED = WSP(bf16_t, WS_MERGED); bf16_t* YB = WSP(bf16_t, WS_YB); bf16_t* YC = WSP(bf16_t, WS_YC);
            BranchOrder S; S.T.init(nullptr, 0, nullptr, 0, 128, NTOK, 1024, G, BX());
            S.A0 = (const char*)WSP(bf16_t, WS_OB); S.A1 = (const char*)YB; S.A2 = (const char*)YC;
            S.B0 = (const char*)(WSP(bf16_t, WS_WBA) + (size_t)l * 1024 * 512); S.B1 = (const char*)(WSP(bf16_t, WS_WBB) + (size_t)l * 1024 * 256); S.B2 = (const char*)(WSP(bf16_t, WS_WBC) + (size_t)l * 1024 * 256);
            pg8::EpiBranchF E{WSP(unsigned char, WS_GQ), MERGED};
            pg8::gemm_phase<false>(lds, S, E);
        }
        SEAM(s0 + 6);
        if (IN(s0 + 7) && (STEP_MASK & (2 << 7))) {
            bf16_t* MERGED = WSP(bf16_t, WS_MERGED); bf16_t* MIX = WSP(bf16_t, WS_MIX);
            pg8::StaticOrder S; S.init(MERGED, 1024, WSP(bf16_t, WS_WOUT) + (size_t)l * 1024 * 1024, 1024, 1024, NTOK, 1024, G, BX());
            pg8::EpiPlain E{MIX, nullptr, 0};
            pg8::gemm_phase<false>(lds, S, E);
        }
        SEAM(s0 + 7);
        if (IN(s0 + 8) && (STEP_MASK & (2 << 8))) {
            const int dm = a.pad;
            rows1m_phase(WSP(bf16_t, WS_XB), WSP(bf16_t, WS_MIX), ARG_IN(19) + (size_t)l * D, ARG_IN(20) + (size_t)l * D, WSP(bf16_t, WS_WRT) + (size_t)l * 64 * PW1, WSP(float, WS_WRT + 768 * 1024) + l * 64,
                        WSP(bf16_t, WS_X1B), dm ? cnt + 4096 * dm : cnt, dm ? WSP(int, WS_OB) : WSP(int, WS_TOK), dm ? WSP(int, WS_OB + 8 * MiB) : WSP(int, WS_RE), dm ? WSP(int, WS_OB + 9 * MiB) : WSP(int, WS_RR), dm ? WSP(float, WS_OB + 10 * MiB) : WSP(float, WS_RG),
                        lds, MISC + 64, MISC + 96, (volatile LAS float*)(MISC + 256), BX(), G, wave, lane);
        }
        SEAM(s0 + 8);
        const bool fillok = (G == 256);
        if (IN(s0 + 9) && (STEP_MASK & (2 << 9))) {
            const int* TOK = WSP(int, WS_TOK); bf16_t* X1B = WSP(bf16_t, WS_X1B); bf16_t* ACT = WSP(bf16_t, WS_ACT);
            moe_prefix(cnt, (volatile LAS int*)(MISC + 16));
            { MoeOrder S{(const volatile LAS int*)(MISC + 16), cnt, TOK, (const char*)X1B, (const char*)(WSP(bf16_t, WS_WUP) + (size_t)l * NE * 2048 * 1024), (size_t)2048 * 1024 * 2, (size_t)256 * 1024 * 2, (size_t)256 * 1024 * 2, 8, G, BX(), 1024, true, -1};
              pg8::EpiUp E{ACT, ARG_IN(24) + (size_t)l * NE * 2048};
              pg8::gemm_phase<true>(lds, S, E); }
            if (fillok) {
                const int c = BX(), ga = 4 * (c & 7) + (c >> 6), p8 = (c >> 3) & 7, r0 = (((volatile LAS int*)(MISC + 16))[32] - 1) & 31;
                if (ga > r0) {
                    count_in_and_wait((unsigned*)(ws + WS_CTL) + CW_MOEF + (l * 32 + ga) * 32, 8u, bar.bar);
                    MoeOrder D{(const volatile LAS int*)(MISC + 16), cnt, TOK, (const char*)WSP(bf16_t, WS_ACT), (const char*)(WSP(bf16_t, WS_WDN) + (size_t)l * NE * 1024 * 1024), (size_t)1024 * 1024 * 2, (size_t)256 * 1024 * 2, (size_t)256 * 1024 * 2, 4, G, c, 1024, false, -1};
                    MoeOne S1{D, p8 < 4 ? ga : 32 + ga, p8 & 3};
                    pg8::EpiYm8 E2{(unsigned char*)WSP(bf16_t, WS_YM), ARG_IN(26) + (size_t)l * NE * 1024};
                    pg8::gemm_phase<false>(lds, S1, E2);
                }
            }
        }
        SEAM(s0 + 9);
        if (IN(s0 + 10) && (STEP_MASK & (2 << 10))) {
            const int* TOK = WSP(int, WS_TOK); bf16_t* ACT = WSP(bf16_t, WS_ACT); bf16_t* YM = WSP(bf16_t, WS_YM);
            if (!(IN(s0 + 9) && (STEP_MASK & (2 << 9)))) moe_prefix(cnt, (volatile LAS int*)(MISC + 16));
            const int r0 = fillok ? ((((volatile LAS int*)(MISC + 16))[32] - 1) & 31) : -1;
            MoeOrder S{(const volatile LAS int*)(MISC + 16), cnt, TOK, (const char*)ACT, (const char*)(WSP(bf16_t, WS_WDN) + (size_t)l * NE * 1024 * 1024), (size_t)1024 * 1024 * 2, (size_t)256 * 1024 * 2, (size_t)256 * 1024 * 2, 4, G, BX(), 1024, false, r0};
            pg8::EpiYm8 E{(unsigned char*)YM, ARG_IN(26) + (size_t)l * NE * 1024};
            pg8::gemm_phase<false>(lds, S, E);
        }
        SEAM(s0 + 10);
        if (IN(s0 + 11) && (STEP_MASK & (2 << 11))) {
            const bool last = (l == NL - 1);
            rows2_phase(WSP(bf16_t, WS_X1B), WSP(unsigned char, WS_YM), cnt, WSP(int, WS_RE), WSP(int, WS_RR), WSP(float, WS_RG), ARG_IN(27) + (size_t)l * D, ARG_IN(28) + (size_t)l * D,
                        last ? a.out : (float*)nullptr, WSP(bf16_t, WS_XB), last ? (const float*)nullptr : ARG_IN(1) + (size_t)(l + 1) * D * NIN, last ? (const float*)nullptr : ARG_IN(2) + (size_t)(l + 1) * 8,
                        WSP(float, WS_LOGF), (volatile LAS float*)lds, GWL(), NGW, lane);
        }
        SEAM(s0 + 11);
    }
#undef IN
#undef SEAM
}

#ifndef MK_MODE
#define MK_MODE 0
#endif
extern "C" void kernel_launch(void* const* d_in, const int* in_sizes, int n_in, void* d_out, int out_size, void* d_ws, size_t ws_size, hipStream_t stream) {
    if (n_in != 29 || out_size != NTOK * D || ws_size < WS_END2) { fprintf(stderr, "kernel_launch: unexpected shapes (n_in %d out %d ws %zu)\n", n_in, out_size, ws_size); return; }
    static int grid = 0;
    if (grid == 0) {
        int dev = 0, cus = 0;
        if (hipGetDevice(&dev) != hipSuccess || hipDeviceGetAttribute(&cus, hipDeviceAttributeMultiprocessorCount, dev) != hipSuccess) { fprintf(stderr, "kernel_launch: device query failed\n"); grid = -1; return; }
        if (hipFuncSetAttribute((const void*)mk_fwd, hipFuncAttributeMaxDynamicSharedMemorySize, LDS_BYTES) != hipSuccess) { fprintf(stderr, "kernel_launch: hipFuncSetAttribute failed\n"); grid = -1; return; }
        int per_cu = 0;
        if (hipOccupancyMaxActiveBlocksPerMultiprocessor(&per_cu, (const void*)mk_fwd, NWAVES * 64, LDS_BYTES) != hipSuccess || per_cu < 1) fprintf(stderr, "kernel_launch: occupancy query reports %d workgroups per CU\n", per_cu);
        (void)hipGetLastError();
        grid = cus;
    }
    if (grid < 0) return;
    unsigned char* ws = (unsigned char*)d_ws;
    (void)hipMemsetAsync(ws + WS_CTL, 0, 1 * MiB, stream);
    Args a{}; for (int i = 0; i < 29; ++i) a.in[i] = (const float*)d_in[i]; a.out = (float*)d_out; a.ws = ws;
#if MK_MODE == 0
    a.step_lo = 0; a.step_hi = N_STEPS; a.bar_region = 0;
    hipLaunchKernelGGL(mk_fwd, dim3(grid), dim3(NWAVES * 64), LDS_BYTES, stream, a);
#elif MK_MODE == 1
    for (int s = 0; s < N_STEPS; ++s) { Args b = a; b.step_lo = s; b.step_hi = s + 1; b.bar_region = s; hipLaunchKernelGGL(mk_fwd, dim3(grid), dim3(NWAVES * 64), LDS_BYTES, stream, b); }
#else
    for (int s = 0; s < N_STEPS; ++s) { const int bit = s == 0 ? 0 : 1 + (s - 1) % STEPS_PER_LAYER; const int rep = ((PROBE_MASK >> bit) & 1) ? PROBE_REP : 1;
        for (int r = 0; r < rep; ++r) { Args b = a; b.step_lo = s; b.step_hi = s + 1; b.bar_region = s; b.pad = (bit == 9 || bit == 2) ? r : 0; hipLaunchKernelGGL(mk_fwd, dim3(grid), dim3(NWAVES * 64), LDS_BYTES, stream, b); } }
#endif
}
```

```cpp
#include <hip/hip_runtime.h>
#include <cstdint>
#include <cstdio>
#include <cmath>

typedef unsigned short bf16_t;
typedef short bf16x8 __attribute__((ext_vector_type(8)));
typedef float f32x4 __attribute__((ext_vector_type(4)));
typedef float f32x2 __attribute__((ext_vector_type(2)));
typedef unsigned u32x4 __attribute__((ext_vector_type(4)));
typedef unsigned u32x2 __attribute__((ext_vector_type(2)));

constexpr int D = 1024, NB = 8, SEQ = 4096, NTOK = NB * SEQ, NL = 4;
constexpr int NIN = 5128, HP = 5120;
constexpr int NE = 32, TOPK = 4;
constexpr int MOE_ROWS = 139264;
constexpr float C2 = 0.125f * 1.4426950408889634f;
constexpr float L2E = 1.4426950408889634f;
constexpr float ALPHA = 1.681792830507429f;
constexpr float LN_EPS = 1e-5f;
constexpr int HC_Q = 0, HC_K = 512, HC_V = 1024, HC_POOL = 1536, HC_SSM = 1792, HC_G = 2048;

constexpr size_t MiB = 1u << 20;
constexpr size_t WS_CTL = 0;
constexpr size_t WS_WIN = 1 * MiB;
constexpr size_t WS_WBA = 41 * MiB;
constexpr size_t WS_WBB = 45 * MiB;
constexpr size_t WS_WBC = 47 * MiB;
constexpr size_t WS_WOUT = 49 * MiB;
constexpr size_t WS_WGLU = 57 * MiB;
constexpr size_t WS_WUP = 80 * MiB;
constexpr size_t WS_WDN = 592 * MiB;
constexpr size_t WS_XA = 848 * MiB;
constexpr size_t WS_X1 = 976 * MiB;
constexpr size_t WS_XB = 1104 * MiB;
constexpr size_t WS_X1B = 1168 * MiB;
constexpr size_t WS_H = 1232 * MiB;
constexpr size_t WS_A3 = 1552 * MiB;
constexpr size_t WS_MERGED = 1576 * MiB;
constexpr size_t WS_MIX = 1640 * MiB;
constexpr size_t WS_YB = 1704 * MiB;
constexpr size_t WS_YCP = 1720 * MiB;
constexpr size_t WS_YC = 1736 * MiB;
constexpr size_t WS_LOGF = 1752 * MiB;
constexpr size_t WS_CUM = 1753 * MiB;
constexpr size_t WS_TOK = 1754 * MiB;
constexpr size_t WS_RE = 1758 * MiB;
constexpr size_t WS_RR = WS_RE + 512 * 1024;
constexpr size_t WS_RG = WS_RR + 512 * 1024;
constexpr size_t WS_ACT = 1760 * MiB;
constexpr size_t WS_YM = 2032 * MiB;
constexpr size_t WS_END = 2304 * MiB;
constexpr int CW_MOEF = 238592;
constexpr int CW_S5C = 237568;
constexpr int CW_ATTQ = 229376;
constexpr int CW_CNT = 200704, CNT_STRIDE = 32;

__device__ __forceinline__ float bf2f(bf16_t b) { return __uint_as_float((unsigned)b << 16); }
__device__ __forceinline__ bf16_t f2bf(float f) { unsigned u = __float_as_uint(f); return (bf16_t)((u + 0x7fffu + ((u >> 16) & 1u)) >> 16); }
__device__ __forceinline__ unsigned pk2(float lo, float hi) { unsigned r; asm("v_cvt_pk_bf16_f32 %0, %1, %2" : "=v"(r) : "v"(lo), "v"(hi)); return r; }
__device__ __forceinline__ float sigmoidf_(float x) { return 1.0f / (1.0f + __expf(-x)); }
__device__ __forceinline__ float wave_sum(float v) {
#pragma unroll
    for (int o = 1; o < 64; o <<= 1) v += __shfl_xor(v, o);
    return v;
}
__device__ __forceinline__ float wave_max_f(float v) {
#pragma unroll
    for (int o = 32; o >= 1; o >>= 1) v = fmaxf(v, __shfl_xor(v, o));
    return v; }
__device__ __forceinline__ int wave_min_i(int v) {
#pragma unroll
    for (int o = 32; o >= 1; o >>= 1) { const int t = __shfl_xor(v, o); v = t < v ? t : v; }
    return v; }
template <int N> __device__ __forceinline__ void reduce_scatter(float (&v)[N], int lane) {
    int s = 32;
#pragma unroll
    for (int n = N / 2; n >= 1; n >>= 1) {
        const bool up = (lane & s) != 0;
#pragma unroll
        for (int i = 0; i < n; ++i) { float hi = v[i + n], lo = v[i]; asm volatile("" : "+v"(hi), "+v"(lo));
            const float keep = up ? hi : lo, send = up ? lo : hi; v[i] = keep + __shfl_xor(send, s); }
        s >>= 1;
    }
    for (; s >= 1; s >>= 1) v[0] += __shfl_xor(v[0], s);
}

__device__ __forceinline__ int dst_row(int mode, int c) {
    if (mode == 1) return c < 1536 ? c : (c < 1544 ? -1 : c - 8);
    if (mode == 2) { const int j = c >> 1, bj = c & 1; return (j >> 7) * 256 + bj * 128 + (j & 127); }
    return c;
}
__device__ __forceinline__ void transpose_item(const float* W, int Nsrc, int K, int Ndst, bf16_t* WT, int mode, float* scr, int item, int lane) {
    (void)Ndst;
    const int nkb = K / 64, nb = item / nkb, kb = item % nkb, k0 = 64 * kb, c0 = 64 * nb;
    const bool cin = (c0 + lane) < Nsrc;
    const float* src = W + (size_t)k0 * Nsrc + c0 + (cin ? lane : 0);
#pragma unroll 16
    for (int kk = 0; kk < 64; ++kk) scr[kk * 65 + lane] = __builtin_nontemporal_load(src + (size_t)kk * Nsrc);
    asm volatile("s_waitcnt lgkmcnt(0)" ::: "memory");
    const int c8 = lane & 7;
#pragma unroll
    for (int i = 0; i < 8; ++i) { const int col = (lane >> 3) + 8 * i; const int n = (c0 + col) < Nsrc ? dst_row(mode, c0 + col) : -1; const float* s = scr + (8 * c8) * 65 + col;
        const float sc = (mode == 1 && n >= 2048) ? -L2E : 1.0f;
        u32x4 o; o.x = pk2(s[0 * 65] * sc, s[1 * 65] * sc); o.y = pk2(s[2 * 65] * sc, s[3 * 65] * sc); o.z = pk2(s[4 * 65] * sc, s[5 * 65] * sc); o.w = pk2(s[6 * 65] * sc, s[7 * 65] * sc);
        if (n >= 0) __builtin_nontemporal_store(o, (u32x4*)(WT + (size_t)n * K + k0 + 8 * c8)); }
    asm volatile("s_waitcnt lgkmcnt(0)" ::: "memory");
}
struct PrepArgs { const float *w_in, *w_ba, *w_bb, *w_bc, *w_out, *w_glu, *w_up, *w_dn; unsigned char* ws; };
__device__ __forceinline__ void prep_items(const PrepArgs& a, float* scr, long gw, long NGW, int lane) {
    constexpr long I_IN = (1024 / 64) * ((NIN + 63) / 64), I_BA = (512 / 64) * (1024 / 64), I_BB = (256 / 64) * (1024 / 64), I_OUT = (1024 / 64) * (1024 / 64), I_GLU = (256 / 64) * (256 / 64);
    constexpr long I_UP = (1024 / 64) * (2048 / 64), I_DN = (1024 / 64) * (1024 / 64);
    constexpr long T_IN = NL * I_IN, T_BA = NL * I_BA, T_BB = NL * I_BB, T_OUT = NL * I_OUT, T_GLU = NL * I_GLU, T_UP = (long)NL * NE * I_UP, T_DN = (long)NL * NE * I_DN;
    constexpr long TOTAL = T_IN + T_BA + 2 * T_BB + T_OUT + T_GLU + T_UP + T_DN;
    for (long it = gw; it < TOTAL; it += NGW) {
        long r = it;
        if (r < T_UP) { const int inst = (int)(r / I_UP), item = (int)(r % I_UP); transpose_item(a.w_up + (size_t)inst * 1024 * 2048, 2048, 1024, 2048, (bf16_t*)(a.ws + WS_WUP) + (size_t)inst * 2048 * 1024, 2, scr, item, lane); continue; } r -= T_UP;
        if (r < T_DN) { const int inst = (int)(r / I_DN), item = (int)(r % I_DN); transpose_item(a.w_dn + (size_t)inst * 1024 * 1024, 1024, 1024, 1024, (bf16_t*)(a.ws + WS_WDN) + (size_t)inst * 1024 * 1024, 0, scr, item, lane); continue; } r -= T_DN;
        if (r < T_IN) { const int inst = (int)(r / I_IN), item = (int)(r % I_IN); transpose_item(a.w_in + (size_t)inst * 1024 * NIN, NIN, 1024, 5120, (bf16_t*)(a.ws + WS_WIN) + (size_t)inst * 5120 * 1024, 1, scr, item, lane); continue; } r -= T_IN;
        if (r < T_BA) { const int inst = (int)(r / I_BA), item = (int)(r % I_BA); transpose_item(a.w_ba + (size_t)inst * 512 * 1024, 1024, 512, 1024, (bf16_t*)(a.ws + WS_WBA) + (size_t)inst * 1024 * 512, 0, scr, item, lane); continue; } r -= T_BA;
        if (r < T_BB) { const int inst = (int)(r / I_BB), item = (int)(r % I_BB); transpose_item(a.w_bb + (size_t)inst * 256 * 1024, 1024, 256, 1024, (bf16_t*)(a.ws + WS_WBB) + (size_t)inst * 1024 * 256, 0, scr, item, lane); continue; } r -= T_BB;
        if (r < T_BB) { const int inst = (int)(r / I_BB), item = (int)(r % I_BB); transpose_item(a.w_bc + (size_t)inst * 256 * 1024, 1024, 256, 1024, (bf16_t*)(a.ws + WS_WBC) + (size_t)inst * 1024 * 256, 0, scr, item, lane); continue; } r -= T_BB;
        if (r < T_OUT) { const int inst = (int)(r / I_OUT), item = (int)(r % I_OUT); transpose_item(a.w_out + (size_t)inst * 1024 * 1024, 1024, 1024, 1024, (bf16_t*)(a.ws + WS_WOUT) + (size_t)inst * 1024 * 1024, 0, scr, item, lane); continue; } r -= T_OUT;
        { const int inst = (int)(r / I_GLU), item = (int)(r % I_GLU); transpose_item(a.w_glu + (size_t)inst * 256 * 256, 256, 256, 256, (bf16_t*)(a.ws + WS_WGLU) + (size_t)inst * 256 * 256, 0, scr, item, lane); }
    }
}

__device__ __forceinline__ void row_ln(f32x4 (&v)[4], const float* g, const float* bta, int lane) {
    float s = 0.f;
#pragma unroll
    for (int j = 0; j < 4; ++j) s += (v[j].x + v[j].y) + (v[j].z + v[j].w);
    const float mean = wave_sum(s) * (1.f / D); float s2 = 0.f;
#pragma unroll
    for (int j = 0; j < 4; ++j) { v[j] = v[j] - mean; s2 += (v[j].x * v[j].x + v[j].y * v[j].y) + (v[j].z * v[j].z + v[j].w * v[j].w); }
    const float rstd = 1.0f / sqrtf(wave_sum(s2) * (1.f / D) + LN_EPS);
#pragma unroll
    for (int j = 0; j < 4; ++j) { const f32x4 gg = *(const f32x4*)(g + 4 * (lane + 64 * j)), bb = *(const f32x4*)(bta + 4 * (lane + 64 * j)); v[j] = v[j] * rstd * gg + bb; }
}
#define GAS __attribute__((address_space(1)))
__device__ __forceinline__ void row_store_bf16(const f32x4 (&v)[4], bf16_t* orow, int lane) {
#pragma unroll
    for (int j = 0; j < 4; ++j) { u32x2 w; asm("v_cvt_pk_bf16_f32 %0, %1, %2" : "=v"(w.x) : "v"(v[j].x), "v"(v[j].y)); asm("v_cvt_pk_bf16_f32 %0, %1, %2" : "=v"(w.y) : "v"(v[j].z), "v"(v[j].w)); *(GAS u32x2*)((GAS bf16_t*)orow + 4 * (lane + 64 * j)) = w; }
}
#define LAS __attribute__((address_space(3)))
namespace pg8 {
constexpr int BM = 256, BK = 64, HALF = 128, HTB = HALF * BK * 2, STAGE_BYTES = 8 * HTB;
__device__ __forceinline__ int lds_byte(int r, int c) { const int st = (r >> 4) * 2 + (c >> 5), rr = r & 15, cc = c & 31, ob = rr * 64 + cc * 2; return st * 1024 + (ob ^ (((ob >> 9) & 1) << 5)); }
__device__ __forceinline__ void stage_rc(int b, int& R, int& C) { const int st = b / 1024, sb = b % 1024, swz = sb ^ (((sb >> 9) & 1) << 5); R = (st >> 1) * 16 + swz / 64; C = (st & 1) * 32 + (swz % 64) / 2; }
__device__ __forceinline__ int perm32(int rho) { const int n = rho >> 4, i = rho & 15; return 8 * (i >> 2) + 4 * n + (i & 3); }

struct Unit { const char* A; const char* B; int pm, pn, e, valid, lt; int lda, ldb, nt, seg; };

typedef f32x4 Acc[2][2][4][2];

template <bool GATHER, class Epi, class Sched>
__device__ __forceinline__ void gemm_phase(LAS unsigned char* lds, const Sched& S, const Epi& E) {
    int tid_ = threadIdx.x; asm volatile("" : "+v"(tid_));
    const int tid = tid_, wid = __builtin_amdgcn_readfirstlane(tid >> 6), lane = tid & 63, wr = wid >> 2, wc = wid & 3, fr = lane & 15, fq = lane >> 4;
    int R0, C0; stage_rc(tid * 16, R0, C0);
    const int Rb0 = (R0 & ~31) + perm32(R0 & 31);
    unsigned vB, vBn, vA = 0, vAn = 0; size_t sB, sBn, sA = 0, sAn = 0;
    unsigned offA[2][2], offN[2][2];
    const size_t kstep = (size_t)(BK * 2);
    const unsigned ldsw = (unsigned)wid * 1024u;
    const int aoff = lds_byte(wr * 64 + fr, fq * 8), boff = lds_byte(wc * 32 + fr, fq * 8);
#define PG8_SA(b, h) (((b) * 2 + (h)) * HTB)
#define PG8_SB(b, h) ((4 + (b) * 2 + (h)) * HTB)
#define PG8_STAGE_B(bufoff, gbase, h, vb, sb) do { _Pragma("unroll") for (int _i = 0; _i < 2; ++_i) \
        __builtin_amdgcn_global_load_lds((const unsigned*)((const char*)(gbase) + (size_t)(2 * (h) + _i) * (sb) + (vb)), (LAS unsigned*)(lds + (bufoff) + ldsw + _i * 8192), 16, 0, 0); } while (0)
#define PG8_STAGE_A(bufoff, gbase, h, va, sa, offs) do { _Pragma("unroll") for (int _i = 0; _i < 2; ++_i) { \
        const char* _p = GATHER ? (const char*)(gbase) + (offs)[h][_i] : (const char*)(gbase) + (size_t)(2 * (h) + _i) * (sa) + (va); \
        __builtin_amdgcn_global_load_lds((const unsigned*)_p, (LAS unsigned*)(lds + (bufoff) + ldsw + _i * 8192), 16, 0, 0); } } while (0)
#define PG8_LDA(dst, b, h) do { _Pragma("unroll") for (int m = 0; m < 4; ++m) _Pragma("unroll") for (int k = 0; k < 2; ++k) dst[m][k] = *(const LAS bf16x8*)(lds + PG8_SA(b, h) + aoff + m * 2048 + k * 1024); } while (0)
#define PG8_LDB(dst, b, h) do { _Pragma("unroll") for (int n = 0; n < 2; ++n) _Pragma("unroll") for (int k = 0; k < 2; ++k) dst[n][k] = *(const LAS bf16x8*)(lds + PG8_SB(b, h) + boff + n * 2048 + k * 1024); } while (0)
#define PG8_MMA(ai, bj, At, Bt) do { __builtin_amdgcn_s_setprio(1); _Pragma("unroll") for (int m = 0; m < 4; ++m) _Pragma("unroll") for (int n = 0; n < 2; ++n) _Pragma("unroll") for (int k = 0; k < 2; ++k) \
        acc[ai][bj][m][n] = __builtin_amdgcn_mfma_f32_16x16x32_bf16(Bt[n][k], At[m][k], acc[ai][bj][m][n], 0, 0, 0); __builtin_amdgcn_s_setprio(0); } while (0)
#define PG8_WAIT_V(n) asm volatile("s_waitcnt vmcnt(" #n ")" ::: "memory")
#define PG8_WAIT_L(n) asm volatile("s_waitcnt lgkmcnt(" #n ")" ::: "memory")
#define PG8_BAR __builtin_amdgcn_s_barrier()
#define PG8_SCHED __builtin_amdgcn_sched_barrier(0)
#define PG8_GEOM(u, oA, va, sa, vb, sb) do { if constexpr (GATHER) S.goff(u, R0, C0, oA); else { va = (unsigned)(R0 * (u).lda + C0) * 2u; sa = (size_t)64 * (u).lda * 2; } \
        vb = (unsigned)(Rb0 * (u).ldb + C0) * 2u; sb = (size_t)64 * (u).ldb * 2; } while (0)
    Unit cur, nxt; int ui = 0;
    if (!S.next(0, cur)) return;
    PG8_GEOM(cur, offA, vA, sA, vB, sB);
#pragma unroll
    for (int h = 0; h < 2; ++h)
#pragma unroll
        for (int i = 0; i < 2; ++i) offN[h][i] = offA[h][i];
    vAn = vA; sAn = sA; vBn = vB; sBn = sB; int nt = cur.nt;
    Acc acc;
#pragma unroll
    for (int a = 0; a < 2; ++a)
#pragma unroll
        for (int b = 0; b < 2; ++b)
#pragma unroll
            for (int m = 0; m < 4; ++m)
#pragma unroll
                for (int n = 0; n < 2; ++n) acc[a][b][m][n] = (f32x4){0.f, 0.f, 0.f, 0.f};
    bf16x8 At[4][2], B0[2][2], B1[2][2];
    const char* cA = cur.A; const char* cB = cur.B;
    E.pre(cur, wr, wc, fr, fq);
    PG8_STAGE_B(PG8_SB(0, 0), cB, 0, vB, sB); PG8_STAGE_B(PG8_SB(0, 1), cB, 1, vB, sB); PG8_STAGE_A(PG8_SA(0, 0), cA, 0, vA, sA, offA); PG8_STAGE_A(PG8_SA(0, 1), cA, 1, vA, sA, offA);
    if (wr == 1) PG8_BAR;
    PG8_WAIT_V(2); PG8_BAR;
    PG8_STAGE_B(PG8_SB(1, 0), cB + kstep, 0, vB, sB); PG8_STAGE_A(PG8_SA(1, 0), cA + kstep, 0, vA, sA, offA); PG8_STAGE_B(PG8_SB(1, 1), cB + kstep, 1, vB, sB);
    PG8_WAIT_V(6); PG8_BAR;
    for (;;) {
        const bool has_next = S.next(ui + 1, nxt);
        const char* nA = has_next ? nxt.A : cA; const char* nB = has_next ? nxt.B : cB;
        if (has_next) PG8_GEOM(nxt, offN, vAn, sAn, vBn, sBn);
#pragma unroll 1
        for (int t = 0; t < nt; t += 2) {
            const bool last = (t == nt - 2);
            const char* a1 = cA + (size_t)(t + 1) * kstep;
            const char* a2 = last ? nA : cA + (size_t)(t + 2) * kstep; const char* b2 = last ? nB : cB + (size_t)(t + 2) * kstep;
            const char* a3 = a2 + kstep; const char* b3 = b2 + kstep;
            unsigned o2[2][2];
            if constexpr (GATHER) {
#pragma unroll
                for (int h = 0; h < 2; ++h)
#pragma unroll
                    for (int i = 0; i < 2; ++i) o2[h][i] = last ? offN[h][i] : offA[h][i];
            }
            const unsigned va2 = last ? vAn : vA, vb2 = last ? vBn : vB; const size_t sa2 = last ? sAn : sA, sb2 = last ? sBn : sB;
            PG8_LDB(B0, 0, 0); PG8_LDB(B1, 0, 1); PG8_SCHED; PG8_LDA(At, 0, 0); PG8_STAGE_A(PG8_SA(1, 1), a1, 1, vA, sA, offA);
            PG8_WAIT_V(8); PG8_WAIT_L(0); PG8_BAR; PG8_MMA(0, 0, At, B0); PG8_MMA(0, 1, At, B1); PG8_BAR; PG8_SCHED;
            PG8_LDA(At, 0, 1); PG8_STAGE_B(PG8_SB(0, 0), b2, 0, vb2, sb2); PG8_STAGE_B(PG8_SB(0, 1), b2, 1, vb2, sb2); PG8_STAGE_A(PG8_SA(0, 0), a2, 0, va2, sa2, o2);
            PG8_WAIT_V(8); PG8_WAIT_L(0); PG8_BAR; PG8_MMA(1, 0, At, B0); PG8_MMA(1, 1, At, B1); PG8_BAR; PG8_SCHED;
            PG8_LDB(B0, 1, 0); PG8_LDB(B1, 1, 1); PG8_SCHED; PG8_LDA(At, 1, 0); PG8_STAGE_A(PG8_SA(0, 1), a2, 1, va2, sa2, o2);
            PG8_WAIT_V(8); PG8_WAIT_L(0); PG8_BAR; PG8_MMA(0, 0, At, B0); PG8_MMA(0, 1, At, B1); PG8_BAR; PG8_SCHED;
            PG8_LDA(At, 1, 1); PG8_STAGE_B(PG8_SB(1, 0), b3, 0, vb2, sb2); PG8_STAGE_B(PG8_SB(1, 1), b3, 1, vb2, sb2); PG8_STAGE_A(PG8_SA(1, 0), a3, 0, va2, sa2, o2);
            PG8_WAIT_V(8); PG8_WAIT_L(0); PG8_BAR; PG8_MMA(1, 0, At, B0); PG8_MMA(1, 1, At, B1); PG8_BAR; PG8_SCHED;
        }
        if (wr == 0) PG8_BAR;
        if constexpr (!Epi::AFTER_DRAIN) E(acc, cur, wr, wc, fr, fq);
        if (!has_next) break;
        if (!E.keep_acc(cur)) {
#pragma unroll
            for (int a = 0; a < 2; ++a)
#pragma unroll
                for (int b = 0; b < 2; ++b)
#pragma unroll
                    for (int m = 0; m < 4; ++m)
#pragma unroll
                        for (int n = 0; n < 2; ++n) acc[a][b][m][n] = (f32x4){0.f, 0.f, 0.f, 0.f};
        }
        cur = nxt; cA = nA; cB = nB; ++ui; nt = cur.nt; vA = vAn; sA = sAn; vB = vBn; sB = sBn;
        if constexpr (GATHER) {
#pragma unroll
            for (int h = 0; h < 2; ++h)
#pragma unroll
                for (int i = 0; i < 2; ++i) offA[h][i] = offN[h][i];
        }
        E.pre(cur, wr, wc, fr, fq);
        if (wr == 1) PG8_BAR;
    }
    PG8_WAIT_V(0);
    PG8_BAR;
    if constexpr (Epi::AFTER_DRAIN) E.after(acc, cur, wr, wc, fr, fq, lds);
#undef PG8_GEOM
#undef PG8_SA
#undef PG8_SB
#undef PG8_STAGE_A
#undef PG8_STAGE_B
#undef PG8_LDA
#undef PG8_LDB
#undef PG8_MMA
#undef PG8_WAIT_V
#undef PG8_WAIT_L
#undef PG8_BAR
#undef PG8_SCHED
}

struct StaticOrder {
    const char* A; const char* B; size_t tstepA, tstepB; int nM, nN, nwg, G, c, lda, ldb, nt;
    __device__ __forceinline__ void init(const void* A_, int lda_, const void* B_, int ldb_, int K, int M, int N, int G_, int c_) {
        A = (const char*)A_; B = (const char*)B_; lda = lda_; ldb = ldb_; nt = K / BK; tstepA = (size_t)BM * lda * 2; tstepB = (size_t)BM * ldb * 2; nM = M / BM; nN = N / BM; nwg = nM * nN; G = G_; c = c_; }
    __device__ __forceinline__ bool next(int i, Unit& u) const {
        const long L = (long)i * G + c; if (L >= nwg) return false;
        int wgid = (int)L; { const int q = nwg / 8, r = nwg % 8, xcd = wgid % 8, off = wgid / 8; wgid = (xcd < r ? xcd * (q + 1) : r * (q + 1) + (xcd - r) * q) + off; }
        const int nig = 8 * nN, gid = wgid / nig, fm = gid * 8, gsz = (nM - fm) < 8 ? (nM - fm) : 8;
        u.pm = fm + ((wgid % nig) % gsz); u.pn = (wgid % nig) / gsz; u.e = 0; u.valid = 256; u.lt = 0; u.lda = lda; u.ldb = ldb; u.nt = nt; u.seg = 0;
        u.A = A + (size_t)u.pm * tstepA; u.B = B + (size_t)u.pn * tstepB; return true;
    }
};
}
namespace pg8 {
__device__ __forceinline__ unsigned cvt_pk_bf16(float lo, float hi) { unsigned r; asm volatile("v_cvt_pk_bf16_f32 %0, %1, %2" : "=v"(r) : "v"(lo), "v"(hi)); return r; }
__device__ __forceinline__ float fsig(float x) { return __builtin_amdgcn_rcpf(1.0f + __builtin_amdgcn_exp2f(-L2E * x)); }
__device__ __forceinline__ u32x4 pack8(const f32x4 v0, const f32x4 v1) { u32x4 w; w.x = cvt_pk_bf16(v0[0], v0[1]); w.y = cvt_pk_bf16(v0[2], v0[3]); w.z = cvt_pk_bf16(v1[0], v1[1]); w.w = cvt_pk_bf16(v1[2], v1[3]); return w; }
__device__ __forceinline__ void unpack8(const u32x4 w, f32x4& v0, f32x4& v1) {
    v0[0] = __uint_as_float(w.x << 16); v0[1] = __uint_as_float(w.x & 0xffff0000u); v0[2] = __uint_as_float(w.y << 16); v0[3] = __uint_as_float(w.y & 0xffff0000u);
    v1[0] = __uint_as_float(w.z << 16); v1[1] = __uint_as_float(w.z & 0xffff0000u); v1[2] = __uint_as_float(w.w << 16); v1[3] = __uint_as_float(w.w & 0xffff0000u); }
__device__ __forceinline__ u32x4 ld16(const void* ubase, unsigned voff) { return *(const u32x4*)((const char*)ubase + voff); }
__device__ __forceinline__ void st16(void* ubase, unsigned voff, u32x4 v) { *(u32x4*)((char*)ubase + voff) = v; }
__device__ __forceinline__ f32x4 ldf4(const void* ubase, unsigned voff) { return *(const f32x4*)((const char*)ubase + voff); }

struct EpiIn { bf16_t* H; bf16_t* A3; unsigned char* GQ;
    static constexpr bool AFTER_DRAIN = false; __device__ __forceinline__ void pre(const Unit&, int, int, int, int) const {} __device__ __forceinline__ bool keep_acc(const Unit&) const { return false; }
    __device__ __forceinline__ void operator()(const Acc& acc, const Unit& u, int wr, int wc, int fr, int fq) const {
        const int pn = u.pn;
        const unsigned vH = (unsigned)(fr * HP + 8 * fq) * 2u, vS = (unsigned)((fq >> 1) * 2048 * 384 + fr * 16 + (fq & 1) * 8) * 2u, vG = (unsigned)(fr * 3072 + 8 * fq);
#pragma unroll
        for (int ai = 0; ai < 2; ++ai)
#pragma unroll
            for (int m = 0; m < 4; ++m) {
#pragma unroll
                for (int bj = 0; bj < 2; ++bj) { f32x4 v0 = acc[ai][bj][m][0], v1 = acc[ai][bj][m][1];
                    if (pn < 2) { v0 = v0 * C2; v1 = v1 * C2; }
                    if (pn >= 8) { unsigned q[8];
#pragma unroll
                        for (int i = 0; i < 4; i += 2) {
                            f32x2 ta = (f32x2){__builtin_amdgcn_exp2f(v0[i]), __builtin_amdgcn_exp2f(v0[i + 1])} + (f32x2){1.0f, 1.0f}, tb = (f32x2){__builtin_amdgcn_exp2f(v1[i]), __builtin_amdgcn_exp2f(v1[i + 1])} + (f32x2){1.0f, 1.0f};
                            f32x2 ya = (f32x2){__builtin_amdgcn_rcpf(ta.x), __builtin_amdgcn_rcpf(ta.y)} * (f32x2){255.0f, 255.0f} + (f32x2){0.5f, 0.5f}, yb = (f32x2){__builtin_amdgcn_rcpf(tb.x), __builtin_amdgcn_rcpf(tb.y)} * (f32x2){255.0f, 255.0f} + (f32x2){0.5f, 0.5f};
                            q[i] = (unsigned)fmaxf(ya.x, 1.0f); q[i + 1] = (unsigned)fmaxf(ya.y, 1.0f); q[4 + i] = (unsigned)fmaxf(yb.x, 1.0f); q[5 + i] = (unsigned)fmaxf(yb.y, 1.0f); }
                        u32x2 w; w.x = q[0] | (q[1] << 8) | (q[2] << 16) | (q[3] << 24); w.y = q[4] | (q[5] << 8) | (q[6] << 16) | (q[7] << 24);
                        *(u32x2*)(GQ + (size_t)(u.pm * 256 + ai * 128 + wr * 64 + m * 16) * 3072 + (pn - 8) * 256 + bj * 128 + wc * 32 + vG) = w; }
                    else if (pn == 7) st16(A3 + ((size_t)(bj * 8 + wc * 2) * 2048 + u.pm * 16 + ai * 8 + wr * 4 + m) * 384, vS, pack8(v0, v1));
                    else st16(H + (size_t)(u.pm * 256 + ai * 128 + wr * 64 + m * 16) * HP + pn * 256 + bj * 128 + wc * 32, vH, pack8(v0, v1)); } }
    }
};
struct EpiGlu { const bf16_t* ycp; const float* bias; bf16_t* yc;
    static constexpr bool AFTER_DRAIN = false; __device__ __forceinline__ void pre(const Unit&, int, int, int, int) const {} __device__ __forceinline__ bool keep_acc(const Unit&) const { return false; }
    __device__ __forceinline__ void operator()(const Acc& acc, const Unit& u, int wr, int wc, int fr, int fq) const {
        const unsigned vo = (unsigned)(fr * 256 + 8 * fq) * 2u;
        f32x4 bv[2][2];
#pragma unroll
        for (int bj = 0; bj < 2; ++bj)
#pragma unroll
            for (int n = 0; n < 2; ++n) bv[bj][n] = ldf4(bias + bj * 128 + wc * 32 + 4 * n, (unsigned)fq * 32u);
#define GL_UB(it) ((size_t)(u.pm * 256 + ((it) >> 3) * 128 + wr * 64 + (((it) >> 1) & 3) * 16) * 256 + ((it) & 1) * 128 + wc * 32)
        u32x4 yn = ld16(ycp + GL_UB(0), vo);
#pragma unroll
        for (int it = 0; it < 16; ++it) { const int ai = it >> 3, m = (it >> 1) & 3, bj = it & 1; const size_t ub = GL_UB(it); f32x4 y0, y1; unpack8(yn, y0, y1);
            if (it + 1 < 16) yn = ld16(ycp + GL_UB(it + 1), vo);
            f32x4 v0 = acc[ai][bj][m][0] + bv[bj][0], v1 = acc[ai][bj][m][1] + bv[bj][1];
#pragma unroll
            for (int i = 0; i < 4; ++i) { v0[i] = y0[i] * fsig(v0[i]); v1[i] = y1[i] * fsig(v1[i]); }
            st16(yc + ub, vo, pack8(v0, v1));
            asm volatile("" ::: "memory"); }
#undef GL_UB
    }
};
struct EpiBranch { const bf16_t* H; bf16_t* merged; int br;
    static constexpr bool AFTER_DRAIN = false; __device__ __forceinline__ void pre(const Unit&, int, int, int, int) const {} __device__ __forceinline__ bool keep_acc(const Unit&) const { return false; }
    __device__ __forceinline__ void operator()(const Acc& acc, const Unit& u, int wr, int wc, int fr, int fq) const {
        const unsigned vH = (unsigned)(fr * HP + 8 * fq) * 2u, vM = (unsigned)(fr * 1024 + 8 * fq) * 2u;
#pragma unroll
        for (int ai = 0; ai < 2; ++ai)
#pragma unroll
            for (int m = 0; m < 4; ++m) { const int rowu = u.pm * 256 + ai * 128 + wr * 64 + m * 16;
#pragma unroll
                for (int bj = 0; bj < 2; ++bj) { const int cu = u.pn * 256 + bj * 128 + wc * 32; f32x4 g0, g1; unpack8(ld16(H + (size_t)rowu * HP + HC_G + br * 1024 + cu, vH), g0, g1);
                    f32x4 v0 = acc[ai][bj][m][0] * g0, v1 = acc[ai][bj][m][1] * g1;
                    if (br > 0) { f32x4 p0, p1; unpack8(ld16(merged + (size_t)rowu * 1024 + cu, vM), p0, p1); v0 = v0 + p0; v1 = v1 + p1; }
                    st16(merged + (size_t)rowu * 1024 + cu, vM, pack8(v0, v1)); }
                asm volatile("" ::: "memory"); }
    }
};
struct EpiBranchF { const unsigned char* GQ; bf16_t* merged;
    static constexpr bool AFTER_DRAIN = false; __device__ __forceinline__ void pre(const Unit&, int, int, int, int) const {} __device__ __forceinline__ bool keep_acc(const Unit& u) const { return u.seg < 2; }
    __device__ __forceinline__ void operator()(Acc& acc, const Unit& u, int wr, int wc, int fr, int fq) const {
        const unsigned vG = (unsigned)(fr * 3072 + 8 * fq), vM = (unsigned)(fr * 1024 + 8 * fq) * 2u; const int seg = u.seg;
        const unsigned char* gbase = GQ + (size_t)(u.pm * 256 + wr * 64) * 3072 + seg * 1024 + u.pn * 256 + wc * 32;
        bf16_t* mbase = merged + (size_t)(u.pm * 256 + wr * 64) * 1024 + u.pn * 256 + wc * 32;
#define BF_LOAD(it, G, Hh) do { const size_t ro_ = (size_t)(((it) >> 3) * 128 + (((it) >> 1) & 3) * 16); const int bj_ = (it) & 1; \
            G = *(const u32x2*)(gbase + ro_ * 3072 + bj_ * 128 + vG); Hh = (u32x2){0xffffffffu, 0xffffffffu}; if (seg < 2) Hh = *(const u32x2*)(gbase + ro_ * 3072 + 1024 + bj_ * 128 + vG); } while (0)
        u32x2 gn, hn; BF_LOAD(0, gn, hn);
#pragma unroll
        for (int it = 0; it < 16; ++it) { const int ai = it >> 3, m = (it >> 1) & 3, bj = it & 1; const size_t ro = (size_t)(ai * 128 + m * 16);
            const u32x2 gw = gn, hw = hn;
            if (it + 1 < 16) BF_LOAD(it + 1, gn, hn);
            f32x4 g0, g1;
            if (seg < 2) {
#pragma unroll
                for (int i = 0; i < 4; ++i) { g0[i] = (float)((gw.x >> (8 * i)) & 255u) * __builtin_amdgcn_rcpf((float)((hw.x >> (8 * i)) & 255u));
                                              g1[i] = (float)((gw.y >> (8 * i)) & 255u) * __builtin_amdgcn_rcpf((float)((hw.y >> (8 * i)) & 255u)); }
            } else {
#pragma unroll
                for (int i = 0; i < 4; ++i) { g0[i] = (float)((gw.x >> (8 * i)) & 255u) * (1.0f / 255.0f); g1[i] = (float)((gw.y >> (8 * i)) & 255u) * (1.0f / 255.0f); }
            }
            acc[ai][bj][m][0] = acc[ai][bj][m][0] * g0; acc[ai][bj][m][1] = acc[ai][bj][m][1] * g1;
            if (seg == 2) st16(mbase + ro * 1024 + bj * 128, vM, pack8(acc[ai][bj][m][0], acc[ai][bj][m][1]));
            asm volatile("" ::: "memory"); }
#undef BF_LOAD
    }
};
struct EpiPlain { bf16_t* O; const float* bias; int bias_estride;
    static constexpr bool AFTER_DRAIN = false; __device__ __forceinline__ void pre(const Unit&, int, int, int, int) const {} __device__ __forceinline__ bool keep_acc(const Unit&) const { return false; }
    __device__ __forceinline__ void operator()(const Acc& acc, const Unit& u, int wr, int wc, int fr, int fq) const {
        const unsigned vo = (unsigned)(fr * 1024 + 8 * fq) * 2u;
        f32x4 bv[2][2];
#pragma unroll
        for (int bj = 0; bj < 2; ++bj)
#pragma unroll
            for (int n = 0; n < 2; ++n) bv[bj][n] = bias ? ldf4(bias + (size_t)u.e * bias_estride + u.pn * 256 + bj * 128 + wc * 32 + 4 * n, (unsigned)fq * 32u) : (f32x4){0.f, 0.f, 0.f, 0.f};
#pragma unroll
        for (int ai = 0; ai < 2; ++ai)
#pragma unroll
            for (int m = 0; m < 4; ++m) { const int rowu = u.pm * 256 + ai * 128 + wr * 64 + m * 16;
#pragma unroll
                for (int bj = 0; bj < 2; ++bj) st16(O + (size_t)rowu * 1024 + u.pn * 256 + bj * 128 + wc * 32, vo, pack8(acc[ai][bj][m][0] + bv[bj][0], acc[ai][bj][m][1] + bv[bj][1])); }
    }
};
struct EpiUp { bf16_t* act; const float* bup;
    static constexpr bool AFTER_DRAIN = false; __device__ __forceinline__ void pre(const Unit&, int, int, int, int) const {} __device__ __forceinline__ bool keep_acc(const Unit&) const { return false; }
    __device__ __forceinline__ void operator()(const Acc& acc, const Unit& u, int wr, int wc, int fr, int fq) const {
        const unsigned vo = (unsigned)(fr * 1024 + 8 * fq) * 2u;
        const int ju = u.pn * 128 + wc * 32;
        f32x4 bb[4];
#pragma unroll
        for (int q = 0; q < 4; ++q) { bb[q] = ldf4(bup + (size_t)u.e * 2048 + 2 * ju + 4 * q, (unsigned)fq * 64u); bb[q][1] += 1.0f; bb[q][3] += 1.0f; }
#pragma unroll
        for (int ai = 0; ai < 2; ++ai)
#pragma unroll
            for (int m = 0; m < 4; ++m) { const int rowu = u.pm * 256 + ai * 128 + wr * 64 + m * 16; f32x4 o[2];
#pragma unroll
                for (int n = 0; n < 2; ++n)
#pragma unroll
                    for (int i2 = 0; i2 < 2; ++i2) { const int q = 4 * n + 2 * i2;
                        f32x2 g = (f32x2){acc[ai][0][m][n][2 * i2], acc[ai][0][m][n][2 * i2 + 1]} + (f32x2){bb[q >> 1][0], bb[(q >> 1)][2]};
                        f32x2 l = (f32x2){acc[ai][1][m][n][2 * i2], acc[ai][1][m][n][2 * i2 + 1]} + (f32x2){bb[q >> 1][1], bb[(q >> 1)][3]};
                        g = __builtin_elementwise_min(g, (f32x2){7.0f, 7.0f}); l.x = __builtin_amdgcn_fmed3f(l.x, -6.0f, 8.0f); l.y = __builtin_amdgcn_fmed3f(l.y, -6.0f, 8.0f);
                        const f32x2 t = g * (-1.702f * L2E); const f32x2 d = (f32x2){__builtin_amdgcn_exp2f(t.x), __builtin_amdgcn_exp2f(t.y)} + (f32x2){1.0f, 1.0f};
                        const f32x2 s = (f32x2){__builtin_amdgcn_rcpf(d.x), __builtin_amdgcn_rcpf(d.y)};
                        const f32x2 r = (g * s) * l; o[n][2 * i2] = r.x; o[n][2 * i2 + 1] = r.y; }
                st16(act + (size_t)rowu * 1024 + ju, vo, pack8(o[0], o[1])); }
    }
};
struct EpiYm8 { unsigned char* O; const float* bias;
    mutable f32x4 bv[2][2];
    static constexpr bool AFTER_DRAIN = false;
    __device__ __forceinline__ void pre(const Unit& u, int, int wc, int, int fq) const {
#pragma unroll
        for (int bj = 0; bj < 2; ++bj)
#pragma unroll
            for (int n = 0; n < 2; ++n) bv[bj][n] = ldf4(bias + (size_t)u.e * 1024 + u.pn * 256 + bj * 128 + wc * 32 + 4 * n, (unsigned)fq * 32u); } __device__ __forceinline__ bool keep_acc(const Unit&) const { return false; }
    __device__ __forceinline__ void operator()(const Acc& acc, const Unit& u, int wr, int wc, int fr, int fq) const {
        const unsigned vo = (unsigned)(fr * 1024 + 8 * fq);
#pragma unroll
        for (int ai = 0; ai < 2; ++ai)
#pragma unroll
            for (int m = 0; m < 4; ++m) { const int rowu = u.pm * 256 + ai * 128 + wr * 64 + m * 16;
#pragma unroll
                for (int bj = 0; bj < 2; ++bj) { const f32x4 a = acc[ai][bj][m][0] + bv[bj][0], b = acc[ai][bj][m][1] + bv[bj][1]; u32x2 w;
                    int t = __builtin_amdgcn_cvt_pk_fp8_f32(a[0], a[1], 0, false); t = __builtin_amdgcn_cvt_pk_fp8_f32(a[2], a[3], t, true); w.x = (unsigned)t;
                    t = __builtin_amdgcn_cvt_pk_fp8_f32(b[0], b[1], 0, false); t = __builtin_amdgcn_cvt_pk_fp8_f32(b[2], b[3], t, true); w.y = (unsigned)t;
                    *(u32x2*)(O + (size_t)rowu * 1024 + u.pn * 256 + bj * 128 + wc * 32 + vo) = w; } }
    }
};
}
#include <hip/hip_bf16.h>
#include <cmath>
namespace attn_body {
using bf16=__hip_bfloat16;
using bf16x8=__attribute__((ext_vector_type(8)))short;
using s16x4=__attribute__((ext_vector_type(4)))short;
using f32x16=__attribute__((ext_vector_type(16)))float;
using u32x4=__attribute__((ext_vector_type(4)))unsigned;
constexpr int BATCH=8,NHEAD=8,SEQ=4096,D=64,DM=5120;
constexpr int NW=8,QBLK=32,QB=QBLK*NW,KVBLK=64,NQB=SEQ/QB;
constexpr int ATTN_PITCH=DM, ATTN_UNIT_ROWS=QB;
__device__ __forceinline__ int crow(int r,int hi){return (r&3)+8*(r>>2)+4*hi;}
#define SBAR() __builtin_amdgcn_sched_barrier(0)
__device__ __forceinline__ void cmask(f32x16&p0,f32x16&p1,int jb,int qrel,int hi){
  const float NEG=-INFINITY; int kb=64*jb+4*hi;
  #pragma unroll
  for(int r=0;r<16;++r){int kv=kb+(r&3)+8*(r>>2); if(kv>qrel)p0[r]=NEG; if(kv+32>qrel)p1[r]=NEG;}
}

constexpr int NSLOT=3, SLOTB=8192;
constexpr int LDS_K=0, LDS_V=NSLOT*SLOTB, LDS_WS=2*NSLOT*SLOTB, LDS_OST=LDS_WS+NW*64*4, LDS_BIAS=LDS_OST+NW*4096, LDS_BYTES=LDS_BIAS+SEQ*4;
constexpr float C2=0.125f*1.4426950408889634f;
__device__ __forceinline__ void glds16(const void*gsrc,unsigned lds_dst){unsigned keep;
  asm volatile("s_mov_b32 %0, m0\n\ts_mov_b32 m0, %2\n\ts_nop 0\n\tglobal_load_lds_dwordx4 %1, off\n\ts_mov_b32 m0, %0":"=&s"(keep):"v"(gsrc),"s"(lds_dst):"memory");}
__device__ __forceinline__ float max3f(float a,float b,float c){float r;asm("v_max3_f32 %0, %1, %2, %3":"=v"(r):"v"(a),"v"(b),"v"(c));return r;}
__device__ __forceinline__ float max2f(float a,float b){float r;asm("v_max_f32_e32 %0, %1, %2":"=v"(r):"v"(a),"v"(b));return r;}
__device__ __forceinline__ float fadd_s(float a,float b){float r;asm("v_add_f32_e32 %0, %1, %2":"=v"(r):"v"(a),"v"(b));return r;}
__device__ __forceinline__ float fsub_s(float a,float b){float r;asm("v_sub_f32_e32 %0, %1, %2":"=v"(r):"v"(a),"v"(b));return r;}
typedef float f32x2_t __attribute__((ext_vector_type(2))); typedef __bf16 bf16x2_t __attribute__((ext_vector_type(2)));
__device__ __forceinline__ unsigned cvtpk_s(float lo,float hi){f32x2_t v={lo,hi};bf16x2_t b=__builtin_convertvector(v,bf16x2_t);return __builtin_bit_cast(unsigned,b);}
#define WAIT_BAR(N) asm volatile("s_waitcnt vmcnt(" #N ") lgkmcnt(0)\n\ts_barrier":::"memory")

__device__ __forceinline__ void qkt(f32x16&p0,f32x16&p1,const char*Kslot,const bf16x8*qr,const f32x16&c0in,const f32x16&c1in,int r32,int hi){
  const char*kb=Kslot+hi*1024+r32*16;
  #pragma unroll
  for(int d0=0;d0<4;++d0){
    const bf16x8 b0=*reinterpret_cast<const bf16x8*>(kb+d0*2048);
    const bf16x8 b1=*reinterpret_cast<const bf16x8*>(kb+d0*2048+512);
    if(d0==0){p0=__builtin_amdgcn_mfma_f32_32x32x16_bf16(b0,qr[0],c0in,0,0,0);p1=__builtin_amdgcn_mfma_f32_32x32x16_bf16(b1,qr[0],c1in,0,0,0);}
    else{p0=__builtin_amdgcn_mfma_f32_32x32x16_bf16(b0,qr[d0],p0,0,0,0);p1=__builtin_amdgcn_mfma_f32_32x32x16_bf16(b1,qr[d0],p1,0,0,0);}}
}
typedef __attribute__((address_space(3))) const char* lds_cptr;
typedef short v4i16_t __attribute__((ext_vector_type(4)));
__device__ __forceinline__ void kload8(bf16x8*kf,lds_cptr kp){
  kf[0]=*(const __attribute__((address_space(3))) bf16x8*)(kp);      kf[1]=*(const __attribute__((address_space(3))) bf16x8*)(kp+512);
  kf[2]=*(const __attribute__((address_space(3))) bf16x8*)(kp+2048); kf[3]=*(const __attribute__((address_space(3))) bf16x8*)(kp+2560);
  kf[4]=*(const __attribute__((address_space(3))) bf16x8*)(kp+4096); kf[5]=*(const __attribute__((address_space(3))) bf16x8*)(kp+4608);
  kf[6]=*(const __attribute__((address_space(3))) bf16x8*)(kp+6144); kf[7]=*(const __attribute__((address_space(3))) bf16x8*)(kp+6656);
}
__device__ __forceinline__ void kload2(bf16x8*kf,lds_cptr kp,int j){ kf[2*j]=*(const __attribute__((address_space(3))) bf16x8*)(kp+j*2048); kf[2*j+1]=*(const __attribute__((address_space(3))) bf16x8*)(kp+j*2048+512); }
__device__ __forceinline__ s16x4 vtr(lds_cptr p){ return __builtin_bit_cast(s16x4,__builtin_amdgcn_ds_read_tr16_b64_v4i16((__attribute__((address_space(3))) v4i16_t*)p)); }
__device__ __forceinline__ float rowmax(const f32x16&p0,const f32x16&p1){
  float a=max3f(p0[0],p0[1],p1[0]),b=max3f(p0[2],p0[3],p1[1]);a=max3f(a,p1[2],p1[3]);
  #pragma unroll
  for(int r=4;r<16;r+=4){a=max3f(a,p0[r],p0[r+1]);b=max3f(b,p0[r+2],p0[r+3]);a=max3f(a,p1[r],p1[r+1]);b=max3f(b,p1[r+2],p1[r+3]);}
  const float m=max2f(a,b);
  auto rr=__builtin_amdgcn_permlane32_swap(__float_as_uint(m),__float_as_uint(m),false,false);
  return max2f(__uint_as_float(rr[0]),__uint_as_float(rr[1]));
}
__device__ __forceinline__ void pv(f32x16*o,int vb,bf16x8 pa0,bf16x8 pa1,bf16x8 pa2,bf16x8 pa3){
  #pragma unroll
  for(int d0=0;d0<2;++d0){s16x4 lo[4],hi[4];
    #pragma unroll
    for(int ks=0;ks<4;++ks){
      asm volatile("ds_read_b64_tr_b16 %0,%1 offset:%c2":"=&v"(lo[ks]):"v"(vb),"i"(d0*4096+ks*1024):"memory");
      asm volatile("ds_read_b64_tr_b16 %0,%1 offset:%c2":"=&v"(hi[ks]):"v"(vb),"i"(d0*4096+ks*1024+512):"memory");}
    asm volatile("s_waitcnt lgkmcnt(0)":::"memory");SBAR();
    #define PK(k) (bf16x8){lo[k][0],lo[k][1],lo[k][2],lo[k][3],hi[k][0],hi[k][1],hi[k][2],hi[k][3]}
    o[d0]=__builtin_amdgcn_mfma_f32_32x32x16_bf16(pa0,PK(0),o[d0],0,0,0);
    o[d0]=__builtin_amdgcn_mfma_f32_32x32x16_bf16(pa1,PK(1),o[d0],0,0,0);
    o[d0]=__builtin_amdgcn_mfma_f32_32x32x16_bf16(pa2,PK(2),o[d0],0,0,0);
    o[d0]=__builtin_amdgcn_mfma_f32_32x32x16_bf16(pa3,PK(3),o[d0],0,0,0);
    #undef PK
  }
}

#ifndef ATTN_STORE16
#define ATTN_STORE16(p,v) (*(u32x4*)(p)=(v))
#endif
typedef __attribute__((address_space(3))) const float* lds_fptr; typedef float f32x4_t __attribute__((ext_vector_type(4)));
__device__ __forceinline__ void bias_tuple(f32x16&c0,f32x16&c1,lds_fptr bp,float mhat){
  #pragma unroll
  for(int g=0;g<4;++g){ const f32x4_t x=*(const __attribute__((address_space(3))) f32x4_t*)(bp+8*g), y=*(const __attribute__((address_space(3))) f32x4_t*)(bp+32+8*g);
    #pragma unroll
    for(int i=0;i<4;++i){ c0[4*g+i]=x[i]-mhat; c1[4*g+i]=y[i]-mhat; } }
}
template<int THRL> __device__ __forceinline__ void attn_unit(int b,int h,int qb,const bf16*Q,const bf16*__restrict__ K,const bf16*__restrict__ V,bf16*O,const float*__restrict__ cum,char*shm){
  int tid_=threadIdx.x; asm volatile("":"+v"(tid_));
  const int tid=tid_,lane=tid&63,r32=lane&31,hi=lane>>5; const int wid=__builtin_amdgcn_readfirstlane(tid>>6);
  const long rowbase=(long)b*SEQ; const int q0=qb*QB;
  const bf16*Qw=Q+(rowbase+q0+wid*QBLK)*DM+h*D;
  const bf16*Kh=K+rowbase*DM+h*D,*Vh=V+rowbase*DM+h*D;
  const unsigned lds0=(unsigned)(uintptr_t)shm;
  float*wsf=(float*)(shm+LDS_WS)+wid*64;
  { const float*cb=cum+(long)(b*NHEAD+h)*SEQ; const float cref=cb[q0]; float*bt=(float*)(shm+LDS_BIAS);
    float cv[8];
    _Pragma("unroll") for(int u=0;u<8;++u){const int j=tid+u*NW*64; cv[u]=(j<q0+QB)?cb[j]:0.f;}
    _Pragma("unroll") for(int u=0;u<8;++u){const int j=tid+u*NW*64; if(j<q0+QB)bt[j]=-1.4426950408889634f*(cv[u]-cref);} }
  asm volatile("s_waitcnt lgkmcnt(0)\n\ts_barrier":::"memory");
  int tskip=0;
  { const int NT0=(q0+QB)/KVBLK; const lds_fptr bt0=(lds_fptr)((lds_cptr)shm+LDS_BIAS);
    const float bv=(lane<NT0)?bt0[64*lane+63]:0.f;
    const unsigned long long mk=__ballot(lane<NT0&&bv<-64.f);
    tskip=__builtin_amdgcn_readfirstlane((int)__popcll(mk))&~1; if(tskip>NT0-4)tskip=NT0-4; }
  const lds_fptr btl=(lds_fptr)((lds_cptr)shm+LDS_BIAS)+4*hi+64*tskip;
  const bf16*Khs=Kh+(long)tskip*KVBLK*DM,*Vhs=Vh+(long)tskip*KVBLK*DM;
  const bf16*ksrc=Khs+(long)lane*DM+wid*8;
  const bf16*vsrc=Vhs+(long)(16*(wid&3)+(lane>>2))*DM+(wid>>2)*32+(lane&3)*8;
  const unsigned kdst=lds0+LDS_K+wid*1024, vdst=lds0+LDS_V+wid*1024;
  #define DMA_K(t,slot) glds16(ksrc+(long)(t)*KVBLK*DM,(unsigned)__builtin_amdgcn_readfirstlane(kdst+(slot)))
  #define DMA_V(t,slot) glds16(vsrc+(long)(t)*KVBLK*DM,(unsigned)__builtin_amdgcn_readfirstlane(vdst+(slot)))
  const int vb0=(int)(lds0+LDS_V)+((lane>>4)&1)*32+(lane&3)*8+(4*hi+((lane&15)>>2))*64;
  const char*Kbase=shm+LDS_K; bf16x8 kf[8];
  const lds_cptr shm3=(lds_cptr)shm; const lds_cptr kp0=shm3+LDS_K+hi*1024+r32*16; const lds_cptr vp0=shm3+LDS_V+((lane>>4)&1)*32+(lane&3)*8+(4*hi+((lane&15)>>2))*64;
  const int NT=(q0+QB)/KVBLK-tskip;
  DMA_K(0,0);DMA_V(0,0);DMA_K(1,SLOTB);
  bf16x8 qr[4];
  #pragma unroll
  for(int d0=0;d0<4;++d0)qr[d0]=*reinterpret_cast<const bf16x8*>(&Qw[(long)r32*DM+d0*16+hi*8]);
  float mhat=0.f,l_reg=0.f;f32x16 o[2];o[0]=f32x16{};o[1]=f32x16{};
  const int qrel=wid*QBLK+r32;
  #define CMASK(P0,P1,t) do{int jb_=(t)-(NT-4); if(jb_>=0)cmask(P0,P1,jb_,qrel,hi);}while(0)
  bool resc=false;
  #define START(P0,P1) do{ const float rm=rowmax(P0,P1); resc=false; \
    { const float dl=rm; mhat=fadd_s(mhat,dl); \
      _Pragma("unroll") for(int r=0;r<16;++r){P0[r]=fsub_s(P0[r],dl);P1[r]=fsub_s(P1[r],dl);} \
      } \
    _Pragma("unroll") for(int r=0;r<16;++r)P0[r]=__builtin_amdgcn_exp2f(P0[r]); }while(0)
  #define RESC() do{ if(resc){ asm volatile("s_waitcnt lgkmcnt(0)":::"memory"); \
      _Pragma("unroll") for(int d_=0;d_<2;++d_) _Pragma("unroll") for(int r=0;r<16;++r)o[d_][r]*=wsf[crow(r,hi)]; } }while(0)
  f32x16 pA0,pA1,pB0,pB1;
  int sl_prev=0,sl_cur=0,sl_next=SLOTB;
  #define ROT() do{sl_prev=sl_cur;sl_cur=sl_next;sl_next=(sl_next==(NSLOT-1)*SLOTB)?0:sl_next+SLOTB;}while(0)
  DMA_K(2,2*SLOTB);
  WAIT_BAR(3);
  { f32x16 c0in,c1in; bias_tuple(c0in,c1in,btl,0.f); qkt(pA0,pA1,Kbase,qr,c0in,c1in,r32,hi); } asm volatile("s_nop 15\n\ts_nop 7":"+v"(pA0),"+v"(pA1));CMASK(pA0,pA1,0);
  START(pA0,pA1);
  _Pragma("unroll") for(int r=0;r<16;++r)pA1[r]=__builtin_amdgcn_exp2f(pA1[r]);
  WAIT_BAR(0);
  DMA_K(3,0);DMA_V(1,SLOTB);
  ROT();
  kload8(kf,kp0+sl_cur);
  WAIT_BAR(2);
  s16x4 vlo[8],vhi[8]; u32x4 pw0,pw1,pw2,pw3;
  #define PKW(P,B) cvtpk_s(P[B],P[B+1])
  #define PAF(k) __builtin_bit_cast(bf16x8,pw##k)
  #define VFR(i) (bf16x8){vlo[i][0],vlo[i][1],vlo[i][2],vlo[i][3],vhi[i][0],vhi[i][1],vhi[i][2],vhi[i][3]}
  #define PIN(x) asm volatile("":"+v"(x))
  #define MX3(a,b,c) __builtin_fmaxf(__builtin_fmaxf((a),(b)),(c))
  #define GAPA(MF,A0,A1,A2,A3,W0,W1,PW) do{ MF; sacc+=A0; sacc+=A1; sacc+=A2; sacc+=A3; PIN(sacc); W0; W1; PIN(PW); SBAR(); }while(0)
  #define EX(v) __builtin_amdgcn_exp2f(v)
  #define GAPB(MF,X,B) do{ MF; X[B]=EX(X[B]); X[B+1]=EX(X[B+1]); X[B+2]=EX(X[B+2]); X[B+3]=EX(X[B+3]); PIN(X); SBAR(); }while(0)
  #define VRD(i) do{ vlo[i]=vtr(vp_+(((i)>>2)*4096+((i)&3)*1024)); vhi[i]=vtr(vp_+(((i)>>2)*4096+((i)&3)*1024+512)); }while(0)
  #define KRD(G,j) do{ if(G){ kload2(kf,kp0+sl_next,j); SBAR(); } }while(0)
  #define STEP(C0,C1,P0,P1,t,GK,GV,GL) do{ SBAR(); \
    const lds_cptr vp_=vp0+sl_prev; bias_tuple(C0,C1,btl+(t)*64,mhat); SBAR(); \
    VRD(0); SBAR(); float sacc=(P0[0]+P0[1]); \
    GAPA(C0=__builtin_amdgcn_mfma_f32_32x32x16_bf16(kf[0],qr[0],C0,0,0,0), P0[2],P0[3],P0[4],P0[5],     pw0[0]=PKW(P0,0), pw0[1]=PKW(P0,2), pw0); \
    VRD(4); SBAR(); GAPA(C1=__builtin_amdgcn_mfma_f32_32x32x16_bf16(kf[1],qr[0],C1,0,0,0), P0[6],P0[7],P0[8],P0[9],     pw0[2]=PKW(P0,4), pw0[3]=PKW(P0,6), pw0); \
    VRD(1); SBAR(); GAPA(C0=__builtin_amdgcn_mfma_f32_32x32x16_bf16(kf[2],qr[1],C0,0,0,0),   P0[10],P0[11],P0[12],P0[13], pw1[0]=PKW(P0,8), pw1[1]=PKW(P0,10), pw1); \
    VRD(5); SBAR(); GAPA(C1=__builtin_amdgcn_mfma_f32_32x32x16_bf16(kf[3],qr[1],C1,0,0,0),   P0[14],P0[15],P1[0],P1[1],   pw1[2]=PKW(P0,12),pw1[3]=PKW(P0,14), pw1); \
    VRD(2); SBAR(); GAPA(C0=__builtin_amdgcn_mfma_f32_32x32x16_bf16(kf[4],qr[2],C0,0,0,0),   P1[2],P1[3],P1[4],P1[5],     pw2[0]=PKW(P1,0), pw2[1]=PKW(P1,2), pw2); \
    VRD(6); SBAR(); GAPA(C1=__builtin_amdgcn_mfma_f32_32x32x16_bf16(kf[5],qr[2],C1,0,0,0),   P1[6],P1[7],P1[8],P1[9],     pw2[2]=PKW(P1,4), pw2[3]=PKW(P1,6), pw2); \
    VRD(3); SBAR(); GAPA(C0=__builtin_amdgcn_mfma_f32_32x32x16_bf16(kf[6],qr[3],C0,0,0,0),   P1[10],P1[11],P1[12],P1[13], pw3[0]=PKW(P1,8), pw3[1]=PKW(P1,10), pw3); \
    VRD(7); SBAR(); GAPA(C1=__builtin_amdgcn_mfma_f32_32x32x16_bf16(kf[7],qr[3],C1,0,0,0),   P1[14],P1[15],0.f,0.f,       pw3[2]=PKW(P1,12),pw3[3]=PKW(P1,14), pw3); \
    l_reg+=sacc; \
    if(GK){DMA_K((t)+3,sl_cur);} if(GV){DMA_V((t)+1,sl_next);} \
    CMASK(C0,C1,t); \
    { float a=MX3(C0[0],C0[1],C1[0]),b=MX3(C0[2],C0[3],C1[1]); a=MX3(a,C1[2],C1[3]); \
      _Pragma("unroll") for(int r=4;r<16;r+=4){a=MX3(a,C0[r],C0[r+1]);b=MX3(b,C0[r+2],C0[r+3]);a=MX3(a,C1[r],C1[r+1]);b=MX3(b,C1[r+2],C1[r+3]);} \
      float rm=__builtin_fmaxf(a,b); { auto rr=__builtin_amdgcn_permlane32_swap(__float_as_uint(rm),__float_as_uint(rm),false,false); rm=__builtin_fmaxf(__uint_as_float(rr[0]),__uint_as_float(rr[1])); } \
      resc=false; \
      if(__builtin_expect(__any(rm>(float)THRL),0)){ const float dl=__builtin_fmaxf(rm,0.f); mhat+=dl; \
        _Pragma("unroll") for(int r=0;r<16;++r){C0[r]-=dl;C1[r]-=dl;} \
        const float f=__builtin_amdgcn_exp2f(-dl); l_reg*=f; if(hi==0)wsf[r32]=f; resc=true; } } \
    SBAR(); \
    GAPB(o[0]=__builtin_amdgcn_mfma_f32_32x32x16_bf16(PAF(0),VFR(0),o[0],0,0,0), C0,0); \
    GAPB(o[1]=__builtin_amdgcn_mfma_f32_32x32x16_bf16(PAF(0),VFR(4),o[1],0,0,0), C0,4); \
    KRD(GL,0); GAPB(o[0]=__builtin_amdgcn_mfma_f32_32x32x16_bf16(PAF(1),VFR(1),o[0],0,0,0), C0,8); \
    KRD(GL,1); GAPB(o[1]=__builtin_amdgcn_mfma_f32_32x32x16_bf16(PAF(1),VFR(5),o[1],0,0,0), C0,12); \
    KRD(GL,2); GAPB(o[0]=__builtin_amdgcn_mfma_f32_32x32x16_bf16(PAF(2),VFR(2),o[0],0,0,0), C1,0); \
    KRD(GL,3); GAPB(o[1]=__builtin_amdgcn_mfma_f32_32x32x16_bf16(PAF(2),VFR(6),o[1],0,0,0), C1,4); \
    GAPB(o[0]=__builtin_amdgcn_mfma_f32_32x32x16_bf16(PAF(3),VFR(3),o[0],0,0,0), C1,8); \
    GAPB(o[1]=__builtin_amdgcn_mfma_f32_32x32x16_bf16(PAF(3),VFR(7),o[1],0,0,0), C1,12); \
    }while(0)
  int t=1;
  #undef CMASK
  #define CMASK(P0,P1,t) do{}while(0)
  for(;t+5<NT;t+=2){
    STEP(pB0,pB1,pA0,pA1,t,true,true,true);     WAIT_BAR(2); RESC(); ROT();
    STEP(pA0,pA1,pB0,pB1,t+1,true,true,true);   WAIT_BAR(2); RESC(); ROT();
  }
  #undef CMASK
  #define CMASK(P0,P1,t) do{int jb_=(t)-(NT-4); if(jb_>=0)cmask(P0,P1,jb_,qrel,hi);}while(0)
  #define ENDW(tt) do{ if((tt)+3<NT){WAIT_BAR(2);} else if((tt)+2<NT){WAIT_BAR(1);} else {WAIT_BAR(0);} }while(0)
  for(;t+1<NT;t+=2){
    STEP(pB0,pB1,pA0,pA1,t,(t+3<NT),(t+1<NT),(t+1<NT));       ENDW(t);   RESC(); ROT();
    STEP(pA0,pA1,pB0,pB1,t+1,(t+4<NT),(t+2<NT),(t+2<NT));     ENDW(t+1); RESC(); ROT();
  }
  STEP(pB0,pB1,pA0,pA1,NT-1,false,false,false); RESC();
  { float sacc=pB0[0]+pB0[1]; _Pragma("unroll") for(int r=2;r<16;++r)sacc+=pB0[r]; _Pragma("unroll") for(int r=0;r<16;++r)sacc+=pB1[r]; l_reg+=sacc;
    pw0=(u32x4){PKW(pB0,0),PKW(pB0,2),PKW(pB0,4),PKW(pB0,6)};pw1=(u32x4){PKW(pB0,8),PKW(pB0,10),PKW(pB0,12),PKW(pB0,14)};pw2=(u32x4){PKW(pB1,0),PKW(pB1,2),PKW(pB1,4),PKW(pB1,6)};pw3=(u32x4){PKW(pB1,8),PKW(pB1,10),PKW(pB1,12),PKW(pB1,14)};
    SBAR(); pv(o,vb0+sl_cur,PAF(0),PAF(1),PAF(2),PAF(3)); }
  #undef PKW
  #undef PAF
  #undef VFR
  #undef PIN
  #undef MX3
  #undef GAPA
  #undef GAPB
  #undef EX
  #undef VRD
  #undef KRD
  #undef STEP
  #undef ENDW
  {auto rr=__builtin_amdgcn_permlane32_swap(__float_as_uint(l_reg),__float_as_uint(l_reg),false,false);l_reg=__uint_as_float(rr[0])+__uint_as_float(rr[1]);}
  if(hi==0)wsf[32+r32]=l_reg;asm volatile("s_waitcnt lgkmcnt(0)":::"memory");
  float rli[16];
  #pragma unroll
  for(int r=0;r<16;++r)rli[r]=__builtin_amdgcn_rcpf(wsf[32+crow(r,hi)]);
  bf16*Ow=O+(rowbase+q0+wid*QBLK)*DM+h*D;
  { bf16*stg=(bf16*)(shm+LDS_OST)+wid*2048;
    #pragma unroll
    for(int r=0;r<16;++r){const int orow=crow(r,hi);
      #pragma unroll
      for(int d0=0;d0<2;++d0)stg[orow*64+d0*32+r32]=__float2bfloat16(o[d0][r]*rli[r]);}
    asm volatile("s_waitcnt lgkmcnt(0)":::"memory");
    #pragma unroll
    for(int i=0;i<4;++i){const int row=i*8+(lane>>3),ch=lane&7; const u32x4 v=*(const u32x4*)(stg+row*64+ch*8); ATTN_STORE16(Ow+(long)row*DM+ch*8,v);} }
  asm volatile("s_waitcnt lgkmcnt(0)\n\ts_barrier":::"memory");
  #undef DMA_K
  #undef DMA_V
  #undef CMASK
  #undef START
  #undef RESC
  #undef ROT
}
constexpr int ATTN_LDS_BYTES=LDS_BYTES;
struct AttnTensors { const bf16* Q; const bf16* K; const bf16* V; bf16* O; const float* cum; };
struct AttnUnit { int bh; int qb; };
struct StaticOrder {
  int vcu;
  __device__ __forceinline__ explicit StaticOrder(int grid,int block):vcu((block%8)*(grid/8)+block/8){}
  __device__ __forceinline__ bool next(int i,AttnUnit&u)const{ if(i>=4||vcu>=256)return false; const int s=vcu&3; u.bh=(vcu>>5)*NHEAD+((((vcu>>2)&7)+2*i)&7); u.qb=(i==0)?s:(i==1)?7-s:(i==2)?8+s:15-s; return true; }
  __device__ __forceinline__ void a_ready(const AttnUnit&)const{}
  __device__ __forceinline__ void done(const AttnUnit&)const{}
};
struct QueueOrder {
  unsigned* q; volatile __attribute__((address_space(3))) int* slot;
  __device__ __forceinline__ bool next(int,AttnUnit&u)const{
    if(threadIdx.x==0)slot[0]=(int)__hip_atomic_fetch_add(q,1u,__ATOMIC_RELAXED,__HIP_MEMORY_SCOPE_AGENT);
    asm volatile("s_waitcnt vmcnt(0) lgkmcnt(0)\n\ts_barrier":::"memory");
    const int v=__builtin_amdgcn_readfirstlane(slot[0]);
    asm volatile("s_waitcnt lgkmcnt(0)\n\ts_barrier":::"memory");
    if(v>=128)return false; u.qb=15-(v>>3); u.bh=7-(v&7); return true; }
  __device__ __forceinline__ void a_ready(const AttnUnit&)const{}
  __device__ __forceinline__ void done(const AttnUnit&)const{}
};
template<class Sched,int THRL=8> __device__ __forceinline__ void attn_phase(char*lds,const AttnTensors&T,const Sched&S){
  AttnUnit u;
  for(int i=0;S.next(i,u);++i){ S.a_ready(u); attn_unit<THRL>(u.bh/NHEAD,u.bh%NHEAD,u.qb,T.Q,T.K,T.V,T.O,T.cum,lds); S.done(u); }
}
#undef SBAR
#undef WAIT_BAR
}
constexpr int NWAVES = 8;
constexpr int RING_BYTES = 131072;
constexpr int LDSCTL_BYTES = 4096, RING_OFF = LDSCTL_BYTES;
constexpr int LDS_BYTES = 147456;
constexpr int CW_BAR = 4096;
typedef __attribute__((address_space(1))) unsigned gu32;

#define XB_TMO      128
#define XB_XCNT(j)  (256  + 64 * (j))
#define XB_XSUB(j)  (1280 + 64 * (j))
#define XB_XGEN(j)  (2304 + 64 * (j))
#define XB_TOP      3328
#define XB_TOPGEN   3392
#define XCD_BAR_WORDS 3456
#define XB_SPIN_CAP (1u << 18)
__device__ __forceinline__ unsigned xb_ld(unsigned* p)              { return __hip_atomic_load(p, __ATOMIC_RELAXED, __HIP_MEMORY_SCOPE_AGENT); }
__device__ __forceinline__ unsigned xb_add(unsigned* p, unsigned v) { return __hip_atomic_fetch_add(p, v, __ATOMIC_RELAXED, __HIP_MEMORY_SCOPE_AGENT); }
__device__ __forceinline__ unsigned xb_xcc_id() { return (unsigned)__builtin_amdgcn_s_getreg((3 << 11) | 20) & 0xFu; }
#define XB_SPIN(cond, bar) do { unsigned _sp = 0; while (cond) { __builtin_amdgcn_s_sleep(1); \
    if ((++_sp & 255u) == 0u) { if (xb_ld(&(bar)[XB_TMO])) break; if (_sp > XB_SPIN_CAP) { atomicAdd(&(bar)[XB_TMO], 1u); break; } } } } while (0)
struct XcdBarrier { unsigned* bar; unsigned x; volatile LAS unsigned* st; };
__device__ __forceinline__ XcdBarrier xcd_barrier_post(unsigned* bar, volatile LAS unsigned* st) {
    XcdBarrier b; b.bar = bar; b.x = xb_xcc_id(); b.st = st;
    if (threadIdx.x == 0) (void)xb_add(&bar[XB_XCNT(b.x)], 1u);
    return b;
}
__device__ __forceinline__ void xcd_barrier_complete(unsigned* bar, unsigned x, unsigned& nloc, unsigned& nx) {
    const unsigned G = gridDim.x * gridDim.y * gridDim.z;
    unsigned sum, cnt, mine, sp = 0u;
    for (;;) {
        sum = 0u; cnt = 0u; mine = 0u;
#pragma unroll
        for (unsigned j = 0; j < 16; ++j) { const unsigned c = xb_ld(&bar[XB_XCNT(j)]); sum += c; cnt += (c > 0u) ? 1u : 0u; mine = (j == x) ? c : mine; }
        if (sum == G) break;
        __builtin_amdgcn_s_sleep(1);
        if ((++sp & 255u) == 0u) { if (xb_ld(&bar[XB_TMO])) break; if (sp > XB_SPIN_CAP) { atomicAdd(&bar[XB_TMO], 1u); break; } }
    }
    nloc = mine > 0u ? mine : 1u; nx = cnt > 0u ? cnt : 1u;
}
__device__ __forceinline__ void xcd_barrier(const XcdBarrier& b) {
    asm volatile("s_waitcnt vmcnt(0)" ::: "memory");
    __syncthreads();
    if (threadIdx.x == 0) {
        unsigned* bar = b.bar;
        __builtin_amdgcn_s_waitcnt(0);
        unsigned nloc = b.st[0], nx = b.st[1];
        if (nloc == 0u) { xcd_barrier_complete(bar, b.x, nloc, nx); b.st[0] = nloc; b.st[1] = nx; }
        const unsigned old = xb_add(&bar[XB_XSUB(b.x)], 1u);
        const unsigned gen = old / nloc;
        if (old + 1u == (gen + 1u) * nloc) {
            __builtin_amdgcn_fence(__ATOMIC_RELEASE, "agent");
            asm volatile("s_waitcnt vmcnt(0)" ::: "memory");
            const unsigned og = xb_add(&bar[XB_TOP], 1u);
            const unsigned tg = og / nx;
            if (og + 1u == (tg + 1u) * nx) xb_add(&bar[XB_TOPGEN], 1u);
            else XB_SPIN(xb_ld(&bar[XB_TOPGEN]) == tg, bar);
            __builtin_amdgcn_fence(__ATOMIC_ACQUIRE, "agent");
            xb_add(&bar[XB_XGEN(b.x)], 1u);
            asm volatile("s_waitcnt vmcnt(0)" ::: "memory");
        } else {
            XB_SPIN(xb_ld(&bar[XB_XGEN(b.x)]) == gen, bar);
            __builtin_amdgcn_fence(__ATOMIC_ACQUIRE, "agent");
            asm volatile("s_waitcnt vmcnt(0)" ::: "memory");
        }
    }
    __syncthreads();
}

struct MoeOrder {
    const volatile LAS int* tpre; const unsigned* cnt; const int* tok; const char* A; const char* B; size_t estepB, tstepB, tstepA; int nN, G, c, lda; bool gather;
    int r0x;
    __device__ __forceinline__ bool unit_at(int mt, int pn, pg8::Unit& u) const {
        if (mt >= tpre[32]) return false;
        const int e = __builtin_amdgcn_readfirstlane((int)((volatile LAS unsigned char*)(tpre + 96))[mt]);
        const int lt = __builtin_amdgcn_readfirstlane(mt - tpre[e]);
        const int rem = tpre[33 + e] - lt * 256;
        u.e = e; u.pm = mt; u.pn = pn; u.valid = rem < 256 ? rem : 256; u.lt = lt; u.lda = 1024; u.ldb = 1024; u.nt = 16; u.seg = 0;
        u.B = B + (size_t)e * estepB + (size_t)pn * tstepB;
        u.A = gather ? A : A + (size_t)mt * tstepA;
        return true;
    }
    __device__ __forceinline__ bool next(int i, pg8::Unit& u) const {
        const int x = c & 7, j = c >> 3, per = (G >> 3) / nN, pn = j % nN; int mt = (i * 8 + x) * per + j / nN;
        if (r0x >= 0) { const int k = r0x + 1; mt = mt < k ? mt : (mt < 2 * k ? 32 + (mt - k) : 64 + (mt - 2 * k)); }
        return unit_at(mt, pn, u);
    }
    __device__ __forceinline__ void goff(const pg8::Unit& u, int R0, int C0, unsigned (&off)[2][2]) const {
#pragma unroll
        for (int h = 0; h < 2; ++h)
#pragma unroll
            for (int i = 0; i < 2; ++i) { const int r = h * 128 + R0 + 64 * i; const int t = r < u.valid ? tok[(size_t)u.e * NTOK + u.lt * 256 + r] : 0; off[h][i] = (unsigned)(t * lda + C0) * 2u; }
    }
};
struct MoeOne { MoeOrder M; int mt, pn;
    __device__ __forceinline__ bool next(int i, pg8::Unit& u) const { if (i) return false; return M.unit_at(mt, pn, u); }
    __device__ __forceinline__ void goff(const pg8::Unit& u, int R0, int C0, unsigned (&off)[2][2]) const { M.goff(u, R0, C0, off); }
};
__device__ __forceinline__ void moe_prefix(const unsigned* cnt, volatile LAS int* tpre) {
    int tid = threadIdx.x; asm volatile("" : "+v"(tid));
    if (tid < 64) { const int c = tid < 32 ? (int)cnt[tid * CNT_STRIDE] : 0; const int tl = (c + 255) >> 8; int inc = tl;
#pragma unroll
        for (int o = 1; o < 32; o <<= 1) { const int t = __shfl_up(inc, o); if (tid >= o) inc += t; }
        if (tid < 32) { tpre[tid] = inc - tl; tpre[33 + tid] = c; if (tid == 31) tpre[32] = inc; } }
    __syncthreads();
    { volatile LAS unsigned char* tmap = (volatile LAS unsigned char*)(tpre + 96);
      const int tot = tpre[32];
      for (int mt = tid; mt < tot; mt += NWAVES * 64) { int e = 0;
#pragma unroll
          for (int k = 1; k < 32; ++k) e += (tpre[k] <= mt) ? 1 : 0;
          tmap[mt] = (unsigned char)e; } }
    __syncthreads();
}

constexpr size_t WS_S5W1 = 58 * MiB;
constexpr size_t WS_S5W3 = 66 * MiB;
constexpr size_t WS_S5A16 = 78 * MiB;
constexpr size_t WS_S5S = 2304 * MiB;
constexpr size_t WS_OB = 2320 * MiB;
constexpr size_t WS_GQ = 2640 * MiB;
constexpr size_t WS_END2 = 2736 * MiB;

struct S5Disc { float lr, li, dt, zr, zi; };
__device__ __forceinline__ S5Disc s5_disc(const float* lam_re, const float* lam_im, const float* log_dt, int g, int p) {
    S5Disc d; d.dt = expf(log_dt[g]); d.lr = lam_re[g * 64 + p]; d.li = lam_im[g * 64 + p];
    const float mag = expf(d.lr * d.dt), ar = mag * cosf(d.li * d.dt), ai = mag * sinf(d.li * d.dt), den = d.lr * d.lr + d.li * d.li, nr = ar - 1.0f;
    d.zr = (nr * d.lr + ai * d.li) / den; d.zi = (ai * d.lr - nr * d.li) / den; return d;
}
__device__ __forceinline__ void s5_apow(const S5Disc& d, float n, float& pr, float& pi) { const float mag = expf(d.lr * d.dt * n); pr = mag * cosf(d.li * d.dt * n); pi = mag * sinf(d.li * d.dt * n); }

struct S5In { const float *lam_re, *lam_im, *log_dt, *b_re, *b_im, *c_re, *c_im, *dsk; };
__device__ __forceinline__ void s5_prep_item(const S5In& in, unsigned char* ws, int l, int g, int kind, int q, int lane) {
    const float* lam_re = in.lam_re + (size_t)l * 1024; const float* lam_im = in.lam_im + (size_t)l * 1024; const float* log_dt = in.log_dt + (size_t)l * 16;
    const float* b_re = in.b_re + (size_t)l * 16384; const float* b_im = in.b_im + (size_t)l * 16384; const float* c_re = in.c_re + (size_t)l * 16384; const float* c_im = in.c_im + (size_t)l * 16384;
    const float* dsk = in.dsk + (size_t)l * 256;
    bf16_t* W1 = (bf16_t*)(ws + WS_S5W1) + ((size_t)l * 16 + g) * 256 * 256;
    bf16_t* W3 = (bf16_t*)(ws + WS_S5W3) + ((size_t)l * 16 + g) * 256 * 384;
    const int p = lane;
    const S5Disc d = s5_disc(lam_re, lam_im, log_dt, g, p);
    if (kind == 0) {
        float pr, pi; s5_apow(d, (float)q, pr, pi);
        float mr[16], mi[16];
#pragma unroll
        for (int h = 0; h < 16; ++h) { const float br = b_re[(g * 64 + p) * 16 + h], bi = b_im[(g * 64 + p) * 16 + h]; const float bbr = d.zr * br - d.zi * bi, bbi = d.zr * bi + d.zi * br;
            mr[h] = pr * bbr - pi * bbi; mi[h] = pr * bbi + pi * bbr; }
        float crv[16], civ[16];
#pragma unroll
        for (int hp = 0; hp < 16; ++hp) { crv[hp] = c_re[(g * 16 + hp) * 64 + p]; civ[hp] = c_im[(g * 16 + hp) * 64 + p]; }
#pragma unroll
        for (int hp = 0; hp < 16; ++hp) {
            const float cr = crv[hp], ci = civ[hp];
            float v[16];
#pragma unroll
            for (int h = 0; h < 16; ++h) v[h] = cr * mr[h] - ci * mi[h];
            reduce_scatter<16>(v, lane);
            const int h = (lane >> 2) & 15;
            float kv = v[0]; if (q == 0 && h == hp) kv += dsk[g * 16 + hp];
            const bf16_t kb = f2bf(kv);
            for (int s = (lane & 3); s + q < 16; s += 4) { const int t = s + q;
                W3[(size_t)(t * 16 + hp) * 384 + s * 16 + h] = kb;
                if (q > 0) W3[(size_t)(s * 16 + hp) * 384 + t * 16 + h] = 0; }
        }
    } else if (kind == 1) {
        float pr, pi; s5_apow(d, (float)(15 - q), pr, pi);
        u32x4 wr0, wr1, wi0, wi1; unsigned wr_[8], wi_[8];
#pragma unroll
        for (int h2 = 0; h2 < 8; ++h2) { float re[2], im[2];
#pragma unroll
            for (int e = 0; e < 2; ++e) { const int h = 2 * h2 + e; const float br = b_re[(g * 64 + p) * 16 + h], bi = b_im[(g * 64 + p) * 16 + h]; const float bbr = d.zr * br - d.zi * bi, bbi = d.zr * bi + d.zi * br;
                re[e] = pr * bbr - pi * bbi; im[e] = pr * bbi + pi * bbr; }
            wr_[h2] = pk2(re[0], re[1]); wi_[h2] = pk2(im[0], im[1]); }
        wr0 = (u32x4){wr_[0], wr_[1], wr_[2], wr_[3]}; wr1 = (u32x4){wr_[4], wr_[5], wr_[6], wr_[7]}; wi0 = (u32x4){wi_[0], wi_[1], wi_[2], wi_[3]}; wi1 = (u32x4){wi_[4], wi_[5], wi_[6], wi_[7]};
        *(u32x4*)(W1 + (size_t)p * 256 + q * 16) = wr0; *(u32x4*)(W1 + (size_t)p * 256 + q * 16 + 8) = wr1;
        *(u32x4*)(W1 + (size_t)(64 + p) * 256 + q * 16) = wi0; *(u32x4*)(W1 + (size_t)(64 + p) * 256 + q * 16 + 8) = wi1;
        const u32x4 z = (u32x4){0u, 0u, 0u, 0u};
        *(u32x4*)(W1 + (size_t)(128 + p) * 256 + q * 16) = z; *(u32x4*)(W1 + (size_t)(128 + p) * 256 + q * 16 + 8) = z;
        *(u32x4*)(W1 + (size_t)(192 + p) * 256 + q * 16) = z; *(u32x4*)(W1 + (size_t)(192 + p) * 256 + q * 16 + 8) = z;
    } else {
        float pr, pi; s5_apow(d, (float)(q + 1), pr, pi);
#pragma unroll
        for (int hp = 0; hp < 16; ++hp) { const float cr = c_re[(g * 16 + hp) * 64 + p], ci = c_im[(g * 16 + hp) * 64 + p];
            W3[(size_t)(q * 16 + hp) * 384 + 256 + p] = f2bf(cr * pr - ci * pi);
            W3[(size_t)(q * 16 + hp) * 384 + 320 + p] = f2bf(-(cr * pi + ci * pr)); }
        if (q == 0) { float ar, ai; s5_apow(d, 16.0f, ar, ai); float* A16 = (float*)(ws + WS_S5A16) + (((size_t)l * 16 + g) * 64 + p) * 2; A16[0] = ar; A16[1] = ai; }
    }
}

__device__ __forceinline__ void s5_scan_wg(const float* S, const float* a16, bf16_t* A3, int b, int g, LAS float* sl) {
    int tid = threadIdx.x; asm volatile("" : "+v"(tid));
    const f32x4* src = (const f32x4*)(S + ((size_t)g * 2048 + b * 256) * 128);
#pragma unroll 1
    for (int i0 = tid; i0 < 8192; i0 += 8 * NWAVES * 64) { f32x4 w[8];
#pragma unroll
        for (int u = 0; u < 8; ++u) w[u] = src[i0 + u * NWAVES * 64];
#pragma unroll
        for (int u = 0; u < 8; ++u) *(LAS f32x4*)(sl + 4 * (i0 + u * NWAVES * 64)) = w[u]; }
    __syncthreads();
    if (tid < 64) {
        const int lane = tid; const float ar = a16[(g * 64 + lane) * 2], ai = a16[(g * 64 + lane) * 2 + 1];
        bf16_t* hp = A3 + ((size_t)g * 2048 + b * 256) * 384 + 256 + lane;
        float hr = 0.f, hi = 0.f;
#pragma unroll 8
        for (int c = 0; c < 256; ++c) { const float sr = sl[c * 128 + lane], si = sl[c * 128 + 64 + lane];
            hp[(size_t)c * 384] = f2bf(hr); hp[(size_t)c * 384 + 64] = f2bf(hi);
            const float nr = ar * hr - ai * hi + sr, ni = ar * hi + ai * hr + si; hr = nr; hi = ni; }
        asm volatile("s_waitcnt vmcnt(0)" ::: "memory");
        __builtin_amdgcn_fence(__ATOMIC_ACQUIRE, "agent");
        asm volatile("s_waitcnt vmcnt(0)" ::: "memory");
    }
    __syncthreads();
}

typedef float f32x16p __attribute__((ext_vector_type(16)));
__device__ __forceinline__ void pool_phase(const bf16_t* H, const float* wpool, const float* pscale, bf16_t* yb, int bx, int G, LAS unsigned char* lds) {
    int tid = threadIdx.x; asm volatile("" : "+v"(tid));
    const int lane = tid & 63, w8 = tid >> 6, g = w8 >> 1, tb = (w8 & 1) * 32, r = lane & 31, hi = lane >> 5;
    LAS bf16_t* ut = (LAS bf16_t*)lds; LAS bf16_t* mxb = (LAS bf16_t*)(lds + 79 * 512);
    bf16x8 wf[4][2]; float ps[2];
#pragma unroll
    for (int ks = 0; ks < 4; ++ks)
#pragma unroll
        for (int cb = 0; cb < 2; ++cb) { unsigned pk[4];
#pragma unroll
            for (int j2 = 0; j2 < 4; ++j2) { const float a = wpool[(g * 64 + 16 * ks + 8 * hi + 2 * j2) * 64 + 32 * cb + r], b = wpool[(g * 64 + 16 * ks + 8 * hi + 2 * j2 + 1) * 64 + 32 * cb + r]; pk[j2] = pk2(a, b); }
            wf[ks][cb] = __builtin_bit_cast(bf16x8, (u32x4){pk[0], pk[1], pk[2], pk[3]}); }
    ps[0] = pscale[g * 64 + r]; ps[1] = pscale[g * 64 + 32 + r];
    u32x4 wn[5];
#pragma unroll
    for (int u = 0; u < 5; ++u) { const int c = tid + u * NWAVES * 64; const int rr = c >> 5, ch8 = (c & 31) * 8; const int tok = bx * 64 - 15 + rr; wn[u] = (u32x4){0u, 0u, 0u, 0u}; if (bx < NTOK / 64 && c < 79 * 32 && tok >= 0) wn[u] = *(const GAS u32x4*)((const GAS bf16_t*)H + (size_t)tok * HP + HC_POOL + ch8); }
    for (int item = bx; item < NTOK / 64; item += G) {
        const int t0 = item * 64;
        {
#pragma unroll
          for (int u = 0; u < 5; ++u) { const int c = tid + u * NWAVES * 64; if (c < 79 * 32) *(LAS u32x4*)(ut + (c >> 5) * 256 + (c & 31) * 8) = wn[u]; }
          const int t1 = (item + G) * 64;
#pragma unroll
          for (int u = 0; u < 5; ++u) { const int c = tid + u * NWAVES * 64; const int rr = c >> 5, ch8 = (c & 31) * 8; const int tok = t1 - 15 + rr; wn[u] = (u32x4){0u, 0u, 0u, 0u}; if (item + G < NTOK / 64 && c < 79 * 32 && tok >= 0) wn[u] = *(const GAS u32x4*)((const GAS bf16_t*)H + (size_t)tok * HP + HC_POOL + ch8); } }
        __syncthreads();
        { const int ch = tid & 255, half = tid >> 8, gg = ch >> 6, w = 2 << gg, l0 = half * 32, tf = (t0 + l0) & (SEQ - 1);
          float s = 0.f;
          for (int k = 1; k < w; ++k) if (tf - k >= 0) s += bf2f(ut[(15 + l0 - k) * 256 + ch]);
#pragma unroll 4
          for (int q = 0; q < 32; ++q) { const int lt = l0 + q, t = tf + q; const float u = bf2f(ut[(15 + lt) * 256 + ch]);
              s += u; if (q > 0 && t >= w) s -= bf2f(ut[(15 + lt - w) * 256 + ch]);
              const int cnt = (t + 1 < w) ? t + 1 : w;
              mxb[lt * 264 + ch] = f2bf(s * __builtin_amdgcn_rcpf((float)cnt) - u); } }
        __syncthreads();
        f32x16p acc[2];
#pragma unroll
        for (int cb = 0; cb < 2; ++cb)
#pragma unroll
            for (int q = 0; q < 16; ++q) acc[cb][q] = 0.f;
#pragma unroll
        for (int ks = 0; ks < 4; ++ks) { const bf16x8 a = *(const LAS bf16x8*)(mxb + (tb + r) * 264 + g * 64 + 16 * ks + 8 * hi);
            acc[0] = __builtin_amdgcn_mfma_f32_32x32x16_bf16(a, wf[ks][0], acc[0], 0, 0, 0); acc[1] = __builtin_amdgcn_mfma_f32_32x32x16_bf16(a, wf[ks][1], acc[1], 0, 0, 0); }
#pragma unroll
        for (int cb = 0; cb < 2; ++cb)
#pragma unroll
            for (int q = 0; q < 16; ++q) { const int tok = t0 + tb + (q & 3) + 8 * (q >> 2) + 4 * hi; yb[(size_t)tok * 256 + g * 64 + 32 * cb + r] = f2bf(acc[cb][q] * ps[cb]); }
        __syncthreads();
    }
}

constexpr int WT_PITCH = 1028;
__device__ __forceinline__ void load_wt_lds(const float* W, int ldw, int ne, volatile LAS float* Tv) {
    int tid0 = threadIdx.x; asm volatile("" : "+v"(tid0));
    LAS float* T = (LAS float*)Tv; const int q = ne >> 2, tot = 1024 * q;
    for (int base = tid0; base < tot; base += 8 * NWAVES * 64) {
        f32x4 w[8];
#pragma unroll
        for (int u = 0; u < 8; ++u) { const int idx = base + u * NWAVES * 64; if (idx < tot) { const int k = idx / q, e4 = (idx - k * q) * 4; w[u] = *(const f32x4*)(W + (size_t)k * ldw + e4); } }
#pragma unroll
        for (int u = 0; u < 8; ++u) { const int idx = base + u * NWAVES * 64; if (idx < tot) { const int k = idx / q, e4 = (idx - k * q) * 4;
            T[(e4 + 0) * WT_PITCH + k] = w[u].x; T[(e4 + 1) * WT_PITCH + k] = w[u].y; T[(e4 + 2) * WT_PITCH + k] = w[u].z; T[(e4 + 3) * WT_PITCH + k] = w[u].w; } }
    }
    __syncthreads();
}
__device__ __forceinline__ void wave_sum2(float& a, float& b) {
#pragma unroll
    for (int o = 1; o < 64; o <<= 1) { const float ta = __shfl_xor(a, o), tb = __shfl_xor(b, o); a += ta; b += tb; } }
__device__ __forceinline__ void wave_max2(float a, float b, float& ra, float& rb) {
#pragma unroll
    for (int o = 32; o >= 1; o >>= 1) { const float ta = __shfl_xor(a, o), tb = __shfl_xor(b, o); a = fmaxf(a, ta); b = fmaxf(b, tb); }
    ra = a; rb = b; }
__device__ __forceinline__ void wave_min2(int a, int b, int& ra, int& rb) {
#pragma unroll
    for (int o = 32; o >= 1; o >>= 1) { const int ta = __shfl_xor(a, o), tb = __shfl_xor(b, o); a = ta < a ? ta : a; b = tb < b ? tb : b; }
    ra = a; rb = b; }
__device__ __forceinline__ void row_ln2(f32x4 (&v)[4], f32x4 (&w)[4], const float* g, const float* bta, int lane) {
    f32x4 gg[4], bb[4];
#pragma unroll
    for (int j = 0; j < 4; ++j) { gg[j] = *(const GAS f32x4*)((const GAS float*)g + 4 * (lane + 64 * j)); bb[j] = *(const GAS f32x4*)((const GAS float*)bta + 4 * (lane + 64 * j)); }
    float s = 0.f, t = 0.f;
#pragma unroll
    for (int j = 0; j < 4; ++j) { s += (v[j].x + v[j].y) + (v[j].z + v[j].w); t += (w[j].x + w[j].y) + (w[j].z + w[j].w); }
    wave_sum2(s, t); const float mv = s * (1.f / D), mw = t * (1.f / D); float s2 = 0.f, t2 = 0.f;
#pragma unroll
    for (int j = 0; j < 4; ++j) { v[j] = v[j] - mv; w[j] = w[j] - mw; s2 += (v[j].x * v[j].x + v[j].y * v[j].y) + (v[j].z * v[j].z + v[j].w * v[j].w); t2 += (w[j].x * w[j].x + w[j].y * w[j].y) + (w[j].z * w[j].z + w[j].w * w[j].w); }
    wave_sum2(s2, t2); const float rv = __builtin_amdgcn_rsqf(s2 * (1.f / D) + LN_EPS), rw = __builtin_amdgcn_rsqf(t2 * (1.f / D) + LN_EPS);
#pragma unroll
    for (int j = 0; j < 4; ++j) { v[j] = v[j] * rv * gg[j] + bb[j]; w[j] = w[j] * rw * gg[j] + bb[j]; }
}
__device__ __forceinline__ void row_ln2s(f32x4 (&v)[4], f32x4 (&w)[4], const float* g, const float* bta, int lane, float& mv, float& rv, float& mw, float& rw) {
    f32x4 gg[4], bb[4];
#pragma unroll
    for (int j = 0; j < 4; ++j) { gg[j] = *(const GAS f32x4*)((const GAS float*)g + 4 * (lane + 64 * j)); bb[j] = *(const GAS f32x4*)((const GAS float*)bta + 4 * (lane + 64 * j)); }
    float s = 0.f, t = 0.f;
#pragma unroll
    for (int j = 0; j < 4; ++j) { s += (v[j].x + v[j].y) + (v[j].z + v[j].w); t += (w[j].x + w[j].y) + (w[j].z + w[j].w); }
    wave_sum2(s, t); mv = s * (1.f / D); mw = t * (1.f / D); float s2 = 0.f, t2 = 0.f;
#pragma unroll
    for (int j = 0; j < 4; ++j) { v[j] = v[j] - mv; w[j] = w[j] - mw; s2 += (v[j].x * v[j].x + v[j].y * v[j].y) + (v[j].z * v[j].z + v[j].w * v[j].w); t2 += (w[j].x * w[j].x + w[j].y * w[j].y) + (w[j].z * w[j].z + w[j].w * w[j].w); }
    wave_sum2(s2, t2); rv = __builtin_amdgcn_rsqf(s2 * (1.f / D) + LN_EPS); rw = __builtin_amdgcn_rsqf(t2 * (1.f / D) + LN_EPS);
#pragma unroll
    for (int j = 0; j < 4; ++j) { v[j] = v[j] * rv * gg[j] + bb[j]; w[j] = w[j] * rw * gg[j] + bb[j]; }
}
template <int N> __device__ __forceinline__ void reduce_scatter2(float (&v)[N], float (&w)[N], int lane) {
    int s = 32;
#pragma unroll
    for (int n = N / 2; n >= 1; n >>= 1) {
        const bool up = (lane & s) != 0;
#pragma unroll
        for (int i = 0; i < n; ++i) { float hi = v[i + n], lo = v[i], hj = w[i + n], lj = w[i]; asm volatile("" : "+v"(hi), "+v"(lo), "+v"(hj), "+v"(lj));
            const float kv = up ? hi : lo, sv = up ? lo : hi, kw = up ? hj : lj, sw = up ? lj : hj; v[i] = kv + __shfl_xor(sv, s); w[i] = kw + __shfl_xor(sw, s); }
        s >>= 1;
    }
    for (; s >= 1; s >>= 1) { const float ta = __shfl_xor(v[0], s), tb = __shfl_xor(w[0], s); v[0] += ta; w[0] += tb; }
}
template <int NEX> __device__ __forceinline__ void row_dot2_lds(const f32x4 (&v0)[4], const f32x4 (&v1)[4], const LAS float* T, float (&a0)[NEX], float (&a1)[NEX], int lane) {
#pragma unroll
    for (int e = 0; e < NEX; ++e) { f32x2 p0 = (f32x2){0.f, 0.f}, p1 = (f32x2){0.f, 0.f};
#pragma unroll
        for (int j = 0; j < 4; ++j) { const f32x4 w = *(const LAS f32x4*)(T + e * WT_PITCH + 4 * (lane + 64 * j));
            p0 = __builtin_elementwise_fma((f32x2){v0[j].x, v0[j].y}, (f32x2){w.x, w.y}, p0); p0 = __builtin_elementwise_fma((f32x2){v0[j].z, v0[j].w}, (f32x2){w.z, w.w}, p0);
            p1 = __builtin_elementwise_fma((f32x2){v1[j].x, v1[j].y}, (f32x2){w.x, w.y}, p1); p1 = __builtin_elementwise_fma((f32x2){v1[j].z, v1[j].w}, (f32x2){w.z, w.w}, p1); }
        a0[e] = p0.x + p0.y; a1[e] = p1.x + p1.y;
        if ((e & 3) == 3) { asm volatile("" ::: "memory"); __builtin_amdgcn_sched_barrier(0); } }
}
__device__ __forceinline__ void row_logf_fin(float (&a)[8], const float* bf_l, float* logf, int m, int lane) {
    reduce_scatter<8>(a, lane);
    if ((lane & 7) == 0) { const int h = lane >> 3; const float z = a[0] + ((const GAS float*)bf_l)[h]; const float ls = fminf(z, 0.f) - 0.6931471805599453f * __builtin_amdgcn_logf(1.0f + __builtin_amdgcn_exp2f(-L2E * fabsf(z)));
        const int b = m / SEQ, t = m % SEQ; ((GAS float*)logf)[((size_t)b * 8 + h) * SEQ + t] = ls; }
}
__device__ __forceinline__ void rows0_phase(const float* x, const float* w_in0, const float* bf0, bf16_t* xb, float* logf, volatile LAS float* T, int gw, int NGW, int lane) {
    asm volatile("" : "+v"(lane));
    load_wt_lds(w_in0 + 1536, NIN, 8, T);
    f32x4 n0[4], n1[4];
    if (2 * gw < NTOK) {
#pragma unroll
        for (int j = 0; j < 4; ++j) { n0[j] = *(const GAS f32x4*)((const GAS float*)x + (size_t)(2 * gw) * D + 4 * (lane + 64 * j)); n1[j] = *(const GAS f32x4*)((const GAS float*)x + (size_t)(2 * gw + 1) * D + 4 * (lane + 64 * j)); } }
    for (int m = 2 * gw; m < NTOK; m += 2 * NGW) {
        f32x4 v0[4], v1[4];
#pragma unroll
        for (int j = 0; j < 4; ++j) { v0[j] = n0[j]; v1[j] = n1[j]; }
        { const int mn = m + 2 * NGW; if (mn < NTOK) {
#pragma unroll
            for (int j = 0; j < 4; ++j) { n0[j] = *(const GAS f32x4*)((const GAS float*)x + (size_t)mn * D + 4 * (lane + 64 * j)); n1[j] = *(const GAS f32x4*)((const GAS float*)x + (size_t)(mn + 1) * D + 4 * (lane + 64 * j)); } } }
        float a0[8], a1[8]; row_dot2_lds<8>(v0, v1, (const LAS float*)T, a0, a1, lane);
        row_store_bf16(v0, xb + (size_t)m * D, lane); row_logf_fin(a0, bf0, logf, m, lane);
        row_store_bf16(v1, xb + (size_t)(m + 1) * D, lane); row_logf_fin(a1, bf0, logf, m + 1, lane);
    }
    __syncthreads();
}
__device__ __forceinline__ void rows1_phase(const bf16_t* xinb, const bf16_t* mix, const float* g1, const float* b1, const float* wr, const float* br, bf16_t* x1b, unsigned* cnt, int* tok, int* re, int* rr, float* rg,
                                            volatile LAS float* T, volatile LAS unsigned* lcnt, volatile LAS unsigned* lbase, volatile LAS float* wscr_all, int bx, int G, int wave, int lane) {
    asm volatile("" : "+v"(lane));
    volatile LAS float* wscr = wscr_all + wave * 32;
    const int tid = wave * 64 + lane;
    if (tid < 32) lcnt[tid] = 0u;
    load_wt_lds(wr, 32, 32, T);
    for (int blk = bx; blk < NTOK / 128; blk += G) {
        const int row0 = blk * 128 + wave * 16;
        int my_e = 0; float my_g = 0.f;
#pragma unroll 1
        for (int i = 0; i < 16; i += 2) {
            const int m = row0 + i; f32x4 v0[4], v1[4];
#pragma unroll
            for (int j = 0; j < 4; ++j) { f32x4 xa, xb_; { const u32x2 wa = *(const u32x2*)(xinb + (size_t)m * D + 4 * (lane + 64 * j)), wb = *(const u32x2*)(xinb + (size_t)(m + 1) * D + 4 * (lane + 64 * j));
                    xa.x = __uint_as_float(wa.x << 16); xa.y = __uint_as_float(wa.x & 0xffff0000u); xa.z = __uint_as_float(wa.y << 16); xa.w = __uint_as_float(wa.y & 0xffff0000u); xb_.x = __uint_as_float(wb.x << 16); xb_.y = __uint_as_float(wb.x & 0xffff0000u); xb_.z = __uint_as_float(wb.y << 16); xb_.w = __uint_as_float(wb.y & 0xffff0000u); }
                const u32x2 ma = *(const u32x2*)(mix + (size_t)m * D + 4 * (lane + 64 * j)), mb = *(const u32x2*)(mix + (size_t)(m + 1) * D + 4 * (lane + 64 * j));
                v0[j].x = ALPHA * xa.x + __uint_as_float(ma.x << 16); v0[j].y = ALPHA * xa.y + __uint_as_float(ma.x & 0xffff0000u); v0[j].z = ALPHA * xa.z + __uint_as_float(ma.y << 16); v0[j].w = ALPHA * xa.w + __uint_as_float(ma.y & 0xffff0000u);
                v1[j].x = ALPHA * xb_.x + __uint_as_float(mb.x << 16); v1[j].y = ALPHA * xb_.y + __uint_as_float(mb.x & 0xffff0000u); v1[j].z = ALPHA * xb_.z + __uint_as_float(mb.y << 16); v1[j].w = ALPHA * xb_.w + __uint_as_float(mb.y & 0xffff0000u); }
            row_ln2(v0, v1, g1, b1, lane);
            row_store_bf16(v0, x1b + (size_t)m * D, lane); row_store_bf16(v1, x1b + (size_t)(m + 1) * D, lane);
            float a0[32], a1[32]; row_dot2_lds<32>(v0, v1, (const LAS float*)T, a0, a1, lane);
            reduce_scatter2<32>(a0, a1, lane);
            const int myexp = (lane >> 1) & 31; const float bre = br[myexp]; const float va = a0[0] + bre, vb = a1[0] + bre;
            int ra = 0, rb = 0;
#pragma unroll
            for (int k = 1; k < 32; ++k) { const int oe = (myexp + k) & 31; const float oa = __shfl(va, 2 * oe), ob = __shfl(vb, 2 * oe);
                ra += (oa > va || (oa == va && oe < myexp)) ? 1 : 0; rb += (ob > vb || (ob == vb && oe < myexp)) ? 1 : 0; }
            float ua[4], ub[4]; int ta[4], tb[4];
#pragma unroll
            for (int k = 0; k < 4; ++k) { const unsigned long long ma = __ballot(ra == k), mb = __ballot(rb == k); const int la = __ffsll((long long)ma) - 1, lb = __ffsll((long long)mb) - 1;
                ta[k] = la >> 1; tb[k] = lb >> 1; ua[k] = __shfl(va, la); ub[k] = __shfl(vb, lb); }
            { const float e1 = __builtin_amdgcn_exp2f(L2E * (ua[1] - ua[0])), e2 = __builtin_amdgcn_exp2f(L2E * (ua[2] - ua[0])), e3 = __builtin_amdgcn_exp2f(L2E * (ua[3] - ua[0])); const float inv = 1.0f / (1.0f + e1 + e2 + e3);
              if ((lane >> 2) == i) { const int k = lane & 3; my_e = k == 0 ? ta[0] : k == 1 ? ta[1] : k == 2 ? ta[2] : ta[3]; my_g = (k == 0 ? 1.0f : k == 1 ? e1 : k == 2 ? e2 : e3) * inv; } }
            { const float e1 = __builtin_amdgcn_exp2f(L2E * (ub[1] - ub[0])), e2 = __builtin_amdgcn_exp2f(L2E * (ub[2] - ub[0])), e3 = __builtin_amdgcn_exp2f(L2E * (ub[3] - ub[0])); const float inv = 1.0f / (1.0f + e1 + e2 + e3);
              if ((lane >> 2) == i + 1) { const int k = lane & 3; my_e = k == 0 ? tb[0] : k == 1 ? tb[1] : k == 2 ? tb[2] : tb[3]; my_g = (k == 0 ? 1.0f : k == 1 ? e1 : k == 2 ? e2 : e3) * inv; } }
        }
        const unsigned lrank = __hip_atomic_fetch_add((LAS unsigned*)lcnt + my_e, 1u, __ATOMIC_RELAXED, __HIP_MEMORY_SCOPE_WORKGROUP);
        __syncthreads();
        if (tid < 32) { const unsigned c = lcnt[tid]; lbase[tid] = c ? atomicAdd(cnt + tid * CNT_STRIDE, c) : 0u; }
        __syncthreads();
        { const unsigned rank = lbase[my_e] + lrank; const int m = row0 + (lane >> 2);
          tok[(size_t)my_e * NTOK + rank] = m; re[(size_t)row0 * 4 + lane] = my_e; rr[(size_t)row0 * 4 + lane] = (int)rank; rg[(size_t)row0 * 4 + lane] = my_g; }
        __syncthreads();
        if (tid < 32) lcnt[tid] = 0u;
        __syncthreads();
    }
}
constexpr size_t WS_WRT = 79 * MiB;
constexpr int PW1 = 1032;
__device__ __forceinline__ void router_prep_item(const float* g1, const float* b1, const float* wr, const float* br, unsigned char* ws, int l, int e, int lane) {
    bf16_t* WT = (bf16_t*)(ws + WS_WRT) + (size_t)l * 64 * PW1; float* GB = (float*)(ws + WS_WRT + 768 * 1024) + l * 64;
    float sg = 0.f, sb = 0.f;
#pragma unroll
    for (int j = 0; j < 16; ++j) { const int k = lane + 64 * j; const float w0 = wr[(size_t)l * 1024 * 32 + k * 32 + e], gk = g1[l * 1024 + k], bk = b1[l * 1024 + k]; const float w = w0 * gk;
        const bf16_t hi = f2bf(w); WT[e * PW1 + k] = hi; WT[(32 + e) * PW1 + k] = f2bf(w - bf2f(hi)); sg += w; sb += bk * w0; }
    sg = wave_sum(sg); sb = wave_sum(sb);
    if (lane == 0) { GB[e] = sg; GB[32 + e] = sb + br[l * 32 + e]; }
}
__device__ __forceinline__ void rows1m_phase(const bf16_t* xinb, const bf16_t* mix, const float* g1, const float* b1, const bf16_t* wtg, const float* gbg, bf16_t* x1b, unsigned* cnt, int* tok, int* re, int* rr, float* rg,
                                             LAS unsigned char* ring, volatile LAS unsigned* lcnt, volatile LAS unsigned* lbase, volatile LAS float* gb  , int bx, int G, int wave, int lane) {
    asm volatile("" : "+v"(lane));
    const int tid = wave * 64 + lane;
    LAS bf16_t* WT = (LAS bf16_t*)ring;
    if (tid < 32) lcnt[tid] = 0u;
    { const GAS u32x4* src = (const GAS u32x4*)wtg; constexpr int NV = 64 * PW1 * 2 / 16;
#pragma unroll 1
      for (int i0 = tid; i0 < NV; i0 += 8 * NWAVES * 64) { u32x4 w[8];
#pragma unroll
          for (int u = 0; u < 8; ++u) { const int i = i0 + u * NWAVES * 64; if (i < NV) w[u] = src[i]; }
#pragma unroll
          for (int u = 0; u < 8; ++u) { const int i = i0 + u * NWAVES * 64; if (i < NV) *(LAS u32x4*)(ring + 16 * i) = w[u]; } }
      if (tid < 64) gb[tid] = ((const GAS float*)gbg)[tid]; }
    __syncthreads();
    const int rrow = lane & 15, grp = lane >> 4;
    for (int blk = bx; blk < NTOK / 128; blk += G) {
        const int row0 = blk * 128 + wave * 16;
        float mu_l = 0.f, rs_l = 0.f;
        u32x2 nxa[4], nxb[4], nma[4], nmb[4];
#pragma unroll
        for (int j = 0; j < 4; ++j) { nxa[j] = *(const GAS u32x2*)((const GAS bf16_t*)xinb + (size_t)row0 * D + 4 * (lane + 64 * j)); nxb[j] = *(const GAS u32x2*)((const GAS bf16_t*)xinb + (size_t)(row0 + 1) * D + 4 * (lane + 64 * j));
                                      nma[j] = *(const GAS u32x2*)((const GAS bf16_t*)mix + (size_t)row0 * D + 4 * (lane + 64 * j)); nmb[j] = *(const GAS u32x2*)((const GAS bf16_t*)mix + (size_t)(row0 + 1) * D + 4 * (lane + 64 * j)); }
#pragma unroll 1
        for (int i = 0; i < 16; i += 2) {
            const int m = row0 + i; f32x4 v0[4], v1[4];
            u32x2 cxa[4], cxb[4], cma[4], cmb[4];
#pragma unroll
            for (int j = 0; j < 4; ++j) { cxa[j] = nxa[j]; cxb[j] = nxb[j]; cma[j] = nma[j]; cmb[j] = nmb[j]; }
            if (i + 2 < 16) {
#pragma unroll
                for (int j = 0; j < 4; ++j) { nxa[j] = *(const GAS u32x2*)((const GAS bf16_t*)xinb + (size_t)(m + 2) * D + 4 * (lane + 64 * j)); nxb[j] = *(const GAS u32x2*)((const GAS bf16_t*)xinb + (size_t)(m + 3) * D + 4 * (lane + 64 * j));
                                              nma[j] = *(const GAS u32x2*)((const GAS bf16_t*)mix + (size_t)(m + 2) * D + 4 * (lane + 64 * j)); nmb[j] = *(const GAS u32x2*)((const GAS bf16_t*)mix + (size_t)(m + 3) * D + 4 * (lane + 64 * j)); }
            }
#pragma unroll
            for (int j = 0; j < 4; ++j) { f32x4 xa, xb_; { const u32x2 wa = cxa[j], wb = cxb[j];
                    xa.x = __uint_as_float(wa.x << 16); xa.y = __uint_as_float(wa.x & 0xffff0000u); xa.z = __uint_as_float(wa.y << 16); xa.w = __uint_as_float(wa.y & 0xffff0000u); xb_.x = __uint_as_float(wb.x << 16); xb_.y = __uint_as_float(wb.x & 0xffff0000u); xb_.z = __uint_as_float(wb.y << 16); xb_.w = __uint_as_float(wb.y & 0xffff0000u); }
                const u32x2 ma = cma[j], mb = cmb[j];
                v0[j].x = ALPHA * xa.x + __uint_as_float(ma.x << 16); v0[j].y = ALPHA * xa.y + __uint_as_float(ma.x & 0xffff0000u); v0[j].z = ALPHA * xa.z + __uint_as_float(ma.y << 16); v0[j].w = ALPHA * xa.w + __uint_as_float(ma.y & 0xffff0000u);
                v1[j].x = ALPHA * xb_.x + __uint_as_float(mb.x << 16); v1[j].y = ALPHA * xb_.y + __uint_as_float(mb.x & 0xffff0000u); v1[j].z = ALPHA * xb_.z + __uint_as_float(mb.y << 16); v1[j].w = ALPHA * xb_.w + __uint_as_float(mb.y & 0xffff0000u); }
            float ma_, ra_, mb_, rb_; row_ln2s(v0, v1, g1, b1, lane, ma_, ra_, mb_, rb_);
            row_store_bf16(v0, x1b + (size_t)m * D, lane); row_store_bf16(v1, x1b + (size_t)(m + 1) * D, lane);
            if (rrow == i) { mu_l = ma_; rs_l = ra_; } if (rrow == i + 1) { mu_l = mb_; rs_l = rb_; }
        }
        f32x4 ax[4], am[4];
#pragma unroll
        for (int t = 0; t < 4; ++t) { ax[t] = (f32x4){0.f, 0.f, 0.f, 0.f}; am[t] = (f32x4){0.f, 0.f, 0.f, 0.f}; }
        { const GAS bf16_t* xp = (const GAS bf16_t*)xinb + (size_t)(row0 + rrow) * D + 8 * grp; const GAS bf16_t* mp = (const GAS bf16_t*)mix + (size_t)(row0 + rrow) * D + 8 * grp; const LAS bf16_t* wp = WT + rrow * PW1 + 8 * grp;
#pragma unroll 8
          for (int ks = 0; ks < 32; ++ks) { const bf16x8 fx = *(const GAS bf16x8*)(xp + 32 * ks), fm = *(const GAS bf16x8*)(mp + 32 * ks);
#pragma unroll
              for (int t = 0; t < 4; ++t) { const bf16x8 fw = *(const LAS bf16x8*)(wp + 16 * t * PW1 + 32 * ks);
                  ax[t] = __builtin_amdgcn_mfma_f32_16x16x32_bf16(fw, fx, ax[t], 0, 0, 0); am[t] = __builtin_amdgcn_mfma_f32_16x16x32_bf16(fw, fm, am[t], 0, 0, 0); } } }
        float v[8]; int ev[8];
#pragma unroll
        for (int t = 0; t < 2; ++t)
#pragma unroll
            for (int r = 0; r < 4; ++r) { const int e = 16 * t + 4 * grp + r; const float P = ALPHA * (ax[t][r] + ax[t + 2][r]) + (am[t][r] + am[t + 2][r]);
                v[4 * t + r] = rs_l * (P - mu_l * gb[e]) + gb[32 + e]; ev[4 * t + r] = e; }
        int kk[8], rk[8];
#pragma unroll
        for (int a = 0; a < 8; ++a) { const int bits = (int)__float_as_uint(v[a]); const int mono = bits ^ ((bits >> 31) & 0x7fffffff); kk[a] = (mono & ~31) | (31 - ev[a]); rk[a] = 0; }
#pragma unroll
        for (int a = 0; a < 8; ++a)
#pragma unroll
            for (int b = 0; b < 8; ++b) if (b != a) rk[a] += (kk[b] > kk[a]) ? 1 : 0;
#pragma unroll
        for (int sg = 1; sg < 4; ++sg) {
#pragma unroll
            for (int b = 0; b < 8; ++b) { const int o = __shfl_xor(kk[b], 16 * sg);
#pragma unroll
                for (int a = 0; a < 8; ++a) rk[a] += (o > kk[a]) ? 1 : 0; } }
        float u[4]; int tsel[4];
#pragma unroll
        for (int k = 0; k < 4; ++k) { unsigned se = 0u, sv = 0u;
#pragma unroll
            for (int a = 0; a < 8; ++a) { const bool hit = rk[a] == k; se |= hit ? (unsigned)(ev[a] + 1) : 0u; sv |= hit ? __float_as_uint(v[a]) : 0u; }
            se |= (unsigned)__shfl_xor((int)se, 16); sv |= (unsigned)__shfl_xor((int)sv, 16); se |= (unsigned)__shfl_xor((int)se, 32); sv |= (unsigned)__shfl_xor((int)sv, 32);
            tsel[k] = (int)se - 1; u[k] = __uint_as_float(sv); }
        const float e1 = __builtin_amdgcn_exp2f(L2E * (u[1] - u[0])), e2 = __builtin_amdgcn_exp2f(L2E * (u[2] - u[0])), e3 = __builtin_amdgcn_exp2f(L2E * (u[3] - u[0])); const float inv = 1.0f / (1.0f + e1 + e2 + e3);
        const int my_e = grp == 0 ? tsel[0] : grp == 1 ? tsel[1] : grp == 2 ? tsel[2] : tsel[3]; const float my_g = (grp == 0 ? 1.0f : grp == 1 ? e1 : grp == 2 ? e2 : e3) * inv;
        const unsigned lrank = __hip_atomic_fetch_add((LAS unsigned*)lcnt + my_e, 1u, __ATOMIC_RELAXED, __HIP_MEMORY_SCOPE_WORKGROUP);
        __syncthreads();
        if (tid < 32) { const unsigned c = lcnt[tid]; lbase[tid] = c ? atomicAdd(cnt + tid * CNT_STRIDE, c) : 0u; }
        __syncthreads();
        { const unsigned rank = lbase[my_e] + lrank; const int m = row0 + rrow;
          tok[(size_t)my_e * NTOK + rank] = m; re[(size_t)m * 4 + grp] = my_e; rr[(size_t)m * 4 + grp] = (int)rank; rg[(size_t)m * 4 + grp] = my_g; }
        __syncthreads();
        if (tid < 32) lcnt[tid] = 0u;
        __syncthreads();
    }
}
__device__ __forceinline__ void rows2_phase(const bf16_t* x1b, const unsigned char* ym, const unsigned* cnt, const int* re, const int* rr, const float* rg, const float* g2, const float* b2,
                                            float* xout, bf16_t* xb, const float* w_in_next, const float* bf_next, float* logf, volatile LAS float* T, int gw, int NGW, int lane) {
    asm volatile("" : "+v"(lane));
    if (w_in_next) load_wt_lds(w_in_next + 1536, NIN, 8, T);
    int pc = lane < 32 ? (int)((((const GAS unsigned*)cnt)[(lane & 31) * CNT_STRIDE] + 255u) & ~255u) : 0; int inc = pc;
#pragma unroll
    for (int o = 1; o < 32; o <<= 1) { const int t = __shfl_up(inc, o); if (lane >= o) inc += t; }
    const int poff = inc - pc;
    typedef int i32x4 __attribute__((ext_vector_type(4)));
    u32x2 nxa[4], nxb[4]; i32x4 ne0, nr0, ne1, nr1; f32x4 ng0, ng1;
#define R2_FETCH(M) do { _Pragma("unroll") for (int j = 0; j < 4; ++j) { nxa[j] = *(const GAS u32x2*)((const GAS bf16_t*)x1b + (size_t)(M) * D + 4 * (lane + 64 * j)); nxb[j] = *(const GAS u32x2*)((const GAS bf16_t*)x1b + (size_t)((M) + 1) * D + 4 * (lane + 64 * j)); } \
        ne0 = *(const GAS i32x4*)((const GAS int*)re + (size_t)(M) * 4); nr0 = *(const GAS i32x4*)((const GAS int*)rr + (size_t)(M) * 4); ng0 = *(const GAS f32x4*)((const GAS float*)rg + (size_t)(M) * 4); \
        ne1 = *(const GAS i32x4*)((const GAS int*)re + (size_t)((M) + 1) * 4); nr1 = *(const GAS i32x4*)((const GAS int*)rr + (size_t)((M) + 1) * 4); ng1 = *(const GAS f32x4*)((const GAS float*)rg + (size_t)((M) + 1) * 4); } while (0)
    if (2 * gw < NTOK) R2_FETCH(2 * gw);
    for (int m = 2 * gw; m < NTOK; m += 2 * NGW) {
        f32x4 v0[4], v1[4]; const i32x4 e0 = ne0, r0 = nr0, e1 = ne1, r1 = nr1; const f32x4 g0 = ng0, g1 = ng1;
#pragma unroll
        for (int j = 0; j < 4; ++j) { const u32x2 wa = nxa[j], wb = nxb[j];
            v0[j].x = ALPHA * __uint_as_float(wa.x << 16); v0[j].y = ALPHA * __uint_as_float(wa.x & 0xffff0000u); v0[j].z = ALPHA * __uint_as_float(wa.y << 16); v0[j].w = ALPHA * __uint_as_float(wa.y & 0xffff0000u);
            v1[j].x = ALPHA * __uint_as_float(wb.x << 16); v1[j].y = ALPHA * __uint_as_float(wb.x & 0xffff0000u); v1[j].z = ALPHA * __uint_as_float(wb.y << 16); v1[j].w = ALPHA * __uint_as_float(wb.y & 0xffff0000u); }
        unsigned y0[4][4], y1[4][4];
#pragma unroll
        for (int k = 0; k < 4; ++k) { const int ra = __shfl(poff, e0[k]) + r0[k], rb = __shfl(poff, e1[k]) + r1[k]; const GAS unsigned char* ya = (const GAS unsigned char*)ym + (size_t)ra * 1024; const GAS unsigned char* yb_ = (const GAS unsigned char*)ym + (size_t)rb * 1024;
#pragma unroll
            for (int j = 0; j < 4; ++j) { y0[k][j] = *(const GAS unsigned*)(ya + 4 * (lane + 64 * j)); y1[k][j] = *(const GAS unsigned*)(yb_ + 4 * (lane + 64 * j)); } }
        { const int mn = m + 2 * NGW; if (mn < NTOK) R2_FETCH(mn); }
#pragma unroll
        for (int k = 0; k < 4; ++k)
#pragma unroll
            for (int j = 0; j < 4; ++j) { const int w = (int)y0[k][j], x = (int)y1[k][j]; const f32x2 ga = (f32x2){g0[k], g0[k]}, gb = (f32x2){g1[k], g1[k]};
                const f32x2 a01 = __builtin_elementwise_fma(__builtin_amdgcn_cvt_pk_f32_fp8(w, false), ga, (f32x2){v0[j].x, v0[j].y}), a23 = __builtin_elementwise_fma(__builtin_amdgcn_cvt_pk_f32_fp8(w, true), ga, (f32x2){v0[j].z, v0[j].w});
                const f32x2 b01 = __builtin_elementwise_fma(__builtin_amdgcn_cvt_pk_f32_fp8(x, false), gb, (f32x2){v1[j].x, v1[j].y}), b23 = __builtin_elementwise_fma(__builtin_amdgcn_cvt_pk_f32_fp8(x, true), gb, (f32x2){v1[j].z, v1[j].w});
                v0[j] = (f32x4){a01.x, a01.y, a23.x, a23.y}; v1[j] = (f32x4){b01.x, b01.y, b23.x, b23.y}; }
        row_ln2(v0, v1, g2, b2, lane);
        if (xout) { _Pragma("unroll") for (int j = 0; j < 4; ++j) { *(GAS f32x4*)((GAS float*)xout + (size_t)m * D + 4 * (lane + 64 * j)) = v0[j]; *(GAS f32x4*)((GAS float*)xout + (size_t)(m + 1) * D + 4 * (lane + 64 * j)) = v1[j]; } }
        if (w_in_next) { float a0[8], a1[8]; row_dot2_lds<8>(v0, v1, (const LAS float*)T, a0, a1, lane);
            row_store_bf16(v0, xb + (size_t)m * D, lane); row_logf_fin(a0, bf_next, logf, m, lane);
            row_store_bf16(v1, xb + (size_t)(m + 1) * D, lane); row_logf_fin(a1, bf_next, logf, m + 1, lane); }
    }
#undef R2_FETCH
    __syncthreads();
}
__device__ __forceinline__ void cumsum_block(const float* logf, float* cum, int bh, volatile LAS float* scr) {
    int tid = threadIdx.x; asm volatile("" : "+v"(tid)); const int lane = tid & 63, wv = tid >> 6;
    const float* src = logf + (size_t)bh * SEQ + tid * 8; float* dst = cum + (size_t)bh * SEQ + tid * 8;
    const f32x4 a = *(const f32x4*)src, b = *(const f32x4*)(src + 4);
    float v[8]; v[0] = a.x; v[1] = v[0] + a.y; v[2] = v[1] + a.z; v[3] = v[2] + a.w; v[4] = v[3] + b.x; v[5] = v[4] + b.y; v[6] = v[5] + b.z; v[7] = v[6] + b.w;
    const float s = v[7]; float inc = s;
#pragma unroll
    for (int o = 1; o < 64; o <<= 1) { const float t = __shfl_up(inc, o); if (lane >= o) inc += t; }
    if (lane == 63) scr[wv] = inc;
    __syncthreads();
    float base = inc - s;
    for (int i = 0; i < wv; ++i) base += scr[i];
    f32x4 o0, o1; o0.x = v[0] + base; o0.y = v[1] + base; o0.z = v[2] + base; o0.w = v[3] + base; o1.x = v[4] + base; o1.y = v[5] + base; o1.z = v[6] + base; o1.w = v[7] + base;
    *(f32x4*)dst = o0; *(f32x4*)(dst + 4) = o1;
    __syncthreads();
}

struct S5Order { const char* A; const char* B; size_t bstep; int G, c, ldb, nt;
    __device__ __forceinline__ bool next(int i, pg8::Unit& u) const {
        const int L = i * G + c; if (L >= 128) return false;
        const int g = L >> 3, pm = L & 7;
        u.A = A + ((size_t)g * 2048 + pm * 256) * 384 * 2; u.B = B + (size_t)g * bstep; u.e = g; u.pm = pm; u.pn = 0; u.valid = 256; u.lt = 0; u.lda = 384; u.ldb = ldb; u.nt = nt; u.seg = 0; return true; }
};
struct BranchOrder { pg8::StaticOrder T; const char *A0, *A1, *A2, *B0, *B1, *B2;
    __device__ __forceinline__ bool next(int i, pg8::Unit& u) const {
        const int ti = i / 3, seg = i - 3 * ti;
        if (!T.next(ti, u)) return false;
        u.seg = seg; u.lda = seg == 0 ? HP : 256; u.ldb = seg == 0 ? 512 : 256; u.nt = seg == 0 ? 8 : 4;
        const char *a0 = A0, *a1 = A1, *a2 = A2, *b0 = B0, *b1 = B1, *b2 = B2; asm volatile("" : "+s"(a0), "+s"(a1), "+s"(a2), "+s"(b0), "+s"(b1), "+s"(b2));
        u.A = (seg == 0 ? a0 : seg == 1 ? a1 : a2) + (size_t)u.pm * 256 * u.lda * 2; u.B = (seg == 0 ? b0 : seg == 1 ? b1 : b2) + (size_t)u.pn * 256 * u.ldb * 2; return true; }
};
namespace pg8 {
struct EpiS1 { float* S;
    static constexpr bool AFTER_DRAIN = false; __device__ __forceinline__ void pre(const Unit&, int, int, int, int) const {} __device__ __forceinline__ bool keep_acc(const Unit&) const { return false; }
    __device__ __forceinline__ void operator()(const Acc& acc, const Unit& u, int wr, int wc, int fr, int fq) const {
        const unsigned vo = (unsigned)(fr * 128 + 8 * fq) * 4u;
#pragma unroll
        for (int ai = 0; ai < 2; ++ai)
#pragma unroll
            for (int m = 0; m < 4; ++m) { float* ub = S + ((size_t)u.e * 2048 + u.pm * 256 + ai * 128 + wr * 64 + m * 16) * 128 + wc * 32;
                *(f32x4*)((char*)ub + vo) = acc[ai][0][m][0]; *(f32x4*)((char*)ub + vo + 16) = acc[ai][0][m][1]; }
    }
};
struct EpiS3 { bf16_t* ycp;
    static constexpr bool AFTER_DRAIN = false; __device__ __forceinline__ void pre(const Unit&, int, int, int, int) const {} __device__ __forceinline__ bool keep_acc(const Unit&) const { return false; }
    __device__ __forceinline__ void operator()(const Acc& acc, const Unit& u, int wr, int wc, int fr, int fq) const {
        const unsigned vo = (unsigned)((fr * 16 + (fq >> 1)) * 256 + (fq & 1) * 8) * 2u;
#pragma unroll
        for (int ai = 0; ai < 2; ++ai)
#pragma unroll
            for (int m = 0; m < 4; ++m)
#pragma unroll
                for (int bj = 0; bj < 2; ++bj) { f32x4 v[2] = {acc[ai][bj][m][0], acc[ai][bj][m][1]};
#pragma unroll
                    for (int n = 0; n < 2; ++n)
#pragma unroll
                        for (int i = 0; i < 4; ++i) { const float y = v[n][i]; v[n][i] = y * fsig(1.5957691216057308f * (y + 0.044715f * y * y * y)); }
                    st16(ycp + ((size_t)(u.pm * 256 + ai * 128 + wr * 64 + m * 16) * 16 + bj * 8 + wc * 2) * 256 + u.e * 16, vo, pack8(v[0], v[1])); }
    }
};
}

struct OneUnit { const char* A; const char* B; int pm, lda, ldb, nt;
    __device__ __forceinline__ bool next(int i, pg8::Unit& u) const {
        if (i) return false;
        u.A = A + (size_t)pm * 256 * lda * 2; u.B = B; u.e = 0; u.pm = pm; u.pn = 0; u.valid = 256; u.lt = 0; u.lda = lda; u.ldb = ldb; u.nt = nt; u.seg = 0; return true; }
};
__device__ __forceinline__ void wg_mem_sync() {
    asm volatile("s_waitcnt vmcnt(0)" ::: "memory");
    __syncthreads();
    if (threadIdx.x == 0) { __builtin_amdgcn_fence(__ATOMIC_ACQUIRE, "agent"); asm volatile("s_waitcnt vmcnt(0)" ::: "memory"); }
    __syncthreads();
}
__device__ __forceinline__ void count_in_and_wait(unsigned* ctr, unsigned n, unsigned* bar) {
    asm volatile("s_waitcnt vmcnt(0)" ::: "memory");
    __syncthreads();
    if (threadIdx.x == 0) {
        __builtin_amdgcn_fence(__ATOMIC_RELEASE, "agent");
        asm volatile("s_waitcnt vmcnt(0)" ::: "memory");
        (void)xb_add(ctr, 1u);
        XB_SPIN(xb_ld(ctr) < n, bar);
        __builtin_amdgcn_fence(__ATOMIC_ACQUIRE, "agent");
        asm volatile("s_waitcnt vmcnt(0)" ::: "memory");
    }
    __syncthreads();
}

#ifndef STEP_MASK
#define STEP_MASK 0x1fff
#endif
struct Args {
    const float* in[29]; float* out; unsigned char* ws;
    int step_lo, step_hi;
    int bar_region, pad;
};
constexpr int STEPS_PER_LAYER = 12, N_STEPS = 1 + NL * STEPS_PER_LAYER;

__global__ void __launch_bounds__(NWAVES * 64, 2) mk_fwd(Args a) {
    extern __shared__ __attribute__((aligned(16))) unsigned char lds_raw[];
    LAS unsigned char* lds0 = (LAS unsigned char*)lds_raw;
    LAS unsigned char* lds = lds0 + RING_OFF;
    volatile LAS unsigned* MISC = (volatile LAS unsigned*)lds0;
    const int tid = threadIdx.x, lane = tid & 63, wave = __builtin_amdgcn_readfirstlane(tid >> 6);
    const int G = gridDim.x;
    const int gw = (int)blockIdx.x * NWAVES + wave, NGW = G * NWAVES;
    unsigned char* ws = a.ws;
    for (int u = tid; u < LDSCTL_BYTES / 4; u += NWAVES * 64) ((LAS unsigned*)lds0)[u] = 0u;
    __syncthreads();
    XcdBarrier bar = xcd_barrier_post((unsigned*)(ws + WS_CTL) + CW_BAR + a.bar_region * XCD_BAR_WORDS, MISC + 8);
    const int lo = a.step_lo, hi = a.step_hi;
#define IN(k) (lo <= (k) && (k) < hi)
#define SEAM(k) do { if (IN(k) && IN((k) + 1)) xcd_barrier(bar); } while (0)
#define BX() ({ int b_ = (int)blockIdx.x; asm volatile("" : "+s"(b_)); b_; })
#define GWL() (BX() * NWAVES + wave)
#define WSP(T, off) ({ unsigned char* w_ = ws; asm volatile("" : "+s"(w_)); (T*)(__attribute__((address_space(1))) T*)(w_ + (off)); })
#define ARG_IN(i) ({ const __attribute__((address_space(4))) char* k_ = (const __attribute__((address_space(4))) char*)__builtin_amdgcn_kernarg_segment_ptr(); asm volatile("" : "+s"(k_)); (const float*)(const __attribute__((address_space(1))) float*)*(const float* const __attribute__((address_space(4)))*)(k_ + 8 * (i)); })

    if (IN(0) && (STEP_MASK & 1)) {
        PrepArgs pa; pa.w_in = ARG_IN(1); pa.w_ba = ARG_IN(15); pa.w_bb = ARG_IN(16); pa.w_bc = ARG_IN(17); pa.w_out = ARG_IN(18); pa.w_glu = ARG_IN(13); pa.w_up = ARG_IN(23); pa.w_dn = ARG_IN(25); pa.ws = ws;
        prep_items(pa, (float*)(lds_raw + RING_OFF + wave * 16640), (long)gw, (long)NGW, lane);
        S5In si; si.lam_re = ARG_IN(5); si.lam_im = ARG_IN(6); si.log_dt = ARG_IN(7); si.b_re = ARG_IN(8); si.b_im = ARG_IN(9); si.c_re = ARG_IN(10); si.c_im = ARG_IN(11); si.dsk = ARG_IN(12);
        for (int it = gw; it < NL * 16 * 48; it += NGW) { const int lg = it / 48, r = it % 48; s5_prep_item(si, ws, lg >> 4, lg & 15, r >> 4, r & 15, lane); }
        for (int it = gw; it < NL * 32; it += NGW) router_prep_item(ARG_IN(19), ARG_IN(20), ARG_IN(21), ARG_IN(22), ws, it >> 5, it & 31, lane);
        __syncthreads();
        rows0_phase(ARG_IN(0), ARG_IN(1), ARG_IN(2), WSP(bf16_t, WS_XB), WSP(float, WS_LOGF), (volatile LAS float*)lds, gw, NGW, lane);
    }
    SEAM(0);

    for (int l = 0; l < NL; ++l) {
        const int s0 = 1 + STEPS_PER_LAYER * l;
        unsigned* cnt = (unsigned*)(ws + WS_CTL) + CW_CNT + NE * CNT_STRIDE * l;
        if (IN(s0 + 0) && (STEP_MASK & (2 << 0))) {
            if (BX() < 64) cumsum_block(WSP(float, WS_LOGF), WSP(float, WS_CUM), BX(), (volatile LAS float*)lds);
            bf16_t* H = WSP(bf16_t, WS_H); bf16_t* A3 = WSP(bf16_t, WS_A3);
            pg8::StaticOrder S; S.init(WSP(bf16_t, WS_XB), 1024, WSP(bf16_t, WS_WIN) + (size_t)l * 5120 * 1024, 1024, 1024, NTOK, 5120, G, BX());
            pg8::EpiIn E{H, A3, WSP(unsigned char, WS_GQ)};
            pg8::gemm_phase<false>(lds, S, E);
        }
        SEAM(s0 + 0);
        if (IN(s0 + 1) && (STEP_MASK & (2 << 1))) {
            if (BX() < 128) {
                const int c = BX();
                { S5Order S{(const char*)WSP(bf16_t, WS_A3), (const char*)(WSP(bf16_t, WS_S5W1) + (size_t)l * 16 * 256 * 256), (size_t)256 * 256 * 2, G, c, 256, 4};
                  pg8::EpiS1 E{WSP(float, WS_S5S)};
                  pg8::gemm_phase<false>(lds, S, E); }
                wg_mem_sync();
                s5_scan_wg(WSP(float, WS_S5S), WSP(float, WS_S5A16) + (size_t)l * 16 * 64 * 2, WSP(bf16_t, WS_A3), c & 7, c >> 3, (LAS float*)lds);
                { S5Order S{(const char*)WSP(bf16_t, WS_A3), (const char*)(WSP(bf16_t, WS_S5W3) + (size_t)l * 16 * 256 * 384), (size_t)256 * 384 * 2, G, c, 384, 6};
                  pg8::EpiS3 E{WSP(bf16_t, WS_YCP)};
                  pg8::gemm_phase<false>(lds, S, E); }
                count_in_and_wait((unsigned*)(ws + WS_CTL) + CW_S5C + (l * 8 + (c & 7)) * 32, 16u, bar.bar);
                { bf16_t* YCP = WSP(bf16_t, WS_YCP); bf16_t* YC = WSP(bf16_t, WS_YC);
                  OneUnit S{(const char*)YCP, (const char*)(WSP(bf16_t, WS_WGLU) + (size_t)l * 65536), (c & 7) * 16 + (c >> 3), 256, 256, 4};
                  pg8::EpiGlu E{YCP, ARG_IN(14) + (size_t)l * 256, YC};
                  pg8::gemm_phase<false>(lds, S, E); }
                __syncthreads();
            }
            {
                bf16_t* H = WSP(bf16_t, WS_H); const float* CUM = WSP(float, WS_CUM);
                const attn_body::AttnTensors AT{(const attn_body::bf16*)(H + HC_Q), (const attn_body::bf16*)(H + HC_K), (const attn_body::bf16*)(H + HC_V), (attn_body::bf16*)WSP(bf16_t, WS_OB), CUM};
                const int vcu = (G % 8 == 0) ? (BX() % 8) * (G / 8) + BX() / 8 : BX(); const int batch = (vcu * 8 / G) & 7;
                attn_body::QueueOrder S{(unsigned*)(ws + WS_CTL) + CW_ATTQ + a.pad * 1024 + (l * 8 + batch) * 32, (volatile LAS int*)(MISC + 60)};
                attn_body::AttnTensors ATb = AT; ATb.Q += (size_t)batch * SEQ * HP; ATb.K += (size_t)batch * SEQ * HP; ATb.V += (size_t)batch * SEQ * HP; ATb.O += (size_t)batch * SEQ * HP; ATb.cum += (size_t)batch * 8 * SEQ;
                attn_body::attn_phase<attn_body::QueueOrder>((char*)lds_raw + RING_OFF, ATb, S);
            }
            __syncthreads();
            {
                const bf16_t* H = WSP(bf16_t, WS_H); const float* wpool = ARG_IN(3) + (size_t)l * 4 * 64 * 64; const float* pscale = ARG_IN(4) + (size_t)l * 256; bf16_t* YB = WSP(bf16_t, WS_YB);
                pool_phase(H, wpool, pscale, YB, BX(), G, lds);
            }
        }
        SEAM(s0 + 5);
        if (IN(s0 + 6) && (STEP_MASK & (2 << 6))) {
            bf16_t* H = WSP(bf16_t, WS_H); bf16_t* MERGED = WSP(bf16_t, WS_MERGED); bf16_t* YB = WSP(bf16_t, WS_YB); bf16_t* YC = WSP(bf16_t, WS_YC);
            BranchOrder S; S.T.init(nullptr, 0, nullptr, 0, 128, NTOK, 1024, G, BX());
            S.A0 = (const char*)WSP(bf16_t, WS_OB); S.A1 = (const char*)YB; S.A2 = (const char*)YC;
            S.B0 = (const char*)(WSP(bf16_t, WS_WBA) + (size_t)l * 1024 * 512); S.B1 = (const char*)(WSP(bf16_t, WS_WBB) + (size_t)l * 1024 * 256); S.B2 = (const char*)(WSP(bf16_t, WS_WBC) + (size_t)l * 1024 * 256);
            pg8::EpiBranchF E{WSP(unsigned char, WS_GQ), MERGED};
            pg8::gemm_phase<false>(lds, S, E);
        }
        SEAM(s0 + 6);
        if (IN(s0 + 7) && (STEP_MASK & (2 << 7))) {
            bf16_t* MERGED = WSP(bf16_t, WS_MERGED); bf16_t* MIX = WSP(bf16_t, WS_MIX);
            pg8::StaticOrder S; S.init(MERGED, 1024, WSP(bf16_t, WS_WOUT) + (size_t)l * 1024 * 1024, 1024, 1024, NTOK, 1024, G, BX());
            pg8::EpiPlain E{MIX, nullptr, 0};
            pg8::gemm_phase<false>(lds, S, E);
        }
        SEAM(s0 + 7);
        if (IN(s0 + 8) && (STEP_MASK & (2 << 8))) {
            const int dm = a.pad;
            rows1m_phase(WSP(bf16_t, WS_XB), WSP(bf16_t, WS_MIX), ARG_IN(19) + (size_t)l * D, ARG_IN(20) + (size_t)l * D, WSP(bf16_t, WS_WRT) + (size_t)l * 64 * PW1, WSP(float, WS_WRT + 768 * 1024) + l * 64,
                        WSP(bf16_t, WS_X1B), dm ? cnt + 4096 * dm : cnt, dm ? WSP(int, WS_OB) : WSP(int, WS_TOK), dm ? WSP(int, WS_OB + 8 * MiB) : WSP(int, WS_RE), dm ? WSP(int, WS_OB + 9 * MiB) : WSP(int, WS_RR), dm ? WSP(float, WS_OB + 10 * MiB) : WSP(float, WS_RG),
                        lds, MISC + 64, MISC + 96, (volatile LAS float*)(MISC + 256), BX(), G, wave, lane);
        }
        SEAM(s0 + 8);
        const bool fillok = (G == 256);
        if (IN(s0 + 9) && (STEP_MASK & (2 << 9))) {
            const int* TOK = WSP(int, WS_TOK); bf16_t* X1B = WSP(bf16_t, WS_X1B); bf16_t* ACT = WSP(bf16_t, WS_ACT);
            moe_prefix(cnt, (volatile LAS int*)(MISC + 16));
            { MoeOrder S{(const volatile LAS int*)(MISC + 16), cnt, TOK, (const char*)X1B, (const char*)(WSP(bf16_t, WS_WUP) + (size_t)l * NE * 2048 * 1024), (size_t)2048 * 1024 * 2, (size_t)256 * 1024 * 2, (size_t)256 * 1024 * 2, 8, G, BX(), 1024, true, -1};
              pg8::EpiUp E{ACT, ARG_IN(24) + (size_t)l * NE * 2048};
              pg8::gemm_phase<true>(lds, S, E); }
            if (fillok) {
                const int c = BX(), ga = 4 * (c & 7) + (c >> 6), p8 = (c >> 3) & 7, r0 = (((volatile LAS int*)(MISC + 16))[32] - 1) & 31;
                if (ga > r0) {
                    count_in_and_wait((unsigned*)(ws + WS_CTL) + CW_MOEF + (l * 32 + ga) * 32, 8u, bar.bar);
                    MoeOrder D{(const volatile LAS int*)(MISC + 16), cnt, TOK, (const char*)WSP(bf16_t, WS_ACT), (const char*)(WSP(bf16_t, WS_WDN) + (size_t)l * NE * 1024 * 1024), (size_t)1024 * 1024 * 2, (size_t)256 * 1024 * 2, (size_t)256 * 1024 * 2, 4, G, c, 1024, false, -1};
                    MoeOne S1{D, p8 < 4 ? ga : 32 + ga, p8 & 3};
                    pg8::EpiYm8 E2{(unsigned char*)WSP(bf16_t, WS_YM), ARG_IN(26) + (size_t)l * NE * 1024};
                    pg8::gemm_phase<false>(lds, S1, E2);
                }
            }
        }
        SEAM(s0 + 9);
        if (IN(s0 + 10) && (STEP_MASK & (2 << 10))) {
            const int* TOK = WSP(int, WS_TOK); bf16_t* ACT = WSP(bf16_t, WS_ACT); bf16_t* YM = WSP(bf16_t, WS_YM);
            if (!(IN(s0 + 9) && (STEP_MASK & (2 << 9)))) moe_prefix(cnt, (volatile LAS int*)(MISC + 16));
            const int r0 = fillok ? ((((volatile LAS int*)(MISC + 16))[32] - 1) & 31) : -1;
            MoeOrder S{(const volatile LAS int*)(MISC + 16), cnt, TOK, (const char*)ACT, (const char*)(WSP(bf16_t, WS_WDN) + (size_t)l * NE * 1024 * 1024), (size_t)1024 * 1024 * 2, (size_t)256 * 1024 * 2, (size_t)256 * 1024 * 2, 4, G, BX(), 1024, false, r0};
            pg8::EpiYm8 E{(unsigned char*)YM, ARG_IN(26) + (size_t)l * NE * 1024};
            pg8::gemm_phase<false>(lds, S, E);
        }
        SEAM(s0 + 10);
        if (IN(s0 + 11) && (STEP_MASK & (2 << 11))) {
            const bool last = (l == NL - 1);
            rows2_phase(WSP(bf16_t, WS_X1B), WSP(unsigned char, WS_YM), cnt, WSP(int, WS_RE), WSP(int, WS_RR), WSP(float, WS_RG), ARG_IN(27) + (size_t)l * D, ARG_IN(28) + (size_t)l * D,
                        last ? a.out : (float*)nullptr, WSP(bf16_t, WS_XB), last ? (const float*)nullptr : ARG_IN(1) + (size_t)(l + 1) * D * NIN, last ? (const float*)nullptr : ARG_IN(2) + (size_t)(l + 1) * 8,
                        WSP(float, WS_LOGF), (volatile LAS float*)lds, GWL(), NGW, lane);
        }
        SEAM(s0 + 11);
    }
#undef IN
#undef SEAM
}

#ifndef MK_MODE
#define MK_MODE 0
#endif
extern "C" void kernel_launch(void* const* d_in, const int* in_sizes, int n_in, void* d_out, int out_size, void* d_ws, size_t ws_size, hipStream_t stream) {
    if (n_in != 29 || out_size != NTOK * D || ws_size < WS_END2) { fprintf(stderr, "kernel_launch: unexpected shapes (n_in %d out %d ws %zu)\n", n_in, out_size, ws_size); return; }
    static int grid = 0;
    if (grid == 0) {
        int dev = 0, cus = 0;
        if (hipGetDevice(&dev) != hipSuccess || hipDeviceGetAttribute(&cus, hipDeviceAttributeMultiprocessorCount, dev) != hipSuccess) { fprintf(stderr, "kernel_launch: device query failed\n"); grid = -1; return; }
        if (hipFuncSetAttribute((const void*)mk_fwd, hipFuncAttributeMaxDynamicSharedMemorySize, LDS_BYTES) != hipSuccess) { fprintf(stderr, "kernel_launch: hipFuncSetAttribute failed\n"); grid = -1; return; }
        int per_cu = 0;
        if (hipOccupancyMaxActiveBlocksPerMultiprocessor(&per_cu, (const void*)mk_fwd, NWAVES * 64, LDS_BYTES) != hipSuccess || per_cu < 1) fprintf(stderr, "kernel_launch: occupancy query reports %d workgroups per CU\n", per_cu);
        (void)hipGetLastError();
        grid = cus;
    }
    if (grid < 0) return;
    unsigned char* ws = (unsigned char*)d_ws;
    (void)hipMemsetAsync(ws + WS_CTL, 0, 1 * MiB, stream);
    Args a{}; for (int i = 0; i < 29; ++i) a.in[i] = (const float*)d_in[i]; a.out = (float*)d_out; a.ws = ws;
#if MK_MODE == 0
    a.step_lo = 0; a.step_hi = N_STEPS; a.bar_region = 0;
    hipLaunchKernelGGL(mk_fwd, dim3(grid), dim3(NWAVES * 64), LDS_BYTES, stream, a);
#elif MK_MODE == 1
    for (int s = 0; s < N_STEPS; ++s) { Args b = a; b.step_lo = s; b.step_hi = s + 1; b.bar_region = s; hipLaunchKernelGGL(mk_fwd, dim3(grid), dim3(NWAVES * 64), LDS_BYTES, stream, b); }
#else
    for (int s = 0; s < N_STEPS; ++s) { const int bit = s == 0 ? 0 : 1 + (s - 1) % STEPS_PER_LAYER; const int rep = ((PROBE_MASK >> bit) & 1) ? PROBE_REP : 1;
        for (int r = 0; r < rep; ++r) { Args b = a; b.step_lo = s; b.step_hi = s + 1; b.bar_region = s; b.pad = (bit == 9 || bit == 2) ? r : 0; hipLaunchKernelGGL(mk_fwd, dim3(grid), dim3(NWAVES * 64), LDS_BYTES, stream, b); } }
#endif
}
```

```cpp
#include <hip/hip_runtime.h>
#include <cstdint>
#include <cstdio>
#include <cmath>

typedef unsigned short bf16_t;
typedef short bf16x8 __attribute__((ext_vector_type(8)));
typedef float f32x4 __attribute__((ext_vector_type(4)));
typedef float f32x2 __attribute__((ext_vector_type(2)));
typedef unsigned u32x4 __attribute__((ext_vector_type(4)));
typedef unsigned u32x2 __attribute__((ext_vector_type(2)));

constexpr int D = 1024, NB = 8, SEQ = 4096, NTOK = NB * SEQ, NL = 4;
constexpr int NIN = 5128, HP = 5120;
constexpr int NE = 32, TOPK = 4;
constexpr int MOE_ROWS = 139264;
constexpr float C2 = 0.125f * 1.4426950408889634f;
constexpr float L2E = 1.4426950408889634f;
constexpr float ALPHA = 1.681792830507429f;
constexpr float LN_EPS = 1e-5f;
constexpr int HC_Q = 0, HC_K = 512, HC_V = 1024, HC_POOL = 1536, HC_SSM = 1792, HC_G = 2048;

constexpr size_t MiB = 1u << 20;
constexpr size_t WS_CTL = 0;
constexpr size_t WS_WIN = 1 * MiB;
constexpr size_t WS_WBA = 41 * MiB;
constexpr size_t WS_WBB = 45 * MiB;
constexpr size_t WS_WBC = 47 * MiB;
constexpr size_t WS_WOUT = 49 * MiB;
constexpr size_t WS_WGLU = 57 * MiB;
constexpr size_t WS_WUP = 80 * MiB;
constexpr size_t WS_WDN = 592 * MiB;
constexpr size_t WS_XA = 848 * MiB;
constexpr size_t WS_X1 = 976 * MiB;
constexpr size_t WS_XB = 1104 * MiB;
constexpr size_t WS_X1B = 1168 * MiB;
constexpr size_t WS_H = 1232 * MiB;
constexpr size_t WS_A3 = 1552 * MiB;
constexpr size_t WS_MERGED = 1576 * MiB;
constexpr size_t WS_MIX = 1640 * MiB;
constexpr size_t WS_YB = 1704 * MiB;
constexpr size_t WS_YCP = 1720 * MiB;
constexpr size_t WS_YC = 1736 * MiB;
constexpr size_t WS_LOGF = 1752 * MiB;
constexpr size_t WS_CUM = 1753 * MiB;
constexpr size_t WS_TOK = 1754 * MiB;
constexpr size_t WS_RE = 1758 * MiB;
constexpr size_t WS_RR = WS_RE + 512 * 1024;
constexpr size_t WS_RG = WS_RR + 512 * 1024;
constexpr size_t WS_ACT = 1760 * MiB;
constexpr size_t WS_YM = 2032 * MiB;
constexpr size_t WS_END = 2304 * MiB;
constexpr int CW_MOEF = 238592;
constexpr int CW_S5C = 237568;
constexpr int CW_ATTQ = 229376;
constexpr int CW_CNT = 200704, CNT_STRIDE = 32;

__device__ __forceinline__ float bf2f(bf16_t b) { return __uint_as_float((unsigned)b << 16); }
__device__ __forceinline__ bf16_t f2bf(float f) { unsigned u = __float_as_uint(f); return (bf16_t)((u + 0x7fffu + ((u >> 16) & 1u)) >> 16); }
__device__ __forceinline__ unsigned pk2(float lo, float hi) { unsigned r; asm("v_cvt_pk_bf16_f32 %0, %1, %2" : "=v"(r) : "v"(lo), "v"(hi)); return r; }
__device__ __forceinline__ float sigmoidf_(float x) { return 1.0f / (1.0f + __expf(-x)); }
__device__ __forceinline__ float wave_sum(float v) {
#pragma unroll
    for (int o = 1; o < 64; o <<= 1) v += __shfl_xor(v, o);
    return v;
}
__device__ __forceinline__ float wave_max_f(float v) {
#pragma unroll
    for (int o = 32; o >= 1; o >>= 1) v = fmaxf(v, __shfl_xor(v, o));
    return v; }
__device__ __forceinline__ int wave_min_i(int v) {
#pragma unroll
    for (int o = 32; o >= 1; o >>= 1) { const int t = __shfl_xor(v, o); v = t < v ? t : v; }
    return v; }
template <int N> __device__ __forceinline__ void reduce_scatter(float (&v)[N], int lane) {
    int s = 32;
#pragma unroll
    for (int n = N / 2; n >= 1; n >>= 1) {
        const bool up = (lane & s) != 0;
#pragma unroll
        for (int i = 0; i < n; ++i) { float hi = v[i + n], lo = v[i]; asm volatile("" : "+v"(hi), "+v"(lo));
            const float keep = up ? hi : lo, send = up ? lo : hi; v[i] = keep + __shfl_xor(send, s); }
        s >>= 1;
    }
    for (; s >= 1; s >>= 1) v[0] += __shfl_xor(v[0], s);
}

__device__ __forceinline__ int dst_row(int mode, int c) {
    if (mode == 1) return c < 1536 ? c : (c < 1544 ? -1 : c - 8);
    if (mode == 2) { const int j = c >> 1, bj = c & 1; return (j >> 7) * 256 + bj * 128 + (j & 127); }
    return c;
}
__device__ __forceinline__ void transpose_item(const float* W, int Nsrc, int K, int Ndst, bf16_t* WT, int mode, float* scr, int item, int lane) {
    (void)Ndst;
    const int nkb = K / 64, nb = item / nkb, kb = item % nkb, k0 = 64 * kb, c0 = 64 * nb;
    const bool cin = (c0 + lane) < Nsrc;
    const float* src = W + (size_t)k0 * Nsrc + c0 + (cin ? lane : 0);
#pragma unroll 16
    for (int kk = 0; kk < 64; ++kk) scr[kk * 65 + lane] = __builtin_nontemporal_load(src + (size_t)kk * Nsrc);
    asm volatile("s_waitcnt lgkmcnt(0)" ::: "memory");
    const int c8 = lane & 7;
#pragma unroll
    for (int i = 0; i < 8; ++i) { const int col = (lane >> 3) + 8 * i; const int n = (c0 + col) < Nsrc ? dst_row(mode, c0 + col) : -1; const float* s = scr + (8 * c8) * 65 + col;
        const float sc = (mode == 1 && n >= 2048) ? -L2E : 1.0f;
        u32x4 o; o.x = pk2(s[0 * 65] * sc, s[1 * 65] * sc); o.y = pk2(s[2 * 65] * sc, s[3 * 65] * sc); o.z = pk2(s[4 * 65] * sc, s[5 * 65] * sc); o.w = pk2(s[6 * 65] * sc, s[7 * 65] * sc);
        if (n >= 0) __builtin_nontemporal_store(o, (u32x4*)(WT + (size_t)n * K + k0 + 8 * c8)); }
    asm volatile("s_waitcnt lgkmcnt(0)" ::: "memory");
}
struct PrepArgs { const float *w_in, *w_ba, *w_bb, *w_bc, *w_out, *w_glu, *w_up, *w_dn; unsigned char* ws; };
__device__ __forceinline__ void prep_items(const PrepArgs& a, float* scr, long gw, long NGW, int lane) {
    constexpr long I_IN = (1024 / 64) * ((NIN + 63) / 64), I_BA = (512 / 64) * (1024 / 64), I_BB = (256 / 64) * (1024 / 64), I_OUT = (1024 / 64) * (1024 / 64), I_GLU = (256 / 64) * (256 / 64);
    constexpr long I_UP = (1024 / 64) * (2048 / 64), I_DN = (1024 / 64) * (1024 / 64);
    constexpr long T_IN = NL * I_IN, T_BA = NL * I_BA, T_BB = NL * I_BB, T_OUT = NL * I_OUT, T_GLU = NL * I_GLU, T_UP = (long)NL * NE * I_UP, T_DN = (long)NL * NE * I_DN;
    constexpr long TOTAL = T_IN + T_BA + 2 * T_BB + T_OUT + T_GLU + T_UP + T_DN;
    for (long it = gw; it < TOTAL; it += NGW) {
        long r = it;
        if (r < T_UP) { const int inst = (int)(r / I_UP), item = (int)(r % I_UP); transpose_item(a.w_up + (size_t)inst * 1024 * 2048, 2048, 1024, 2048, (bf16_t*)(a.ws + WS_WUP) + (size_t)inst * 2048 * 1024, 2, scr, item, lane); continue; } r -= T_UP;
        if (r < T_DN) { const int inst = (int)(r / I_DN), item = (int)(r % I_DN); transpose_item(a.w_dn + (size_t)inst * 1024 * 1024, 1024, 1024, 1024, (bf16_t*)(a.ws + WS_WDN) + (size_t)inst * 1024 * 1024, 0, scr, item, lane); continue; } r -= T_DN;
        if (r < T_IN) { const int inst = (int)(r / I_IN), item = (int)(r % I_IN); transpose_item(a.w_in + (size_t)inst * 1024 * NIN, NIN, 1024, 5120, (bf16_t*)(a.ws + WS_WIN) + (size_t)inst * 5120 * 1024, 1, scr, item, lane); continue; } r -= T_IN;
        if (r < T_BA) { const int inst = (int)(r / I_BA), item = (int)(r % I_BA); transpose_item(a.w_ba + (size_t)inst * 512 * 1024, 1024, 512, 1024, (bf16_t*)(a.ws + WS_WBA) + (size_t)inst * 1024 * 512, 0, scr, item, lane); continue; } r -= T_BA;
        if (r < T_BB) { const int inst = (int)(r / I_BB), item = (int)(r % I_BB); transpose_item(a.w_bb + (size_t)inst * 256 * 1024, 1024, 256, 1024, (bf16_t*)(a.ws + WS_WBB) + (size_t)inst * 1024 * 256, 0, scr, item, lane); continue; } r -= T_BB;
        if (r < T_BB) { const int inst = (int)(r / I_BB), item = (int)(r % I_BB); transpose_item(a.w_bc + (size_t)inst * 256 * 1024, 1024, 256, 1024, (bf16_t*)(a.ws + WS_WBC) + (size_t)inst * 1024 * 256, 0, scr, item, lane); continue; } r -= T_BB;
        if (r < T_OUT) { const int inst = (int)(r / I_OUT), item = (int)(r % I_OUT); transpose_item(a.w_out + (size_t)inst * 1024 * 1024, 1024, 1024, 1024, (bf16_t*)(a.ws + WS_WOUT) + (size_t)inst * 1024 * 1024, 0, scr, item, lane); continue; } r -= T_OUT;
        { const int inst = (int)(r / I_GLU), item = (int)(r % I_GLU); transpose_item(a.w_glu + (size_t)inst * 256 * 256, 256, 256, 256, (bf16_t*)(a.ws + WS_WGLU) + (size_t)inst * 256 * 256, 0, scr, item, lane); }
    }
}

__device__ __forceinline__ void row_ln(f32x4 (&v)[4], const float* g, const float* bta, int lane) {
    float s = 0.f;
#pragma unroll
    for (int j = 0; j < 4; ++j) s += (v[j].x + v[j].y) + (v[j].z + v[j].w);
    const float mean = wave_sum(s) * (1.f / D); float s2 = 0.f;
#pragma unroll
    for (int j = 0; j < 4; ++j) { v[j] = v[j] - mean; s2 += (v[j].x * v[j].x + v[j].y * v[j].y) + (v[j].z * v[j].z + v[j].w * v[j].w); }
    const float rstd = 1.0f / sqrtf(wave_sum(s2) * (1.f / D) + LN_EPS);
#pragma unroll
    for (int j = 0; j < 4; ++j) { const f32x4 gg = *(const f32x4*)(g + 4 * (lane + 64 * j)), bb = *(const f32x4*)(bta + 4 * (lane + 64 * j)); v[j] = v[j] * rstd * gg + bb; }
}
#define GAS __attribute__((address_space(1)))
__device__ __forceinline__ void row_store_bf16(const f32x4 (&v)[4], bf16_t* orow, int lane) {
#pragma unroll
    for (int j = 0; j < 4; ++j) { u32x2 w; asm("v_cvt_pk_bf16_f32 %0, %1, %2" : "=v"(w.x) : "v"(v[j].x), "v"(v[j].y)); asm("v_cvt_pk_bf16_f32 %0, %1, %2" : "=v"(w.y) : "v"(v[j].z), "v"(v[j].w)); *(GAS u32x2*)((GAS bf16_t*)orow + 4 * (lane + 64 * j)) = w; }
}
#define LAS __attribute__((address_space(3)))
namespace pg8 {
constexpr int BM = 256, BK = 64, HALF = 128, HTB = HALF * BK * 2, STAGE_BYTES = 8 * HTB;
__device__ __forceinline__ int lds_byte(int r, int c) { const int st = (r >> 4) * 2 + (c >> 5), rr = r & 15, cc = c & 31, ob = rr * 64 + cc * 2; return st * 1024 + (ob ^ (((ob >> 9) & 1) << 5)); }
__device__ __forceinline__ void stage_rc(int b, int& R, int& C) { const int st = b / 1024, sb = b % 1024, swz = sb ^ (((sb >> 9) & 1) << 5); R = (st >> 1) * 16 + swz / 64; C = (st & 1) * 32 + (swz % 64) / 2; }
__device__ __forceinline__ int perm32(int rho) { const int n = rho >> 4, i = rho & 15; return 8 * (i >> 2) + 4 * n + (i & 3); }

struct Unit { const char* A; const char* B; int pm, pn, e, valid, lt; int lda, ldb, nt, seg; };

typedef f32x4 Acc[2][2][4][2];

template <bool GATHER, class Epi, class Sched>
__device__ __forceinline__ void gemm_phase(LAS unsigned char* lds, const Sched& S, const Epi& E) {
    int tid_ = threadIdx.x; asm volatile("" : "+v"(tid_));
    const int tid = tid_, wid = __builtin_amdgcn_readfirstlane(tid >> 6), lane = tid & 63, wr = wid >> 2, wc = wid & 3, fr = lane & 15, fq = lane >> 4;
    int R0, C0; stage_rc(tid * 16, R0, C0);
    const int Rb0 = (R0 & ~31) + perm32(R0 & 31);
    unsigned vB, vBn, vA = 0, vAn = 0; size_t sB, sBn, sA = 0, sAn = 0;
    unsigned offA[2][2], offN[2][2];
    const size_t kstep = (size_t)(BK * 2);
    const unsigned ldsw = (unsigned)wid * 1024u;
    const int aoff = lds_byte(wr * 64 + fr, fq * 8), boff = lds_byte(wc * 32 + fr, fq * 8);
#define PG8_SA(b, h) (((b) * 2 + (h)) * HTB)
#define PG8_SB(b, h) ((4 + (b) * 2 + (h)) * HTB)
#define PG8_STAGE_B(bufoff, gbase, h, vb, sb) do { _Pragma("unroll") for (int _i = 0; _i < 2; ++_i) \
        __builtin_amdgcn_global_load_lds((const unsigned*)((const char*)(gbase) + (size_t)(2 * (h) + _i) * (sb) + (vb)), (LAS unsigned*)(lds + (bufoff) + ldsw + _i * 8192), 16, 0, 0); } while (0)
#define PG8_STAGE_A(bufoff, gbase, h, va, sa, offs) do { _Pragma("unroll") for (int _i = 0; _i < 2; ++_i) { \
        const char* _p = GATHER ? (const char*)(gbase) + (offs)[h][_i] : (const char*)(gbase) + (size_t)(2 * (h) + _i) * (sa) + (va); \
        __builtin_amdgcn_global_load_lds((const unsigned*)_p, (LAS unsigned*)(lds + (bufoff) + ldsw + _i * 8192), 16, 0, 0); } } while (0)
#define PG8_LDA(dst, b, h) do { _Pragma("unroll") for (int m = 0; m < 4; ++m) _Pragma("unroll") for (int k = 0; k < 2; ++k) dst[m][k] = *(const LAS bf16x8*)(lds + PG8_SA(b, h) + aoff + m * 2048 + k * 1024); } while (0)
#define PG8_LDB(dst, b, h) do { _Pragma("unroll") for (int n = 0; n < 2; ++n) _Pragma("unroll") for (int k = 0; k < 2; ++k) dst[n][k] = *(const LAS bf16x8*)(lds + PG8_SB(b, h) + boff + n * 2048 + k * 1024); } while (0)
#define PG8_MMA(ai, bj, At, Bt) do { __builtin_amdgcn_s_setprio(1); _Pragma("unroll") for (int m = 0; m < 4; ++m) _Pragma("unroll") for (int n = 0; n < 2; ++n) _Pragma("unroll") for (int k = 0; k < 2; ++k) \
        acc[ai][bj][m][n] = __builtin_amdgcn_mfma_f32_16x16x32_bf16(Bt[n][k], At[m][k], acc[ai][bj][m][n], 0, 0, 0); __builtin_amdgcn_s_setprio(0); } while (0)
#define PG8_WAIT_V(n) asm volatile("s_waitcnt vmcnt(" #n ")" ::: "memory")
#define PG8_WAIT_L(n) asm volatile("s_waitcnt lgkmcnt(" #n ")" ::: "memory")
#define PG8_BAR __builtin_amdgcn_s_barrier()
#define PG8_SCHED __builtin_amdgcn_sched_barrier(0)
#define PG8_GEOM(u, oA, va, sa, vb, sb) do { if constexpr (GATHER) S.goff(u, R0, C0, oA); else { va = (unsigned)(R0 * (u).lda + C0) * 2u; sa = (size_t)64 * (u).lda * 2; } \
        vb = (unsigned)(Rb0 * (u).ldb + C0) * 2u; sb = (size_t)64 * (u).ldb * 2; } while (0)
    Unit cur, nxt; int ui = 0;
    if (!S.next(0, cur)) return;
    PG8_GEOM(cur, offA, vA, sA, vB, sB);
#pragma unroll
    for (int h = 0; h < 2; ++h)
#pragma unroll
        for (int i = 0; i < 2; ++i) offN[h][i] = offA[h][i];
    vAn = vA; sAn = sA; vBn = vB; sBn = sB; int nt = cur.nt;
    Acc acc;
#pragma unroll
    for (int a = 0; a < 2; ++a)
#pragma unroll
        for (int b = 0; b < 2; ++b)
#pragma unroll
            for (int m = 0; m < 4; ++m)
#pragma unroll
                for (int n = 0; n < 2; ++n) acc[a][b][m][n] = (f32x4){0.f, 0.f, 0.f, 0.f};
    bf16x8 At[4][2], B0[2][2], B1[2][2];
    const char* cA = cur.A; const char* cB = cur.B;
    E.pre(cur, wr, wc, fr, fq);
    PG8_STAGE_B(PG8_SB(0, 0), cB, 0, vB, sB); PG8_STAGE_B(PG8_SB(0, 1), cB, 1, vB, sB); PG8_STAGE_A(PG8_SA(0, 0), cA, 0, vA, sA, offA); PG8_STAGE_A(PG8_SA(0, 1), cA, 1, vA, sA, offA);
    if (wr == 1) PG8_BAR;
    PG8_WAIT_V(2); PG8_BAR;
    PG8_STAGE_B(PG8_SB(1, 0), cB + kstep, 0, vB, sB); PG8_STAGE_A(PG8_SA(1, 0), cA + kstep, 0, vA, sA, offA); PG8_STAGE_B(PG8_SB(1, 1), cB + kstep, 1, vB, sB);
    PG8_WAIT_V(6); PG8_BAR;
    for (;;) {
        const bool has_next = S.next(ui + 1, nxt);
        const char* nA = has_next ? nxt.A : cA; const char* nB = has_next ? nxt.B : cB;
        if (has_next) PG8_GEOM(nxt, offN, vAn, sAn, vBn, sBn);
#pragma unroll 1
        for (int t = 0; t < nt; t += 2) {
            const bool last = (t == nt - 2);
            const char* a1 = cA + (size_t)(t + 1) * kstep;
            const char* a2 = last ? nA : cA + (size_t)(t + 2) * kstep; const char* b2 = last ? nB : cB + (size_t)(t + 2) * kstep;
            const char* a3 = a2 + kstep; const char* b3 = b2 + kstep;
            unsigned o2[2][2];
            if constexpr (GATHER) {
#pragma unroll
                for (int h = 0; h < 2; ++h)
#pragma unroll
                    for (int i = 0; i < 2; ++i) o2[h][i] = last ? offN[h][i] : offA[h][i];
            }
            const unsigned va2 = last ? vAn : vA, vb2 = last ? vBn : vB; const size_t sa2 = last ? sAn : sA, sb2 = last ? sBn : sB;
            PG8_LDB(B0, 0, 0); PG8_LDB(B1, 0, 1); PG8_SCHED; PG8_LDA(At, 0, 0); PG8_STAGE_A(PG8_SA(1, 1), a1, 1, vA, sA, offA);
            PG8_WAIT_V(8); PG8_WAIT_L(0); PG8_BAR; PG8_MMA(0, 0, At, B0); PG8_MMA(0, 1, At, B1); PG8_BAR; PG8_SCHED;
            PG8_LDA(At, 0, 1); PG8_STAGE_B(PG8_SB(0, 0), b2, 0, vb2, sb2); PG8_STAGE_B(PG8_SB(0, 1), b2, 1, vb2, sb2); PG8_STAGE_A(PG8_SA(0, 0), a2, 0, va2, sa2, o2);
            PG8_WAIT_V(8); PG8_WAIT_L(0); PG8_BAR; PG8_MMA(1, 0, At, B0); PG8_MMA(1, 1, At, B1); PG8_BAR; PG8_SCHED;
            PG8_LDB(B0, 1, 0); PG8_LDB(B1, 1, 1); PG8_SCHED; PG8_LDA(At, 1, 0); PG8_STAGE_A(PG8_SA(0, 1), a2, 1, va2, sa2, o2);
            PG8_WAIT_V(8); PG8_WAIT_L(0); PG8_BAR; PG8_MMA(0, 0, At, B0); PG8_MMA(0, 1, At, B1); PG8_BAR; PG8_SCHED;
            PG8_LDA(At, 1, 1); PG8_STAGE_B(PG8_SB(1, 0), b3, 0, vb2, sb2); PG8_STAGE_B(PG8_SB(1, 1), b3, 1, vb2, sb2); PG8_STAGE_A(PG8_SA(1, 0), a3, 0, va2, sa2, o2);
            PG8_WAIT_V(8); PG8_WAIT_L(0); PG8_BAR; PG8_MMA(1, 0, At, B0); PG8_MMA(1, 1, At, B1); PG8_BAR; PG8_SCHED;
        }
        if (wr == 0) PG8_BAR;
        if constexpr (!Epi::AFTER_DRAIN) E(acc, cur, wr, wc, fr, fq);
        if (!has_next) break;
        if (!E.keep_acc(cur)) {
#pragma unroll
            for (int a = 0; a < 2; ++a)
#pragma unroll
                for (int b = 0; b < 2; ++b)
#pragma unroll
                    for (int m = 0; m < 4; ++m)
#pragma unroll
                        for (int n = 0; n < 2; ++n) acc[a][b][m][n] = (f32x4){0.f, 0.f, 0.f, 0.f};
        }
        cur = nxt; cA = nA; cB = nB; ++ui; nt = cur.nt; vA = vAn; sA = sAn; vB = vBn; sB = sBn;
        if constexpr (GATHER) {
#pragma unroll
            for (int h = 0; h < 2; ++h)
#pragma unroll
                for (int i = 0; i < 2; ++i) offA[h][i] = offN[h][i];
        }
        E.pre(cur, wr, wc, fr, fq);
        if (wr == 1) PG8_BAR;
    }
    PG8_WAIT_V(0);
    PG8_BAR;
    if constexpr (Epi::AFTER_DRAIN) E.after(acc, cur, wr, wc, fr, fq, lds);
#undef PG8_GEOM
#undef PG8_SA
#undef PG8_SB
#undef PG8_STAGE_A
#undef PG8_STAGE_B
#undef PG8_LDA
#undef PG8_LDB
#undef PG8_MMA
#undef PG8_WAIT_V
#undef PG8_WAIT_L
#undef PG8_BAR
#undef PG8_SCHED
}

struct StaticOrder {
    const char* A; const char* B; size_t tstepA, tstepB; int nM, nN, nwg, G, c, lda, ldb, nt;
    __device__ __forceinline__ void init(const void* A_, int lda_, const void* B_, int ldb_, int K, int M, int N, int G_, int c_) {
        A = (const char*)A_; B = (const char*)B_; lda = lda_; ldb = ldb_; nt = K / BK; tstepA = (size_t)BM * lda * 2; tstepB = (size_t)BM * ldb * 2; nM = M / BM; nN = N / BM; nwg = nM * nN; G = G_; c = c_; }
    __device__ __forceinline__ bool next(int i, Unit& u) const {
        const long L = (long)i * G + c; if (L >= nwg) return false;
        int wgid = (int)L; { const int q = nwg / 8, r = nwg % 8, xcd = wgid % 8, off = wgid / 8; wgid = (xcd < r ? xcd * (q + 1) : r * (q + 1) + (xcd - r) * q) + off; }
        const int nig = 8 * nN, gid = wgid / nig, fm = gid * 8, gsz = (nM - fm) < 8 ? (nM - fm) : 8;
        u.pm = fm + ((wgid % nig) % gsz); u.pn = (wgid % nig) / gsz; u.e = 0; u.valid = 256; u.lt = 0; u.lda = lda; u.ldb = ldb; u.nt = nt; u.seg = 0;
        u.A = A + (size_t)u.pm * tstepA; u.B = B + (size_t)u.pn * tstepB; return true;
    }
};
}
namespace pg8 {
__device__ __forceinline__ unsigned cvt_pk_bf16(float lo, float hi) { unsigned r; asm volatile("v_cvt_pk_bf16_f32 %0, %1, %2" : "=v"(r) : "v"(lo), "v"(hi)); return r; }
__device__ __forceinline__ float fsig(float x) { return __builtin_amdgcn_rcpf(1.0f + __builtin_amdgcn_exp2f(-L2E * x)); }
__device__ __forceinline__ u32x4 pack8(const f32x4 v0, const f32x4 v1) { u32x4 w; w.x = cvt_pk_bf16(v0[0], v0[1]); w.y = cvt_pk_bf16(v0[2], v0[3]); w.z = cvt_pk_bf16(v1[0], v1[1]); w.w = cvt_pk_bf16(v1[2], v1[3]); return w; }
__device__ __forceinline__ void unpack8(const u32x4 w, f32x4& v0, f32x4& v1) {
    v0[0] = __uint_as_float(w.x << 16); v0[1] = __uint_as_float(w.x & 0xffff0000u); v0[2] = __uint_as_float(w.y << 16); v0[3] = __uint_as_float(w.y & 0xffff0000u);
    v1[0] = __uint_as_float(w.z << 16); v1[1] = __uint_as_float(w.z & 0xffff0000u); v1[2] = __uint_as_float(w.w << 16); v1[3] = __uint_as_float(w.w & 0xffff0000u); }
__device__ __forceinline__ u32x4 ld16(const void* ubase, unsigned voff) { return *(const u32x4*)((const char*)ubase + voff); }
__device__ __forceinline__ void st16(void* ubase, unsigned voff, u32x4 v) { *(u32x4*)((char*)ubase + voff) = v; }
__device__ __forceinline__ f32x4 ldf4(const void* ubase, unsigned voff) { return *(const f32x4*)((const char*)ubase + voff); }

struct EpiIn { bf16_t* H; bf16_t* A3; unsigned char* GQ;
    static constexpr bool AFTER_DRAIN = false; __device__ __forceinline__ void pre(const Unit&, int, int, int, int) const {} __device__ __forceinline__ bool keep_acc(const Unit&) const { return false; }
    __device__ __forceinline__ void operator()(const Acc& acc, const Unit& u, int wr, int wc, int fr, int fq) const {
        const int pn = u.pn;
        const unsigned vH = (unsigned)(fr * HP + 8 * fq) * 2u, vS = (unsigned)((fq >> 1) * 2048 * 384 + fr * 16 + (fq & 1) * 8) * 2u, vG = (unsigned)(fr * 3072 + 8 * fq);
#pragma unroll
        for (int ai = 0; ai < 2; ++ai)
#pragma unroll
            for (int m = 0; m < 4; ++m) {
#pragma unroll
                for (int bj = 0; bj < 2; ++bj) { f32x4 v0 = acc[ai][bj][m][0], v1 = acc[ai][bj][m][1];
                    if (pn < 2) { v0 = v0 * C2; v1 = v1 * C2; }
                    if (pn >= 8) { unsigned q[8];
#pragma unroll
                        for (int i = 0; i < 4; i += 2) {
                            f32x2 ta = (f32x2){__builtin_amdgcn_exp2f(v0[i]), __builtin_amdgcn_exp2f(v0[i + 1])} + (f32x2){1.0f, 1.0f}, tb = (f32x2){__builtin_amdgcn_exp2f(v1[i]), __builtin_amdgcn_exp2f(v1[i + 1])} + (f32x2){1.0f, 1.0f};
                            f32x2 ya = (f32x2){__builtin_amdgcn_rcpf(ta.x), __builtin_amdgcn_rcpf(ta.y)} * (f32x2){255.0f, 255.0f} + (f32x2){0.5f, 0.5f}, yb = (f32x2){__builtin_amdgcn_rcpf(tb.x), __builtin_amdgcn_rcpf(tb.y)} * (f32x2){255.0f, 255.0f} + (f32x2){0.5f, 0.5f};
                            q[i] = (unsigned)fmaxf(ya.x, 1.0f); q[i + 1] = (unsigned)fmaxf(ya.y, 1.0f); q[4 + i] = (unsigned)fmaxf(yb.x, 1.0f); q[5 + i] = (unsigned)fmaxf(yb.y, 1.0f); }
                        u32x2 w; w.x = q[0] | (q[1] << 8) | (q[2] << 16) | (q[3] << 24); w.y = q[4] | (q[5] << 8) | (q[6] << 16) | (q[7] << 24);
                        *(u32x2*)(GQ + (size_t)(u.pm * 256 + ai * 128 + wr * 64 + m * 16) * 3072 + (pn - 8) * 256 + bj * 128 + wc * 32 + vG) = w; }
                    else if (pn == 7) st16(A3 + ((size_t)(bj * 8 + wc * 2) * 2048 + u.pm * 16 + ai * 8 + wr * 4 + m) * 384, vS, pack8(v0, v1));
                    else st16(H + (size_t)(u.pm * 256 + ai * 128 + wr * 64 + m * 16) * HP + pn * 256 + bj * 128 + wc * 32, vH, pack8(v0, v1)); } }
    }
};
struct EpiGlu { const bf16_t* ycp; const float* bias; bf16_t* yc;
    static constexpr bool AFTER_DRAIN = false; __device__ __forceinline__ void pre(const Unit&, int, int, int, int) const {} __device__ __forceinline__ bool keep_acc(const Unit&) const { return false; }
    __device__ __forceinline__ void operator()(const Acc& acc, const Unit& u, int wr, int wc, int fr, int fq) const {
        const unsigned vo = (unsigned)(fr * 256 + 8 * fq) * 2u;
        f32x4 bv[2][2];
#pragma unroll
        for (int bj = 0; bj < 2; ++bj)
#pragma unroll
            for (int n = 0; n < 2; ++n) bv[bj][n] = ldf4(bias + bj * 128 + wc * 32 + 4 * n, (unsigned)fq * 32u);
#define GL_UB(it) ((size_t)(u.pm * 256 + ((it) >> 3) * 128 + wr * 64 + (((it) >> 1) & 3) * 16) * 256 + ((it) & 1) * 128 + wc * 32)
        u32x4 yn = ld16(ycp + GL_UB(0), vo);
#pragma unroll
        for (int it = 0; it < 16; ++it) { const int ai = it >> 3, m = (it >> 1) & 3, bj = it & 1; const size_t ub = GL_UB(it); f32x4 y0, y1; unpack8(yn, y0, y1);
            if (it + 1 < 16) yn = ld16(ycp + GL_UB(it + 1), vo);
            f32x4 v0 = acc[ai][bj][m][0] + bv[bj][0], v1 = acc[ai][bj][m][1] + bv[bj][1];
#pragma unroll
            for (int i = 0; i < 4; ++i) { v0[i] = y0[i] * fsig(v0[i]); v1[i] = y1[i] * fsig(v1[i]); }
            st16(yc + ub, vo, pack8(v0, v1));
            asm volatile("" ::: "memory"); }
#undef GL_UB
    }
};
struct EpiBranch { const bf16_t* H; bf16_t* merged; int br;
    static constexpr bool AFTER_DRAIN = false; __device__ __forceinline__ void pre(const Unit&, int, int, int, int) const {} __device__ __forceinline__ bool keep_acc(const Unit&) const { return false; }
    __device__ __forceinline__ void operator()(const Acc& acc, const Unit& u, int wr, int wc, int fr, int fq) const {
        const unsigned vH = (unsigned)(fr * HP + 8 * fq) * 2u, vM = (unsigned)(fr * 1024 + 8 * fq) * 2u;
#pragma unroll
        for (int ai = 0; ai < 2; ++ai)
#pragma unroll
            for (int m = 0; m < 4; ++m) { const int rowu = u.pm * 256 + ai * 128 + wr * 64 + m * 16;
#pragma unroll
                for (int bj = 0; bj < 2; ++bj) { const int cu = u.pn * 256 + bj * 128 + wc * 32; f32x4 g0, g1; unpack8(ld16(H + (size_t)rowu * HP + HC_G + br * 1024 + cu, vH), g0, g1);
                    f32x4 v0 = acc[ai][bj][m][0] * g0, v1 = acc[ai][bj][m][1] * g1;
                    if (br > 0) { f32x4 p0, p1; unpack8(ld16(merged + (size_t)rowu * 1024 + cu, vM), p0, p1); v0 = v0 + p0; v1 = v1 + p1; }
                    st16(merged + (size_t)rowu * 1024 + cu, vM, pack8(v0, v1)); }
                asm volatile("" ::: "memory"); }
    }
};
struct EpiBranchF { const unsigned char* GQ; bf16_t* merged;
    static constexpr bool AFTER_DRAIN = false; __device__ __forceinline__ void pre(const Unit&, int, int, int, int) const {} __device__ __forceinline__ bool keep_acc(const Unit& u) const { return u.seg < 2; }
    __device__ __forceinline__ void operator()(Acc& acc, const Unit& u, int wr, int wc, int fr, int fq) const {
        const unsigned vG = (unsigned)(fr * 3072 + 8 * fq), vM = (unsigned)(fr * 1024 + 8 * fq) * 2u; const int seg = u.seg;
        const unsigned char* gbase = GQ + (size_t)(u.pm * 256 + wr * 64) * 3072 + seg * 1024 + u.pn * 256 + wc * 32;
        bf16_t* mbase = merged + (size_t)(u.pm * 256 + wr * 64) * 1024 + u.pn * 256 + wc * 32;
#define BF_LOAD(it, G, Hh) do { const size_t ro_ = (size_t)(((it) >> 3) * 128 + (((it) >> 1) & 3) * 16); const int bj_ = (it) & 1; \
            G = *(const u32x2*)(gbase + ro_ * 3072 + bj_ * 128 + vG); Hh = (u32x2){0xffffffffu, 0xffffffffu}; if (seg < 2) Hh = *(const u32x2*)(gbase + ro_ * 3072 + 1024 + bj_ * 128 + vG); } while (0)
        u32x2 gn, hn; BF_LOAD(0, gn, hn);
#pragma unroll
        for (int it = 0; it < 16; ++it) { const int ai = it >> 3, m = (it >> 1) & 3, bj = it & 1; const size_t ro = (size_t)(ai * 128 + m * 16);
            const u32x2 gw = gn, hw = hn;
            if (it + 1 < 16) BF_LOAD(it + 1, gn, hn);
            f32x4 g0, g1;
            if (seg < 2) {
#pragma unroll
                for (int i = 0; i < 4; ++i) { g0[i] = (float)((gw.x >> (8 * i)) & 255u) * __builtin_amdgcn_rcpf((float)((hw.x >> (8 * i)) & 255u));
                                              g1[i] = (float)((gw.y >> (8 * i)) & 255u) * __builtin_amdgcn_rcpf((float)((hw.y >> (8 * i)) & 255u)); }
            } else {
#pragma unroll
                for (int i = 0; i < 4; ++i) { g0[i] = (float)((gw.x >> (8 * i)) & 255u) * (1.0f / 255.0f); g1[i] = (float)((gw.y >> (8 * i)) & 255u) * (1.0f / 255.0f); }
            }
            acc[ai][bj][m][0] = acc[ai][bj][m][0] * g0; acc[ai][bj][m][1] = acc[ai][bj][m][1] * g1;
            if (seg == 2) st16(mbase + ro * 1024 + bj * 128, vM, pack8(acc[ai][bj][m][0], acc[ai][bj][m][1]));
            asm volatile("" ::: "memory"); }
#undef BF_LOAD
    }
};
struct EpiPlain { bf16_t* O; const float* bias; int bias_estride;
    static constexpr bool AFTER_DRAIN = false; __device__ __forceinline__ void pre(const Unit&, int, int, int, int) const {} __device__ __forceinline__ bool keep_acc(const Unit&) const { return false; }
    __device__ __forceinline__ void operator()(const Acc& acc, const Unit& u, int wr, int wc, int fr, int fq) const {
        const unsigned vo = (unsigned)(fr * 1024 + 8 * fq) * 2u;
        f32x4 bv[2][2];
#pragma unroll
        for (int bj = 0; bj < 2; ++bj)
#pragma unroll
            for (int n = 0; n < 2; ++n) bv[bj][n] = bias ? ldf4(bias + (size_t)u.e * bias_estride + u.pn * 256 + bj * 128 + wc * 32 + 4 * n, (unsigned)fq * 32u) : (f32x4){0.f, 0.f, 0.f, 0.f};
#pragma unroll
        for (int ai = 0; ai < 2; ++ai)
#pragma unroll
            for (int m = 0; m < 4; ++m) { const int rowu = u.pm * 256 + ai * 128 + wr * 64 + m * 16;
#pragma unroll
                for (int bj = 0; bj < 2; ++bj) st16(O + (size_t)rowu * 1024 + u.pn * 256 + bj * 128 + wc * 32, vo, pack8(acc[ai][bj][m][0] + bv[bj][0], acc[ai][bj][m][1] + bv[bj][1])); }
    }
};
struct EpiUp { bf16_t* act; const float* bup;
    static constexpr bool AFTER_DRAIN = false; __device__ __forceinline__ void pre(const Unit&, int, int, int, int) const {} __device__ __forceinline__ bool keep_acc(const Unit&) const { return false; }
    __device__ __forceinline__ void operator()(const Acc& acc, const Unit& u, int wr, int wc, int fr, int fq) const {
        const unsigned vo = (unsigned)(fr * 1024 + 8 * fq) * 2u;
        const int ju = u.pn * 128 + wc * 32;
        f32x4 bb[4];
#pragma unroll
        for (int q = 0; q < 4; ++q) { bb[q] = ldf4(bup + (size_t)u.e * 2048 + 2 * ju + 4 * q, (unsigned)fq * 64u); bb[q][1] += 1.0f; bb[q][3] += 1.0f; }
#pragma unroll
        for (int ai = 0; ai < 2; ++ai)
#pragma unroll
            for (int m = 0; m < 4; ++m) { const int rowu = u.pm * 256 + ai * 128 + wr * 64 + m * 16; f32x4 o[2];
#pragma unroll
                for (int n = 0; n < 2; ++n)
#pragma unroll
                    for (int i2 = 0; i2 < 2; ++i2) { const int q = 4 * n + 2 * i2;
                        f32x2 g = (f32x2){acc[ai][0][m][n][2 * i2], acc[ai][0][m][n][2 * i2 + 1]} + (f32x2){bb[q >> 1][0], bb[(q >> 1)][2]};
                        f32x2 l = (f32x2){acc[ai][1][m][n][2 * i2], acc[ai][1][m][n][2 * i2 + 1]} + (f32x2){bb[q >> 1][1], bb[(q >> 1)][3]};
                        g = __builtin_elementwise_min(g, (f32x2){7.0f, 7.0f}); l.x = __builtin_amdgcn_fmed3f(l.x, -6.0f, 8.0f); l.y = __builtin_amdgcn_fmed3f(l.y, -6.0f, 8.0f);
                        const f32x2 t = g * (-1.702f * L2E); const f32x2 d = (f32x2){__builtin_amdgcn_exp2f(t.x), __builtin_amdgcn_exp2f(t.y)} + (f32x2){1.0f, 1.0f};
                        const f32x2 s = (f32x2){__builtin_amdgcn_rcpf(d.x), __builtin_amdgcn_rcpf(d.y)};
                        const f32x2 r = (g * s) * l; o[n][2 * i2] = r.x; o[n][2 * i2 + 1] = r.y; }
                st16(act + (size_t)rowu * 1024 + ju, vo, pack8(o[0], o[1])); }
    }
};
struct EpiYm8 { unsigned char* O; const float* bias;
    mutable f32x4 bv[2][2];
    static constexpr bool AFTER_DRAIN = false;
    __device__ __forceinline__ void pre(const Unit& u, int, int wc, int, int fq) const {
#pragma unroll
        for (int bj = 0; bj < 2; ++bj)
#pragma unroll
            for (int n = 0; n < 2; ++n) bv[bj][n] = ldf4(bias + (size_t)u.e * 1024 + u.pn * 256 + bj * 128 + wc * 32 + 4 * n, (unsigned)fq * 32u); } __device__ __forceinline__ bool keep_acc(const Unit&) const { return false; }
    __device__ __forceinline__ void operator()(const Acc& acc, const Unit& u, int wr, int wc, int fr, int fq) const {
        const unsigned vo = (unsigned)(fr * 1024 + 8 * fq);
#pragma unroll
        for (int ai = 0; ai < 2; ++ai)
#pragma unroll
            for (int m = 0; m < 4; ++m) { const int rowu = u.pm * 256 + ai * 128 + wr * 64 + m * 16;
#pragma unroll
                for (int bj = 0; bj < 2; ++bj) { const f32x4 a = acc[ai][bj][m][0] + bv[bj][0], b = acc[ai][bj][m][1] + bv[bj][1]; u32x2 w;
                    int t = __builtin_amdgcn_cvt_pk_fp8_f32(a[0], a[1], 0, false); t = __builtin_amdgcn_cvt_pk_fp8_f32(a[2], a[3], t, true); w.x = (unsigned)t;
                    t = __builtin_amdgcn_cvt_pk_fp8_f32(b[0], b[1], 0, false); t = __builtin_amdgcn_cvt_pk_fp8_f32(b[2], b[3], t, true); w.y = (unsigned)t;
                    *(u32x2*)(O + (size_t)rowu * 1024 + u.pn * 256 + bj * 128 + wc * 32 + vo) = w; } }
    }
};
}
#include <hip/hip_bf16.h>
#include <cmath>
namespace attn_body {
using bf16=__hip_bfloat16;
using bf16x8=__attribute__((ext_vector_type(8)))short;
using s16x4=__attribute__((ext_vector_type(4)))short;
using f32x16=__attribute__((ext_vector_type(16)))float;
using u32x4=__attribute__((ext_vector_type(4)))unsigned;
constexpr int BATCH=8,NHEAD=8,SEQ=4096,D=64,DM=5120;
constexpr int NW=8,QBLK=32,QB=QBLK*NW,KVBLK=64,NQB=SEQ/QB;
constexpr int ATTN_PITCH=DM, ATTN_UNIT_ROWS=QB;
__device__ __forceinline__ int crow(int r,int hi){return (r&3)+8*(r>>2)+4*hi;}
#define SBAR() __builtin_amdgcn_sched_barrier(0)
__device__ __forceinline__ void cmask(f32x16&p0,f32x16&p1,int jb,int qrel,int hi){
  const float NEG=-INFINITY; int kb=64*jb+4*hi;
  #pragma unroll
  for(int r=0;r<16;++r){int kv=kb+(r&3)+8*(r>>2); if(kv>qrel)p0[r]=NEG; if(kv+32>qrel)p1[r]=NEG;}
}

constexpr int NSLOT=3, SLOTB=8192;
constexpr int LDS_K=0, LDS_V=NSLOT*SLOTB, LDS_WS=2*NSLOT*SLOTB, LDS_OST=LDS_WS+NW*64*4, LDS_BIAS=LDS_OST+NW*4096, LDS_BYTES=LDS_BIAS+SEQ*4;
constexpr float C2=0.125f*1.4426950408889634f;
__device__ __forceinline__ void glds16(const void*gsrc,unsigned lds_dst){unsigned keep;
  asm volatile("s_mov_b32 %0, m0\n\ts_mov_b32 m0, %2\n\ts_nop 0\n\tglobal_load_lds_dwordx4 %1, off\n\ts_mov_b32 m0, %0":"=&s"(keep):"v"(gsrc),"s"(lds_dst):"memory");}
__device__ __forceinline__ float max3f(float a,float b,float c){float r;asm("v_max3_f32 %0, %1, %2, %3":"=v"(r):"v"(a),"v"(b),"v"(c));return r;}
__device__ __forceinline__ float max2f(float a,float b){float r;asm("v_max_f32_e32 %0, %1, %2":"=v"(r):"v"(a),"v"(b));return r;}
__device__ __forceinline__ float fadd_s(float a,float b){float r;asm("v_add_f32_e32 %0, %1, %2":"=v"(r):"v"(a),"v"(b));return r;}
__device__ __forceinline__ float fsub_s(float a,float b){float r;asm("v_sub_f32_e32 %0, %1, %2":"=v"(r):"v"(a),"v"(b));return r;}
typedef float f32x2_t __attribute__((ext_vector_type(2))); typedef __bf16 bf16x2_t __attribute__((ext_vector_type(2)));
__device__ __forceinline__ unsigned cvtpk_s(float lo,float hi){f32x2_t v={lo,hi};bf16x2_t b=__builtin_convertvector(v,bf16x2_t);return __builtin_bit_cast(unsigned,b);}
#define WAIT_BAR(N) asm volatile("s_waitcnt vmcnt(" #N ") lgkmcnt(0)\n\ts_barrier":::"memory")

__device__ __forceinline__ void qkt(f32x16&p0,f32x16&p1,const char*Kslot,const bf16x8*qr,const f32x16&c0in,const f32x16&c1in,int r32,int hi){
  const char*kb=Kslot+hi*1024+r32*16;
  #pragma unroll
  for(int d0=0;d0<4;++d0){
    const bf16x8 b0=*reinterpret_cast<const bf16x8*>(kb+d0*2048);
    const bf16x8 b1=*reinterpret_cast<const bf16x8*>(kb+d0*2048+512);
    if(d0==0){p0=__builtin_amdgcn_mfma_f32_32x32x16_bf16(b0,qr[0],c0in,0,0,0);p1=__builtin_amdgcn_mfma_f32_32x32x16_bf16(b1,qr[0],c1in,0,0,0);}
    else{p0=__builtin_amdgcn_mfma_f32_32x32x16_bf16(b0,qr[d0],p0,0,0,0);p1=__builtin_amdgcn_mfma_f32_32x32x16_bf16(b1,qr[d0],p1,0,0,0);}}
}
typedef __attribute__((address_space(3))) const char* lds_cptr;
typedef short v4i16_t __attribute__((ext_vector_type(4)));
__device__ __forceinline__ void kload8(bf16x8*kf,lds_cptr kp){
  kf[0]=*(const __attribute__((address_space(3))) bf16x8*)(kp);      kf[1]=*(const __attribute__((address_space(3))) bf16x8*)(kp+512);
  kf[2]=*(const __attribute__((address_space(3))) bf16x8*)(kp+2048); kf[3]=*(const __attribute__((address_space(3))) bf16x8*)(kp+2560);
  kf[4]=*(const __attribute__((address_space(3))) bf16x8*)(kp+4096); kf[5]=*(const __attribute__((address_space(3))) bf16x8*)(kp+4608);
  kf[6]=*(const __attribute__((address_space(3))) bf16x8*)(kp+6144); kf[7]=*(const __attribute__((address_space(3))) bf16x8*)(kp+6656);
}
__device__ __forceinline__ void kload2(bf16x8*kf,lds_cptr kp,int j){ kf[2*j]=*(const __attribute__((address_space(3))) bf16x8*)(kp+j*2048); kf[2*j+1]=*(const __attribute__((address_space(3))) bf16x8*)(kp+j*2048+512); }
__device__ __forceinline__ s16x4 vtr(lds_cptr p){ return __builtin_bit_cast(s16x4,__builtin_amdgcn_ds_read_tr16_b64_v4i16((__attribute__((address_space(3))) v4i16_t*)p)); }
__device__ __forceinline__ float rowmax(const f32x16&p0,const f32x16&p1){
  float a=max3f(p0[0],p0[1],p1[0]),b=max3f(p0[2],p0[3],p1[1]);a=max3f(a,p1[2],p1[3]);
  #pragma unroll
  for(int r=4;r<16;r+=4){a=max3f(a,p0[r],p0[r+1]);b=max3f(b,p0[r+2],p0[r+3]);a=max3f(a,p1[r],p1[r+1]);b=max3f(b,p1[r+2],p1[r+3]);}
  const float m=max2f(a,b);
  auto rr=__builtin_amdgcn_permlane32_swap(__float_as_uint(m),__float_as_uint(m),false,false);
  return max2f(__uint_as_float(rr[0]),__uint_as_float(rr[1]));
}
__device__ __forceinline__ void pv(f32x16*o,int vb,bf16x8 pa0,bf16x8 pa1,bf16x8 pa2,bf16x8 pa3){
  #pragma unroll
  for(int d0=0;d0<2;++d0){s16x4 lo[4],hi[4];
    #pragma unroll
    for(int ks=0;ks<4;++ks){
      asm volatile("ds_read_b64_tr_b16 %0,%1 offset:%c2":"=&v"(lo[ks]):"v"(vb),"i"(d0*4096+ks*1024):"memory");
      asm volatile("ds_read_b64_tr_b16 %0,%1 offset:%c2":"=&v"(hi[ks]):"v"(vb),"i"(d0*4096+ks*1024+512):"memory");}
    asm volatile("s_waitcnt lgkmcnt(0)":::"memory");SBAR();
    #define PK(k) (bf16x8){lo[k][0],lo[k][1],lo[k][2],lo[k][3],hi[k][0],hi[k][1],hi[k][2],hi[k][3]}
    o[d0]=__builtin_amdgcn_mfma_f32_32x32x16_bf16(pa0,PK(0),o[d0],0,0,0);
    o[d0]=__builtin_amdgcn_mfma_f32_32x32x16_bf16(pa1,PK(1),o[d0],0,0,0);
    o[d0]=__builtin_amdgcn_mfma_f32_32x32x16_bf16(pa2,PK(2),o[d0],0,0,0);
    o[d0]=__builtin_amdgcn_mfma_f32_32x32x16_bf16(pa3,PK(3),o[d0],0,0,0);
    #undef PK
  }
}

#ifndef ATTN_STORE16
#define ATTN_STORE16(p,v) (*(u32x4*)(p)=(v))
#endif
typedef __attribute__((address_space(3))) const float* lds_fptr; typedef float f32x4_t __attribute__((ext_vector_type(4)));
__device__ __forceinline__ void bias_tuple(f32x16&c0,f32x16&c1,lds_fptr bp,float mhat){
  #pragma unroll
  for(int g=0;g<4;++g){ const f32x4_t x=*(const __attribute__((address_space(3))) f32x4_t*)(bp+8*g), y=*(const __attribute__((address_space(3))) f32x4_t*)(bp+32+8*g);
    #pragma unroll
    for(int i=0;i<4;++i){ c0[4*g+i]=x[i]-mhat; c1[4*g+i]=y[i]-mhat; } }
}
template<int THRL> __device__ __forceinline__ void attn_unit(int b,int h,int qb,const bf16*Q,const bf16*__restrict__ K,const bf16*__restrict__ V,bf16*O,const float*__restrict__ cum,char*shm){
  int tid_=threadIdx.x; asm volatile("":"+v"(tid_));
  const int tid=tid_,lane=tid&63,r32=lane&31,hi=lane>>5; const int wid=__builtin_amdgcn_readfirstlane(tid>>6);
  const long rowbase=(long)b*SEQ; const int q0=qb*QB;
  const bf16*Qw=Q+(rowbase+q0+wid*QBLK)*DM+h*D;
  const bf16*Kh=K+rowbase*DM+h*D,*Vh=V+rowbase*DM+h*D;
  const unsigned lds0=(unsigned)(uintptr_t)shm;
  float*wsf=(float*)(shm+LDS_WS)+wid*64;
  { const float*cb=cum+(long)(b*NHEAD+h)*SEQ; const float cref=cb[q0]; float*bt=(float*)(shm+LDS_BIAS);
    float cv[8];
    _Pragma("unroll") for(int u=0;u<8;++u){const int j=tid+u*NW*64; cv[u]=(j<q0+QB)?cb[j]:0.f;}
    _Pragma("unroll") for(int u=0;u<8;++u){const int j=tid+u*NW*64; if(j<q0+QB)bt[j]=-1.4426950408889634f*(cv[u]-cref);} }
  asm volatile("s_waitcnt lgkmcnt(0)\n\ts_barrier":::"memory");
  int tskip=0;
  { const int NT0=(q0+QB)/KVBLK; const lds_fptr bt0=(lds_fptr)((lds_cptr)shm+LDS_BIAS);
    const float bv=(lane<NT0)?bt0[64*lane+63]:0.f;
    const unsigned long long mk=__ballot(lane<NT0&&bv<-64.f);
    tskip=__builtin_amdgcn_readfirstlane((int)__popcll(mk))&~1; if(tskip>NT0-4)tskip=NT0-4; }
  const lds_fptr btl=(lds_fptr)((lds_cptr)shm+LDS_BIAS)+4*hi+64*tskip;
  const bf16*Khs=Kh+(long)tskip*KVBLK*DM,*Vhs=Vh+(long)tskip*KVBLK*DM;
  const bf16*ksrc=Khs+(long)lane*DM+wid*8;
  const bf16*vsrc=Vhs+(long)(16*(wid&3)+(lane>>2))*DM+(wid>>2)*32+(lane&3)*8;
  const unsigned kdst=lds0+LDS_K+wid*1024, vdst=lds0+LDS_V+wid*1024;
  #define DMA_K(t,slot) glds16(ksrc+(long)(t)*KVBLK*DM,(unsigned)__builtin_amdgcn_readfirstlane(kdst+(slot)))
  #define DMA_V(t,slot) glds16(vsrc+(long)(t)*KVBLK*DM,(unsigned)__builtin_amdgcn_readfirstlane(vdst+(slot)))
  const int vb0=(int)(lds0+LDS_V)+((lane>>4)&1)*32+(lane&3)*8+(4*hi+((lane&15)>>2))*64;
  const char*Kbase=shm+LDS_K; bf16x8 kf[8];
  const lds_cptr shm3=(lds_cptr)shm; const lds_cptr kp0=shm3+LDS_K+hi*1024+r32*16; const lds_cptr vp0=shm3+LDS_V+((lane>>4)&1)*32+(lane&3)*8+(4*hi+((lane&15)>>2))*64;
  const int NT=(q0+QB)/KVBLK-tskip;
  DMA_K(0,0);DMA_V(0,0);DMA_K(1,SLOTB);
  bf16x8 qr[4];
  #pragma unroll
  for(int d0=0;d0<4;++d0)qr[d0]=*reinterpret_cast<const bf16x8*>(&Qw[(long)r32*DM+d0*16+hi*8]);
  float mhat=0.f,l_reg=0.f;f32x16 o[2];o[0]=f32x16{};o[1]=f32x16{};
  const int qrel=wid*QBLK+r32;
  #define CMASK(P0,P1,t) do{int jb_=(t)-(NT-4); if(jb_>=0)cmask(P0,P1,jb_,qrel,hi);}while(0)
  bool resc=false;
  #define START(P0,P1) do{ const float rm=rowmax(P0,P1); resc=false; \
    { const float dl=rm; mhat=fadd_s(mhat,dl); \
      _Pragma("unroll") for(int r=0;r<16;++r){P0[r]=fsub_s(P0[r],dl);P1[r]=fsub_s(P1[r],dl);} \
      } \
    _Pragma("unroll") for(int r=0;r<16;++r)P0[r]=__builtin_amdgcn_exp2f(P0[r]); }while(0)
  #define RESC() do{ if(resc){ asm volatile("s_waitcnt lgkmcnt(0)":::"memory"); \
      _Pragma("unroll") for(int d_=0;d_<2;++d_) _Pragma("unroll") for(int r=0;r<16;++r)o[d_][r]*=wsf[crow(r,hi)]; } }while(0)
  f32x16 pA0,pA1,pB0,pB1;
  int sl_prev=0,sl_cur=0,sl_next=SLOTB;
  #define ROT() do{sl_prev=sl_cur;sl_cur=sl_next;sl_next=(sl_next==(NSLOT-1)*SLOTB)?0:sl_next+SLOTB;}while(0)
  DMA_K(2,2*SLOTB);
  WAIT_BAR(3);
  { f32x16 c0in,c1in; bias_tuple(c0in,c1in,btl,0.f); qkt(pA0,pA1,Kbase,qr,c0in,c1in,r32,hi); } asm volatile("s_nop 15\n\ts_nop 7":"+v"(pA0),"+v"(pA1));CMASK(pA0,pA1,0);
  START(pA0,pA1);
  _Pragma("unroll") for(int r=0;r<16;++r)pA1[r]=__builtin_amdgcn_exp2f(pA1[r]);
  WAIT_BAR(0);
  DMA_K(3,0);DMA_V(1,SLOTB);
  ROT();
  kload8(kf,kp0+sl_cur);
  WAIT_BAR(2);
  s16x4 vlo[8],vhi[8]; u32x4 pw0,pw1,pw2,pw3;
  #define PKW(P,B) cvtpk_s(P[B],P[B+1])
  #define PAF(k) __builtin_bit_cast(bf16x8,pw##k)
  #define VFR(i) (bf16x8){vlo[i][0],vlo[i][1],vlo[i][2],vlo[i][3],vhi[i][0],vhi[i][1],vhi[i][2],vhi[i][3]}
  #define PIN(x) asm volatile("":"+v"(x))
  #define MX3(a,b,c) __builtin_fmaxf(__builtin_fmaxf((a),(b)),(c))
  #define GAPA(MF,A0,A1,A2,A3,W0,W1,PW) do{ MF; sacc+=A0; sacc+=A1; sacc+=A2; sacc+=A3; PIN(sacc); W0; W1; PIN(PW); SBAR(); }while(0)
  #define EX(v) __builtin_amdgcn_exp2f(v)
  #define GAPB(MF,X,B) do{ MF; X[B]=EX(X[B]); X[B+1]=EX(X[B+1]); X[B+2]=EX(X[B+2]); X[B+3]=EX(X[B+3]); PIN(X); SBAR(); }while(0)
  #define VRD(i) do{ vlo[i]=vtr(vp_+(((i)>>2)*4096+((i)&3)*1024)); vhi[i]=vtr(vp_+(((i)>>2)*4096+((i)&3)*1024+512)); }while(0)
  #define KRD(G,j) do{ if(G){ kload2(kf,kp0+sl_next,j); SBAR(); } }while(0)
  #define STEP(C0,C1,P0,P1,t,GK,GV,GL) do{ SBAR(); \
    const lds_cptr vp_=vp0+sl_prev; bias_tuple(C0,C1,btl+(t)*64,mhat); SBAR(); \
    VRD(0); SBAR(); float sacc=(P0[0]+P0[1]); \
    GAPA(C0=__builtin_amdgcn_mfma_f32_32x32x16_bf16(kf[0],qr[0],C0,0,0,0), P0[2],P0[3],P0[4],P0[5],     pw0[0]=PKW(P0,0), pw0[1]=PKW(P0,2), pw0); \
    VRD(4); SBAR(); GAPA(C1=__builtin_amdgcn_mfma_f32_32x32x16_bf16(kf[1],qr[0],C1,0,0,0), P0[6],P0[7],P0[8],P0[9],     pw0[2]=PKW(P0,4), pw0[3]=PKW(P0,6), pw0); \
    VRD(1); SBAR(); GAPA(C0=__builtin_amdgcn_mfma_f32_32x32x16_bf16(kf[2],qr[1],C0,0,0,0),   P0[10],P0[11],P0[12],P0[13], pw1[0]=PKW(P0,8), pw1[1]=PKW(P0,10), pw1); \
    VRD(5); SBAR(); GAPA(C1=__builtin_amdgcn_mfma_f32_32x32x16_bf16(kf[3],qr[1],C1,0,0,0),   P0[14],P0[15],P1[0],P1[1],   pw1[2]=PKW(P0,12),pw1[3]=PKW(P0,14), pw1); \
    VRD(2); SBAR(); GAPA(C0=__builtin_amdgcn_mfma_f32_32x32x16_bf16(kf[4],qr[2],C0,0,0,0),   P1[2],P1[3],P1[4],P1[5],     pw2[0]=PKW(P1,0), pw2[1]=PKW(P1,2), pw2); \
    VRD(6); SBAR(); GAPA(C1=__builtin_amdgcn_mfma_f32_32x32x16_bf16(kf[5],qr[2],C1,0,0,0),   P1[6],P1[7],P1[8],P1[9],     pw2[2]=PKW(P1,4), pw2[3]=PKW(P1,6), pw2); \
    VRD(3); SBAR(); GAPA(C0=__builtin_amdgcn_mfma_f32_32x32x16_bf16(kf[6],qr[3],C0,0,0,0),   P1[10],P1[11],P1[12],P1[13], pw3[0]=PKW(P1,8), pw3[1]=PKW(P1,10), pw3); \
    VRD(7); SBAR(); GAPA(C1=__builtin_amdgcn_mfma_f32_32x32x16_bf16(kf[7],qr[3],C1,0,0,0),   P1[14],P1[15],0.f,0.f,       pw3[2]=PKW(P1,12),pw3[3]=PKW(P1,14), pw3); \
    l_reg+=sacc; \
    if(GK){DMA_K((t)+3,sl_cur);} if(GV){DMA_V((t)+1,sl_next);} \
    CMASK(C0,C1,t); \
    { float a=MX3(C0[0],C0[1],C1[0]),b=MX3(C0[2],C0[3],C1[1]); a=MX3(a,C1[2],C1[3]); \
      _Pragma("unroll") for(int r=4;r<16;r+=4){a=MX3(a,C0[r],C0[r+1]);b=MX3(b,C0[r+2],C0[r+3]);a=MX3(a,C1[r],C1[r+1]);b=MX3(b,C1[r+2],C1[r+3]);} \
      float rm=__builtin_fmaxf(a,b); { auto rr=__builtin_amdgcn_permlane32_swap(__float_as_uint(rm),__float_as_uint(rm),false,false); rm=__builtin_fmaxf(__uint_as_float(rr[0]),__uint_as_float(rr[1])); } \
      resc=false; \
      if(__builtin_expect(__any(rm>(float)THRL),0)){ const float dl=__builtin_fmaxf(rm,0.f); mhat+=dl; \
        _Pragma("unroll") for(int r=0;r<16;++r){C0[r]-=dl;C1[r]-=dl;} \
        const float f=__builtin_amdgcn_exp2f(-dl); l_reg*=f; if(hi==0)wsf[r32]=f; resc=true; } } \
    SBAR(); \
    GAPB(o[0]=__builtin_amdgcn_mfma_f32_32x32x16_bf16(PAF(0),VFR(0),o[0],0,0,0), C0,0); \
    GAPB(o[1]=__builtin_amdgcn_mfma_f32_32x32x16_bf16(PAF(0),VFR(4),o[1],0,0,0), C0,4); \
    KRD(GL,0); GAPB(o[0]=__builtin_amdgcn_mfma_f32_32x32x16_bf16(PAF(1),VFR(1),o[0],0,0,0), C0,8); \
    KRD(GL,1); GAPB(o[1]=__builtin_amdgcn_mfma_f32_32x32x16_bf16(PAF(1),VFR(5),o[1],0,0,0), C0,12); \
    KRD(GL,2); GAPB(o[0]=__builtin_amdgcn_mfma_f32_32x32x16_bf16(PAF(2),VFR(2),o[0],0,0,0), C1,0); \
    KRD(GL,3); GAPB(o[1]=__builtin_amdgcn_mfma_f32_32x32x16_bf16(PAF(2),VFR(6),o[1],0,0,0), C1,4); \
    GAPB(o[0]=__builtin_amdgcn_mfma_f32_32x32x16_bf16(PAF(3),VFR(3),o[0],0,0,0), C1,8); \
    GAPB(o[1]=__builtin_amdgcn_mfma_f32_32x32x16_bf16(PAF(3),VFR(7),o[1],0,0,0), C1,12); \
    }while(0)
  int t=1;
  #undef CMASK
  #define CMASK(P0,P1,t) do{}while(0)
  for(;t+5<NT;t+=2){
    STEP(pB0,pB1,pA0,pA1,t,true,true,true);     WAIT_BAR(2); RESC(); ROT();
    STEP(pA0,pA1,pB0,pB1,t+1,true,true,true);   WAIT_BAR(2); RESC(); ROT();
  }
  #undef CMASK
  #define CMASK(P0,P1,t) do{int jb_=(t)-(NT-4); if(jb_>=0)cmask(P0,P1,jb_,qrel,hi);}while(0)
  #define ENDW(tt) do{ if((tt)+3<NT){WAIT_BAR(2);} else if((tt)+2<NT){WAIT_BAR(1);} else {WAIT_BAR(0);} }while(0)
  for(;t+1<NT;t+=2){
    STEP(pB0,pB1,pA0,pA1,t,(t+3<NT),(t+1<NT),(t+1<NT));       ENDW(t);   RESC(); ROT();
    STEP(pA0,pA1,pB0,pB1,t+1,(t+4<NT),(t+2<NT),(t+2<NT));     ENDW(t+1); RESC(); ROT();
  }
  STEP(pB0,pB1,pA0,pA1,NT-1,false,false,false); RESC();
  { float sacc=pB0[0]+pB0[1]; _Pragma("unroll") for(int r=2;r<16;++r)sacc+=pB0[r]; _Pragma("unroll") for(int r=0;r<16;++r)sacc+=pB1[r]; l_reg+=sacc;
    pw0=(u32x4){PKW(pB0,0),PKW(pB0,2),PKW(pB0,4),PKW(pB0,6)};pw1=(u32x4){PKW(pB0,8),PKW(pB0,10),PKW(pB0,12),PKW(pB0,14)};pw2=(u32x4){PKW(pB1,0),PKW(pB1,2),PKW(pB1,4),PKW(pB1,6)};pw3=(u32x4){PKW(pB1,8),PKW(pB1,10),PKW(pB1,12),PKW(pB1,14)};
    SBAR(); pv(o,vb0+sl_cur,PAF(0),PAF(1),PAF(2),PAF(3)); }
  #undef PKW
  #undef PAF
  #undef VFR
  #undef PIN
  #undef MX3
  #undef GAPA
  #undef GAPB
  #undef EX
  #undef VRD
  #undef KRD
  #undef STEP
  #undef ENDW
  {auto rr=__builtin_amdgcn_permlane32_swap(__float_as_uint(l_reg),__float_as_uint(l_reg),false,false);l_reg=__uint_as_float(rr[0])+__uint_as_float(rr[1]);}
  if(hi==0)wsf[32+r32]=l_reg;asm volatile("s_waitcnt lgkmcnt(0)":::"memory");
  float rli[16];
  #pragma unroll
  for(int r=0;r<16;++r)rli[r]=__builtin_amdgcn_rcpf(wsf[32+crow(r,hi)]);
  bf16*Ow=O+(rowbase+q0+wid*QBLK)*DM+h*D;
  { bf16*stg=(bf16*)(shm+LDS_OST)+wid*2048;
    #pragma unroll
    for(int r=0;r<16;++r){const int orow=crow(r,hi);
      #pragma unroll
      for(int d0=0;d0<2;++d0)stg[orow*64+d0*32+r32]=__float2bfloat16(o[d0][r]*rli[r]);}
    asm volatile("s_waitcnt lgkmcnt(0)":::"memory");
    #pragma unroll
    for(int i=0;i<4;++i){const int row=i*8+(lane>>3),ch=lane&7; const u32x4 v=*(const u32x4*)(stg+row*64+ch*8); ATTN_STORE16(Ow+(long)row*DM+ch*8,v);} }
  asm volatile("s_waitcnt lgkmcnt(0)\n\ts_barrier":::"memory");
  #undef DMA_K
  #undef DMA_V
  #undef CMASK
  #undef START
  #undef RESC
  #undef ROT
}
constexpr int ATTN_LDS_BYTES=LDS_BYTES;
struct AttnTensors { const bf16* Q; const bf16* K; const bf16* V; bf16* O; const float* cum; };
struct AttnUnit { int bh; int qb; };
struct StaticOrder {
  int vcu;
  __device__ __forceinline__ explicit StaticOrder(int grid,int block):vcu((block%8)*(grid/8)+block/8){}
  __device__ __forceinline__ bool next(int i,AttnUnit&u)const{ if(i>=4||vcu>=256)return false; const int s=vcu&3; u.bh=(vcu>>5)*NHEAD+((((vcu>>2)&7)+2*i)&7); u.qb=(i==0)?s:(i==1)?7-s:(i==2)?8+s:15-s; return true; }
  __device__ __forceinline__ void a_ready(const AttnUnit&)const{}
  __device__ __forceinline__ void done(const AttnUnit&)const{}
};
struct QueueOrder {
  unsigned* q; volatile __attribute__((address_space(3))) int* slot;
  __device__ __forceinline__ bool next(int,AttnUnit&u)const{
    if(threadIdx.x==0)slot[0]=(int)__hip_atomic_fetch_add(q,1u,__ATOMIC_RELAXED,__HIP_MEMORY_SCOPE_AGENT);
    asm volatile("s_waitcnt vmcnt(0) lgkmcnt(0)\n\ts_barrier":::"memory");
    const int v=__builtin_amdgcn_readfirstlane(slot[0]);
    asm volatile("s_waitcnt lgkmcnt(0)\n\ts_barrier":::"memory");
    if(v>=128)return false; u.qb=15-(v>>3); u.bh=7-(v&7); return true; }
  __device__ __forceinline__ void a_ready(const AttnUnit&)const{}
  __device__ __forceinline__ void done(const AttnUnit&)const{}
};
template<class Sched,int THRL=8> __device__ __forceinline__ void attn_phase(char*lds,const AttnTensors&T,const Sched&S){
  AttnUnit u;
  for(int i=0;S.next(i,u);++i){ S.a_ready(u); attn_unit<THRL>(u.bh/NHEAD,u.bh%NHEAD,u.qb,T.Q,T.K,T.V,T.O,T.cum,lds); S.done(u); }
}
#undef SBAR
#undef WAIT_BAR
}
constexpr int NWAVES = 8;
constexpr int RING_BYTES = 131072;
constexpr int LDSCTL_BYTES = 4096, RING_OFF = LDSCTL_BYTES;
constexpr int LDS_BYTES = 147456;
constexpr int CW_BAR = 4096;
typedef __attribute__((address_space(1))) unsigned gu32;

#define XB_TMO      128
#define XB_XCNT(j)  (256  + 64 * (j))
#define XB_XSUB(j)  (1280 + 64 * (j))
#define XB_XGEN(j)  (2304 + 64 * (j))
#define XB_TOP      3328
#define XB_TOPGEN   3392
#define XCD_BAR_WORDS 3456
#define XB_SPIN_CAP (1u << 18)
__device__ __forceinline__ unsigned xb_ld(unsigned* p)              { return __hip_atomic_load(p, __ATOMIC_RELAXED, __HIP_MEMORY_SCOPE_AGENT); }
__device__ __forceinline__ unsigned xb_add(unsigned* p, unsigned v) { return __hip_atomic_fetch_add(p, v, __ATOMIC_RELAXED, __HIP_MEMORY_SCOPE_AGENT); }
__device__ __forceinline__ unsigned xb_xcc_id() { return (unsigned)__builtin_amdgcn_s_getreg((3 << 11) | 20) & 0xFu; }
#define XB_SPIN(cond, bar) do { unsigned _sp = 0; while (cond) { __builtin_amdgcn_s_sleep(1); \
    if ((++_sp & 255u) == 0u) { if (xb_ld(&(bar)[XB_TMO])) break; if (_sp > XB_SPIN_CAP) { atomicAdd(&(bar)[XB_TMO], 1u); break; } } } } while (0)
struct XcdBarrier { unsigned* bar; unsigned x; volatile LAS unsigned* st; };
__device__ __forceinline__ XcdBarrier xcd_barrier_post(unsigned* bar, volatile LAS unsigned* st) {
    XcdBarrier b; b.bar = bar; b.x = xb_xcc_id(); b.st = st;
    if (threadIdx.x == 0) (void)xb_add(&bar[XB_XCNT(b.x)], 1u);
    return b;
}
__device__ __forceinline__ void xcd_barrier_complete(unsigned* bar, unsigned x, unsigned& nloc, unsigned& nx) {
    const unsigned G = gridDim.x * gridDim.y * gridDim.z;
    unsigned sum, cnt, mine, sp = 0u;
    for (;;) {
        sum = 0u; cnt = 0u; mine = 0u;
#pragma unroll
        for (unsigned j = 0; j < 16; ++j) { const unsigned c = xb_ld(&bar[XB_XCNT(j)]); sum += c; cnt += (c > 0u) ? 1u : 0u; mine = (j == x) ? c : mine; }
        if (sum == G) break;
        __builtin_amdgcn_s_sleep(1);
        if ((++sp & 255u) == 0u) { if (xb_ld(&bar[XB_TMO])) break; if (sp > XB_SPIN_CAP) { atomicAdd(&bar[XB_TMO], 1u); break; } }
    }
    nloc = mine > 0u ? mine : 1u; nx = cnt > 0u ? cnt : 1u;
}
__device__ __forceinline__ void xcd_barrier(const XcdBarrier& b) {
    asm volatile("s_waitcnt vmcnt(0)" ::: "memory");
    __syncthreads();
    if (threadIdx.x == 0) {
        unsigned* bar = b.bar;
        __builtin_amdgcn_s_waitcnt(0);
        unsigned nloc = b.st[0], nx = b.st[1];
        if (nloc == 0u) { xcd_barrier_complete(bar, b.x, nloc, nx); b.st[0] = nloc; b.st[1] = nx; }
        const unsigned old = xb_add(&bar[XB_XSUB(b.x)], 1u);
        const unsigned gen = old / nloc;
        if (old + 1u == (gen + 1u) * nloc) {
            __builtin_amdgcn_fence(__ATOMIC_RELEASE, "agent");
            asm volatile("s_waitcnt vmcnt(0)" ::: "memory");
            const unsigned og = xb_add(&bar[XB_TOP], 1u);
            const unsigned tg = og / nx;
            if (og + 1u == (tg + 1u) * nx) xb_add(&bar[XB_TOPGEN], 1u);
            else XB_SPIN(xb_ld(&bar[XB_TOPGEN]) == tg, bar);
            __builtin_amdgcn_fence(__ATOMIC_ACQUIRE, "agent");
            xb_add(&bar[XB_XGEN(b.x)], 1u);
            asm volatile("s_waitcnt vmcnt(0)" ::: "memory");
        } else {
            XB_SPIN(xb_ld(&bar[XB_XGEN(b.x)]) == gen, bar);
            __builtin_amdgcn_fence(__ATOMIC_ACQUIRE, "agent");
            asm volatile("s_waitcnt vmcnt(0)" ::: "memory");
        }
    }
    __syncthreads();
}

struct MoeOrder {
    const volatile LAS int* tpre; const unsigned* cnt; const int* tok; const char* A; const char* B; size_t estepB, tstepB, tstepA; int nN, G, c, lda; bool gather;
    int r0x;
    __device__ __forceinline__ bool unit_at(int mt, int pn, pg8::Unit& u) const {
        if (mt >= tpre[32]) return false;
        const int e = __builtin_amdgcn_readfirstlane((int)((volatile LAS unsigned char*)(tpre + 96))[mt]);
        const int lt = __builtin_amdgcn_readfirstlane(mt - tpre[e]);
        const int rem = tpre[33 + e] - lt * 256;
        u.e = e; u.pm = mt; u.pn = pn; u.valid = rem < 256 ? rem : 256; u.lt = lt; u.lda = 1024; u.ldb = 1024; u.nt = 16; u.seg = 0;
        u.B = B + (size_t)e * estepB + (size_t)pn * tstepB;
        u.A = gather ? A : A + (size_t)mt * tstepA;
        return true;
    }
    __device__ __forceinline__ bool next(int i, pg8::Unit& u) const {
        const int x = c & 7, j = c >> 3, per = (G >> 3) / nN, pn = j % nN; int mt = (i * 8 + x) * per + j / nN;
        if (r0x >= 0) { const int k = r0x + 1; mt = mt < k ? mt : (mt < 2 * k ? 32 + (mt - k) : 64 + (mt - 2 * k)); }
        return unit_at(mt, pn, u);
    }
    __device__ __forceinline__ void goff(const pg8::Unit& u, int R0, int C0, unsigned (&off)[2][2]) const {
#pragma unroll
        for (int h = 0; h < 2; ++h)
#pragma unroll
            for (int i = 0; i < 2; ++i) { const int r = h * 128 + R0 + 64 * i; const int t = r < u.valid ? tok[(size_t)u.e * NTOK + u.lt * 256 + r] : 0; off[h][i] = (unsigned)(t * lda + C0) * 2u; }
    }
};
struct MoeOne { MoeOrder M; int mt, pn;
    __device__ __forceinline__ bool next(int i, pg8::Unit& u) const { if (i) return false; return M.unit_at(mt, pn, u); }
    __device__ __forceinline__ void goff(const pg8::Unit& u, int R0, int C0, unsigned (&off)[2][2]) const { M.goff(u, R0, C0, off); }
};
__device__ __forceinline__ void moe_prefix(const unsigned* cnt, volatile LAS int* tpre) {
    int tid = threadIdx.x; asm volatile("" : "+v"(tid));
    if (tid < 64) { const int c = tid < 32 ? (int)cnt[tid * CNT_STRIDE] : 0; const int tl = (c + 255) >> 8; int inc = tl;
#pragma unroll
        for (int o = 1; o < 32; o <<= 1) { const int t = __shfl_up(inc, o); if (tid >= o) inc += t; }
        if (tid < 32) { tpre[tid] = inc - tl; tpre[33 + tid] = c; if (tid == 31) tpre[32] = inc; } }
    __syncthreads();
    { volatile LAS unsigned char* tmap = (volatile LAS unsigned char*)(tpre + 96);
      const int tot = tpre[32];
      for (int mt = tid; mt < tot; mt += NWAVES * 64) { int e = 0;
#pragma unroll
          for (int k = 1; k < 32; ++k) e += (tpre[k] <= mt) ? 1 : 0;
          tmap[mt] = (unsigned char)e; } }
    __syncthreads();
}

constexpr size_t WS_S5W1 = 58 * MiB;
constexpr size_t WS_S5W3 = 66 * MiB;
constexpr size_t WS_S5A16 = 78 * MiB;
constexpr size_t WS_S5S = 2304 * MiB;
constexpr size_t WS_OB = 2320 * MiB;
constexpr size_t WS_GQ = 2640 * MiB;
constexpr size_t WS_END2 = 2736 * MiB;

struct S5Disc { float lr, li, dt, zr, zi; };
__device__ __forceinline__ S5Disc s5_disc(const float* lam_re, const float* lam_im, const float* log_dt, int g, int p) {
    S5Disc d; d.dt = expf(log_dt[g]); d.lr = lam_re[g * 64 + p]; d.li = lam_im[g * 64 + p];
    const float mag = expf(d.lr * d.dt), ar = mag * cosf(d.li * d.dt), ai = mag * sinf(d.li * d.dt), den = d.lr * d.lr + d.li * d.li, nr = ar - 1.0f;
    d.zr = (nr * d.lr + ai * d.li) / den; d.zi = (ai * d.lr - nr * d.li) / den; return d;
}
__device__ __forceinline__ void s5_apow(const S5Disc& d, float n, float& pr, float& pi) { const float mag = expf(d.lr * d.dt * n); pr = mag * cosf(d.li * d.dt * n); pi = mag * sinf(d.li * d.dt * n); }

struct S5In { const float *lam_re, *lam_im, *log_dt, *b_re, *b_im, *c_re, *c_im, *dsk; };
__device__ __forceinline__ void s5_prep_item(const S5In& in, unsigned char* ws, int l, int g, int kind, int q, int lane) {
    const float* lam_re = in.lam_re + (size_t)l * 1024; const float* lam_im = in.lam_im + (size_t)l * 1024; const float* log_dt = in.log_dt + (size_t)l * 16;
    const float* b_re = in.b_re + (size_t)l * 16384; const float* b_im = in.b_im + (size_t)l * 16384; const float* c_re = in.c_re + (size_t)l * 16384; const float* c_im = in.c_im + (size_t)l * 16384;
    const float* dsk = in.dsk + (size_t)l * 256;
    bf16_t* W1 = (bf16_t*)(ws + WS_S5W1) + ((size_t)l * 16 + g) * 256 * 256;
    bf16_t* W3 = (bf16_t*)(ws + WS_S5W3) + ((size_t)l * 16 + g) * 256 * 384;
    const int p = lane;
    const S5Disc d = s5_disc(lam_re, lam_im, log_dt, g, p);
    if (kind == 0) {
        float pr, pi; s5_apow(d, (float)q, pr, pi);
        float mr[16], mi[16];
#pragma unroll
        for (int h = 0; h < 16; ++h) { const float br = b_re[(g * 64 + p) * 16 + h], bi = b_im[(g * 64 + p) * 16 + h]; const float bbr = d.zr * br - d.zi * bi, bbi = d.zr * bi + d.zi * br;
            mr[h] = pr * bbr - pi * bbi; mi[h] = pr * bbi + pi * bbr; }
        float crv[16], civ[16];
#pragma unroll
        for (int hp = 0; hp < 16; ++hp) { crv[hp] = c_re[(g * 16 + hp) * 64 + p]; civ[hp] = c_im[(g * 16 + hp) * 64 + p]; }
#pragma unroll
        for (int hp = 0; hp < 16; ++hp) {
            const float cr = crv[hp], ci = civ[hp];
            float v[16];
#pragma unroll
            for (int h = 0; h < 16; ++h) v[h] = cr * mr[h] - ci * mi[h];
            reduce_scatter<16>(v, lane);
            const int h = (lane >> 2) & 15;
            float kv = v[0]; if (q == 0 && h == hp) kv += dsk[g * 16 + hp];
            const bf16_t kb = f2bf(kv);
            for (int s = (lane & 3); s + q < 16; s += 4) { const int t = s + q;
                W3[(size_t)(t * 16 + hp) * 384 + s * 16 + h] = kb;
                if (q > 0) W3[(size_t)(s * 16 + hp) * 384 + t * 16 + h] = 0; }
        }
    } else if (kind == 1) {
        float pr, pi; s5_apow(d, (float)(15 - q), pr, pi);
        u32x4 wr0, wr1, wi0, wi1; unsigned wr_[8], wi_[8];
#pragma unroll
        for (int h2 = 0; h2 < 8; ++h2) { float re[2], im[2];
#pragma unroll
            for (int e = 0; e < 2; ++e) { const int h = 2 * h2 + e; const float br = b_re[(g * 64 + p) * 16 + h], bi = b_im[(g * 64 + p) * 16 + h]; const float bbr = d.zr * br - d.zi * bi, bbi = d.zr * bi + d.zi * br;
                re[e] = pr * bbr - pi * bbi; im[e] = pr * bbi + pi * bbr; }
            wr_[h2] = pk2(re[0], re[1]); wi_[h2] = pk2(im[0], im[1]); }
        wr0 = (u32x4){wr_[0], wr_[1], wr_[2], wr_[3]}; wr1 = (u32x4){wr_[4], wr_[5], wr_[6], wr_[7]}; wi0 = (u32x4){wi_[0], wi_[1], wi_[2], wi_[3]}; wi1 = (u32x4){wi_[4], wi_[5], wi_[6], wi_[7]};
        *(u32x4*)(W1 + (size_t)p * 256 + q * 16) = wr0; *(u32x4*)(W1 + (size_t)p * 256 + q * 16 + 8) = wr1;
        *(u32x4*)(W1 + (size_t)(64 + p) * 256 + q * 16) = wi0; *(u32x4*)(W1 + (size_t)(64 + p) * 256 + q * 16 + 8) = wi1;
        const u32x4 z = (u32x4){0u, 0u, 0u, 0u};
        *(u32x4*)(W1 + (size_t)(128 + p) * 256 + q * 16) = z; *(u32x4*)(W1 + (size_t)(128 + p) * 256 + q * 16 + 8) = z;
        *(u32x4*)(W1 + (size_t)(192 + p) * 256 + q * 16) = z; *(u32x4*)(W1 + (size_t)(192 + p) * 256 + q * 16 + 8) = z;
    } else {
        float pr, pi; s5_apow(d, (float)(q + 1), pr, pi);
#pragma unroll
        for (int hp = 0; hp < 16; ++hp) { const float cr = c_re[(g * 16 + hp) * 64 + p], ci = c_im[(g * 16 + hp) * 64 + p];
            W3[(size_t)(q * 16 + hp) * 384 + 256 + p] = f2bf(cr * pr - ci * pi);
            W3[(size_t)(q * 16 + hp) * 384 + 320 + p] = f2bf(-(cr * pi + ci * pr)); }
        if (q == 0) { float ar, ai; s5_apow(d, 16.0f, ar, ai); float* A16 = (float*)(ws + WS_S5A16) + (((size_t)l * 16 + g) * 64 + p) * 2; A16[0] = ar; A16[1] = ai; }
    }
}

__device__ __forceinline__ void s5_scan_wg(const float* S, const float* a16, bf16_t* A3, int b, int g, LAS float* sl) {
    int tid = threadIdx.x; asm volatile("" : "+v"(tid));
    const f32x4* src = (const f32x4*)(S + ((size_t)g * 2048 + b * 256) * 128);
#pragma unroll 1
    for (int i0 = tid; i0 < 8192; i0 += 8 * NWAVES * 64) { f32x4 w[8];
#pragma unroll
        for (int u = 0; u < 8; ++u) w[u] = src[i0 + u * NWAVES * 64];
#pragma unroll
        for (int u = 0; u < 8; ++u) *(LAS f32x4*)(sl + 4 * (i0 + u * NWAVES * 64)) = w[u]; }
    __syncthreads();
    if (tid < 64) {
        const int lane = tid; const float ar = a16[(g * 64 + lane) * 2], ai = a16[(g * 64 + lane) * 2 + 1];
        bf16_t* hp = A3 + ((size_t)g * 2048 + b * 256) * 384 + 256 + lane;
        float hr = 0.f, hi = 0.f;
#pragma unroll 8
        for (int c = 0; c < 256; ++c) { const float sr = sl[c * 128 + lane], si = sl[c * 128 + 64 + lane];
            hp[(size_t)c * 384] = f2bf(hr); hp[(size_t)c * 384 + 64] = f2bf(hi);
            const float nr = ar * hr - ai * hi + sr, ni = ar * hi + ai * hr + si; hr = nr; hi = ni; }
        asm volatile("s_waitcnt vmcnt(0)" ::: "memory");
        __builtin_amdgcn_fence(__ATOMIC_ACQUIRE, "agent");
        asm volatile("s_waitcnt vmcnt(0)" ::: "memory");
    }
    __syncthreads();
}

typedef float f32x16p __attribute__((ext_vector_type(16)));
__device__ __forceinline__ void pool_phase(const bf16_t* H, const float* wpool, const float* pscale, bf16_t* yb, int bx, int G, LAS unsigned char* lds) {
    int tid = threadIdx.x; asm volatile("" : "+v"(tid));
    const int lane = tid & 63, w8 = tid >> 6, g = w8 >> 1, tb = (w8 & 1) * 32, r = lane & 31, hi = lane >> 5;
    LAS bf16_t* ut = (LAS bf16_t*)lds; LAS bf16_t* mxb = (LAS bf16_t*)(lds + 79 * 512);
    bf16x8 wf[4][2]; float ps[2];
#pragma unroll
    for (int ks = 0; ks < 4; ++ks)
#pragma unroll
        for (int cb = 0; cb < 2; ++cb) { unsigned pk[4];
#pragma unroll
            for (int j2 = 0; j2 < 4; ++j2) { const float a = wpool[(g * 64 + 16 * ks + 8 * hi + 2 * j2) * 64 + 32 * cb + r], b = wpool[(g * 64 + 16 * ks + 8 * hi + 2 * j2 + 1) * 64 + 32 * cb + r]; pk[j2] = pk2(a, b); }
            wf[ks][cb] = __builtin_bit_cast(bf16x8, (u32x4){pk[0], pk[1], pk[2], pk[3]}); }
    ps[0] = pscale[g * 64 + r]; ps[1] = pscale[g * 64 + 32 + r];
    u32x4 wn[5];
#pragma unroll
    for (int u = 0; u < 5; ++u) { const int c = tid + u * NWAVES * 64; const int rr = c >> 5, ch8 = (c & 31) * 8; const int tok = bx * 64 - 15 + rr; wn[u] = (u32x4){0u, 0u, 0u, 0u}; if (bx < NTOK / 64 && c < 79 * 32 && tok >= 0) wn[u] = *(const GAS u32x4*)((const GAS bf16_t*)H + (size_t)tok * HP + HC_POOL + ch8); }
    for (int item = bx; item < NTOK / 64; item += G) {
        const int t0 = item * 64;
        {
#pragma unroll
          for (int u = 0; u < 5; ++u) { const int c = tid + u * NWAVES * 64; if (c < 79 * 32) *(LAS u32x4*)(ut + (c >> 5) * 256 + (c & 31) * 8) = wn[u]; }
          const int t1 = (item + G) * 64;
#pragma unroll
          for (int u = 0; u < 5; ++u) { const int c = tid + u * NWAVES * 64; const int rr = c >> 5, ch8 = (c & 31) * 8; const int tok = t1 - 15 + rr; wn[u] = (u32x4){0u, 0u, 0u, 0u}; if (item + G < NTOK / 64 && c < 79 * 32 && tok >= 0) wn[u] = *(const GAS u32x4*)((const GAS bf16_t*)H + (size_t)tok * HP + HC_POOL + ch8); } }
        __syncthreads();
        { const int ch = tid & 255, half = tid >> 8, gg = ch >> 6, w = 2 << gg, l0 = half * 32, tf = (t0 + l0) & (SEQ - 1);
          float s = 0.f;
          for (int k = 1; k < w; ++k) if (tf - k >= 0) s += bf2f(ut[(15 + l0 - k) * 256 + ch]);
#pragma unroll 4
          for (int q = 0; q < 32; ++q) { const int lt = l0 + q, t = tf + q; const float u = bf2f(ut[(15 + lt) * 256 + ch]);
              s += u; if (q > 0 && t >= w) s -= bf2f(ut[(15 + lt - w) * 256 + ch]);
              const int cnt = (t + 1 < w) ? t + 1 : w;
              mxb[lt * 264 + ch] = f2bf(s * __builtin_amdgcn_rcpf((float)cnt) - u); } }
        __syncthreads();
        f32x16p acc[2];
#pragma unroll
        for (int cb = 0; cb < 2; ++cb)
#pragma unroll
            for (int q = 0; q < 16; ++q) acc[cb][q] = 0.f;
#pragma unroll
        for (int ks = 0; ks < 4; ++ks) { const bf16x8 a = *(const LAS bf16x8*)(mxb + (tb + r) * 264 + g * 64 + 16 * ks + 8 * hi);
            acc[0] = __builtin_amdgcn_mfma_f32_32x32x16_bf16(a, wf[ks][0], acc[0], 0, 0, 0); acc[1] = __builtin_amdgcn_mfma_f32_32x32x16_bf16(a, wf[ks][1], acc[1], 0, 0, 0); }
#pragma unroll
        for (int cb = 0; cb < 2; ++cb)
#pragma unroll
            for (int q = 0; q < 16; ++q) { const int tok = t0 + tb + (q & 3) + 8 * (q >> 2) + 4 * hi; yb[(size_t)tok * 256 + g * 64 + 32 * cb + r] = f2bf(acc[cb][q] * ps[cb]); }
        __syncthreads();
    }
}

constexpr int WT_PITCH = 1028;
__device__ __forceinline__ void load_wt_lds(const float* W, int ldw, int ne, volatile LAS float* Tv) {
    int tid0 = threadIdx.x; asm volatile("" : "+v"(tid0));
    LAS float* T = (LAS float*)Tv; const int q = ne >> 2, tot = 1024 * q;
    for (int base = tid0; base < tot; base += 8 * NWAVES * 64) {
        f32x4 w[8];
#pragma unroll
        for (int u = 0; u < 8; ++u) { const int idx = base + u * NWAVES * 64; if (idx < tot) { const int k = idx / q, e4 = (idx - k * q) * 4; w[u] = *(const f32x4*)(W + (size_t)k * ldw + e4); } }
#pragma unroll
        for (int u = 0; u < 8; ++u) { const int idx = base + u * NWAVES * 64; if (idx < tot) { const int k = idx / q, e4 = (idx - k * q) * 4;
            T[(e4 + 0) * WT_PITCH + k] = w[u].x; T[(e4 + 1) * WT_PITCH + k] = w[u].y; T[(e4 + 2) * WT_PITCH + k] = w[u].z; T[(e4 + 3) * WT_PITCH + k] = w[u].w; } }
    }
    __syncthreads();
}
__device__ __forceinline__ void wave_sum2(float& a, float& b) {
#pragma unroll
    for (int o = 1; o < 64; o <<= 1) { const float ta = __shfl_xor(a, o), tb = __shfl_xor(b, o); a += ta; b += tb; } }
__device__ __forceinline__ void wave_max2(float a, float b, float& ra, float& rb) {
#pragma unroll
    for (int o = 32; o >= 1; o >>= 1) { const float ta = __shfl_xor(a, o), tb = __shfl_xor(b, o); a = fmaxf(a, ta); b = fmaxf(b, tb); }
    ra = a; rb = b; }
__device__ __forceinline__ void wave_min2(int a, int b, int& ra, int& rb) {
#pragma unroll
    for (int o = 32; o >= 1; o >>= 1) { const int ta = __shfl_xor(a, o), tb = __shfl_xor(b, o); a = ta < a ? ta : a; b = tb < b ? tb : b; }
    ra = a; rb = b; }
__device__ __forceinline__ void row_ln2(f32x4 (&v)[4], f32x4 (&w)[4], const float* g, const float* bta, int lane) {
    f32x4 gg[4], bb[4];
#pragma unroll
    for (int j = 0; j < 4; ++j) { gg[j] = *(const GAS f32x4*)((const GAS float*)g + 4 * (lane + 64 * j)); bb[j] = *(const GAS f32x4*)((const GAS float*)bta + 4 * (lane + 64 * j)); }
    float s = 0.f, t = 0.f;
#pragma unroll
    for (int j = 0; j < 4; ++j) { s += (v[j].x + v[j].y) + (v[j].z + v[j].w); t += (w[j].x + w[j].y) + (w[j].z + w[j].w); }
    wave_sum2(s, t); const float mv = s * (1.f / D), mw = t * (1.f / D); float s2 = 0.f, t2 = 0.f;
#pragma unroll
    for (int j = 0; j < 4; ++j) { v[j] = v[j] - mv; w[j] = w[j] - mw; s2 += (v[j].x * v[j].x + v[j].y * v[j].y) + (v[j].z * v[j].z + v[j].w * v[j].w); t2 += (w[j].x * w[j].x + w[j].y * w[j].y) + (w[j].z * w[j].z + w[j].w * w[j].w); }
    wave_sum2(s2, t2); const float rv = __builtin_amdgcn_rsqf(s2 * (1.f / D) + LN_EPS), rw = __builtin_amdgcn_rsqf(t2 * (1.f / D) + LN_EPS);
#pragma unroll
    for (int j = 0; j < 4; ++j) { v[j] = v[j] * rv * gg[j] + bb[j]; w[j] = w[j] * rw * gg[j] + bb[j]; }
}
__device__ __forceinline__ void row_ln2s(f32x4 (&v)[4], f32x4 (&w)[4], const float* g, const float* bta, int lane, float& mv, float& rv, float& mw, float& rw) {
    f32x4 gg[4], bb[4];
#pragma unroll
    for (int j = 0; j < 4; ++j) { gg[j] = *(const GAS f32x4*)((const GAS float*)g + 4 * (lane + 64 * j)); bb[j] = *(const GAS f32x4*)((const GAS float*)bta + 4 * (lane + 64 * j)); }
    float s = 0.f, t = 0.f;
#pragma unroll
    for (int j = 0; j < 4; ++j) { s += (v[j].x + v[j].y) + (v[j].z + v[j].w); t += (w[j].x + w[j].y) + (w[j].z + w[j].w); }
    wave_sum2(s, t); mv = s * (1.f / D); mw = t * (1.f / D); float s2 = 0.f, t2 = 0.f;
#pragma unroll
    for (int j = 0; j < 4; ++j) { v[j] = v[j] - mv; w[j] = w[j] - mw; s2 += (v[j].x * v[j].x + v[j].y * v[j].y) + (v[j].z * v[j].z + v[j].w * v[j].w); t2 += (w[j].x * w[j].x + w[j].y * w[j].y) + (w[j].z * w[j].z + w[j].w * w[j].w); }
    wave_sum2(s2, t2); rv = __builtin_amdgcn_rsqf(s2 * (1.f / D) + LN_EPS); rw = __builtin_amdgcn_rsqf(t2 * (1.f / D) + LN_EPS);
#pragma unroll
    for (int j = 0; j < 4; ++j) { v[j] = v[j] * rv * gg[j] + bb[j]; w[j] = w[j] * rw * gg[j] + bb[j]; }
}
template <int N> __device__ __forceinline__ void reduce_scatter2(float (&v)[N], float (&w)[N], int lane) {
    int s = 32;
#pragma unroll
    for (int n = N / 2; n >= 1; n >>= 1) {
        const bool up = (lane & s) != 0;
#pragma unroll
        for (int i = 0; i < n; ++i) { float hi = v[i + n], lo = v[i], hj = w[i + n], lj = w[i]; asm volatile("" : "+v"(hi), "+v"(lo), "+v"(hj), "+v"(lj));
            const float kv = up ? hi : lo, sv = up ? lo : hi, kw = up ? hj : lj, sw = up ? lj : hj; v[i] = kv + __shfl_xor(sv, s); w[i] = kw + __shfl_xor(sw, s); }
        s >>= 1;
    }
    for (; s >= 1; s >>= 1) { const float ta = __shfl_xor(v[0], s), tb = __shfl_xor(w[0], s); v[0] += ta; w[0] += tb; }
}
template <int NEX> __device__ __forceinline__ void row_dot2_lds(const f32x4 (&v0)[4], const f32x4 (&v1)[4], const LAS float* T, float (&a0)[NEX], float (&a1)[NEX], int lane) {
#pragma unroll
    for (int e = 0; e < NEX; ++e) { f32x2 p0 = (f32x2){0.f, 0.f}, p1 = (f32x2){0.f, 0.f};
#pragma unroll
        for (int j = 0; j < 4; ++j) { const f32x4 w = *(const LAS f32x4*)(T + e * WT_PITCH + 4 * (lane + 64 * j));
            p0 = __builtin_elementwise_fma((f32x2){v0[j].x, v0[j].y}, (f32x2){w.x, w.y}, p0); p0 = __builtin_elementwise_fma((f32x2){v0[j].z, v0[j].w}, (f32x2){w.z, w.w}, p0);
            p1 = __builtin_elementwise_fma((f32x2){v1[j].x, v1[j].y}, (f32x2){w.x, w.y}, p1); p1 = __builtin_elementwise_fma((f32x2){v1[j].z, v1[j].w}, (f32x2){w.z, w.w}, p1); }
        a0[e] = p0.x + p0.y; a1[e] = p1.x + p1.y;
        if ((e & 3) == 3) { asm volatile("" ::: "memory"); __builtin_amdgcn_sched_barrier(0); } }
}
__device__ __forceinline__ void row_logf_fin(float (&a)[8], const float* bf_l, float* logf, int m, int lane) {
    reduce_scatter<8>(a, lane);
    if ((lane & 7) == 0) { const int h = lane >> 3; const float z = a[0] + ((const GAS float*)bf_l)[h]; const float ls = fminf(z, 0.f) - 0.6931471805599453f * __builtin_amdgcn_logf(1.0f + __builtin_amdgcn_exp2f(-L2E * fabsf(z)));
        const int b = m / SEQ, t = m % SEQ; ((GAS float*)logf)[((size_t)b * 8 + h) * SEQ + t] = ls; }
}
__device__ __forceinline__ void rows0_phase(const float* x, const float* w_in0, const float* bf0, bf16_t* xb, float* logf, volatile LAS float* T, int gw, int NGW, int lane) {
    asm volatile("" : "+v"(lane));
    load_wt_lds(w_in0 + 1536, NIN, 8, T);
    f32x4 n0[4], n1[4];
    if (2 * gw < NTOK) {
#pragma unroll
        for (int j = 0; j < 4; ++j) { n0[j] = *(const GAS f32x4*)((const GAS float*)x + (size_t)(2 * gw) * D + 4 * (lane + 64 * j)); n1[j] = *(const GAS f32x4*)((const GAS float*)x + (size_t)(2 * gw + 1) * D + 4 * (lane + 64 * j)); } }
    for (int m = 2 * gw; m < NTOK; m += 2 * NGW) {
        f32x4 v0[4], v1[4];
#pragma unroll
        for (int j = 0; j < 4; ++j) { v0[j] = n0[j]; v1[j] = n1[j]; }
        { const int mn = m + 2 * NGW; if (mn < NTOK) {
#pragma unroll
            for (int j = 0; j < 4; ++j) { n0[j] = *(const GAS f32x4*)((const GAS float*)x + (size_t)mn * D + 4 * (lane + 64 * j)); n1[j] = *(const GAS f32x4*)((const GAS float*)x + (size_t)(mn + 1) * D + 4 * (lane + 64 * j)); } } }
        float a0[8], a1[8]; row_dot2_lds<8>(v0, v1, (const LAS float*)T, a0, a1, lane);
        row_store_bf16(v0, xb + (size_t)m * D, lane); row_logf_fin(a0, bf0, logf, m, lane);
        row_store_bf16(v1, xb + (size_t)(m + 1) * D, lane); row_logf_fin(a1, bf0, logf, m + 1, lane);
    }
    __syncthreads();
}
__device__ __forceinline__ void rows1_phase(const bf16_t* xinb, const bf16_t* mix, const float* g1, const float* b1, const float* wr, const float* br, bf16_t* x1b, unsigned* cnt, int* tok, int* re, int* rr, float* rg,
                                            volatile LAS float* T, volatile LAS unsigned* lcnt, volatile LAS unsigned* lbase, volatile LAS float* wscr_all, int bx, int G, int wave, int lane) {
    asm volatile("" : "+v"(lane));
    volatile LAS float* wscr = wscr_all + wave * 32;
    const int tid = wave * 64 + lane;
    if (tid < 32) lcnt[tid] = 0u;
    load_wt_lds(wr, 32, 32, T);
    for (int blk = bx; blk < NTOK / 128; blk += G) {
        const int row0 = blk * 128 + wave * 16;
        int my_e = 0; float my_g = 0.f;
#pragma unroll 1
        for (int i = 0; i < 16; i += 2) {
            const int m = row0 + i; f32x4 v0[4], v1[4];
#pragma unroll
            for (int j = 0; j < 4; ++j) { f32x4 xa, xb_; { const u32x2 wa = *(const u32x2*)(xinb + (size_t)m * D + 4 * (lane + 64 * j)), wb = *(const u32x2*)(xinb + (size_t)(m + 1) * D + 4 * (lane + 64 * j));
                    xa.x = __uint_as_float(wa.x << 16); xa.y = __uint_as_float(wa.x & 0xffff0000u); xa.z = __uint_as_float(wa.y << 16); xa.w = __uint_as_float(wa.y & 0xffff0000u); xb_.x = __uint_as_float(wb.x << 16); xb_.y = __uint_as_float(wb.x & 0xffff0000u); xb_.z = __uint_as_float(wb.y << 16); xb_.w = __uint_as_float(wb.y & 0xffff0000u); }
                const u32x2 ma = *(const u32x2*)(mix + (size_t)m * D + 4 * (lane + 64 * j)), mb = *(const u32x2*)(mix + (size_t)(m + 1) * D + 4 * (lane + 64 * j));
                v0[j].x = ALPHA * xa.x + __uint_as_float(ma.x << 16); v0[j].y = ALPHA * xa.y + __uint_as_float(ma.x & 0xffff0000u); v0[j].z = ALPHA * xa.z + __uint_as_float(ma.y << 16); v0[j].w = ALPHA * xa.w + __uint_as_float(ma.y & 0xffff0000u);
                v1[j].x = ALPHA * xb_.x + __uint_as_float(mb.x << 16); v1[j].y = ALPHA * xb_.y + __uint_as_float(mb.x & 0xffff0000u); v1[j].z = ALPHA * xb_.z + __uint_as_float(mb.y << 16); v1[j].w = ALPHA * xb_.w + __uint_as_float(mb.y & 0xffff0000u); }
            row_ln2(v0, v1, g1, b1, lane);
            row_store_bf16(v0, x1b + (size_t)m * D, lane); row_store_bf16(v1, x1b + (size_t)(m + 1) * D, lane);
            float a0[32], a1[32]; row_dot2_lds<32>(v0, v1, (const LAS float*)T, a0, a1, lane);
            reduce_scatter2<32>(a0, a1, lane);
            const int myexp = (lane >> 1) & 31; const float bre = br[myexp]; const float va = a0[0] + bre, vb = a1[0] + bre;
            int ra = 0, rb = 0;
#pragma unroll
            for (int k = 1; k < 32; ++k) { const int oe = (myexp + k) & 31; const float oa = __shfl(va, 2 * oe), ob = __shfl(vb, 2 * oe);
                ra += (oa > va || (oa == va && oe < myexp)) ? 1 : 0; rb += (ob > vb || (ob == vb && oe < myexp)) ? 1 : 0; }
            float ua[4], ub[4]; int ta[4], tb[4];
#pragma unroll
            for (int k = 0; k < 4; ++k) { const unsigned long long ma = __ballot(ra == k), mb = __ballot(rb == k); const int la = __ffsll((long long)ma) - 1, lb = __ffsll((long long)mb) - 1;
                ta[k] = la >> 1; tb[k] = lb >> 1; ua[k] = __shfl(va, la); ub[k] = __shfl(vb, lb); }
            { const float e1 = __builtin_amdgcn_exp2f(L2E * (ua[1] - ua[0])), e2 = __builtin_amdgcn_exp2f(L2E * (ua[2] - ua[0])), e3 = __builtin_amdgcn_exp2f(L2E * (ua[3] - ua[0])); const float inv = 1.0f / (1.0f + e1 + e2 + e3);
              if ((lane >> 2) == i) { const int k = lane & 3; my_e = k == 0 ? ta[0] : k == 1 ? ta[1] : k == 2 ? ta[2] : ta[3]; my_g = (k == 0 ? 1.0f : k == 1 ? e1 : k == 2 ? e2 : e3) * inv; } }
            { const float e1 = __builtin_amdgcn_exp2f(L2E * (ub[1] - ub[0])), e2 = __builtin_amdgcn_exp2f(L2E * (ub[2] - ub[0])), e3 = __builtin_amdgcn_exp2f(L2E * (ub[3] - ub[0])); const float inv = 1.0f / (1.0f + e1 + e2 + e3);
              if ((lane >> 2) == i + 1) { const int k = lane & 3; my_e = k == 0 ? tb[0] : k == 1 ? tb[1] : k == 2 ? tb[2] : tb[3]; my_g = (k == 0 ? 1.0f : k == 1 ? e1 : k == 2 ? e2 : e3) * inv; } }
        }
        const unsigned lrank = __hip_atomic_fetch_add((LAS unsigned*)lcnt + my_e, 1u, __ATOMIC_RELAXED, __HIP_MEMORY_SCOPE_WORKGROUP);
        __syncthreads();
        if (tid < 32) { const unsigned c = lcnt[tid]; lbase[tid] = c ? atomicAdd(cnt + tid * CNT_STRIDE, c) : 0u; }
        __syncthreads();
        { const unsigned rank = lbase[my_e] + lrank; const int m = row0 + (lane >> 2);
          tok[(size_t)my_e * NTOK + rank] = m; re[(size_t)row0 * 4 + lane] = my_e; rr[(size_t)row0 * 4 + lane] = (int)rank; rg[(size_t)row0 * 4 + lane] = my_g; }
        __syncthreads();
        if (tid < 32) lcnt[tid] = 0u;
        __syncthreads();
    }
}
constexpr size_t WS_WRT = 79 * MiB;
constexpr int PW1 = 1032;
__device__ __forceinline__ void router_prep_item(const float* g1, const float* b1, const float* wr, const float* br, unsigned char* ws, int l, int e, int lane) {
    bf16_t* WT = (bf16_t*)(ws + WS_WRT) + (size_t)l * 64 * PW1; float* GB = (float*)(ws + WS_WRT + 768 * 1024) + l * 64;
    float sg = 0.f, sb = 0.f;
#pragma unroll
    for (int j = 0; j < 16; ++j) { const int k = lane + 64 * j; const float w0 = wr[(size_t)l * 1024 * 32 + k * 32 + e], gk = g1[l * 1024 + k], bk = b1[l * 1024 + k]; const float w = w0 * gk;
        const bf16_t hi = f2bf(w); WT[e * PW1 + k] = hi; WT[(32 + e) * PW1 + k] = f2bf(w - bf2f(hi)); sg += w; sb += bk * w0; }
    sg = wave_sum(sg); sb = wave_sum(sb);
    if (lane == 0) { GB[e] = sg; GB[32 + e] = sb + br[l * 32 + e]; }
}
__device__ __forceinline__ void rows1m_phase(const bf16_t* xinb, const bf16_t* mix, const float* g1, const float* b1, const bf16_t* wtg, const float* gbg, bf16_t* x1b, unsigned* cnt, int* tok, int* re, int* rr, float* rg,
                                             LAS unsigned char* ring, volatile LAS unsigned* lcnt, volatile LAS unsigned* lbase, volatile LAS float* gb  , int bx, int G, int wave, int lane) {
    asm volatile("" : "+v"(lane));
    const int tid = wave * 64 + lane;
    LAS bf16_t* WT = (LAS bf16_t*)ring;
    if (tid < 32) lcnt[tid] = 0u;
    { const GAS u32x4* src = (const GAS u32x4*)wtg; constexpr int NV = 64 * PW1 * 2 / 16;
#pragma unroll 1
      for (int i0 = tid; i0 < NV; i0 += 9 * NWAVES * 64) { u32x4 w[9];
#pragma unroll
          for (int u = 0; u < 9; ++u) { const int i = i0 + u * NWAVES * 64; if (i < NV) w[u] = src[i]; }
#pragma unroll
          for (int u = 0; u < 9; ++u) { const int i = i0 + u * NWAVES * 64; if (i < NV) *(LAS u32x4*)(ring + 16 * i) = w[u]; } }
      if (tid < 64) gb[tid] = ((const GAS float*)gbg)[tid]; }
    __syncthreads();
    const int rrow = lane & 15, grp = lane >> 4;
    for (int blk = bx; blk < NTOK / 128; blk += G) {
        const int row0 = blk * 128 + wave * 16;
        float mu_l = 0.f, rs_l = 0.f;
        u32x2 nxa[4], nxb[4], nma[4], nmb[4];
#pragma unroll
        for (int j = 0; j < 4; ++j) { nxa[j] = *(const GAS u32x2*)((const GAS bf16_t*)xinb + (size_t)row0 * D + 4 * (lane + 64 * j)); nxb[j] = *(const GAS u32x2*)((const GAS bf16_t*)xinb + (size_t)(row0 + 1) * D + 4 * (lane + 64 * j));
                                      nma[j] = *(const GAS u32x2*)((const GAS bf16_t*)mix + (size_t)row0 * D + 4 * (lane + 64 * j)); nmb[j] = *(const GAS u32x2*)((const GAS bf16_t*)mix + (size_t)(row0 + 1) * D + 4 * (lane + 64 * j)); }
#pragma unroll 1
        for (int i = 0; i < 16; i += 2) {
            const int m = row0 + i; f32x4 v0[4], v1[4];
            u32x2 cxa[4], cxb[4], cma[4], cmb[4];
#pragma unroll
            for (int j = 0; j < 4; ++j) { cxa[j] = nxa[j]; cxb[j] = nxb[j]; cma[j] = nma[j]; cmb[j] = nmb[j]; }
            if (i + 2 < 16) {
#pragma unroll
                for (int j = 0; j < 4; ++j) { nxa[j] = *(const GAS u32x2*)((const GAS bf16_t*)xinb + (size_t)(m + 2) * D + 4 * (lane + 64 * j)); nxb[j] = *(const GAS u32x2*)((const GAS bf16_t*)xinb + (size_t)(m + 3) * D + 4 * (lane + 64 * j));
                                              nma[j] = *(const GAS u32x2*)((const GAS bf16_t*)mix + (size_t)(m + 2) * D + 4 * (lane + 64 * j)); nmb[j] = *(const GAS u32x2*)((const GAS bf16_t*)mix + (size_t)(m + 3) * D + 4 * (lane + 64 * j)); }
            }
#pragma unroll
            for (int j = 0; j < 4; ++j) { f32x4 xa, xb_; { const u32x2 wa = cxa[j], wb = cxb[j];
                    xa.x = __uint_as_float(wa.x << 16); xa.y = __uint_as_float(wa.x & 0xffff0000u); xa.z = __uint_as_float(wa.y << 16); xa.w = __uint_as_float(wa.y & 0xffff0000u); xb_.x = __uint_as_float(wb.x << 16); xb_.y = __uint_as_float(wb.x & 0xffff0000u); xb_.z = __uint_as_float(wb.y << 16); xb_.w = __uint_as_float(wb.y & 0xffff0000u); }
                const u32x2 ma = cma[j], mb = cmb[j];
                v0[j].x = ALPHA * xa.x + __uint_as_float(ma.x << 16); v0[j].y = ALPHA * xa.y + __uint_as_float(ma.x & 0xffff0000u); v0[j].z = ALPHA * xa.z + __uint_as_float(ma.y << 16); v0[j].w = ALPHA * xa.w + __uint_as_float(ma.y & 0xffff0000u);
                v1[j].x = ALPHA * xb_.x + __uint_as_float(mb.x << 16); v1[j].y = ALPHA * xb_.y + __uint_as_float(mb.x & 0xffff0000u); v1[j].z = ALPHA * xb_.z + __uint_as_float(mb.y << 16); v1[j].w = ALPHA * xb_.w + __uint_as_float(mb.y & 0xffff0000u); }
            float ma_, ra_, mb_, rb_; row_ln2s(v0, v1, g1, b1, lane, ma_, ra_, mb_, rb_);
            row_store_bf16(v0, x1b + (size_t)m * D, lane); row_store_bf16(v1, x1b + (size_t)(m + 1) * D, lane);
            if (rrow == i) { mu_l = ma_; rs_l = ra_; } if (rrow == i + 1) { mu_l = mb_; rs_l = rb_; }
        }
        f32x4 ax[4], am[4];
#pragma unroll
        for (int t = 0; t < 4; ++t) { ax[t] = (f32x4){0.f, 0.f, 0.f, 0.f}; am[t] = (f32x4){0.f, 0.f, 0.f, 0.f}; }
        { const GAS bf16_t* xp = (const GAS bf16_t*)xinb + (size_t)(row0 + rrow) * D + 8 * grp; const GAS bf16_t* mp = (const GAS bf16_t*)mix + (size_t)(row0 + rrow) * D + 8 * grp; const LAS bf16_t* wp = WT + rrow * PW1 + 8 * grp;
#pragma unroll 8
          for (int ks = 0; ks < 32; ++ks) { const bf16x8 fx = *(const GAS bf16x8*)(xp + 32 * ks), fm = *(const GAS bf16x8*)(mp + 32 * ks);
#pragma unroll
              for (int t = 0; t < 4; ++t) { const bf16x8 fw = *(const LAS bf16x8*)(wp + 16 * t * PW1 + 32 * ks);
                  ax[t] = __builtin_amdgcn_mfma_f32_16x16x32_bf16(fw, fx, ax[t], 0, 0, 0); am[t] = __builtin_amdgcn_mfma_f32_16x16x32_bf16(fw, fm, am[t], 0, 0, 0); } } }
        float v[8]; int ev[8];
#pragma unroll
        for (int t = 0; t < 2; ++t)
#pragma unroll
            for (int r = 0; r < 4; ++r) { const int e = 16 * t + 4 * grp + r; const float P = ALPHA * (ax[t][r] + ax[t + 2][r]) + (am[t][r] + am[t + 2][r]);
                v[4 * t + r] = rs_l * (P - mu_l * gb[e]) + gb[32 + e]; ev[4 * t + r] = e; }
        int kk[8], rk[8];
#pragma unroll
        for (int a = 0; a < 8; ++a) { const int bits = (int)__float_as_uint(v[a]); const int mono = bits ^ ((bits >> 31) & 0x7fffffff); kk[a] = (mono & ~31) | (31 - ev[a]); rk[a] = 0; }
#pragma unroll
        for (int a = 0; a < 8; ++a)
#pragma unroll
            for (int b = 0; b < 8; ++b) if (b != a) rk[a] += (kk[b] > kk[a]) ? 1 : 0;
#pragma unroll
        for (int sg = 1; sg < 4; ++sg) {
#pragma unroll
            for (int b = 0; b < 8; ++b) { const int o = __shfl_xor(kk[b], 16 * sg);
#pragma unroll
                for (int a = 0; a < 8; ++a) rk[a] += (o > kk[a]) ? 1 : 0; } }
        float u[4]; int tsel[4];
#pragma unroll
        for (int k = 0; k < 4; ++k) { unsigned se = 0u, sv = 0u;
#pragma unroll
            for (int a = 0; a < 8; ++a) { const bool hit = rk[a] == k; se |= hit ? (unsigned)(ev[a] + 1) : 0u; sv |= hit ? __float_as_uint(v[a]) : 0u; }
            se |= (unsigned)__shfl_xor((int)se, 16); sv |= (unsigned)__shfl_xor((int)sv, 16); se |= (unsigned)__shfl_xor((int)se, 32); sv |= (unsigned)__shfl_xor((int)sv, 32);
            tsel[k] = (int)se - 1; u[k] = __uint_as_float(sv); }
        const float e1 = __builtin_amdgcn_exp2f(L2E * (u[1] - u[0])), e2 = __builtin_amdgcn_exp2f(L2E * (u[2] - u[0])), e3 = __builtin_amdgcn_exp2f(L2E * (u[3] - u[0])); const float inv = 1.0f / (1.0f + e1 + e2 + e3);
        const int my_e = grp == 0 ? tsel[0] : grp == 1 ? tsel[1] : grp == 2 ? tsel[2] : tsel[3]; const float my_g = (grp == 0 ? 1.0f : grp == 1 ? e1 : grp == 2 ? e2 : e3) * inv;
        const unsigned lrank = __hip_atomic_fetch_add((LAS unsigned*)lcnt + my_e, 1u, __ATOMIC_RELAXED, __HIP_MEMORY_SCOPE_WORKGROUP);
        __syncthreads();
        if (tid < 32) { const unsigned c = lcnt[tid]; lbase[tid] = c ? atomicAdd(cnt + tid * CNT_STRIDE, c) : 0u; }
        __syncthreads();
        { const unsigned rank = lbase[my_e] + lrank; const int m = row0 + rrow;
          tok[(size_t)my_e * NTOK + rank] = m; re[(size_t)m * 4 + grp] = my_e; rr[(size_t)m * 4 + grp] = (int)rank; rg[(size_t)m * 4 + grp] = my_g; }
        __syncthreads();
        if (tid < 32) lcnt[tid] = 0u;
        __syncthreads();
    }
}
__device__ __forceinline__ void rows2_phase(const bf16_t* x1b, const unsigned char* ym, const unsigned* cnt, const int* re, const int* rr, const float* rg, const float* g2, const float* b2,
                                            float* xout, bf16_t* xb, const float* w_in_next, const float* bf_next, float* logf, volatile LAS float* T, int gw, int NGW, int lane) {
    asm volatile("" : "+v"(lane));
    int pc = lane < 32 ? (int)((((const GAS unsigned*)cnt)[(lane & 31) * CNT_STRIDE] + 255u) & ~255u) : 0; int inc = pc;
#pragma unroll
    for (int o = 1; o < 32; o <<= 1) { const int t = __shfl_up(inc, o); if (lane >= o) inc += t; }
    const int poff = inc - pc;
    typedef int i32x4 __attribute__((ext_vector_type(4)));
    u32x2 nxa[4], nxb[4]; i32x4 ne0, nr0, ne1, nr1; f32x4 ng0, ng1;
#define R2_FETCH(M) do { _Pragma("unroll") for (int j = 0; j < 4; ++j) { nxa[j] = *(const GAS u32x2*)((const GAS bf16_t*)x1b + (size_t)(M) * D + 4 * (lane + 64 * j)); nxb[j] = *(const GAS u32x2*)((const GAS bf16_t*)x1b + (size_t)((M) + 1) * D + 4 * (lane + 64 * j)); } \
        ne0 = *(const GAS i32x4*)((const GAS int*)re + (size_t)(M) * 4); nr0 = *(const GAS i32x4*)((const GAS int*)rr + (size_t)(M) * 4); ng0 = *(const GAS f32x4*)((const GAS float*)rg + (size_t)(M) * 4); \
        ne1 = *(const GAS i32x4*)((const GAS int*)re + (size_t)((M) + 1) * 4); nr1 = *(const GAS i32x4*)((const GAS int*)rr + (size_t)((M) + 1) * 4); ng1 = *(const GAS f32x4*)((const GAS float*)rg + (size_t)((M) + 1) * 4); } while (0)
    if (2 * gw < NTOK) R2_FETCH(2 * gw);
    if (w_in_next) load_wt_lds(w_in_next + 1536, NIN, 8, T);
    for (int m = 2 * gw; m < NTOK; m += 2 * NGW) {
        f32x4 v0[4], v1[4]; const i32x4 e0 = ne0, r0 = nr0, e1 = ne1, r1 = nr1; const f32x4 g0 = ng0, g1 = ng1;
#pragma unroll
        for (int j = 0; j < 4; ++j) { const u32x2 wa = nxa[j], wb = nxb[j];
            v0[j].x = ALPHA * __uint_as_float(wa.x << 16); v0[j].y = ALPHA * __uint_as_float(wa.x & 0xffff0000u); v0[j].z = ALPHA * __uint_as_float(wa.y << 16); v0[j].w = ALPHA * __uint_as_float(wa.y & 0xffff0000u);
            v1[j].x = ALPHA * __uint_as_float(wb.x << 16); v1[j].y = ALPHA * __uint_as_float(wb.x & 0xffff0000u); v1[j].z = ALPHA * __uint_as_float(wb.y << 16); v1[j].w = ALPHA * __uint_as_float(wb.y & 0xffff0000u); }
        unsigned y0[4][4], y1[4][4];
#pragma unroll
        for (int k = 0; k < 4; ++k) { const int ra = __shfl(poff, e0[k]) + r0[k], rb = __shfl(poff, e1[k]) + r1[k]; const GAS unsigned char* ya = (const GAS unsigned char*)ym + (size_t)ra * 1024; const GAS unsigned char* yb_ = (const GAS unsigned char*)ym + (size_t)rb * 1024;
#pragma unroll
            for (int j = 0; j < 4; ++j) { y0[k][j] = *(const GAS unsigned*)(ya + 4 * (lane + 64 * j)); y1[k][j] = *(const GAS unsigned*)(yb_ + 4 * (lane + 64 * j)); } }
        { const int mn = m + 2 * NGW; if (mn < NTOK) R2_FETCH(mn); }
#pragma unroll
        for (int k = 0; k < 4; ++k)
#pragma unroll
            for (int j = 0; j < 4; ++j) { const int w = (int)y0[k][j], x = (int)y1[k][j]; const f32x2 ga = (f32x2){g0[k], g0[k]}, gb = (f32x2){g1[k], g1[k]};
                const f32x2 a01 = __builtin_elementwise_fma(__builtin_amdgcn_cvt_pk_f32_fp8(w, false), ga, (f32x2){v0[j].x, v0[j].y}), a23 = __builtin_elementwise_fma(__builtin_amdgcn_cvt_pk_f32_fp8(w, true), ga, (f32x2){v0[j].z, v0[j].w});
                const f32x2 b01 = __builtin_elementwise_fma(__builtin_amdgcn_cvt_pk_f32_fp8(x, false), gb, (f32x2){v1[j].x, v1[j].y}), b23 = __builtin_elementwise_fma(__builtin_amdgcn_cvt_pk_f32_fp8(x, true), gb, (f32x2){v1[j].z, v1[j].w});
                v0[j] = (f32x4){a01.x, a01.y, a23.x, a23.y}; v1[j] = (f32x4){b01.x, b01.y, b23.x, b23.y}; }
        row_ln2(v0, v1, g2, b2, lane);
        if (xout) { _Pragma("unroll") for (int j = 0; j < 4; ++j) { *(GAS f32x4*)((GAS float*)xout + (size_t)m * D + 4 * (lane + 64 * j)) = v0[j]; *(GAS f32x4*)((GAS float*)xout + (size_t)(m + 1) * D + 4 * (lane + 64 * j)) = v1[j]; } }
        if (w_in_next) { float a0[8], a1[8]; row_dot2_lds<8>(v0, v1, (const LAS float*)T, a0, a1, lane);
            row_store_bf16(v0, xb + (size_t)m * D, lane); row_logf_fin(a0, bf_next, logf, m, lane);
            row_store_bf16(v1, xb + (size_t)(m + 1) * D, lane); row_logf_fin(a1, bf_next, logf, m + 1, lane); }
    }
#undef R2_FETCH
    __syncthreads();
}
__device__ __forceinline__ void cumsum_block(const float* logf, float* cum, int bh, volatile LAS float* scr) {
    int tid = threadIdx.x; asm volatile("" : "+v"(tid)); const int lane = tid & 63, wv = tid >> 6;
    const float* src = logf + (size_t)bh * SEQ + tid * 8; float* dst = cum + (size_t)bh * SEQ + tid * 8;
    const f32x4 a = *(const f32x4*)src, b = *(const f32x4*)(src + 4);
    float v[8]; v[0] = a.x; v[1] = v[0] + a.y; v[2] = v[1] + a.z; v[3] = v[2] + a.w; v[4] = v[3] + b.x; v[5] = v[4] + b.y; v[6] = v[5] + b.z; v[7] = v[6] + b.w;
    const float s = v[7]; float inc = s;
#pragma unroll
    for (int o = 1; o < 64; o <<= 1) { const float t = __shfl_up(inc, o); if (lane >= o) inc += t; }
    if (lane == 63) scr[wv] = inc;
    __syncthreads();
    float base = inc - s;
    for (int i = 0; i < wv; ++i) base += scr[i];
    f32x4 o0, o1; o0.x = v[0] + base; o0.y = v[1] + base; o0.z = v[2] + base; o0.w = v[3] + base; o1.x = v[4] + base; o1.y = v[5] + base; o1.z = v[6] + base; o1.w = v[7] + base;
    *(f32x4*)dst = o0; *(f32x4*)(dst + 4) = o1;
    __syncthreads();
}

struct S5Order { const char* A; const char* B; size_t bstep; int G, c, ldb, nt;
    __device__ __forceinline__ bool next(int i, pg8::Unit& u) const {
        const int L = i * G + c; if (L >= 128) return false;
        const int g = L >> 3, pm = L & 7;
        u.A = A + ((size_t)g * 2048 + pm * 256) * 384 * 2; u.B = B + (size_t)g * bstep; u.e = g; u.pm = pm; u.pn = 0; u.valid = 256; u.lt = 0; u.lda = 384; u.ldb = ldb; u.nt = nt; u.seg = 0; return true; }
};
struct BranchOrder { pg8::StaticOrder T; const char *A0, *A1, *A2, *B0, *B1, *B2;
    __device__ __forceinline__ bool next(int i, pg8::Unit& u) const {
        const int ti = i / 3, seg = i - 3 * ti;
        if (!T.next(ti, u)) return false;
        u.seg = seg; u.lda = seg == 0 ? HP : 256; u.ldb = seg == 0 ? 512 : 256; u.nt = seg == 0 ? 8 : 4;
        const char *a0 = A0, *a1 = A1, *a2 = A2, *b0 = B0, *b1 = B1, *b2 = B2; asm volatile("" : "+s"(a0), "+s"(a1), "+s"(a2), "+s"(b0), "+s"(b1), "+s"(b2));
        u.A = (seg == 0 ? a0 : seg == 1 ? a1 : a2) + (size_t)u.pm * 256 * u.lda * 2; u.B = (seg == 0 ? b0 : seg == 1 ? b1 : b2) + (size_t)u.pn * 256 * u.ldb * 2; return true; }
};
namespace pg8 {
struct EpiS1 { float* S;
    static constexpr bool AFTER_DRAIN = false; __device__ __forceinline__ void pre(const Unit&, int, int, int, int) const {} __device__ __forceinline__ bool keep_acc(const Unit&) const { return false; }
    __device__ __forceinline__ void operator()(const Acc& acc, const Unit& u, int wr, int wc, int fr, int fq) const {
        const unsigned vo = (unsigned)(fr * 128 + 8 * fq) * 4u;
#pragma unroll
        for (int ai = 0; ai < 2; ++ai)
#pragma unroll
            for (int m = 0; m < 4; ++m) { float* ub = S + ((size_t)u.e * 2048 + u.pm * 256 + ai * 128 + wr * 64 + m * 16) * 128 + wc * 32;
                *(f32x4*)((char*)ub + vo) = acc[ai][0][m][0]; *(f32x4*)((char*)ub + vo + 16) = acc[ai][0][m][1]; }
    }
};
struct EpiS3 { bf16_t* ycp;
    static constexpr bool AFTER_DRAIN = false; __device__ __forceinline__ void pre(const Unit&, int, int, int, int) const {} __device__ __forceinline__ bool keep_acc(const Unit&) const { return false; }
    __device__ __forceinline__ void operator()(const Acc& acc, const Unit& u, int wr, int wc, int fr, int fq) const {
        const unsigned vo = (unsigned)((fr * 16 + (fq >> 1)) * 256 + (fq & 1) * 8) * 2u;
#pragma unroll
        for (int ai = 0; ai < 2; ++ai)
#pragma unroll
            for (int m = 0; m < 4; ++m)
#pragma unroll
                for (int bj = 0; bj < 2; ++bj) { f32x4 v[2] = {acc[ai][bj][m][0], acc[ai][bj][m][1]};
#pragma unroll
                    for (int n = 0; n < 2; ++n)
#pragma unroll
                        for (int i = 0; i < 4; ++i) { const float y = v[n][i]; v[n][i] = y * fsig(1.5957691216057308f * (y + 0.044715f * y * y * y)); }
                    st16(ycp + ((size_t)(u.pm * 256 + ai * 128 + wr * 64 + m * 16) * 16 + bj * 8 + wc * 2) * 256 + u.e * 16, vo, pack8(v[0], v[1])); }
    }
};
}

struct OneUnit { const char* A; const char* B; int pm, lda, ldb, nt;
    __device__ __forceinline__ bool next(int i, pg8::Unit& u) const {
        if (i) return false;
        u.A = A + (size_t)pm * 256 * lda * 2; u.B = B; u.e = 0; u.pm = pm; u.pn = 0; u.valid = 256; u.lt = 0; u.lda = lda; u.ldb = ldb; u.nt = nt; u.seg = 0; return true; }
};
__device__ __forceinline__ void wg_mem_sync() {
    asm volatile("s_waitcnt vmcnt(0)" ::: "memory");
    __syncthreads();
    if (threadIdx.x == 0) { __builtin_amdgcn_fence(__ATOMIC_ACQUIRE, "agent"); asm volatile("s_waitcnt vmcnt(0)" ::: "memory"); }
    __syncthreads();
}
__device__ __forceinline__ void count_in_and_wait(unsigned* ctr, unsigned n, unsigned* bar) {
    asm volatile("s_waitcnt vmcnt(0)" ::: "memory");
    __syncthreads();
    if (threadIdx.x == 0) {
        __builtin_amdgcn_fence(__ATOMIC_RELEASE, "agent");
        asm volatile("s_waitcnt vmcnt(0)" ::: "memory");
        (void)xb_add(ctr, 1u);
        XB_SPIN(xb_ld(ctr) < n, bar);
        __builtin_amdgcn_fence(__ATOMIC_ACQUIRE, "agent");
        asm volatile("s_waitcnt vmcnt(0)" ::: "memory");
    }
    __syncthreads();
}

#ifndef STEP_MASK
#define STEP_MASK 0x1fff
#endif
struct Args {
    const float* in[29]; float* out; unsigned char* ws;
    int step_lo, step_hi;
    int bar_region, pad;
};
constexpr int STEPS_PER_LAYER = 12, N_STEPS = 1 + NL * STEPS_PER_LAYER;

__global__ void __launch_bounds__(NWAVES * 64, 2) mk_fwd(Args a) {
    extern __shared__ __attribute__((aligned(16))) unsigned char lds_raw[];
    LAS unsigned char* lds0 = (LAS unsigned char*)lds_raw;
    LAS unsigned char* lds = lds0 + RING_OFF;
    volatile LAS unsigned* MISC = (volatile LAS unsigned*)lds0;
    const int tid = threadIdx.x, lane = tid & 63, wave = __builtin_amdgcn_readfirstlane(tid >> 6);
    const int G = gridDim.x;
    const int gw = (int)blockIdx.x * NWAVES + wave, NGW = G * NWAVES;
    unsigned char* ws = a.ws;
    for (int u = tid; u < LDSCTL_BYTES / 4; u += NWAVES * 64) ((LAS unsigned*)lds0)[u] = 0u;
    __syncthreads();
    XcdBarrier bar = xcd_barrier_post((unsigned*)(ws + WS_CTL) + CW_BAR + a.bar_region * XCD_BAR_WORDS, MISC + 8);
    const int lo = a.step_lo, hi = a.step_hi;
#define IN(k) (lo <= (k) && (k) < hi)
#define SEAM(k) do { if (IN(k) && IN((k) + 1)) xcd_barrier(bar); } while (0)
#define BX() ({ int b_ = (int)blockIdx.x; asm volatile("" : "+s"(b_)); b_; })
#define GWL() (BX() * NWAVES + wave)
#define WSP(T, off) ({ unsigned char* w_ = ws; asm volatile("" : "+s"(w_)); (T*)(__attribute__((address_space(1))) T*)(w_ + (off)); })
#define ARG_IN(i) ({ const __attribute__((address_space(4))) char* k_ = (const __attribute__((address_space(4))) char*)__builtin_amdgcn_kernarg_segment_ptr(); asm volatile("" : "+s"(k_)); (const float*)(const __attribute__((address_space(1))) float*)*(const float* const __attribute__((address_space(4)))*)(k_ + 8 * (i)); })

    if (IN(0) && (STEP_MASK & 1)) {
        PrepArgs pa; pa.w_in = ARG_IN(1); pa.w_ba = ARG_IN(15); pa.w_bb = ARG_IN(16); pa.w_bc = ARG_IN(17); pa.w_out = ARG_IN(18); pa.w_glu = ARG_IN(13); pa.w_up = ARG_IN(23); pa.w_dn = ARG_IN(25); pa.ws = ws;
        prep_items(pa, (float*)(lds_raw + RING_OFF + wave * 16640), (long)gw, (long)NGW, lane);
        S5In si; si.lam_re = ARG_IN(5); si.lam_im = ARG_IN(6); si.log_dt = ARG_IN(7); si.b_re = ARG_IN(8); si.b_im = ARG_IN(9); si.c_re = ARG_IN(10); si.c_im = ARG_IN(11); si.dsk = ARG_IN(12);
        for (int it = gw; it < NL * 16 * 48; it += NGW) { const int lg = it / 48, r = it % 48; s5_prep_item(si, ws, lg >> 4, lg & 15, r >> 4, r & 15, lane); }
        for (int it = gw; it < NL * 32; it += NGW) router_prep_item(ARG_IN(19), ARG_IN(20), ARG_IN(21), ARG_IN(22), ws, it >> 5, it & 31, lane);
        __syncthreads();
        rows0_phase(ARG_IN(0), ARG_IN(1), ARG_IN(2), WSP(bf16_t, WS_XB), WSP(float, WS_LOGF), (volatile LAS float*)lds, gw, NGW, lane);
    }
    SEAM(0);

    for (int l = 0; l < NL; ++l) {
        const int s0 = 1 + STEPS_PER_LAYER * l;
        unsigned* cnt = (unsigned*)(ws + WS_CTL) + CW_CNT + NE * CNT_STRIDE * l;
        if (IN(s0 + 0) && (STEP_MASK & (2 << 0))) {
            if (BX() < 64) cumsum_block(WSP(float, WS_LOGF), WSP(float, WS_CUM), BX(), (volatile LAS float*)lds);
            bf16_t* H = WSP(bf16_t, WS_H); bf16_t* A3 = WSP(bf16_t, WS_A3);
            pg8::StaticOrder S; S.init(WSP(bf16_t, WS_XB), 1024, WSP(bf16_t, WS_WIN) + (size_t)l * 5120 * 1024, 1024, 1024, NTOK, 5120, G, BX());
            pg8::EpiIn E{H, A3, WSP(unsigned char, WS_GQ)};
            pg8::gemm_phase<false>(lds, S, E);
        }
        SEAM(s0 + 0);
        if (IN(s0 + 1) && (STEP_MASK & (2 << 1))) {
            if (BX() < 128) {
                const int c = BX();
                { S5Order S{(const char*)WSP(bf16_t, WS_A3), (const char*)(WSP(bf16_t, WS_S5W1) + (size_t)l * 16 * 256 * 256), (size_t)256 * 256 * 2, G, c, 256, 4};
                  pg8::EpiS1 E{WSP(float, WS_S5S)};
                  pg8::gemm_phase<false>(lds, S, E); }
                wg_mem_sync();
                s5_scan_wg(WSP(float, WS_S5S), WSP(float, WS_S5A16) + (size_t)l * 16 * 64 * 2, WSP(bf16_t, WS_A3), c & 7, c >> 3, (LAS float*)lds);
                { S5Order S{(const char*)WSP(bf16_t, WS_A3), (const char*)(WSP(bf16_t, WS_S5W3) + (size_t)l * 16 * 256 * 384), (size_t)256 * 384 * 2, G, c, 384, 6};
                  pg8::EpiS3 E{WSP(bf16_t, WS_YCP)};
                  pg8::gemm_phase<false>(lds, S, E); }
                count_in_and_wait((unsigned*)(ws + WS_CTL) + CW_S5C + (l * 8 + (c & 7)) * 32, 16u, bar.bar);
                { bf16_t* YCP = WSP(bf16_t, WS_YCP); bf16_t* YC = WSP(bf16_t, WS_YC);
                  OneUnit S{(const char*)YCP, (const char*)(WSP(bf16_t, WS_WGLU) + (size_t)l * 65536), (c & 7) * 16 + (c >> 3), 256, 256, 4};
                  pg8::EpiGlu E{YCP, ARG_IN(14) + (size_t)l * 256, YC};
                  pg8::gemm_phase<false>(lds, S, E); }
                __syncthreads();
            }
            {
                bf16_t* H = WSP(bf16_t, WS_H); const float* CUM = WSP(float, WS_CUM);
                const attn_body::AttnTensors AT{(const attn_body::bf16*)(H + HC_Q), (const attn_body::bf16*)(H + HC_K), (const attn_body::bf16*)(H + HC_V), (attn_body::bf16*)WSP(bf16_t, WS_OB), CUM};
                const int vcu = (G % 8 == 0) ? (BX() % 8) * (G / 8) + BX() / 8 : BX(); const int batch = (vcu * 8 / G) & 7;
                attn_body::QueueOrder S{(unsigned*)(ws + WS_CTL) + CW_ATTQ + a.pad * 1024 + (l * 8 + batch) * 32, (volatile LAS int*)(MISC + 60)};
                attn_body::AttnTensors ATb = AT; ATb.Q += (size_t)batch * SEQ * HP; ATb.K += (size_t)batch * SEQ * HP; ATb.V += (size_t)batch * SEQ * HP; ATb.O += (size_t)batch * SEQ * HP; ATb.cum += (size_t)batch * 8 * SEQ;
                attn_body::attn_phase<attn_body::QueueOrder>((char*)lds_raw + RING_OFF, ATb, S);
            }
            __syncthreads();
            {
                const bf16_t* H = WSP(bf16_t, WS_H); const float* wpool = ARG_IN(3) + (size_t)l * 4 * 64 * 64; const float* pscale = ARG_IN(4) + (size_t)l * 256; bf16_t* YB = WSP(bf16_t, WS_YB);
                pool_phase(H, wpool, pscale, YB, BX(), G, lds);
            }
        }
        SEAM(s0 + 5);
        if (IN(s0 + 6) && (STEP_MASK & (2 << 6))) {
            bf16_t* H = WSP(bf16_t, WS_H); bf16_t* MERGED = WSP(bf16_t, WS_MERGED); bf16_t* YB = WSP(bf16_t, WS_YB); bf16_t* YC = WSP(bf16_t, WS_YC);
            BranchOrder S; S.T.init(nullptr, 0, nullptr, 0, 128, NTOK, 1024, G, BX());
            S.A0 = (const char*)WSP(bf16_t, WS_OB); S.A1 = (const char*)YB; S.A2 = (const char*)YC;
            S.B0 = (const char*)(WSP(bf16_t, WS_WBA) + (size_t)l * 1024 * 512); S.B1 = (const char*)(WSP(bf16_t, WS_WBB) + (size_t)l * 1024 * 256); S.B2 = (const char*)(WSP(bf16_t, WS_WBC) + (size_t)l * 1024 * 256);
            pg8::EpiBranchF E{WSP(unsigned char, WS_GQ), MERGED};
            pg8::gemm_phase<false>(lds, S, E);
        }
        SEAM(s0 + 6);
        if (IN(s0 + 7) && (STEP_MASK & (2 << 7))) {
            bf16_t* MERGED = WSP(bf16_t, WS_MERGED); bf16_t* MIX = WSP(bf16_t, WS_MIX);
            pg8::StaticOrder S; S.init(MERGED, 1024, WSP(bf16_t, WS_WOUT) + (size_t)l * 1024 * 1024, 1024, 1024, NTOK, 1024, G, BX());
            pg8::EpiPlain E{MIX, nullptr, 0};
            pg8::gemm_phase<false>(lds, S, E);
        }
        SEAM(s0 + 7);
        if (IN(s0 + 8) && (STEP_MASK & (2 << 8))) {
            const int dm = a.pad;
            rows1m_phase(WSP(bf16_t, WS_XB), WSP(bf16_t, WS_MIX), ARG_IN(19) + (size_t)l * D, ARG_IN(20) + (size_t)l * D, WSP(bf16_t, WS_WRT) + (size_t)l * 64 * PW1, WSP(float, WS_WRT + 768 * 1024) + l * 64,
                        WSP(bf16_t, WS_X1B), dm ? cnt + 4096 * dm : cnt, dm ? WSP(int, WS_OB) : WSP(int, WS_TOK), dm ? WSP(int, WS_OB + 8 * MiB) : WSP(int, WS_RE), dm ? WSP(int, WS_OB + 9 * MiB) : WSP(int, WS_RR), dm ? WSP(float, WS_OB + 10 * MiB) : WSP(float, WS_RG),
                        lds, MISC + 64, MISC + 96, (volatile LAS float*)(MISC + 256), BX(), G, wave, lane);
        }
        SEAM(s0 + 8);
        const bool fillok = (G == 256);
        if (IN(s0 + 9) && (STEP_MASK & (2 << 9))) {
            const int* TOK = WSP(int, WS_TOK); bf16_t* X1B = WSP(bf16_t, WS_X1B); bf16_t* ACT = WSP(bf16_t, WS_ACT);
            moe_prefix(cnt, (volatile LAS int*)(MISC + 16));
            { MoeOrder S{(const volatile LAS int*)(MISC + 16), cnt, TOK, (const char*)X1B, (const char*)(WSP(bf16_t, WS_WUP) + (size_t)l * NE * 2048 * 1024), (size_t)2048 * 1024 * 2, (size_t)256 * 1024 * 2, (size_t)256 * 1024 * 2, 8, G, BX(), 1024, true, -1};
              pg8::EpiUp E{ACT, ARG_IN(24) + (size_t)l * NE * 2048};
              pg8::gemm_phase<true>(lds, S, E); }
            if (fillok) {
                const int c = BX(), ga = 4 * (c & 7) + (c >> 6), p8 = (c >> 3) & 7, r0 = (((volatile LAS int*)(MISC + 16))[32] - 1) & 31;
                if (ga > r0) {
                    count_in_and_wait((unsigned*)(ws + WS_CTL) + CW_MOEF + (l * 32 + ga) * 32, 8u, bar.bar);
                    MoeOrder D{(const volatile LAS int*)(MISC + 16), cnt, TOK, (const char*)WSP(bf16_t, WS_ACT), (const char*)(WSP(bf16_t, WS_WDN) + (size_t)l * NE * 1024 * 1024), (size_t)1024 * 1024 * 2, (size_t)256 * 1024 * 2, (size_t)256 * 1024 * 2, 4, G, c, 1024, false, -1};
                    MoeOne S1{D, p8 < 4 ? ga : 32 + ga, p8 & 3};
                    pg8::EpiYm8 E2{(unsigned char*)WSP(bf16_t, WS_YM), ARG_IN(26) + (size_t)l * NE * 1024};
                    pg8::gemm_phase<false>(lds, S1, E2);
                }
            }
        }
        SEAM(s0 + 9);
        if (IN(s0 + 10) && (STEP_MASK & (2 << 10))) {
            const int* TOK = WSP(int, WS_TOK); bf16_t* ACT = WSP(bf16_t, WS_ACT); bf16_t* YM = WSP(bf16_t, WS_YM);
            if (!(IN(s0 + 9) && (STEP_MASK & (2 << 9)))) moe_prefix(cnt, (volatile LAS int*)(MISC + 16));
            const int r0 = fillok ? ((((volatile LAS int*)(MISC + 16))[32] - 1) & 31) : -1;
            MoeOrder S{(const volatile LAS int*)(MISC + 16), cnt, TOK, (const char*)ACT, (const char*)(WSP(bf16_t, WS_WDN) + (size_t)l * NE * 1024 * 1024), (size_t)1024 * 1024 * 2, (size_t)256 * 1024 * 2, (size_t)256 * 1024 * 2, 4, G, BX(), 1024, false, r0};
            pg8::EpiYm8 E{(unsigned char*)YM, ARG_IN(26) + (size_t)l * NE * 1024};
            pg8::gemm_phase<false>(lds, S, E);
        }
        SEAM(s0 + 10);
        if (IN(s0 + 11) && (STEP_MASK & (2 << 11))) {
            const bool last = (l == NL - 1);
            rows2_phase(WSP(bf16_t, WS_X1B), WSP(unsigned char, WS_YM), cnt, WSP(int, WS_RE), WSP(int, WS_RR), WSP(float, WS_RG), ARG_IN(27) + (size_t)l * D, ARG_IN(28) + (size_t)l * D,
                        last ? a.out : (float*)nullptr, WSP(bf16_t, WS_XB), last ? (const float*)nullptr : ARG_IN(1) + (size_t)(l + 1) * D * NIN, last ? (const float*)nullptr : ARG_IN(2) + (size_t)(l + 1) * 8,
                        WSP(float, WS_LOGF), (volatile LAS float*)lds, GWL(), NGW, lane);
        }
        SEAM(s0 + 11);
    }
#undef IN
#undef SEAM
}

#ifndef MK_MODE
#define MK_MODE 0
#endif
extern "C" void kernel_launch(void* const* d_in, const int* in_sizes, int n_in, void* d_out, int out_size, void* d_ws, size_t ws_size, hipStream_t stream) {
    if (n_in != 29 || out_size != NTOK * D || ws_size < WS_END2) { fprintf(stderr, "kernel_launch: unexpected shapes (n_in %d out %d ws %zu)\n", n_in, out_size, ws_size); return; }
    static int grid = 0;
    if (grid == 0) {
        int dev = 0, cus = 0;
        if (hipGetDevice(&dev) != hipSuccess || hipDeviceGetAttribute(&cus, hipDeviceAttributeMultiprocessorCount, dev) != hipSuccess) { fprintf(stderr, "kernel_launch: device query failed\n"); grid = -1; return; }
        if (hipFuncSetAttribute((const void*)mk_fwd, hipFuncAttributeMaxDynamicSharedMemorySize, LDS_BYTES) != hipSuccess) { fprintf(stderr, "kernel_launch: hipFuncSetAttribute failed\n"); grid = -1; return; }
        int per_cu = 0;
        if (hipOccupancyMaxActiveBlocksPerMultiprocessor(&per_cu, (const void*)mk_fwd, NWAVES * 64, LDS_BYTES) != hipSuccess || per_cu < 1) fprintf(stderr, "kernel_launch: occupancy query reports %d workgroups per CU\n", per_cu);
        (void)hipGetLastError();
        grid = cus;
    }
    if (grid < 0) return;
    unsigned char* ws = (unsigned char*)d_ws;
    (void)hipMemsetAsync(ws + WS_CTL, 0, 1 * MiB, stream);
    Args a{}; for (int i = 0; i < 29; ++i) a.in[i] = (const float*)d_in[i]; a.out = (float*)d_out; a.ws = ws;
#if MK_MODE == 0
    a.step_lo = 0; a.step_hi = N_STEPS; a.bar_region = 0;
    hipLaunchKernelGGL(mk_fwd, dim3(grid), dim3(NWAVES * 64), LDS_BYTES, stream, a);
#elif MK_MODE == 1
    for (int s = 0; s < N_STEPS; ++s) { Args b = a; b.step_lo = s; b.step_hi = s + 1; b.bar_region = s; hipLaunchKernelGGL(mk_fwd, dim3(grid), dim3(NWAVES * 64), LDS_BYTES, stream, b); }
#else
    for (int s = 0; s < N_STEPS; ++s) { const int bit = s == 0 ? 0 : 1 + (s - 1) % STEPS_PER_LAYER; const int rep = ((PROBE_MASK >> bit) & 1) ? PROBE_REP : 1;
        for (int r = 0; r < rep; ++r) { Args b = a; b.step_lo = s; b.step_hi = s + 1; b.bar_region = s; b.pad = (bit == 9 || bit == 2) ? r : 0; hipLaunchKernelGGL(mk_fwd, dim3(grid), dim3(NWAVES * 64), LDS_BYTES, stream, b); } }
#endif
}
```

```cpp
#include <hip/hip_runtime.h>
#include <cstdint>
#include <cstdio>
#include <cmath>

typedef unsigned short bf16_t;
typedef short bf16x8 __attribute__((ext_vector_type(8)));
typedef float f32x4 __attribute__((ext_vector_type(4)));
typedef float f32x2 __attribute__((ext_vector_type(2)));
typedef unsigned u32x4 __attribute__((ext_vector_type(4)));
typedef unsigned u32x2 __attribute__((ext_vector_type(2)));

constexpr int D = 1024, NB = 8, SEQ = 4096, NTOK = NB * SEQ, NL = 4;
constexpr int NIN = 5128, HP = 5120;
constexpr int NE = 32, TOPK = 4;
constexpr int MOE_ROWS = 139264;
constexpr float C2 = 0.125f * 1.4426950408889634f;
constexpr float L2E = 1.4426950408889634f;
constexpr float ALPHA = 1.681792830507429f;
constexpr float LN_EPS = 1e-5f;
constexpr int HC_Q = 0, HC_K = 512, HC_V = 1024, HC_POOL = 1536, HC_SSM = 1792, HC_G = 2048;

constexpr size_t MiB = 1u << 20;
constexpr size_t WS_CTL = 0;
constexpr size_t WS_WIN = 1 * MiB;
constexpr size_t WS_WBA = 41 * MiB;
constexpr size_t WS_WBB = 45 * MiB;
constexpr size_t WS_WBC = 47 * MiB;
constexpr size_t WS_WOUT = 49 * MiB;
constexpr size_t WS_WGLU = 57 * MiB;
constexpr size_t WS_WUP = 80 * MiB;
constexpr size_t WS_WDN = 592 * MiB;
constexpr size_t WS_XA = 848 * MiB;
constexpr size_t WS_X1 = 976 * MiB;
constexpr size_t WS_XB = 1104 * MiB;
constexpr size_t WS_X1B = 1168 * MiB;
constexpr size_t WS_H = 1232 * MiB;
constexpr size_t WS_A3 = 1552 * MiB;
constexpr size_t WS_MERGED = 1576 * MiB;
constexpr size_t WS_MIX = 1640 * MiB;
constexpr size_t WS_YB = 1704 * MiB;
constexpr size_t WS_YCP = 1720 * MiB;
constexpr size_t WS_YC = 1736 * MiB;
constexpr size_t WS_LOGF = 1752 * MiB;
constexpr size_t WS_CUM = 1753 * MiB;
constexpr size_t WS_TOK = 1754 * MiB;
constexpr size_t WS_RE = 1758 * MiB;
constexpr size_t WS_RR = WS_RE + 512 * 1024;
constexpr size_t WS_RG = WS_RR + 512 * 1024;
constexpr size_t WS_ACT = 1760 * MiB;
constexpr size_t WS_YM = 2032 * MiB;
constexpr size_t WS_END = 2304 * MiB;
constexpr int CW_MOEF = 238592;
constexpr int CW_S5C = 237568;
constexpr int CW_ATTQ = 229376;
constexpr int CW_CNT = 200704, CNT_STRIDE = 32;

__device__ __forceinline__ float bf2f(bf16_t b) { return __uint_as_float((unsigned)b << 16); }
__device__ __forceinline__ bf16_t f2bf(float f) { unsigned u = __float_as_uint(f); return (bf16_t)((u + 0x7fffu + ((u >> 16) & 1u)) >> 16); }
__device__ __forceinline__ unsigned pk2(float lo, float hi) { unsigned r; asm("v_cvt_pk_bf16_f32 %0, %1, %2" : "=v"(r) : "v"(lo), "v"(hi)); return r; }
__device__ __forceinline__ float sigmoidf_(float x) { return 1.0f / (1.0f + __expf(-x)); }
__device__ __forceinline__ float wave_sum(float v) {
#pragma unroll
    for (int o = 1; o < 64; o <<= 1) v += __shfl_xor(v, o);
    return v;
}
__device__ __forceinline__ float wave_max_f(float v) {
#pragma unroll
    for (int o = 32; o >= 1; o >>= 1) v = fmaxf(v, __shfl_xor(v, o));
    return v; }
__device__ __forceinline__ int wave_min_i(int v) {
#pragma unroll
    for (int o = 32; o >= 1; o >>= 1) { const int t = __shfl_xor(v, o); v = t < v ? t : v; }
    return v; }
template <int N> __device__ __forceinline__ void reduce_scatter(float (&v)[N], int lane) {
    int s = 32;
#pragma unroll
    for (int n = N / 2; n >= 1; n >>= 1) {
        const bool up = (lane & s) != 0;
#pragma unroll
        for (int i = 0; i < n; ++i) { float hi = v[i + n], lo = v[i]; asm volatile("" : "+v"(hi), "+v"(lo));
            const float keep = up ? hi : lo, send = up ? lo : hi; v[i] = keep + __shfl_xor(send, s); }
        s >>= 1;
    }
    for (; s >= 1; s >>= 1) v[0] += __shfl_xor(v[0], s);
}

__device__ __forceinline__ int dst_row(int mode, int c) {
    if (mode == 1) return c < 1536 ? c : (c < 1544 ? -1 : c - 8);
    if (mode == 2) { const int j = c >> 1, bj = c & 1; return (j >> 7) * 256 + bj * 128 + (j & 127); }
    return c;
}
__device__ __forceinline__ void transpose_item(const float* W, int Nsrc, int K, int Ndst, bf16_t* WT, int mode, float* scr, int item, int lane) {
    (void)Ndst;
    const int nkb = K / 64, nb = item / nkb, kb = item % nkb, k0 = 64 * kb, c0 = 64 * nb;
    const bool cin = (c0 + lane) < Nsrc;
    const float* src = W + (size_t)k0 * Nsrc + c0 + (cin ? lane : 0);
#pragma unroll 16
    for (int kk = 0; kk < 64; ++kk) scr[kk * 65 + lane] = __builtin_nontemporal_load(src + (size_t)kk * Nsrc);
    asm volatile("s_waitcnt lgkmcnt(0)" ::: "memory");
    const int c8 = lane & 7;
#pragma unroll
    for (int i = 0; i < 8; ++i) { const int col = (lane >> 3) + 8 * i; const int n = (c0 + col) < Nsrc ? dst_row(mode, c0 + col) : -1; const float* s = scr + (8 * c8) * 65 + col;
        const float sc = (mode == 1 && n >= 2048) ? -L2E : 1.0f;
        u32x4 o; o.x = pk2(s[0 * 65] * sc, s[1 * 65] * sc); o.y = pk2(s[2 * 65] * sc, s[3 * 65] * sc); o.z = pk2(s[4 * 65] * sc, s[5 * 65] * sc); o.w = pk2(s[6 * 65] * sc, s[7 * 65] * sc);
        if (n >= 0) __builtin_nontemporal_store(o, (u32x4*)(WT + (size_t)n * K + k0 + 8 * c8)); }
    asm volatile("s_waitcnt lgkmcnt(0)" ::: "memory");
}
struct PrepArgs { const float *w_in, *w_ba, *w_bb, *w_bc, *w_out, *w_glu, *w_up, *w_dn; unsigned char* ws; };
__device__ __forceinline__ void prep_items(const PrepArgs& a, float* scr, long gw, long NGW, int lane) {
    constexpr long I_IN = (1024 / 64) * ((NIN + 63) / 64), I_BA = (512 / 64) * (1024 / 64), I_BB = (256 / 64) * (1024 / 64), I_OUT = (1024 / 64) * (1024 / 64), I_GLU = (256 / 64) * (256 / 64);
    constexpr long I_UP = (1024 / 64) * (2048 / 64), I_DN = (1024 / 64) * (1024 / 64);
    constexpr long T_IN = NL * I_IN, T_BA = NL * I_BA, T_BB = NL * I_BB, T_OUT = NL * I_OUT, T_GLU = NL * I_GLU, T_UP = (long)NL * NE * I_UP, T_DN = (long)NL * NE * I_DN;
    constexpr long TOTAL = T_IN + T_BA + 2 * T_BB + T_OUT + T_GLU + T_UP + T_DN;
    for (long it = gw; it < TOTAL; it += NGW) {
        long r = it;
        if (r < T_UP) { const int inst = (int)(r / I_UP), item = (int)(r % I_UP); transpose_item(a.w_up + (size_t)inst * 1024 * 2048, 2048, 1024, 2048, (bf16_t*)(a.ws + WS_WUP) + (size_t)inst * 2048 * 1024, 2, scr, item, lane); continue; } r -= T_UP;
        if (r < T_DN) { const int inst = (int)(r / I_DN), item = (int)(r % I_DN); transpose_item(a.w_dn + (size_t)inst * 1024 * 1024, 1024, 1024, 1024, (bf16_t*)(a.ws + WS_WDN) + (size_t)inst * 1024 * 1024, 0, scr, item, lane); continue; } r -= T_DN;
        if (r < T_IN) { const int inst = (int)(r / I_IN), item = (int)(r % I_IN); transpose_item(a.w_in + (size_t)inst * 1024 * NIN, NIN, 1024, 5120, (bf16_t*)(a.ws + WS_WIN) + (size_t)inst * 5120 * 1024, 1, scr, item, lane); continue; } r -= T_IN;
        if (r < T_BA) { const int inst = (int)(r / I_BA), item = (int)(r % I_BA); transpose_item(a.w_ba + (size_t)inst * 512 * 1024, 1024, 512, 1024, (bf16_t*)(a.ws + WS_WBA) + (size_t)inst * 1024 * 512, 0, scr, item, lane); continue; } r -= T_BA;
        if (r < T_BB) { const int inst = (int)(r / I_BB), item = (int)(r % I_BB); transpose_item(a.w_bb + (size_t)inst * 256 * 1024, 1024, 256, 1024, (bf16_t*)(a.ws + WS_WBB) + (size_t)inst * 1024 * 256, 0, scr, item, lane); continue; } r -= T_BB;
        if (r < T_BB) { const int inst = (int)(r / I_BB), item = (int)(r % I_BB); transpose_item(a.w_bc + (size_t)inst * 256 * 1024, 1024, 256, 1024, (bf16_t*)(a.ws + WS_WBC) + (size_t)inst * 1024 * 256, 0, scr, item, lane); continue; } r -= T_BB;
        if (r < T_OUT) { const int inst = (int)(r / I_OUT), item = (int)(r % I_OUT); transpose_item(a.w_out + (size_t)inst * 1024 * 1024, 1024, 1024, 1024, (bf16_t*)(a.ws + WS_WOUT) + (size_t)inst * 1024 * 1024, 0, scr, item, lane); continue; } r -= T_OUT;
        { const int inst = (int)(r / I_GLU), item = (int)(r % I_GLU); transpose_item(a.w_glu + (size_t)inst * 256 * 256, 256, 256, 256, (bf16_t*)(a.ws + WS_WGLU) + (size_t)inst * 256 * 256, 0, scr, item, lane); }
    }
}

__device__ __forceinline__ void row_ln(f32x4 (&v)[4], const float* g, const float* bta, int lane) {
    float s = 0.f;
#pragma unroll
    for (int j = 0; j < 4; ++j) s += (v[j].x + v[j].y) + (v[j].z + v[j].w);
    const float mean = wave_sum(s) * (1.f / D); float s2 = 0.f;
#pragma unroll
    for (int j = 0; j < 4; ++j) { v[j] = v[j] - mean; s2 += (v[j].x * v[j].x + v[j].y * v[j].y) + (v[j].z * v[j].z + v[j].w * v[j].w); }
    const float rstd = 1.0f / sqrtf(wave_sum(s2) * (1.f / D) + LN_EPS);
#pragma unroll
    for (int j = 0; j < 4; ++j) { const f32x4 gg = *(const f32x4*)(g + 4 * (lane + 64 * j)), bb = *(const f32x4*)(bta + 4 * (lane + 64 * j)); v[j] = v[j] * rstd * gg + bb; }
}
#define GAS __attribute__((address_space(1)))
__device__ __forceinline__ void row_store_bf16(const f32x4 (&v)[4], bf16_t* orow, int lane) {
#pragma unroll
    for (int j = 0; j < 4; ++j) { u32x2 w; asm("v_cvt_pk_bf16_f32 %0, %1, %2" : "=v"(w.x) : "v"(v[j].x), "v"(v[j].y)); asm("v_cvt_pk_bf16_f32 %0, %1, %2" : "=v"(w.y) : "v"(v[j].z), "v"(v[j].w)); *(GAS u32x2*)((GAS bf16_t*)orow + 4 * (lane + 64 * j)) = w; }
}
#define LAS __attribute__((address_space(3)))
namespace pg8 {
constexpr int BM = 256, BK = 64, HALF = 128, HTB = HALF * BK * 2, STAGE_BYTES = 8 * HTB;
__device__ __forceinline__ int lds_byte(int r, int c) { const int st = (r >> 4) * 2 + (c >> 5), rr = r & 15, cc = c & 31, ob = rr * 64 + cc * 2; return st * 1024 + (ob ^ (((ob >> 9) & 1) << 5)); }
__device__ __forceinline__ void stage_rc(int b, int& R, int& C) { const int st = b / 1024, sb = b % 1024, swz = sb ^ (((sb >> 9) & 1) << 5); R = (st >> 1) * 16 + swz / 64; C = (st & 1) * 32 + (swz % 64) / 2; }
__device__ __forceinline__ int perm32(int rho) { const int n = rho >> 4, i = rho & 15; return 8 * (i >> 2) + 4 * n + (i & 3); }

struct Unit { const char* A; const char* B; int pm, pn, e, valid, lt; int lda, ldb, nt, seg; };

typedef f32x4 Acc[2][2][4][2];

template <bool GATHER, class Epi, class Sched>
__device__ __forceinline__ void gemm_phase(LAS unsigned char* lds, const Sched& S, const Epi& E) {
    int tid_ = threadIdx.x; asm volatile("" : "+v"(tid_));
    const int tid = tid_, wid = __builtin_amdgcn_readfirstlane(tid >> 6), lane = tid & 63, wr = wid >> 2, wc = wid & 3, fr = lane & 15, fq = lane >> 4;
    int R0, C0; stage_rc(tid * 16, R0, C0);
    const int Rb0 = (R0 & ~31) + perm32(R0 & 31);
    unsigned vB, vBn, vA = 0, vAn = 0; size_t sB, sBn, sA = 0, sAn = 0;
    unsigned offA[2][2], offN[2][2];
    const size_t kstep = (size_t)(BK * 2);
    const unsigned ldsw = (unsigned)wid * 1024u;
    const int aoff = lds_byte(wr * 64 + fr, fq * 8), boff = lds_byte(wc * 32 + fr, fq * 8);
#define PG8_SA(b, h) (((b) * 2 + (h)) * HTB)
#define PG8_SB(b, h) ((4 + (b) * 2 + (h)) * HTB)
#define PG8_STAGE_B(bufoff, gbase, h, vb, sb) do { _Pragma("unroll") for (int _i = 0; _i < 2; ++_i) \
        __builtin_amdgcn_global_load_lds((const unsigned*)((const char*)(gbase) + (size_t)(2 * (h) + _i) * (sb) + (vb)), (LAS unsigned*)(lds + (bufoff) + ldsw + _i * 8192), 16, 0, 0); } while (0)
#define PG8_STAGE_A(bufoff, gbase, h, va, sa, offs) do { _Pragma("unroll") for (int _i = 0; _i < 2; ++_i) { \
        const char* _p = GATHER ? (const char*)(gbase) + (offs)[h][_i] : (const char*)(gbase) + (size_t)(2 * (h) + _i) * (sa) + (va); \
        __builtin_amdgcn_global_load_lds((const unsigned*)_p, (LAS unsigned*)(lds + (bufoff) + ldsw + _i * 8192), 16, 0, 0); } } while (0)
#define PG8_LDA(dst, b, h) do { _Pragma("unroll") for (int m = 0; m < 4; ++m) _Pragma("unroll") for (int k = 0; k < 2; ++k) dst[m][k] = *(const LAS bf16x8*)(lds + PG8_SA(b, h) + aoff + m * 2048 + k * 1024); } while (0)
#define PG8_LDB(dst, b, h) do { _Pragma("unroll") for (int n = 0; n < 2; ++n) _Pragma("unroll") for (int k = 0; k < 2; ++k) dst[n][k] = *(const LAS bf16x8*)(lds + PG8_SB(b, h) + boff + n * 2048 + k * 1024); } while (0)
#define PG8_MMA(ai, bj, At, Bt) do { __builtin_amdgcn_s_setprio(1); _Pragma("unroll") for (int m = 0; m < 4; ++m) _Pragma("unroll") for (int n = 0; n < 2; ++n) _Pragma("unroll") for (int k = 0; k < 2; ++k) \
        acc[ai][bj][m][n] = __builtin_amdgcn_mfma_f32_16x16x32_bf16(Bt[n][k], At[m][k], acc[ai][bj][m][n], 0, 0, 0); __builtin_amdgcn_s_setprio(0); } while (0)
#define PG8_WAIT_V(n) asm volatile("s_waitcnt vmcnt(" #n ")" ::: "memory")
#define PG8_WAIT_L(n) asm volatile("s_waitcnt lgkmcnt(" #n ")" ::: "memory")
#define PG8_BAR __builtin_amdgcn_s_barrier()
#define PG8_SCHED __builtin_amdgcn_sched_barrier(0)
#define PG8_GEOM(u, oA, va, sa, vb, sb) do { if constexpr (GATHER) S.goff(u, R0, C0, oA); else { va = (unsigned)(R0 * (u).lda + C0) * 2u; sa = (size_t)64 * (u).lda * 2; } \
        vb = (unsigned)(Rb0 * (u).ldb + C0) * 2u; sb = (size_t)64 * (u).ldb * 2; } while (0)
    Unit cur, nxt; int ui = 0;
    if (!S.next(0, cur)) return;
    PG8_GEOM(cur, offA, vA, sA, vB, sB);
#pragma unroll
    for (int h = 0; h < 2; ++h)
#pragma unroll
        for (int i = 0; i < 2; ++i) offN[h][i] = offA[h][i];
    vAn = vA; sAn = sA; vBn = vB; sBn = sB; int nt = cur.nt;
    Acc acc;
#pragma unroll
    for (int a = 0; a < 2; ++a)
#pragma unroll
        for (int b = 0; b < 2; ++b)
#pragma unroll
            for (int m = 0; m < 4; ++m)
#pragma unroll
                for (int n = 0; n < 2; ++n) acc[a][b][m][n] = (f32x4){0.f, 0.f, 0.f, 0.f};
    bf16x8 At[4][2], B0[2][2], B1[2][2];
    const char* cA = cur.A; const char* cB = cur.B;
    E.pre(cur, wr, wc, fr, fq);
    PG8_STAGE_B(PG8_SB(0, 0), cB, 0, vB, sB); PG8_STAGE_B(PG8_SB(0, 1), cB, 1, vB, sB); PG8_STAGE_A(PG8_SA(0, 0), cA, 0, vA, sA, offA); PG8_STAGE_A(PG8_SA(0, 1), cA, 1, vA, sA, offA);
    if (wr == 1) PG8_BAR;
    PG8_WAIT_V(2); PG8_BAR;
    PG8_STAGE_B(PG8_SB(1, 0), cB + kstep, 0, vB, sB); PG8_STAGE_A(PG8_SA(1, 0), cA + kstep, 0, vA, sA, offA); PG8_STAGE_B(PG8_SB(1, 1), cB + kstep, 1, vB, sB);
    PG8_WAIT_V(6); PG8_BAR;
    for (;;) {
        const bool has_next = S.next(ui + 1, nxt);
        const char* nA = has_next ? nxt.A : cA; const char* nB = has_next ? nxt.B : cB;
        if (has_next) PG8_GEOM(nxt, offN, vAn, sAn, vBn, sBn);
#pragma unroll 1
        for (int t = 0; t < nt; t += 2) {
            const bool last = (t == nt - 2);
            const char* a1 = cA + (size_t)(t + 1) * kstep;
            const char* a2 = last ? nA : cA + (size_t)(t + 2) * kstep; const char* b2 = last ? nB : cB + (size_t)(t + 2) * kstep;
            const char* a3 = a2 + kstep; const char* b3 = b2 + kstep;
            unsigned o2[2][2];
            if constexpr (GATHER) {
#pragma unroll
                for (int h = 0; h < 2; ++h)
#pragma unroll
                    for (int i = 0; i < 2; ++i) o2[h][i] = last ? offN[h][i] : offA[h][i];
            }
            const unsigned va2 = last ? vAn : vA, vb2 = last ? vBn : vB; const size_t sa2 = last ? sAn : sA, sb2 = last ? sBn : sB;
            PG8_LDB(B0, 0, 0); PG8_LDB(B1, 0, 1); PG8_SCHED; PG8_LDA(At, 0, 0); PG8_STAGE_A(PG8_SA(1, 1), a1, 1, vA, sA, offA);
            PG8_WAIT_V(8); PG8_WAIT_L(0); PG8_BAR; PG8_MMA(0, 0, At, B0); PG8_MMA(0, 1, At, B1); PG8_BAR; PG8_SCHED;
            PG8_LDA(At, 0, 1); PG8_STAGE_B(PG8_SB(0, 0), b2, 0, vb2, sb2); PG8_STAGE_B(PG8_SB(0, 1), b2, 1, vb2, sb2); PG8_STAGE_A(PG8_SA(0, 0), a2, 0, va2, sa2, o2);
            PG8_WAIT_V(8); PG8_WAIT_L(0); PG8_BAR; PG8_MMA(1, 0, At, B0); PG8_MMA(1, 1, At, B1); PG8_BAR; PG8_SCHED;
            PG8_LDB(B0, 1, 0); PG8_LDB(B1, 1, 1); PG8_SCHED; PG8_LDA(At, 1, 0); PG8_STAGE_A(PG8_SA(0, 1), a2, 1, va2, sa2, o2);
            PG8_WAIT_V(8); PG8_WAIT_L(0); PG8_BAR; PG8_MMA(0, 0, At, B0); PG8_MMA(0, 1, At, B1); PG8_BAR; PG8_SCHED;
            PG8_LDA(At, 1, 1); PG8_STAGE_B(PG8_SB(1, 0), b3, 0, vb2, sb2); PG8_STAGE_B(PG8_SB(1, 1), b3, 1, vb2, sb2); PG8_STAGE_A(PG8_SA(1, 0), a3, 0, va2, sa2, o2);
            PG8_WAIT_V(8); PG8_WAIT_L(0); PG8_BAR; PG8_MMA(1, 0, At, B0); PG8_MMA(1, 1, At, B1); PG8_BAR; PG8_SCHED;
        }
        if (wr == 0) PG8_BAR;
        if constexpr (!Epi::AFTER_DRAIN) E(acc, cur, wr, wc, fr, fq);
        if (!has_next) break;
        if (!E.keep_acc(cur)) {
#pragma unroll
            for (int a = 0; a < 2; ++a)
#pragma unroll
                for (int b = 0; b < 2; ++b)
#pragma unroll
                    for (int m = 0; m < 4; ++m)
#pragma unroll
                        for (int n = 0; n < 2; ++n) acc[a][b][m][n] = (f32x4){0.f, 0.f, 0.f, 0.f};
        }
        cur = nxt; cA = nA; cB = nB; ++ui; nt = cur.nt; vA = vAn; sA = sAn; vB = vBn; sB = sBn;
        if constexpr (GATHER) {
#pragma unroll
            for (int h = 0; h < 2; ++h)
#pragma unroll
                for (int i = 0; i < 2; ++i) offA[h][i] = offN[h][i];
        }
        E.pre(cur, wr, wc, fr, fq);
        if (wr == 1) PG8_BAR;
    }
    PG8_WAIT_V(0);
    PG8_BAR;
    if constexpr (Epi::AFTER_DRAIN) E.after(acc, cur, wr, wc, fr, fq, lds);
#undef PG8_GEOM
#undef PG8_SA
#undef PG8_SB
#undef PG8_STAGE_A
#undef PG8_STAGE_B
#undef PG8_LDA
#undef PG8_LDB
#undef PG8_MMA
#undef PG8_WAIT_V
#undef PG8_WAIT_L
#undef PG8_BAR
#undef PG8_SCHED
}

struct StaticOrder {
    const char* A; const char* B; size_t tstepA, tstepB; int nM, nN, nwg, G, c, lda, ldb, nt;
    __device__ __forceinline__ void init(const void* A_, int lda_, const void* B_, int ldb_, int K, int M, int N, int G_, int c_) {
        A = (const char*)A_; B = (const char*)B_; lda = lda_; ldb = ldb_; nt = K / BK; tstepA = (size_t)BM * lda * 2; tstepB = (size_t)BM * ldb * 2; nM = M / BM; nN = N / BM; nwg = nM * nN; G = G_; c = c_; }
    __device__ __forceinline__ bool next(int i, Unit& u) const {
        const long L = (long)i * G + c; if (L >= nwg) return false;
        int wgid = (int)L; { const int q = nwg / 8, r = nwg % 8, xcd = wgid % 8, off = wgid / 8; wgid = (xcd < r ? xcd * (q + 1) : r * (q + 1) + (xcd - r) * q) + off; }
        const int nig = 8 * nN, gid = wgid / nig, fm = gid * 8, gsz = (nM - fm) < 8 ? (nM - fm) : 8;
        u.pm = fm + ((wgid % nig) % gsz); u.pn = (wgid % nig) / gsz; u.e = 0; u.valid = 256; u.lt = 0; u.lda = lda; u.ldb = ldb; u.nt = nt; u.seg = 0;
        u.A = A + (size_t)u.pm * tstepA; u.B = B + (size_t)u.pn * tstepB; return true;
    }
};
}
namespace pg8 {
__device__ __forceinline__ unsigned cvt_pk_bf16(float lo, float hi) { unsigned r; asm volatile("v_cvt_pk_bf16_f32 %0, %1, %2" : "=v"(r) : "v"(lo), "v"(hi)); return r; }
__device__ __forceinline__ float fsig(float x) { return __builtin_amdgcn_rcpf(1.0f + __builtin_amdgcn_exp2f(-L2E * x)); }
__device__ __forceinline__ u32x4 pack8(const f32x4 v0, const f32x4 v1) { u32x4 w; w.x = cvt_pk_bf16(v0[0], v0[1]); w.y = cvt_pk_bf16(v0[2], v0[3]); w.z = cvt_pk_bf16(v1[0], v1[1]); w.w = cvt_pk_bf16(v1[2], v1[3]); return w; }
__device__ __forceinline__ void unpack8(const u32x4 w, f32x4& v0, f32x4& v1) {
    v0[0] = __uint_as_float(w.x << 16); v0[1] = __uint_as_float(w.x & 0xffff0000u); v0[2] = __uint_as_float(w.y << 16); v0[3] = __uint_as_float(w.y & 0xffff0000u);
    v1[0] = __uint_as_float(w.z << 16); v1[1] = __uint_as_float(w.z & 0xffff0000u); v1[2] = __uint_as_float(w.w << 16); v1[3] = __uint_as_float(w.w & 0xffff0000u); }
__device__ __forceinline__ u32x4 ld16(const void* ubase, unsigned voff) { return *(const u32x4*)((const char*)ubase + voff); }
__device__ __forceinline__ void st16(void* ubase, unsigned voff, u32x4 v) { *(u32x4*)((char*)ubase + voff) = v; }
__device__ __forceinline__ f32x4 ldf4(const void* ubase, unsigned voff) { return *(const f32x4*)((const char*)ubase + voff); }

struct EpiIn { bf16_t* H; bf16_t* A3; unsigned char* GQ;
    static constexpr bool AFTER_DRAIN = false; __device__ __forceinline__ void pre(const Unit&, int, int, int, int) const {} __device__ __forceinline__ bool keep_acc(const Unit&) const { return false; }
    __device__ __forceinline__ void operator()(const Acc& acc, const Unit& u, int wr, int wc, int fr, int fq) const {
        const int pn = u.pn;
        const unsigned vH = (unsigned)(fr * HP + 8 * fq) * 2u, vS = (unsigned)((fq >> 1) * 2048 * 384 + fr * 16 + (fq & 1) * 8) * 2u, vG = (unsigned)(fr * 3072 + 8 * fq);
#pragma unroll
        for (int ai = 0; ai < 2; ++ai)
#pragma unroll
            for (int m = 0; m < 4; ++m) {
#pragma unroll
                for (int bj = 0; bj < 2; ++bj) { f32x4 v0 = acc[ai][bj][m][0], v1 = acc[ai][bj][m][1];
                    if (pn < 2) { v0 = v0 * C2; v1 = v1 * C2; }
                    if (pn >= 8) { unsigned q[8];
#pragma unroll
                        for (int i = 0; i < 4; i += 2) {
                            f32x2 ta = (f32x2){__builtin_amdgcn_exp2f(v0[i]), __builtin_amdgcn_exp2f(v0[i + 1])} + (f32x2){1.0f, 1.0f}, tb = (f32x2){__builtin_amdgcn_exp2f(v1[i]), __builtin_amdgcn_exp2f(v1[i + 1])} + (f32x2){1.0f, 1.0f};
                            f32x2 ya = (f32x2){__builtin_amdgcn_rcpf(ta.x), __builtin_amdgcn_rcpf(ta.y)} * (f32x2){255.0f, 255.0f} + (f32x2){0.5f, 0.5f}, yb = (f32x2){__builtin_amdgcn_rcpf(tb.x), __builtin_amdgcn_rcpf(tb.y)} * (f32x2){255.0f, 255.0f} + (f32x2){0.5f, 0.5f};
                            q[i] = (unsigned)fmaxf(ya.x, 1.0f); q[i + 1] = (unsigned)fmaxf(ya.y, 1.0f); q[4 + i] = (unsigned)fmaxf(yb.x, 1.0f); q[5 + i] = (unsigned)fmaxf(yb.y, 1.0f); }
                        u32x2 w; w.x = q[0] | (q[1] << 8) | (q[2] << 16) | (q[3] << 24); w.y = q[4] | (q[5] << 8) | (q[6] << 16) | (q[7] << 24);
                        *(u32x2*)(GQ + (size_t)(u.pm * 256 + ai * 128 + wr * 64 + m * 16) * 3072 + (pn - 8) * 256 + bj * 128 + wc * 32 + vG) = w; }
                    else if (pn == 7) st16(A3 + ((size_t)(bj * 8 + wc * 2) * 2048 + u.pm * 16 + ai * 8 + wr * 4 + m) * 384, vS, pack8(v0, v1));
                    else st16(H + (size_t)(u.pm * 256 + ai * 128 + wr * 64 + m * 16) * HP + pn * 256 + bj * 128 + wc * 32, vH, pack8(v0, v1)); } }
    }
};
struct EpiGlu { const bf16_t* ycp; const float* bias; bf16_t* yc;
    static constexpr bool AFTER_DRAIN = false; __device__ __forceinline__ void pre(const Unit&, int, int, int, int) const {} __device__ __forceinline__ bool keep_acc(const Unit&) const { return false; }
    __device__ __forceinline__ void operator()(const Acc& acc, const Unit& u, int wr, int wc, int fr, int fq) const {
        const unsigned vo = (unsigned)(fr * 256 + 8 * fq) * 2u;
        f32x4 bv[2][2];
#pragma unroll
        for (int bj = 0; bj < 2; ++bj)
#pragma unroll
            for (int n = 0; n < 2; ++n) bv[bj][n] = ldf4(bias + bj * 128 + wc * 32 + 4 * n, (unsigned)fq * 32u);
#define GL_UB(it) ((size_t)(u.pm * 256 + ((it) >> 3) * 128 + wr * 64 + (((it) >> 1) & 3) * 16) * 256 + ((it) & 1) * 128 + wc * 32)
        u32x4 yn = ld16(ycp + GL_UB(0), vo);
#pragma unroll
        for (int it = 0; it < 16; ++it) { const int ai = it >> 3, m = (it >> 1) & 3, bj = it & 1; const size_t ub = GL_UB(it); f32x4 y0, y1; unpack8(yn, y0, y1);
            if (it + 1 < 16) yn = ld16(ycp + GL_UB(it + 1), vo);
            f32x4 v0 = acc[ai][bj][m][0] + bv[bj][0], v1 = acc[ai][bj][m][1] + bv[bj][1];
#pragma unroll
            for (int i = 0; i < 4; ++i) { v0[i] = y0[i] * fsig(v0[i]); v1[i] = y1[i] * fsig(v1[i]); }
            st16(yc + ub, vo, pack8(v0, v1));
            asm volatile("" ::: "memory"); }
#undef GL_UB
    }
};
struct EpiBranch { const bf16_t* H; bf16_t* merged; int br;
    static constexpr bool AFTER_DRAIN = false; __device__ __forceinline__ void pre(const Unit&, int, int, int, int) const {} __device__ __forceinline__ bool keep_acc(const Unit&) const { return false; }
    __device__ __forceinline__ void operator()(const Acc& acc, const Unit& u, int wr, int wc, int fr, int fq) const {
        const unsigned vH = (unsigned)(fr * HP + 8 * fq) * 2u, vM = (unsigned)(fr * 1024 + 8 * fq) * 2u;
#pragma unroll
        for (int ai = 0; ai < 2; ++ai)
#pragma unroll
            for (int m = 0; m < 4; ++m) { const int rowu = u.pm * 256 + ai * 128 + wr * 64 + m * 16;
#pragma unroll
                for (int bj = 0; bj < 2; ++bj) { const int cu = u.pn * 256 + bj * 128 + wc * 32; f32x4 g0, g1; unpack8(ld16(H + (size_t)rowu * HP + HC_G + br * 1024 + cu, vH), g0, g1);
                    f32x4 v0 = acc[ai][bj][m][0] * g0, v1 = acc[ai][bj][m][1] * g1;
                    if (br > 0) { f32x4 p0, p1; unpack8(ld16(merged + (size_t)rowu * 1024 + cu, vM), p0, p1); v0 = v0 + p0; v1 = v1 + p1; }
                    st16(merged + (size_t)rowu * 1024 + cu, vM, pack8(v0, v1)); }
                asm volatile("" ::: "memory"); }
    }
};
struct EpiBranchF { const unsigned char* GQ; bf16_t* merged;
    static constexpr bool AFTER_DRAIN = false; __device__ __forceinline__ void pre(const Unit&, int, int, int, int) const {} __device__ __forceinline__ bool keep_acc(const Unit& u) const { return u.seg < 2; }
    __device__ __forceinline__ void operator()(Acc& acc, const Unit& u, int wr, int wc, int fr, int fq) const {
        const unsigned vG = (unsigned)(fr * 3072 + 8 * fq), vM = (unsigned)(fr * 1024 + 8 * fq) * 2u; const int seg = u.seg;
        const unsigned char* gbase = GQ + (size_t)(u.pm * 256 + wr * 64) * 3072 + seg * 1024 + u.pn * 256 + wc * 32;
        bf16_t* mbase = merged + (size_t)(u.pm * 256 + wr * 64) * 1024 + u.pn * 256 + wc * 32;
#define BF_LOAD(it, G, Hh) do { const size_t ro_ = (size_t)(((it) >> 3) * 128 + (((it) >> 1) & 3) * 16); const int bj_ = (it) & 1; \
            G = *(const u32x2*)(gbase + ro_ * 3072 + bj_ * 128 + vG); Hh = (u32x2){0xffffffffu, 0xffffffffu}; if (seg < 2) Hh = *(const u32x2*)(gbase + ro_ * 3072 + 1024 + bj_ * 128 + vG); } while (0)
        u32x2 gn, hn; BF_LOAD(0, gn, hn);
#pragma unroll
        for (int it = 0; it < 16; ++it) { const int ai = it >> 3, m = (it >> 1) & 3, bj = it & 1; const size_t ro = (size_t)(ai * 128 + m * 16);
            const u32x2 gw = gn, hw = hn;
            if (it + 1 < 16) BF_LOAD(it + 1, gn, hn);
            f32x4 g0, g1;
            if (seg < 2) {
#pragma unroll
                for (int i = 0; i < 4; ++i) { g0[i] = (float)((gw.x >> (8 * i)) & 255u) * __builtin_amdgcn_rcpf((float)((hw.x >> (8 * i)) & 255u));
                                              g1[i] = (float)((gw.y >> (8 * i)) & 255u) * __builtin_amdgcn_rcpf((float)((hw.y >> (8 * i)) & 255u)); }
            } else {
#pragma unroll
                for (int i = 0; i < 4; ++i) { g0[i] = (float)((gw.x >> (8 * i)) & 255u) * (1.0f / 255.0f); g1[i] = (float)((gw.y >> (8 * i)) & 255u) * (1.0f / 255.0f); }
            }
            acc[ai][bj][m][0] = acc[ai][bj][m][0] * g0; acc[ai][bj][m][1] = acc[ai][bj][m][1] * g1;
            if (seg == 2) st16(mbase + ro * 1024 + bj * 128, vM, pack8(acc[ai][bj][m][0], acc[ai][bj][m][1]));
            asm volatile("" ::: "memory"); }
#undef BF_LOAD
    }
};
struct EpiPlain { bf16_t* O; const float* bias; int bias_estride;
    static constexpr bool AFTER_DRAIN = false; __device__ __forceinline__ void pre(const Unit&, int, int, int, int) const {} __device__ __forceinline__ bool keep_acc(const Unit&) const { return false; }
    __device__ __forceinline__ void operator()(const Acc& acc, const Unit& u, int wr, int wc, int fr, int fq) const {
        const unsigned vo = (unsigned)(fr * 1024 + 8 * fq) * 2u;
        f32x4 bv[2][2];
#pragma unroll
        for (int bj = 0; bj < 2; ++bj)
#pragma unroll
            for (int n = 0; n < 2; ++n) bv[bj][n] = bias ? ldf4(bias + (size_t)u.e * bias_estride + u.pn * 256 + bj * 128 + wc * 32 + 4 * n, (unsigned)fq * 32u) : (f32x4){0.f, 0.f, 0.f, 0.f};
#pragma unroll
        for (int ai = 0; ai < 2; ++ai)
#pragma unroll
            for (int m = 0; m < 4; ++m) { const int rowu = u.pm * 256 + ai * 128 + wr * 64 + m * 16;
#pragma unroll
                for (int bj = 0; bj < 2; ++bj) st16(O + (size_t)rowu * 1024 + u.pn * 256 + bj * 128 + wc * 32, vo, pack8(acc[ai][bj][m][0] + bv[bj][0], acc[ai][bj][m][1] + bv[bj][1])); }
    }
};
struct EpiUp { bf16_t* act; const float* bup;
    static constexpr bool AFTER_DRAIN = false; __device__ __forceinline__ void pre(const Unit&, int, int, int, int) const {} __device__ __forceinline__ bool keep_acc(const Unit&) const { return false; }
    __device__ __forceinline__ void operator()(const Acc& acc, const Unit& u, int wr, int wc, int fr, int fq) const {
        const unsigned vo = (unsigned)(fr * 1024 + 8 * fq) * 2u;
        const int ju = u.pn * 128 + wc * 32;
        f32x4 bb[4];
#pragma unroll
        for (int q = 0; q < 4; ++q) { bb[q] = ldf4(bup + (size_t)u.e * 2048 + 2 * ju + 4 * q, (unsigned)fq * 64u); bb[q][1] += 1.0f; bb[q][3] += 1.0f; }
#pragma unroll
        for (int ai = 0; ai < 2; ++ai)
#pragma unroll
            for (int m = 0; m < 4; ++m) { const int rowu = u.pm * 256 + ai * 128 + wr * 64 + m * 16; f32x4 o[2];
#pragma unroll
                for (int n = 0; n < 2; ++n)
#pragma unroll
                    for (int i2 = 0; i2 < 2; ++i2) { const int q = 4 * n + 2 * i2;
                        f32x2 g = (f32x2){acc[ai][0][m][n][2 * i2], acc[ai][0][m][n][2 * i2 + 1]} + (f32x2){bb[q >> 1][0], bb[(q >> 1)][2]};
                        f32x2 l = (f32x2){acc[ai][1][m][n][2 * i2], acc[ai][1][m][n][2 * i2 + 1]} + (f32x2){bb[q >> 1][1], bb[(q >> 1)][3]};
                        g = __builtin_elementwise_min(g, (f32x2){7.0f, 7.0f}); l.x = __builtin_amdgcn_fmed3f(l.x, -6.0f, 8.0f); l.y = __builtin_amdgcn_fmed3f(l.y, -6.0f, 8.0f);
                        const f32x2 t = g * (-1.702f * L2E); const f32x2 d = (f32x2){__builtin_amdgcn_exp2f(t.x), __builtin_amdgcn_exp2f(t.y)} + (f32x2){1.0f, 1.0f};
                        const f32x2 s = (f32x2){__builtin_amdgcn_rcpf(d.x), __builtin_amdgcn_rcpf(d.y)};
                        const f32x2 r = (g * s) * l; o[n][2 * i2] = r.x; o[n][2 * i2 + 1] = r.y; }
                st16(act + (size_t)rowu * 1024 + ju, vo, pack8(o[0], o[1])); }
    }
};
struct EpiYm8 { unsigned char* O; const float* bias;
    mutable f32x4 bv[2][2];
    static constexpr bool AFTER_DRAIN = false;
    __device__ __forceinline__ void pre(const Unit& u, int, int wc, int, int fq) const {
#pragma unroll
        for (int bj = 0; bj < 2; ++bj)
#pragma unroll
            for (int n = 0; n < 2; ++n) bv[bj][n] = ldf4(bias + (size_t)u.e * 1024 + u.pn * 256 + bj * 128 + wc * 32 + 4 * n, (unsigned)fq * 32u); } __device__ __forceinline__ bool keep_acc(const Unit&) const { return false; }
    __device__ __forceinline__ void operator()(const Acc& acc, const Unit& u, int wr, int wc, int fr, int fq) const {
        const unsigned vo = (unsigned)(fr * 1024 + 8 * fq);
#pragma unroll
        for (int ai = 0; ai < 2; ++ai)
#pragma unroll
            for (int m = 0; m < 4; ++m) { const int rowu = u.pm * 256 + ai * 128 + wr * 64 + m * 16;
#pragma unroll
                for (int bj = 0; bj < 2; ++bj) { const f32x4 a = acc[ai][bj][m][0] + bv[bj][0], b = acc[ai][bj][m][1] + bv[bj][1]; u32x2 w;
                    int t = __builtin_amdgcn_cvt_pk_fp8_f32(a[0], a[1], 0, false); t = __builtin_amdgcn_cvt_pk_fp8_f32(a[2], a[3], t, true); w.x = (unsigned)t;
                    t = __builtin_amdgcn_cvt_pk_fp8_f32(b[0], b[1], 0, false); t = __builtin_amdgcn_cvt_pk_fp8_f32(b[2], b[3], t, true); w.y = (unsigned)t;
                    *(u32x2*)(O + (size_t)rowu * 1024 + u.pn * 256 + bj * 128 + wc * 32 + vo) = w; } }
    }
};
}
#include <hip/hip_bf16.h>
#include <cmath>
namespace attn_body {
using bf16=__hip_bfloat16;
using bf16x8=__attribute__((ext_vector_type(8)))short;
using s16x4=__attribute__((ext_vector_type(4)))short;
using f32x16=__attribute__((ext_vector_type(16)))float;
using u32x4=__attribute__((ext_vector_type(4)))unsigned;
constexpr int BATCH=8,NHEAD=8,SEQ=4096,D=64,DM=5120;
constexpr int NW=8,QBLK=32,QB=QBLK*NW,KVBLK=64,NQB=SEQ/QB;
constexpr int ATTN_PITCH=DM, ATTN_UNIT_ROWS=QB;
__device__ __forceinline__ int crow(int r,int hi){return (r&3)+8*(r>>2)+4*hi;}
#define SBAR() __builtin_amdgcn_sched_barrier(0)
__device__ __forceinline__ void cmask(f32x16&p0,f32x16&p1,int jb,int qrel,int hi){
  const float NEG=-INFINITY; int kb=64*jb+4*hi;
  #pragma unroll
  for(int r=0;r<16;++r){int kv=kb+(r&3)+8*(r>>2); if(kv>qrel)p0[r]=NEG; if(kv+32>qrel)p1[r]=NEG;}
}

constexpr int NSLOT=3, SLOTB=8192;
constexpr int LDS_K=0, LDS_V=NSLOT*SLOTB, LDS_WS=2*NSLOT*SLOTB, LDS_OST=LDS_WS+NW*64*4, LDS_BIAS=LDS_OST+NW*4096, LDS_BYTES=LDS_BIAS+SEQ*4;
constexpr float C2=0.125f*1.4426950408889634f;
__device__ __forceinline__ void glds16(const void*gsrc,unsigned lds_dst){unsigned keep;
  asm volatile("s_mov_b32 %0, m0\n\ts_mov_b32 m0, %2\n\ts_nop 0\n\tglobal_load_lds_dwordx4 %1, off\n\ts_mov_b32 m0, %0":"=&s"(keep):"v"(gsrc),"s"(lds_dst):"memory");}
__device__ __forceinline__ float max3f(float a,float b,float c){float r;asm("v_max3_f32 %0, %1, %2, %3":"=v"(r):"v"(a),"v"(b),"v"(c));return r;}
__device__ __forceinline__ float max2f(float a,float b){float r;asm("v_max_f32_e32 %0, %1, %2":"=v"(r):"v"(a),"v"(b));return r;}
__device__ __forceinline__ float fadd_s(float a,float b){float r;asm("v_add_f32_e32 %0, %1, %2":"=v"(r):"v"(a),"v"(b));return r;}
__device__ __forceinline__ float fsub_s(float a,float b){float r;asm("v_sub_f32_e32 %0, %1, %2":"=v"(r):"v"(a),"v"(b));return r;}
typedef float f32x2_t __attribute__((ext_vector_type(2))); typedef __bf16 bf16x2_t __attribute__((ext_vector_type(2)));
__device__ __forceinline__ unsigned cvtpk_s(float lo,float hi){f32x2_t v={lo,hi};bf16x2_t b=__builtin_convertvector(v,bf16x2_t);return __builtin_bit_cast(unsigned,b);}
#define WAIT_BAR(N) asm volatile("s_waitcnt vmcnt(" #N ") lgkmcnt(0)\n\ts_barrier":::"memory")

__device__ __forceinline__ void qkt(f32x16&p0,f32x16&p1,const char*Kslot,const bf16x8*qr,const f32x16&c0in,const f32x16&c1in,int r32,int hi){
  const char*kb=Kslot+hi*1024+r32*16;
  #pragma unroll
  for(int d0=0;d0<4;++d0){
    const bf16x8 b0=*reinterpret_cast<const bf16x8*>(kb+d0*2048);
    const bf16x8 b1=*reinterpret_cast<const bf16x8*>(kb+d0*2048+512);
    if(d0==0){p0=__builtin_amdgcn_mfma_f32_32x32x16_bf16(b0,qr[0],c0in,0,0,0);p1=__builtin_amdgcn_mfma_f32_32x32x16_bf16(b1,qr[0],c1in,0,0,0);}
    else{p0=__builtin_amdgcn_mfma_f32_32x32x16_bf16(b0,qr[d0],p0,0,0,0);p1=__builtin_amdgcn_mfma_f32_32x32x16_bf16(b1,qr[d0],p1,0,0,0);}}
}
typedef __attribute__((address_space(3))) const char* lds_cptr;
typedef short v4i16_t __attribute__((ext_vector_type(4)));
__device__ __forceinline__ void kload8(bf16x8*kf,lds_cptr kp){
  kf[0]=*(const __attribute__((address_space(3))) bf16x8*)(kp);      kf[1]=*(const __attribute__((address_space(3))) bf16x8*)(kp+512);
  kf[2]=*(const __attribute__((address_space(3))) bf16x8*)(kp+2048); kf[3]=*(const __attribute__((address_space(3))) bf16x8*)(kp+2560);
  kf[4]=*(const __attribute__((address_space(3))) bf16x8*)(kp+4096); kf[5]=*(const __attribute__((address_space(3))) bf16x8*)(kp+4608);
  kf[6]=*(const __attribute__((address_space(3))) bf16x8*)(kp+6144); kf[7]=*(const __attribute__((address_space(3))) bf16x8*)(kp+6656);
}
__device__ __forceinline__ void kload2(bf16x8*kf,lds_cptr kp,int j){ kf[2*j]=*(const __attribute__((address_space(3))) bf16x8*)(kp+j*2048); kf[2*j+1]=*(const __attribute__((address_space(3))) bf16x8*)(kp+j*2048+512); }
__device__ __forceinline__ s16x4 vtr(lds_cptr p){ return __builtin_bit_cast(s16x4,__builtin_amdgcn_ds_read_tr16_b64_v4i16((__attribute__((address_space(3))) v4i16_t*)p)); }
__device__ __forceinline__ float rowmax(const f32x16&p0,const f32x16&p1){
  float a=max3f(p0[0],p0[1],p1[0]),b=max3f(p0[2],p0[3],p1[1]);a=max3f(a,p1[2],p1[3]);
  #pragma unroll
  for(int r=4;r<16;r+=4){a=max3f(a,p0[r],p0[r+1]);b=max3f(b,p0[r+2],p0[r+3]);a=max3f(a,p1[r],p1[r+1]);b=max3f(b,p1[r+2],p1[r+3]);}
  const float m=max2f(a,b);
  auto rr=__builtin_amdgcn_permlane32_swap(__float_as_uint(m),__float_as_uint(m),false,false);
  return max2f(__uint_as_float(rr[0]),__uint_as_float(rr[1]));
}
__device__ __forceinline__ void pv(f32x16*o,int vb,bf16x8 pa0,bf16x8 pa1,bf16x8 pa2,bf16x8 pa3){
  #pragma unroll
  for(int d0=0;d0<2;++d0){s16x4 lo[4],hi[4];
    #pragma unroll
    for(int ks=0;ks<4;++ks){
      asm volatile("ds_read_b64_tr_b16 %0,%1 offset:%c2":"=&v"(lo[ks]):"v"(vb),"i"(d0*4096+ks*1024):"memory");
      asm volatile("ds_read_b64_tr_b16 %0,%1 offset:%c2":"=&v"(hi[ks]):"v"(vb),"i"(d0*4096+ks*1024+512):"memory");}
    asm volatile("s_waitcnt lgkmcnt(0)":::"memory");SBAR();
    #define PK(k) (bf16x8){lo[k][0],lo[k][1],lo[k][2],lo[k][3],hi[k][0],hi[k][1],hi[k][2],hi[k][3]}
    o[d0]=__builtin_amdgcn_mfma_f32_32x32x16_bf16(pa0,PK(0),o[d0],0,0,0);
    o[d0]=__builtin_amdgcn_mfma_f32_32x32x16_bf16(pa1,PK(1),o[d0],0,0,0);
    o[d0]=__builtin_amdgcn_mfma_f32_32x32x16_bf16(pa2,PK(2),o[d0],0,0,0);
    o[d0]=__builtin_amdgcn_mfma_f32_32x32x16_bf16(pa3,PK(3),o[d0],0,0,0);
    #undef PK
  }
}

#ifndef ATTN_STORE16
#define ATTN_STORE16(p,v) (*(u32x4*)(p)=(v))
#endif
typedef __attribute__((address_space(3))) const float* lds_fptr; typedef float f32x4_t __attribute__((ext_vector_type(4)));
__device__ __forceinline__ void bias_tuple(f32x16&c0,f32x16&c1,lds_fptr bp,float mhat){
  #pragma unroll
  for(int g=0;g<4;++g){ const f32x4_t x=*(const __attribute__((address_space(3))) f32x4_t*)(bp+8*g), y=*(const __attribute__((address_space(3))) f32x4_t*)(bp+32+8*g);
    #pragma unroll
    for(int i=0;i<4;++i){ c0[4*g+i]=x[i]-mhat; c1[4*g+i]=y[i]-mhat; } }
}
template<int THRL> __device__ __forceinline__ void attn_unit(int b,int h,int qb,const bf16*Q,const bf16*__restrict__ K,const bf16*__restrict__ V,bf16*O,const float*__restrict__ cum,char*shm){
  int tid_=threadIdx.x; asm volatile("":"+v"(tid_));
  const int tid=tid_,lane=tid&63,r32=lane&31,hi=lane>>5; const int wid=__builtin_amdgcn_readfirstlane(tid>>6);
  const long rowbase=(long)b*SEQ; const int q0=qb*QB;
  const bf16*Qw=Q+(rowbase+q0+wid*QBLK)*DM+h*D;
  const bf16*Kh=K+rowbase*DM+h*D,*Vh=V+rowbase*DM+h*D;
  const unsigned lds0=(unsigned)(uintptr_t)shm;
  float*wsf=(float*)(shm+LDS_WS)+wid*64;
  { const float*cb=cum+(long)(b*NHEAD+h)*SEQ; const float cref=cb[q0]; float*bt=(float*)(shm+LDS_BIAS);
    float cv[8];
    _Pragma("unroll") for(int u=0;u<8;++u){const int j=tid+u*NW*64; cv[u]=(j<q0+QB)?cb[j]:0.f;}
    _Pragma("unroll") for(int u=0;u<8;++u){const int j=tid+u*NW*64; if(j<q0+QB)bt[j]=-1.4426950408889634f*(cv[u]-cref);} }
  asm volatile("s_waitcnt lgkmcnt(0)\n\ts_barrier":::"memory");
  int tskip=0;
  { const int NT0=(q0+QB)/KVBLK; const lds_fptr bt0=(lds_fptr)((lds_cptr)shm+LDS_BIAS);
    const float bv=(lane<NT0)?bt0[64*lane+63]:0.f;
    const unsigned long long mk=__ballot(lane<NT0&&bv<-64.f);
    tskip=__builtin_amdgcn_readfirstlane((int)__popcll(mk))&~1; if(tskip>NT0-4)tskip=NT0-4; }
  const lds_fptr btl=(lds_fptr)((lds_cptr)shm+LDS_BIAS)+4*hi+64*tskip;
  const bf16*Khs=Kh+(long)tskip*KVBLK*DM,*Vhs=Vh+(long)tskip*KVBLK*DM;
  const bf16*ksrc=Khs+(long)lane*DM+wid*8;
  const bf16*vsrc=Vhs+(long)(16*(wid&3)+(lane>>2))*DM+(wid>>2)*32+(lane&3)*8;
  const unsigned kdst=lds0+LDS_K+wid*1024, vdst=lds0+LDS_V+wid*1024;
  #define DMA_K(t,slot) glds16(ksrc+(long)(t)*KVBLK*DM,(unsigned)__builtin_amdgcn_readfirstlane(kdst+(slot)))
  #define DMA_V(t,slot) glds16(vsrc+(long)(t)*KVBLK*DM,(unsigned)__builtin_amdgcn_readfirstlane(vdst+(slot)))
  const int vb0=(int)(lds0+LDS_V)+((lane>>4)&1)*32+(lane&3)*8+(4*hi+((lane&15)>>2))*64;
  const char*Kbase=shm+LDS_K; bf16x8 kf[8];
  const lds_cptr shm3=(lds_cptr)shm; const lds_cptr kp0=shm3+LDS_K+hi*1024+r32*16; const lds_cptr vp0=shm3+LDS_V+((lane>>4)&1)*32+(lane&3)*8+(4*hi+((lane&15)>>2))*64;
  const int NT=(q0+QB)/KVBLK-tskip;
  DMA_K(0,0);DMA_V(0,0);DMA_K(1,SLOTB);
  bf16x8 qr[4];
  #pragma unroll
  for(int d0=0;d0<4;++d0)qr[d0]=*reinterpret_cast<const bf16x8*>(&Qw[(long)r32*DM+d0*16+hi*8]);
  float mhat=0.f,l_reg=0.f;f32x16 o[2];o[0]=f32x16{};o[1]=f32x16{};
  const int qrel=wid*QBLK+r32;
  #define CMASK(P0,P1,t) do{int jb_=(t)-(NT-4); if(jb_>=0)cmask(P0,P1,jb_,qrel,hi);}while(0)
  bool resc=false;
  #define START(P0,P1) do{ const float rm=rowmax(P0,P1); resc=false; \
    { const float dl=rm; mhat=fadd_s(mhat,dl); \
      _Pragma("unroll") for(int r=0;r<16;++r){P0[r]=fsub_s(P0[r],dl);P1[r]=fsub_s(P1[r],dl);} \
      } \
    _Pragma("unroll") for(int r=0;r<16;++r)P0[r]=__builtin_amdgcn_exp2f(P0[r]); }while(0)
  #define RESC() do{ if(resc){ asm volatile("s_waitcnt lgkmcnt(0)":::"memory"); \
      _Pragma("unroll") for(int d_=0;d_<2;++d_) _Pragma("unroll") for(int r=0;r<16;++r)o[d_][r]*=wsf[crow(r,hi)]; } }while(0)
  f32x16 pA0,pA1,pB0,pB1;
  int sl_prev=0,sl_cur=0,sl_next=SLOTB;
  #define ROT() do{sl_prev=sl_cur;sl_cur=sl_next;sl_next=(sl_next==(NSLOT-1)*SLOTB)?0:sl_next+SLOTB;}while(0)
  DMA_K(2,2*SLOTB);
  WAIT_BAR(3);
  { f32x16 c0in,c1in; bias_tuple(c0in,c1in,btl,0.f); qkt(pA0,pA1,Kbase,qr,c0in,c1in,r32,hi); } asm volatile("s_nop 15\n\ts_nop 7":"+v"(pA0),"+v"(pA1));CMASK(pA0,pA1,0);
  START(pA0,pA1);
  _Pragma("unroll") for(int r=0;r<16;++r)pA1[r]=__builtin_amdgcn_exp2f(pA1[r]);
  WAIT_BAR(0);
  DMA_K(3,0);DMA_V(1,SLOTB);
  ROT();
  kload8(kf,kp0+sl_cur);
  WAIT_BAR(2);
  s16x4 vlo[8],vhi[8]; u32x4 pw0,pw1,pw2,pw3;
  #define PKW(P,B) cvtpk_s(P[B],P[B+1])
  #define PAF(k) __builtin_bit_cast(bf16x8,pw##k)
  #define VFR(i) (bf16x8){vlo[i][0],vlo[i][1],vlo[i][2],vlo[i][3],vhi[i][0],vhi[i][1],vhi[i][2],vhi[i][3]}
  #define PIN(x) asm volatile("":"+v"(x))
  #define MX3(a,b,c) __builtin_fmaxf(__builtin_fmaxf((a),(b)),(c))
  #define GAPA(MF,A0,A1,A2,A3,W0,W1,PW) do{ MF; sacc+=A0; sacc+=A1; sacc+=A2; sacc+=A3; PIN(sacc); W0; W1; PIN(PW); SBAR(); }while(0)
  #define EX(v) __builtin_amdgcn_exp2f(v)
  #define GAPB(MF,X,B) do{ MF; X[B]=EX(X[B]); X[B+1]=EX(X[B+1]); X[B+2]=EX(X[B+2]); X[B+3]=EX(X[B+3]); PIN(X); SBAR(); }while(0)
  #define VRD(i) do{ vlo[i]=vtr(vp_+(((i)>>2)*4096+((i)&3)*1024)); vhi[i]=vtr(vp_+(((i)>>2)*4096+((i)&3)*1024+512)); }while(0)
  #define KRD(G,j) do{ if(G){ kload2(kf,kp0+sl_next,j); SBAR(); } }while(0)
  #define STEP(C0,C1,P0,P1,t,GK,GV,GL) do{ SBAR(); \
    const lds_cptr vp_=vp0+sl_prev; bias_tuple(C0,C1,btl+(t)*64,mhat); SBAR(); \
    VRD(0); SBAR(); float sacc=(P0[0]+P0[1]); \
    GAPA(C0=__builtin_amdgcn_mfma_f32_32x32x16_bf16(kf[0],qr[0],C0,0,0,0), P0[2],P0[3],P0[4],P0[5],     pw0[0]=PKW(P0,0), pw0[1]=PKW(P0,2), pw0); \
    VRD(4); SBAR(); GAPA(C1=__builtin_amdgcn_mfma_f32_32x32x16_bf16(kf[1],qr[0],C1,0,0,0), P0[6],P0[7],P0[8],P0[9],     pw0[2]=PKW(P0,4), pw0[3]=PKW(P0,6), pw0); \
    VRD(1); SBAR(); GAPA(C0=__builtin_amdgcn_mfma_f32_32x32x16_bf16(kf[2],qr[1],C0,0,0,0),   P0[10],P0[11],P0[12],P0[13], pw1[0]=PKW(P0,8), pw1[1]=PKW(P0,10), pw1); \
    VRD(5); SBAR(); GAPA(C1=__builtin_amdgcn_mfma_f32_32x32x16_bf16(kf[3],qr[1],C1,0,0,0),   P0[14],P0[15],P1[0],P1[1],   pw1[2]=PKW(P0,12),pw1[3]=PKW(P0,14), pw1); \
    VRD(2); SBAR(); GAPA(C0=__builtin_amdgcn_mfma_f32_32x32x16_bf16(kf[4],qr[2],C0,0,0,0),   P1[2],P1[3],P1[4],P1[5],     pw2[0]=PKW(P1,0), pw2[1]=PKW(P1,2), pw2); \
    VRD(6); SBAR(); GAPA(C1=__builtin_amdgcn_mfma_f32_32x32x16_bf16(kf[5],qr[2],C1,0,0,0),   P1[6],P1[7],P1[8],P1[9],     pw2[2]=PKW(P1,4), pw2[3]=PKW(P1,6), pw2); \
    VRD(3); SBAR(); GAPA(C0=__builtin_amdgcn_mfma_f32_32x32x16_bf16(kf[6],qr[3],C0,0,0,0),   P1[10],P1[11],P1[12],P1[13], pw3[0]=PKW(P1,8), pw3[1]=PKW(P1,10), pw3); \
    VRD(7); SBAR(); GAPA(C1=__builtin_amdgcn_mfma_f32_32x32x16_bf16(kf[7],qr[3],C1,0,0,0),   P1[14],P1[15],0.f,0.f,       pw3[2]=PKW(P1,12),pw3[3]=PKW(P1,14), pw3); \
    l_reg+=sacc; \
    if(GK){DMA_K((t)+3,sl_cur);} if(GV){DMA_V((t)+1,sl_next);} \
    CMASK(C0,C1,t); \
    { float a=MX3(C0[0],C0[1],C1[0]),b=MX3(C0[2],C0[3],C1[1]); a=MX3(a,C1[2],C1[3]); \
      _Pragma("unroll") for(int r=4;r<16;r+=4){a=MX3(a,C0[r],C0[r+1]);b=MX3(b,C0[r+2],C0[r+3]);a=MX3(a,C1[r],C1[r+1]);b=MX3(b,C1[r+2],C1[r+3]);} \
      float rm=__builtin_fmaxf(a,b); { auto rr=__builtin_amdgcn_permlane32_swap(__float_as_uint(rm),__float_as_uint(rm),false,false); rm=__builtin_fmaxf(__uint_as_float(rr[0]),__uint_as_float(rr[1])); } \
      resc=false; \
      if(__builtin_expect(__any(rm>(float)THRL),0)){ const float dl=__builtin_fmaxf(rm,0.f); mhat+=dl; \
        _Pragma("unroll") for(int r=0;r<16;++r){C0[r]-=dl;C1[r]-=dl;} \
        const float f=__builtin_amdgcn_exp2f(-dl); l_reg*=f; if(hi==0)wsf[r32]=f; resc=true; } } \
    SBAR(); \
    GAPB(o[0]=__builtin_amdgcn_mfma_f32_32x32x16_bf16(PAF(0),VFR(0),o[0],0,0,0), C0,0); \
    GAPB(o[1]=__builtin_amdgcn_mfma_f32_32x32x16_bf16(PAF(0),VFR(4),o[1],0,0,0), C0,4); \
    KRD(GL,0); GAPB(o[0]=__builtin_amdgcn_mfma_f32_32x32x16_bf16(PAF(1),VFR(1),o[0],0,0,0), C0,8); \
    KRD(GL,1); GAPB(o[1]=__builtin_amdgcn_mfma_f32_32x32x16_bf16(PAF(1),VFR(5),o[1],0,0,0), C0,12); \
    KRD(GL,2); GAPB(o[0]=__builtin_amdgcn_mfma_f32_32x32x16_bf16(PAF(2),VFR(2),o[0],0,0,0), C1,0); \
    KRD(GL,3); GAPB(o[1]=__builtin_amdgcn_mfma_f32_32x32x16_bf16(PAF(2),VFR(6),o[1],0,0,0), C1,4); \
    GAPB(o[0]=__builtin_amdgcn_mfma_f32_32x32x16_bf16(PAF(3),VFR(3),o[0],0,0,0), C1,8); \
    GAPB(o[1]=__builtin_amdgcn_mfma_f32_32x32x16_bf16(PAF(3),VFR(7),o[1],0,0,0), C1,12); \
    }while(0)
  int t=1;
  #undef CMASK
  #define CMASK(P0,P1,t) do{}while(0)
  for(;t+5<NT;t+=2){
    STEP(pB0,pB1,pA0,pA1,t,true,true,true);     WAIT_BAR(2); RESC(); ROT();
    STEP(pA0,pA1,pB0,pB1,t+1,true,true,true);   WAIT_BAR(2); RESC(); ROT();
  }
  #undef CMASK
  #define CMASK(P0,P1,t) do{int jb_=(t)-(NT-4); if(jb_>=0)cmask(P0,P1,jb_,qrel,hi);}while(0)
  #define ENDW(tt) do{ if((tt)+3<NT){WAIT_BAR(2);} else if((tt)+2<NT){WAIT_BAR(1);} else {WAIT_BAR(0);} }while(0)
  for(;t+1<NT;t+=2){
    STEP(pB0,pB1,pA0,pA1,t,(t+3<NT),(t+1<NT),(t+1<NT));       ENDW(t);   RESC(); ROT();
    STEP(pA0,pA1,pB0,pB1,t+1,(t+4<NT),(t+2<NT),(t+2<NT));     ENDW(t+1); RESC(); ROT();
  }
  STEP(pB0,pB1,pA0,pA1,NT-1,false,false,false); RESC();
  { float sacc=pB0[0]+pB0[1]; _Pragma("unroll") for(int r=2;r<16;++r)sacc+=pB0[r]; _Pragma("unroll") for(int r=0;r<16;++r)sacc+=pB1[r]; l_reg+=sacc;
    pw0=(u32x4){PKW(pB0,0),PKW(pB0,2),PKW(pB0,4),PKW(pB0,6)};pw1=(u32x4){PKW(pB0,8),PKW(pB0,10),PKW(pB0,12),PKW(pB0,14)};pw2=(u32x4){PKW(pB1,0),PKW(pB1,2),PKW(pB1,4),PKW(pB1,6)};pw3=(u32x4){PKW(pB1,8),PKW(pB1,10),PKW(pB1,12),PKW(pB1,14)};
    SBAR(); pv(o,vb0+sl_cur,PAF(0),PAF(1),PAF(2),PAF(3)); }
  #undef PKW
  #undef PAF
  #undef VFR
  #undef PIN
  #undef MX3
  #undef GAPA
  #undef GAPB
  #undef EX
  #undef VRD
  #undef KRD
  #undef STEP
  #undef ENDW
  {auto rr=__builtin_amdgcn_permlane32_swap(__float_as_uint(l_reg),__float_as_uint(l_reg),false,false);l_reg=__uint_as_float(rr[0])+__uint_as_float(rr[1]);}
  if(hi==0)wsf[32+r32]=l_reg;asm volatile("s_waitcnt lgkmcnt(0)":::"memory");
  float rli[16];
  #pragma unroll
  for(int r=0;r<16;++r)rli[r]=__builtin_amdgcn_rcpf(wsf[32+crow(r,hi)]);
  bf16*Ow=O+(rowbase+q0+wid*QBLK)*DM+h*D;
  { bf16*stg=(bf16*)(shm+LDS_OST)+wid*2048;
    #pragma unroll
    for(int r=0;r<16;++r){const int orow=crow(r,hi);
      #pragma unroll
      for(int d0=0;d0<2;++d0)stg[orow*64+d0*32+r32]=__float2bfloat16(o[d0][r]*rli[r]);}
    asm volatile("s_waitcnt lgkmcnt(0)":::"memory");
    #pragma unroll
    for(int i=0;i<4;++i){const int row=i*8+(lane>>3),ch=lane&7; const u32x4 v=*(const u32x4*)(stg+row*64+ch*8); ATTN_STORE16(Ow+(long)row*DM+ch*8,v);} }
  asm volatile("s_waitcnt lgkmcnt(0)\n\ts_barrier":::"memory");
  #undef DMA_K
  #undef DMA_V
  #undef CMASK
  #undef START
  #undef RESC
  #undef ROT
}
constexpr int ATTN_LDS_BYTES=LDS_BYTES;
struct AttnTensors { const bf16* Q; const bf16* K; const bf16* V; bf16* O; const float* cum; };
struct AttnUnit { int bh; int qb; };
struct StaticOrder {
  int vcu;
  __device__ __forceinline__ explicit StaticOrder(int grid,int block):vcu((block%8)*(grid/8)+block/8){}
  __device__ __forceinline__ bool next(int i,AttnUnit&u)const{ if(i>=4||vcu>=256)return false; const int s=vcu&3; u.bh=(vcu>>5)*NHEAD+((((vcu>>2)&7)+2*i)&7); u.qb=(i==0)?s:(i==1)?7-s:(i==2)?8+s:15-s; return true; }
  __device__ __forceinline__ void a_ready(const AttnUnit&)const{}
  __device__ __forceinline__ void done(const AttnUnit&)const{}
};
struct QueueOrder {
  unsigned* q; volatile __attribute__((address_space(3))) int* slot;
  __device__ __forceinline__ bool next(int,AttnUnit&u)const{
    if(threadIdx.x==0)slot[0]=(int)__hip_atomic_fetch_add(q,1u,__ATOMIC_RELAXED,__HIP_MEMORY_SCOPE_AGENT);
    asm volatile("s_waitcnt vmcnt(0) lgkmcnt(0)\n\ts_barrier":::"memory");
    const int v=__builtin_amdgcn_readfirstlane(slot[0]);
    asm volatile("s_waitcnt lgkmcnt(0)\n\ts_barrier":::"memory");
    if(v>=128)return false; u.qb=15-(v>>3); u.bh=7-(v&7); return true; }
  __device__ __forceinline__ void a_ready(const AttnUnit&)const{}
  __device__ __forceinline__ void done(const AttnUnit&)const{}
};
template<class Sched,int THRL=8> __device__ __forceinline__ void attn_phase(char*lds,const AttnTensors&T,const Sched&S){
  AttnUnit u;
  for(int i=0;S.next(i,u);++i){ S.a_ready(u); attn_unit<THRL>(u.bh/NHEAD,u.bh%NHEAD,u.qb,T.Q,T.K,T.V,T.O,T.cum,lds); S.done(u); }
}
#undef SBAR
#undef WAIT_BAR
}
constexpr int NWAVES = 8;
constexpr int RING_BYTES = 131072;
constexpr int LDSCTL_BYTES = 4096, RING_OFF = LDSCTL_BYTES;
constexpr int LDS_BYTES = 147456;
constexpr int CW_BAR = 4096;
typedef __attribute__((address_space(1))) unsigned gu32;

#define XB_TMO      128
#define XB_XCNT(j)  (256  + 64 * (j))
#define XB_XSUB(j)  (1280 + 64 * (j))
#define XB_XGEN(j)  (2304 + 64 * (j))
#define XB_TOP      3328
#define XB_TOPGEN   3392
#define XCD_BAR_WORDS 3456
#define XB_SPIN_CAP (1u << 18)
__device__ __forceinline__ unsigned xb_ld(unsigned* p)              { return __hip_atomic_load(p, __ATOMIC_RELAXED, __HIP_MEMORY_SCOPE_AGENT); }
__device__ __forceinline__ unsigned xb_add(unsigned* p, unsigned v) { return __hip_atomic_fetch_add(p, v, __ATOMIC_RELAXED, __HIP_MEMORY_SCOPE_AGENT); }
__device__ __forceinline__ unsigned xb_xcc_id() { return (unsigned)__builtin_amdgcn_s_getreg((3 << 11) | 20) & 0xFu; }
#define XB_SPIN(cond, bar) do { unsigned _sp = 0; while (cond) { __builtin_amdgcn_s_sleep(1); \
    if ((++_sp & 255u) == 0u) { if (xb_ld(&(bar)[XB_TMO])) break; if (_sp > XB_SPIN_CAP) { atomicAdd(&(bar)[XB_TMO], 1u); break; } } } } while (0)
struct XcdBarrier { unsigned* bar; unsigned x; volatile LAS unsigned* st; };
__device__ __forceinline__ XcdBarrier xcd_barrier_post(unsigned* bar, volatile LAS unsigned* st) {
    XcdBarrier b; b.bar = bar; b.x = xb_xcc_id(); b.st = st;
    if (threadIdx.x == 0) (void)xb_add(&bar[XB_XCNT(b.x)], 1u);
    return b;
}
__device__ __forceinline__ void xcd_barrier_complete(unsigned* bar, unsigned x, unsigned& nloc, unsigned& nx) {
    const unsigned G = gridDim.x * gridDim.y * gridDim.z;
    unsigned sum, cnt, mine, sp = 0u;
    for (;;) {
        sum = 0u; cnt = 0u; mine = 0u;
#pragma unroll
        for (unsigned j = 0; j < 16; ++j) { const unsigned c = xb_ld(&bar[XB_XCNT(j)]); sum += c; cnt += (c > 0u) ? 1u : 0u; mine = (j == x) ? c : mine; }
        if (sum == G) break;
        __builtin_amdgcn_s_sleep(1);
        if ((++sp & 255u) == 0u) { if (xb_ld(&bar[XB_TMO])) break; if (sp > XB_SPIN_CAP) { atomicAdd(&bar[XB_TMO], 1u); break; } }
    }
    nloc = mine > 0u ? mine : 1u; nx = cnt > 0u ? cnt : 1u;
}
__device__ __forceinline__ void xcd_barrier(const XcdBarrier& b) {
    asm volatile("s_waitcnt vmcnt(0)" ::: "memory");
    __syncthreads();
    if (threadIdx.x == 0) {
        unsigned* bar = b.bar;
        __builtin_amdgcn_s_waitcnt(0);
        unsigned nloc = b.st[0], nx = b.st[1];
        if (nloc == 0u) { xcd_barrier_complete(bar, b.x, nloc, nx); b.st[0] = nloc; b.st[1] = nx; }
        const unsigned old = xb_add(&bar[XB_XSUB(b.x)], 1u);
        const unsigned gen = old / nloc;
        if (old + 1u == (gen + 1u) * nloc) {
            __builtin_amdgcn_fence(__ATOMIC_RELEASE, "agent");
            asm volatile("s_waitcnt vmcnt(0)" ::: "memory");
            const unsigned og = xb_add(&bar[XB_TOP], 1u);
            const unsigned tg = og / nx;
            if (og + 1u == (tg + 1u) * nx) xb_add(&bar[XB_TOPGEN], 1u);
            else XB_SPIN(xb_ld(&bar[XB_TOPGEN]) == tg, bar);
            __builtin_amdgcn_fence(__ATOMIC_ACQUIRE, "agent");
            xb_add(&bar[XB_XGEN(b.x)], 1u);
            asm volatile("s_waitcnt vmcnt(0)" ::: "memory");
        } else {
            XB_SPIN(xb_ld(&bar[XB_XGEN(b.x)]) == gen, bar);
            __builtin_amdgcn_fence(__ATOMIC_ACQUIRE, "agent");
            asm volatile("s_waitcnt vmcnt(0)" ::: "memory");
        }
    }
    __syncthreads();
}

struct MoeOrder {
    const volatile LAS int* tpre; const unsigned* cnt; const int* tok; const char* A; const char* B; size_t estepB, tstepB, tstepA; int nN, G, c, lda; bool gather;
    int r0x;
    __device__ __forceinline__ bool unit_at(int mt, int pn, pg8::Unit& u) const {
        if (mt >= tpre[32]) return false;
        const int e = __builtin_amdgcn_readfirstlane((int)((volatile LAS unsigned char*)(tpre + 96))[mt]);
        const int lt = __builtin_amdgcn_readfirstlane(mt - tpre[e]);
        const int rem = tpre[33 + e] - lt * 256;
        u.e = e; u.pm = mt; u.pn = pn; u.valid = rem < 256 ? rem : 256; u.lt = lt; u.lda = 1024; u.ldb = 1024; u.nt = 16; u.seg = 0;
        u.B = B + (size_t)e * estepB + (size_t)pn * tstepB;
        u.A = gather ? A : A + (size_t)mt * tstepA;
        return true;
    }
    __device__ __forceinline__ bool next(int i, pg8::Unit& u) const {
        const int x = c & 7, j = c >> 3, per = (G >> 3) / nN, pn = j % nN; int mt = (i * 8 + x) * per + j / nN;
        if (r0x >= 0) { const int k = r0x + 1; mt = mt < k ? mt : (mt < 2 * k ? 32 + (mt - k) : 64 + (mt - 2 * k)); }
        return unit_at(mt, pn, u);
    }
    __device__ __forceinline__ void goff(const pg8::Unit& u, int R0, int C0, unsigned (&off)[2][2]) const {
#pragma unroll
        for (int h = 0; h < 2; ++h)
#pragma unroll
            for (int i = 0; i < 2; ++i) { const int r = h * 128 + R0 + 64 * i; const int t = r < u.valid ? ((const __attribute__((address_space(1))) int*)tok)[(size_t)u.e * NTOK + u.lt * 256 + r] : 0;     off[h][i] = (unsigned)(t * lda + C0) * 2u; }
    }
};
struct MoeOne { MoeOrder M; int mt, pn;
    __device__ __forceinline__ bool next(int i, pg8::Unit& u) const { if (i) return false; return M.unit_at(mt, pn, u); }
    __device__ __forceinline__ void goff(const pg8::Unit& u, int R0, int C0, unsigned (&off)[2][2]) const { M.goff(u, R0, C0, off); }
};
__device__ __forceinline__ void moe_prefix(const unsigned* cnt, volatile LAS int* tpre) {
    int tid = threadIdx.x; asm volatile("" : "+v"(tid));
    if (tid < 64) { const int c = tid < 32 ? (int)cnt[tid * CNT_STRIDE] : 0; const int tl = (c + 255) >> 8; int inc = tl;
#pragma unroll
        for (int o = 1; o < 32; o <<= 1) { const int t = __shfl_up(inc, o); if (tid >= o) inc += t; }
        if (tid < 32) { tpre[tid] = inc - tl; tpre[33 + tid] = c; if (tid == 31) tpre[32] = inc; } }
    __syncthreads();
    { volatile LAS unsigned char* tmap = (volatile LAS unsigned char*)(tpre + 96);
      const int tot = tpre[32];
      for (int mt = tid; mt < tot; mt += NWAVES * 64) { int e = 0;
#pragma unroll
          for (int k = 1; k < 32; ++k) e += (tpre[k] <= mt) ? 1 : 0;
          tmap[mt] = (unsigned char)e; } }
    __syncthreads();
}

constexpr size_t WS_S5W1 = 58 * MiB;
constexpr size_t WS_S5W3 = 66 * MiB;
constexpr size_t WS_S5A16 = 78 * MiB;
constexpr size_t WS_S5S = 2304 * MiB;
constexpr size_t WS_OB = 2320 * MiB;
constexpr size_t WS_GQ = 2640 * MiB;
constexpr size_t WS_END2 = 2736 * MiB;

struct S5Disc { float lr, li, dt, zr, zi; };
__device__ __forceinline__ S5Disc s5_disc(const float* lam_re, const float* lam_im, const float* log_dt, int g, int p) {
    S5Disc d; d.dt = expf(log_dt[g]); d.lr = lam_re[g * 64 + p]; d.li = lam_im[g * 64 + p];
    const float mag = expf(d.lr * d.dt), ar = mag * cosf(d.li * d.dt), ai = mag * sinf(d.li * d.dt), den = d.lr * d.lr + d.li * d.li, nr = ar - 1.0f;
    d.zr = (nr * d.lr + ai * d.li) / den; d.zi = (ai * d.lr - nr * d.li) / den; return d;
}
__device__ __forceinline__ void s5_apow(const S5Disc& d, float n, float& pr, float& pi) { const float mag = expf(d.lr * d.dt * n); pr = mag * cosf(d.li * d.dt * n); pi = mag * sinf(d.li * d.dt * n); }

struct S5In { const float *lam_re, *lam_im, *log_dt, *b_re, *b_im, *c_re, *c_im, *dsk; };
__device__ __forceinline__ void s5_prep_item(const S5In& in, unsigned char* ws, int l, int g, int kind, int q, int lane) {
    const float* lam_re = in.lam_re + (size_t)l * 1024; const float* lam_im = in.lam_im + (size_t)l * 1024; const float* log_dt = in.log_dt + (size_t)l * 16;
    const float* b_re = in.b_re + (size_t)l * 16384; const float* b_im = in.b_im + (size_t)l * 16384; const float* c_re = in.c_re + (size_t)l * 16384; const float* c_im = in.c_im + (size_t)l * 16384;
    const float* dsk = in.dsk + (size_t)l * 256;
    bf16_t* W1 = (bf16_t*)(ws + WS_S5W1) + ((size_t)l * 16 + g) * 256 * 256;
    bf16_t* W3 = (bf16_t*)(ws + WS_S5W3) + ((size_t)l * 16 + g) * 256 * 384;
    const int p = lane;
    const S5Disc d = s5_disc(lam_re, lam_im, log_dt, g, p);
    if (kind == 0) {
        float pr, pi; s5_apow(d, (float)q, pr, pi);
        float mr[16], mi[16];
#pragma unroll
        for (int h = 0; h < 16; ++h) { const float br = b_re[(g * 64 + p) * 16 + h], bi = b_im[(g * 64 + p) * 16 + h]; const float bbr = d.zr * br - d.zi * bi, bbi = d.zr * bi + d.zi * br;
            mr[h] = pr * bbr - pi * bbi; mi[h] = pr * bbi + pi * bbr; }
        float crv[16], civ[16];
#pragma unroll
        for (int hp = 0; hp < 16; ++hp) { crv[hp] = c_re[(g * 16 + hp) * 64 + p]; civ[hp] = c_im[(g * 16 + hp) * 64 + p]; }
#pragma unroll
        for (int hp = 0; hp < 16; ++hp) {
            const float cr = crv[hp], ci = civ[hp];
            float v[16];
#pragma unroll
            for (int h = 0; h < 16; ++h) v[h] = cr * mr[h] - ci * mi[h];
            reduce_scatter<16>(v, lane);
            const int h = (lane >> 2) & 15;
            float kv = v[0]; if (q == 0 && h == hp) kv += dsk[g * 16 + hp];
            const bf16_t kb = f2bf(kv);
            for (int s = (lane & 3); s + q < 16; s += 4) { const int t = s + q;
                W3[(size_t)(t * 16 + hp) * 384 + s * 16 + h] = kb;
                if (q > 0) W3[(size_t)(s * 16 + hp) * 384 + t * 16 + h] = 0; }
        }
    } else if (kind == 1) {
        float pr, pi; s5_apow(d, (float)(15 - q), pr, pi);
        u32x4 wr0, wr1, wi0, wi1; unsigned wr_[8], wi_[8];
#pragma unroll
        for (int h2 = 0; h2 < 8; ++h2) { float re[2], im[2];
#pragma unroll
            for (int e = 0; e < 2; ++e) { const int h = 2 * h2 + e; const float br = b_re[(g * 64 + p) * 16 + h], bi = b_im[(g * 64 + p) * 16 + h]; const float bbr = d.zr * br - d.zi * bi, bbi = d.zr * bi + d.zi * br;
                re[e] = pr * bbr - pi * bbi; im[e] = pr * bbi + pi * bbr; }
            wr_[h2] = pk2(re[0], re[1]); wi_[h2] = pk2(im[0], im[1]); }
        wr0 = (u32x4){wr_[0], wr_[1], wr_[2], wr_[3]}; wr1 = (u32x4){wr_[4], wr_[5], wr_[6], wr_[7]}; wi0 = (u32x4){wi_[0], wi_[1], wi_[2], wi_[3]}; wi1 = (u32x4){wi_[4], wi_[5], wi_[6], wi_[7]};
        *(u32x4*)(W1 + (size_t)p * 256 + q * 16) = wr0; *(u32x4*)(W1 + (size_t)p * 256 + q * 16 + 8) = wr1;
        *(u32x4*)(W1 + (size_t)(64 + p) * 256 + q * 16) = wi0; *(u32x4*)(W1 + (size_t)(64 + p) * 256 + q * 16 + 8) = wi1;
        const u32x4 z = (u32x4){0u, 0u, 0u, 0u};
        *(u32x4*)(W1 + (size_t)(128 + p) * 256 + q * 16) = z; *(u32x4*)(W1 + (size_t)(128 + p) * 256 + q * 16 + 8) = z;
        *(u32x4*)(W1 + (size_t)(192 + p) * 256 + q * 16) = z; *(u32x4*)(W1 + (size_t)(192 + p) * 256 + q * 16 + 8) = z;
    } else {
        float pr, pi; s5_apow(d, (float)(q + 1), pr, pi);
#pragma unroll
        for (int hp = 0; hp < 16; ++hp) { const float cr = c_re[(g * 16 + hp) * 64 + p], ci = c_im[(g * 16 + hp) * 64 + p];
            W3[(size_t)(q * 16 + hp) * 384 + 256 + p] = f2bf(cr * pr - ci * pi);
            W3[(size_t)(q * 16 + hp) * 384 + 320 + p] = f2bf(-(cr * pi + ci * pr)); }
        if (q == 0) { float ar, ai; s5_apow(d, 16.0f, ar, ai); float* A16 = (float*)(ws + WS_S5A16) + (((size_t)l * 16 + g) * 64 + p) * 2; A16[0] = ar; A16[1] = ai; }
    }
}

__device__ __forceinline__ void s5_scan_wg(const float* S, const float* a16, bf16_t* A3, int b, int g, LAS float* sl) {
    int tid = threadIdx.x; asm volatile("" : "+v"(tid));
    const f32x4* src = (const f32x4*)(S + ((size_t)g * 2048 + b * 256) * 128);
#pragma unroll 1
    for (int i0 = tid; i0 < 8192; i0 += 8 * NWAVES * 64) { f32x4 w[8];
#pragma unroll
        for (int u = 0; u < 8; ++u) w[u] = src[i0 + u * NWAVES * 64];
#pragma unroll
        for (int u = 0; u < 8; ++u) *(LAS f32x4*)(sl + 4 * (i0 + u * NWAVES * 64)) = w[u]; }
    __syncthreads();
    if (tid < 64) {
        const int lane = tid; const float ar = a16[(g * 64 + lane) * 2], ai = a16[(g * 64 + lane) * 2 + 1];
        bf16_t* hp = A3 + ((size_t)g * 2048 + b * 256) * 384 + 256 + lane;
        float hr = 0.f, hi = 0.f;
#pragma unroll 8
        for (int c = 0; c < 256; ++c) { const float sr = sl[c * 128 + lane], si = sl[c * 128 + 64 + lane];
            hp[(size_t)c * 384] = f2bf(hr); hp[(size_t)c * 384 + 64] = f2bf(hi);
            const float nr = ar * hr - ai * hi + sr, ni = ar * hi + ai * hr + si; hr = nr; hi = ni; }
        asm volatile("s_waitcnt vmcnt(0)" ::: "memory");
        __builtin_amdgcn_fence(__ATOMIC_ACQUIRE, "agent");
        asm volatile("s_waitcnt vmcnt(0)" ::: "memory");
    }
    __syncthreads();
}

typedef float f32x16p __attribute__((ext_vector_type(16)));
__device__ __forceinline__ void pool_phase(const bf16_t* H, const float* wpool, const float* pscale, bf16_t* yb, int bx, int G, LAS unsigned char* lds) {
    int tid = threadIdx.x; asm volatile("" : "+v"(tid));
    const int lane = tid & 63, w8 = tid >> 6, g = w8 >> 1, tb = (w8 & 1) * 32, r = lane & 31, hi = lane >> 5;
    LAS bf16_t* ut = (LAS bf16_t*)lds; LAS bf16_t* mxb = (LAS bf16_t*)(lds + 79 * 512);
    bf16x8 wf[4][2]; float ps[2];
#pragma unroll
    for (int ks = 0; ks < 4; ++ks)
#pragma unroll
        for (int cb = 0; cb < 2; ++cb) { unsigned pk[4];
#pragma unroll
            for (int j2 = 0; j2 < 4; ++j2) { const float a = wpool[(g * 64 + 16 * ks + 8 * hi + 2 * j2) * 64 + 32 * cb + r], b = wpool[(g * 64 + 16 * ks + 8 * hi + 2 * j2 + 1) * 64 + 32 * cb + r]; pk[j2] = pk2(a, b); }
            wf[ks][cb] = __builtin_bit_cast(bf16x8, (u32x4){pk[0], pk[1], pk[2], pk[3]}); }
    ps[0] = pscale[g * 64 + r]; ps[1] = pscale[g * 64 + 32 + r];
    u32x4 wn[5];
#pragma unroll
    for (int u = 0; u < 5; ++u) { const int c = tid + u * NWAVES * 64; const int rr = c >> 5, ch8 = (c & 31) * 8; const int tok = bx * 64 - 15 + rr; wn[u] = (u32x4){0u, 0u, 0u, 0u}; if (bx < NTOK / 64 && c < 79 * 32 && tok >= 0) wn[u] = *(const GAS u32x4*)((const GAS bf16_t*)H + (size_t)tok * HP + HC_POOL + ch8); }
    for (int item = bx; item < NTOK / 64; item += G) {
        const int t0 = item * 64;
        {
#pragma unroll
          for (int u = 0; u < 5; ++u) { const int c = tid + u * NWAVES * 64; if (c < 79 * 32) *(LAS u32x4*)(ut + (c >> 5) * 256 + (c & 31) * 8) = wn[u]; }
          const int t1 = (item + G) * 64;
#pragma unroll
          for (int u = 0; u < 5; ++u) { const int c = tid + u * NWAVES * 64; const int rr = c >> 5, ch8 = (c & 31) * 8; const int tok = t1 - 15 + rr; wn[u] = (u32x4){0u, 0u, 0u, 0u}; if (item + G < NTOK / 64 && c < 79 * 32 && tok >= 0) wn[u] = *(const GAS u32x4*)((const GAS bf16_t*)H + (size_t)tok * HP + HC_POOL + ch8); } }
        __syncthreads();
        { const int ch = tid & 255, half = tid >> 8, gg = ch >> 6, w = 2 << gg, l0 = half * 32, tf = (t0 + l0) & (SEQ - 1);
          float s = 0.f;
          for (int k = 1; k < w; ++k) if (tf - k >= 0) s += bf2f(ut[(15 + l0 - k) * 256 + ch]);
#pragma unroll 4
          for (int q = 0; q < 32; ++q) { const int lt = l0 + q, t = tf + q; const float u = bf2f(ut[(15 + lt) * 256 + ch]);
              s += u; if (q > 0 && t >= w) s -= bf2f(ut[(15 + lt - w) * 256 + ch]);
              const int cnt = (t + 1 < w) ? t + 1 : w;
              mxb[lt * 264 + ch] = f2bf(s * __builtin_amdgcn_rcpf((float)cnt) - u); } }
        __syncthreads();
        f32x16p acc[2];
#pragma unroll
        for (int cb = 0; cb < 2; ++cb)
#pragma unroll
            for (int q = 0; q < 16; ++q) acc[cb][q] = 0.f;
#pragma unroll
        for (int ks = 0; ks < 4; ++ks) { const bf16x8 a = *(const LAS bf16x8*)(mxb + (tb + r) * 264 + g * 64 + 16 * ks + 8 * hi);
            acc[0] = __builtin_amdgcn_mfma_f32_32x32x16_bf16(a, wf[ks][0], acc[0], 0, 0, 0); acc[1] = __builtin_amdgcn_mfma_f32_32x32x16_bf16(a, wf[ks][1], acc[1], 0, 0, 0); }
#pragma unroll
        for (int cb = 0; cb < 2; ++cb)
#pragma unroll
            for (int q = 0; q < 16; ++q) { const int tok = t0 + tb + (q & 3) + 8 * (q >> 2) + 4 * hi; yb[(size_t)tok * 256 + g * 64 + 32 * cb + r] = f2bf(acc[cb][q] * ps[cb]); }
        __syncthreads();
    }
}

constexpr int WT_PITCH = 1028;
__device__ __forceinline__ void load_wt_lds(const float* W, int ldw, int ne, volatile LAS float* Tv) {
    int tid0 = threadIdx.x; asm volatile("" : "+v"(tid0));
    LAS float* T = (LAS float*)Tv; const int q = ne >> 2, tot = 1024 * q;
    for (int base = tid0; base < tot; base += 8 * NWAVES * 64) {
        f32x4 w[8];
#pragma unroll
        for (int u = 0; u < 8; ++u) { const int idx = base + u * NWAVES * 64; if (idx < tot) { const int k = idx / q, e4 = (idx - k * q) * 4; w[u] = *(const f32x4*)(W + (size_t)k * ldw + e4); } }
#pragma unroll
        for (int u = 0; u < 8; ++u) { const int idx = base + u * NWAVES * 64; if (idx < tot) { const int k = idx / q, e4 = (idx - k * q) * 4;
            T[(e4 + 0) * WT_PITCH + k] = w[u].x; T[(e4 + 1) * WT_PITCH + k] = w[u].y; T[(e4 + 2) * WT_PITCH + k] = w[u].z; T[(e4 + 3) * WT_PITCH + k] = w[u].w; } }
    }
    __syncthreads();
}
__device__ __forceinline__ void wave_sum2(float& a, float& b) {
#pragma unroll
    for (int o = 1; o < 64; o <<= 1) { const float ta = __shfl_xor(a, o), tb = __shfl_xor(b, o); a += ta; b += tb; } }
__device__ __forceinline__ void wave_max2(float a, float b, float& ra, float& rb) {
#pragma unroll
    for (int o = 32; o >= 1; o >>= 1) { const float ta = __shfl_xor(a, o), tb = __shfl_xor(b, o); a = fmaxf(a, ta); b = fmaxf(b, tb); }
    ra = a; rb = b; }
__device__ __forceinline__ void wave_min2(int a, int b, int& ra, int& rb) {
#pragma unroll
    for (int o = 32; o >= 1; o >>= 1) { const int ta = __shfl_xor(a, o), tb = __shfl_xor(b, o); a = ta < a ? ta : a; b = tb < b ? tb : b; }
    ra = a; rb = b; }
__device__ __forceinline__ void row_ln2(f32x4 (&v)[4], f32x4 (&w)[4], const float* g, const float* bta, int lane) {
    f32x4 gg[4], bb[4];
#pragma unroll
    for (int j = 0; j < 4; ++j) { gg[j] = *(const GAS f32x4*)((const GAS float*)g + 4 * (lane + 64 * j)); bb[j] = *(const GAS f32x4*)((const GAS float*)bta + 4 * (lane + 64 * j)); }
    float s = 0.f, t = 0.f;
#pragma unroll
    for (int j = 0; j < 4; ++j) { s += (v[j].x + v[j].y) + (v[j].z + v[j].w); t += (w[j].x + w[j].y) + (w[j].z + w[j].w); }
    wave_sum2(s, t); const float mv = s * (1.f / D), mw = t * (1.f / D); float s2 = 0.f, t2 = 0.f;
#pragma unroll
    for (int j = 0; j < 4; ++j) { v[j] = v[j] - mv; w[j] = w[j] - mw; s2 += (v[j].x * v[j].x + v[j].y * v[j].y) + (v[j].z * v[j].z + v[j].w * v[j].w); t2 += (w[j].x * w[j].x + w[j].y * w[j].y) + (w[j].z * w[j].z + w[j].w * w[j].w); }
    wave_sum2(s2, t2); const float rv = __builtin_amdgcn_rsqf(s2 * (1.f / D) + LN_EPS), rw = __builtin_amdgcn_rsqf(t2 * (1.f / D) + LN_EPS);
#pragma unroll
    for (int j = 0; j < 4; ++j) { v[j] = v[j] * rv * gg[j] + bb[j]; w[j] = w[j] * rw * gg[j] + bb[j]; }
}
__device__ __forceinline__ void row_ln2s(f32x4 (&v)[4], f32x4 (&w)[4], const float* g, const float* bta, int lane, float& mv, float& rv, float& mw, float& rw) {
    f32x4 gg[4], bb[4];
#pragma unroll
    for (int j = 0; j < 4; ++j) { gg[j] = *(const GAS f32x4*)((const GAS float*)g + 4 * (lane + 64 * j)); bb[j] = *(const GAS f32x4*)((const GAS float*)bta + 4 * (lane + 64 * j)); }
    float s = 0.f, t = 0.f;
#pragma unroll
    for (int j = 0; j < 4; ++j) { s += (v[j].x + v[j].y) + (v[j].z + v[j].w); t += (w[j].x + w[j].y) + (w[j].z + w[j].w); }
    wave_sum2(s, t); mv = s * (1.f / D); mw = t * (1.f / D); float s2 = 0.f, t2 = 0.f;
#pragma unroll
    for (int j = 0; j < 4; ++j) { v[j] = v[j] - mv; w[j] = w[j] - mw; s2 += (v[j].x * v[j].x + v[j].y * v[j].y) + (v[j].z * v[j].z + v[j].w * v[j].w); t2 += (w[j].x * w[j].x + w[j].y * w[j].y) + (w[j].z * w[j].z + w[j].w * w[j].w); }
    wave_sum2(s2, t2); rv = __builtin_amdgcn_rsqf(s2 * (1.f / D) + LN_EPS); rw = __builtin_amdgcn_rsqf(t2 * (1.f / D) + LN_EPS);
#pragma unroll
    for (int j = 0; j < 4; ++j) { v[j] = v[j] * rv * gg[j] + bb[j]; w[j] = w[j] * rw * gg[j] + bb[j]; }
}
template <int N> __device__ __forceinline__ void reduce_scatter2(float (&v)[N], float (&w)[N], int lane) {
    int s = 32;
#pragma unroll
    for (int n = N / 2; n >= 1; n >>= 1) {
        const bool up = (lane & s) != 0;
#pragma unroll
        for (int i = 0; i < n; ++i) { float hi = v[i + n], lo = v[i], hj = w[i + n], lj = w[i]; asm volatile("" : "+v"(hi), "+v"(lo), "+v"(hj), "+v"(lj));
            const float kv = up ? hi : lo, sv = up ? lo : hi, kw = up ? hj : lj, sw = up ? lj : hj; v[i] = kv + __shfl_xor(sv, s); w[i] = kw + __shfl_xor(sw, s); }
        s >>= 1;
    }
    for (; s >= 1; s >>= 1) { const float ta = __shfl_xor(v[0], s), tb = __shfl_xor(w[0], s); v[0] += ta; w[0] += tb; }
}
template <int NEX> __device__ __forceinline__ void row_dot2_lds(const f32x4 (&v0)[4], const f32x4 (&v1)[4], const LAS float* T, float (&a0)[NEX], float (&a1)[NEX], int lane) {
#pragma unroll
    for (int e = 0; e < NEX; ++e) { f32x2 p0 = (f32x2){0.f, 0.f}, p1 = (f32x2){0.f, 0.f};
#pragma unroll
        for (int j = 0; j < 4; ++j) { const f32x4 w = *(const LAS f32x4*)(T + e * WT_PITCH + 4 * (lane + 64 * j));
            p0 = __builtin_elementwise_fma((f32x2){v0[j].x, v0[j].y}, (f32x2){w.x, w.y}, p0); p0 = __builtin_elementwise_fma((f32x2){v0[j].z, v0[j].w}, (f32x2){w.z, w.w}, p0);
            p1 = __builtin_elementwise_fma((f32x2){v1[j].x, v1[j].y}, (f32x2){w.x, w.y}, p1); p1 = __builtin_elementwise_fma((f32x2){v1[j].z, v1[j].w}, (f32x2){w.z, w.w}, p1); }
        a0[e] = p0.x + p0.y; a1[e] = p1.x + p1.y;
        if ((e & 3) == 3) { asm volatile("" ::: "memory"); __builtin_amdgcn_sched_barrier(0); } }
}
__device__ __forceinline__ void row_logf_fin(float (&a)[8], const float* bf_l, float* logf, int m, int lane) {
    reduce_scatter<8>(a, lane);
    if ((lane & 7) == 0) { const int h = lane >> 3; const float z = a[0] + ((const GAS float*)bf_l)[h]; const float ls = fminf(z, 0.f) - 0.6931471805599453f * __builtin_amdgcn_logf(1.0f + __builtin_amdgcn_exp2f(-L2E * fabsf(z)));
        const int b = m / SEQ, t = m % SEQ; ((GAS float*)logf)[((size_t)b * 8 + h) * SEQ + t] = ls; }
}
__device__ __forceinline__ void rows0_phase(const float* x, const float* w_in0, const float* bf0, bf16_t* xb, float* logf, volatile LAS float* T, int gw, int NGW, int lane) {
    asm volatile("" : "+v"(lane));
    load_wt_lds(w_in0 + 1536, NIN, 8, T);
    f32x4 n0[4], n1[4];
    if (2 * gw < NTOK) {
#pragma unroll
        for (int j = 0; j < 4; ++j) { n0[j] = *(const GAS f32x4*)((const GAS float*)x + (size_t)(2 * gw) * D + 4 * (lane + 64 * j)); n1[j] = *(const GAS f32x4*)((const GAS float*)x + (size_t)(2 * gw + 1) * D + 4 * (lane + 64 * j)); } }
    for (int m = 2 * gw; m < NTOK; m += 2 * NGW) {
        f32x4 v0[4], v1[4];
#pragma unroll
        for (int j = 0; j < 4; ++j) { v0[j] = n0[j]; v1[j] = n1[j]; }
        { const int mn = m + 2 * NGW; if (mn < NTOK) {
#pragma unroll
            for (int j = 0; j < 4; ++j) { n0[j] = *(const GAS f32x4*)((const GAS float*)x + (size_t)mn * D + 4 * (lane + 64 * j)); n1[j] = *(const GAS f32x4*)((const GAS float*)x + (size_t)(mn + 1) * D + 4 * (lane + 64 * j)); } } }
        float a0[8], a1[8]; row_dot2_lds<8>(v0, v1, (const LAS float*)T, a0, a1, lane);
        row_store_bf16(v0, xb + (size_t)m * D, lane); row_logf_fin(a0, bf0, logf, m, lane);
        row_store_bf16(v1, xb + (size_t)(m + 1) * D, lane); row_logf_fin(a1, bf0, logf, m + 1, lane);
    }
    __syncthreads();
}
__device__ __forceinline__ void rows1_phase(const bf16_t* xinb, const bf16_t* mix, const float* g1, const float* b1, const float* wr, const float* br, bf16_t* x1b, unsigned* cnt, int* tok, int* re, int* rr, float* rg,
                                            volatile LAS float* T, volatile LAS unsigned* lcnt, volatile LAS unsigned* lbase, volatile LAS float* wscr_all, int bx, int G, int wave, int lane) {
    asm volatile("" : "+v"(lane));
    volatile LAS float* wscr = wscr_all + wave * 32;
    const int tid = wave * 64 + lane;
    if (tid < 32) lcnt[tid] = 0u;
    load_wt_lds(wr, 32, 32, T);
    for (int blk = bx; blk < NTOK / 128; blk += G) {
        const int row0 = blk * 128 + wave * 16;
        int my_e = 0; float my_g = 0.f;
#pragma unroll 1
        for (int i = 0; i < 16; i += 2) {
            const int m = row0 + i; f32x4 v0[4], v1[4];
#pragma unroll
            for (int j = 0; j < 4; ++j) { f32x4 xa, xb_; { const u32x2 wa = *(const u32x2*)(xinb + (size_t)m * D + 4 * (lane + 64 * j)), wb = *(const u32x2*)(xinb + (size_t)(m + 1) * D + 4 * (lane + 64 * j));
                    xa.x = __uint_as_float(wa.x << 16); xa.y = __uint_as_float(wa.x & 0xffff0000u); xa.z = __uint_as_float(wa.y << 16); xa.w = __uint_as_float(wa.y & 0xffff0000u); xb_.x = __uint_as_float(wb.x << 16); xb_.y = __uint_as_float(wb.x & 0xffff0000u); xb_.z = __uint_as_float(wb.y << 16); xb_.w = __uint_as_float(wb.y & 0xffff0000u); }
                const u32x2 ma = *(const u32x2*)(mix + (size_t)m * D + 4 * (lane + 64 * j)), mb = *(const u32x2*)(mix + (size_t)(m + 1) * D + 4 * (lane + 64 * j));
                v0[j].x = ALPHA * xa.x + __uint_as_float(ma.x << 16); v0[j].y = ALPHA * xa.y + __uint_as_float(ma.x & 0xffff0000u); v0[j].z = ALPHA * xa.z + __uint_as_float(ma.y << 16); v0[j].w = ALPHA * xa.w + __uint_as_float(ma.y & 0xffff0000u);
                v1[j].x = ALPHA * xb_.x + __uint_as_float(mb.x << 16); v1[j].y = ALPHA * xb_.y + __uint_as_float(mb.x & 0xffff0000u); v1[j].z = ALPHA * xb_.z + __uint_as_float(mb.y << 16); v1[j].w = ALPHA * xb_.w + __uint_as_float(mb.y & 0xffff0000u); }
            row_ln2(v0, v1, g1, b1, lane);
            row_store_bf16(v0, x1b + (size_t)m * D, lane); row_store_bf16(v1, x1b + (size_t)(m + 1) * D, lane);
            float a0[32], a1[32]; row_dot2_lds<32>(v0, v1, (const LAS float*)T, a0, a1, lane);
            reduce_scatter2<32>(a0, a1, lane);
            const int myexp = (lane >> 1) & 31; const float bre = br[myexp]; const float va = a0[0] + bre, vb = a1[0] + bre;
            int ra = 0, rb = 0;
#pragma unroll
            for (int k = 1; k < 32; ++k) { const int oe = (myexp + k) & 31; const float oa = __shfl(va, 2 * oe), ob = __shfl(vb, 2 * oe);
                ra += (oa > va || (oa == va && oe < myexp)) ? 1 : 0; rb += (ob > vb || (ob == vb && oe < myexp)) ? 1 : 0; }
            float ua[4], ub[4]; int ta[4], tb[4];
#pragma unroll
            for (int k = 0; k < 4; ++k) { const unsigned long long ma = __ballot(ra == k), mb = __ballot(rb == k); const int la = __ffsll((long long)ma) - 1, lb = __ffsll((long long)mb) - 1;
                ta[k] = la >> 1; tb[k] = lb >> 1; ua[k] = __shfl(va, la); ub[k] = __shfl(vb, lb); }
            { const float e1 = __builtin_amdgcn_exp2f(L2E * (ua[1] - ua[0])), e2 = __builtin_amdgcn_exp2f(L2E * (ua[2] - ua[0])), e3 = __builtin_amdgcn_exp2f(L2E * (ua[3] - ua[0])); const float inv = 1.0f / (1.0f + e1 + e2 + e3);
              if ((lane >> 2) == i) { const int k = lane & 3; my_e = k == 0 ? ta[0] : k == 1 ? ta[1] : k == 2 ? ta[2] : ta[3]; my_g = (k == 0 ? 1.0f : k == 1 ? e1 : k == 2 ? e2 : e3) * inv; } }
            { const float e1 = __builtin_amdgcn_exp2f(L2E * (ub[1] - ub[0])), e2 = __builtin_amdgcn_exp2f(L2E * (ub[2] - ub[0])), e3 = __builtin_amdgcn_exp2f(L2E * (ub[3] - ub[0])); const float inv = 1.0f / (1.0f + e1 + e2 + e3);
              if ((lane >> 2) == i + 1) { const int k = lane & 3; my_e = k == 0 ? tb[0] : k == 1 ? tb[1] : k == 2 ? tb[2] : tb[3]; my_g = (k == 0 ? 1.0f : k == 1 ? e1 : k == 2 ? e2 : e3) * inv; } }
        }
        const unsigned lrank = __hip_atomic_fetch_add((LAS unsigned*)lcnt + my_e, 1u, __ATOMIC_RELAXED, __HIP_MEMORY_SCOPE_WORKGROUP);
        __syncthreads();
        if (tid < 32) { const unsigned c = lcnt[tid]; lbase[tid] = c ? atomicAdd(cnt + tid * CNT_STRIDE, c) : 0u; }
        __syncthreads();
        { const unsigned rank = lbase[my_e] + lrank; const int m = row0 + (lane >> 2);
          tok[(size_t)my_e * NTOK + rank] = m; re[(size_t)row0 * 4 + lane] = my_e; rr[(size_t)row0 * 4 + lane] = (int)rank; rg[(size_t)row0 * 4 + lane] = my_g; }
        __syncthreads();
        if (tid < 32) lcnt[tid] = 0u;
        __syncthreads();
    }
}
constexpr size_t WS_WRT = 79 * MiB;
constexpr int PW1 = 1032;
__device__ __forceinline__ void router_prep_item(const float* g1, const float* b1, const float* wr, const float* br, unsigned char* ws, int l, int e, int lane) {
    bf16_t* WT = (bf16_t*)(ws + WS_WRT) + (size_t)l * 64 * PW1; float* GB = (float*)(ws + WS_WRT + 768 * 1024) + l * 64;
    float sg = 0.f, sb = 0.f;
#pragma unroll
    for (int j = 0; j < 16; ++j) { const int k = lane + 64 * j; const float w0 = wr[(size_t)l * 1024 * 32 + k * 32 + e], gk = g1[l * 1024 + k], bk = b1[l * 1024 + k]; const float w = w0 * gk;
        const bf16_t hi = f2bf(w); WT[e * PW1 + k] = hi; WT[(32 + e) * PW1 + k] = f2bf(w - bf2f(hi)); sg += w; sb += bk * w0; }
    sg = wave_sum(sg); sb = wave_sum(sb);
    if (lane == 0) { GB[e] = sg; GB[32 + e] = sb + br[l * 32 + e]; }
}
__device__ __forceinline__ void rows1m_phase(const bf16_t* xinb, const bf16_t* mix, const float* g1, const float* b1, const bf16_t* wtg, const float* gbg, bf16_t* x1b, unsigned* cnt, int* tok, int* re, int* rr, float* rg,
                                             LAS unsigned char* ring, volatile LAS unsigned* lcnt, volatile LAS unsigned* lbase, volatile LAS float* gb  , int bx, int G, int wave, int lane) {
    asm volatile("" : "+v"(lane));
    const int tid = wave * 64 + lane;
    LAS bf16_t* WT = (LAS bf16_t*)ring;
    if (tid < 32) lcnt[tid] = 0u;
    { const GAS u32x4* src = (const GAS u32x4*)wtg; constexpr int NV = 64 * PW1 * 2 / 16;
#pragma unroll 1
      for (int i0 = tid; i0 < NV; i0 += 9 * NWAVES * 64) { u32x4 w[9];
#pragma unroll
          for (int u = 0; u < 9; ++u) { const int i = i0 + u * NWAVES * 64; if (i < NV) w[u] = src[i]; }
#pragma unroll
          for (int u = 0; u < 9; ++u) { const int i = i0 + u * NWAVES * 64; if (i < NV) *(LAS u32x4*)(ring + 16 * i) = w[u]; } }
      if (tid < 64) gb[tid] = ((const GAS float*)gbg)[tid]; }
    __syncthreads();
    const int rrow = lane & 15, grp = lane >> 4;
    for (int blk = bx; blk < NTOK / 128; blk += G) {
        const int row0 = blk * 128 + wave * 16;
        float mu_l = 0.f, rs_l = 0.f;
        u32x2 nxa[4], nxb[4], nma[4], nmb[4];
#pragma unroll
        for (int j = 0; j < 4; ++j) { nxa[j] = *(const GAS u32x2*)((const GAS bf16_t*)xinb + (size_t)row0 * D + 4 * (lane + 64 * j)); nxb[j] = *(const GAS u32x2*)((const GAS bf16_t*)xinb + (size_t)(row0 + 1) * D + 4 * (lane + 64 * j));
                                      nma[j] = *(const GAS u32x2*)((const GAS bf16_t*)mix + (size_t)row0 * D + 4 * (lane + 64 * j)); nmb[j] = *(const GAS u32x2*)((const GAS bf16_t*)mix + (size_t)(row0 + 1) * D + 4 * (lane + 64 * j)); }
#pragma unroll 1
        for (int i = 0; i < 16; i += 2) {
            const int m = row0 + i; f32x4 v0[4], v1[4];
            u32x2 cxa[4], cxb[4], cma[4], cmb[4];
#pragma unroll
            for (int j = 0; j < 4; ++j) { cxa[j] = nxa[j]; cxb[j] = nxb[j]; cma[j] = nma[j]; cmb[j] = nmb[j]; }
            if (i + 2 < 16) {
#pragma unroll
                for (int j = 0; j < 4; ++j) { nxa[j] = *(const GAS u32x2*)((const GAS bf16_t*)xinb + (size_t)(m + 2) * D + 4 * (lane + 64 * j)); nxb[j] = *(const GAS u32x2*)((const GAS bf16_t*)xinb + (size_t)(m + 3) * D + 4 * (lane + 64 * j));
                                              nma[j] = *(const GAS u32x2*)((const GAS bf16_t*)mix + (size_t)(m + 2) * D + 4 * (lane + 64 * j)); nmb[j] = *(const GAS u32x2*)((const GAS bf16_t*)mix + (size_t)(m + 3) * D + 4 * (lane + 64 * j)); }
            }
#pragma unroll
            for (int j = 0; j < 4; ++j) { f32x4 xa, xb_; { const u32x2 wa = cxa[j], wb = cxb[j];
                    xa.x = __uint_as_float(wa.x << 16); xa.y = __uint_as_float(wa.x & 0xffff0000u); xa.z = __uint_as_float(wa.y << 16); xa.w = __uint_as_float(wa.y & 0xffff0000u); xb_.x = __uint_as_float(wb.x << 16); xb_.y = __uint_as_float(wb.x & 0xffff0000u); xb_.z = __uint_as_float(wb.y << 16); xb_.w = __uint_as_float(wb.y & 0xffff0000u); }
                const u32x2 ma = cma[j], mb = cmb[j];
                v0[j].x = ALPHA * xa.x + __uint_as_float(ma.x << 16); v0[j].y = ALPHA * xa.y + __uint_as_float(ma.x & 0xffff0000u); v0[j].z = ALPHA * xa.z + __uint_as_float(ma.y << 16); v0[j].w = ALPHA * xa.w + __uint_as_float(ma.y & 0xffff0000u);
                v1[j].x = ALPHA * xb_.x + __uint_as_float(mb.x << 16); v1[j].y = ALPHA * xb_.y + __uint_as_float(mb.x & 0xffff0000u); v1[j].z = ALPHA * xb_.z + __uint_as_float(mb.y << 16); v1[j].w = ALPHA * xb_.w + __uint_as_float(mb.y & 0xffff0000u); }
            float ma_, ra_, mb_, rb_; row_ln2s(v0, v1, g1, b1, lane, ma_, ra_, mb_, rb_);
            row_store_bf16(v0, x1b + (size_t)m * D, lane); row_store_bf16(v1, x1b + (size_t)(m + 1) * D, lane);
            if (rrow == i) { mu_l = ma_; rs_l = ra_; } if (rrow == i + 1) { mu_l = mb_; rs_l = rb_; }
        }
        f32x4 ax[4], am[4];
#pragma unroll
        for (int t = 0; t < 4; ++t) { ax[t] = (f32x4){0.f, 0.f, 0.f, 0.f}; am[t] = (f32x4){0.f, 0.f, 0.f, 0.f}; }
        { const GAS bf16_t* xp = (const GAS bf16_t*)xinb + (size_t)(row0 + rrow) * D + 8 * grp; const GAS bf16_t* mp = (const GAS bf16_t*)mix + (size_t)(row0 + rrow) * D + 8 * grp; const LAS bf16_t* wp = WT + rrow * PW1 + 8 * grp;
#pragma unroll 8
          for (int ks = 0; ks < 32; ++ks) { const bf16x8 fx = *(const GAS bf16x8*)(xp + 32 * ks), fm = *(const GAS bf16x8*)(mp + 32 * ks);
#pragma unroll
              for (int t = 0; t < 4; ++t) { const bf16x8 fw = *(const LAS bf16x8*)(wp + 16 * t * PW1 + 32 * ks);
                  ax[t] = __builtin_amdgcn_mfma_f32_16x16x32_bf16(fw, fx, ax[t], 0, 0, 0); am[t] = __builtin_amdgcn_mfma_f32_16x16x32_bf16(fw, fm, am[t], 0, 0, 0); } } }
        float v[8]; int ev[8];
#pragma unroll
        for (int t = 0; t < 2; ++t)
#pragma unroll
            for (int r = 0; r < 4; ++r) { const int e = 16 * t + 4 * grp + r; const float P = ALPHA * (ax[t][r] + ax[t + 2][r]) + (am[t][r] + am[t + 2][r]);
                v[4 * t + r] = rs_l * (P - mu_l * gb[e]) + gb[32 + e]; ev[4 * t + r] = e; }
        int kk[8], rk[8];
#pragma unroll
        for (int a = 0; a < 8; ++a) { const int bits = (int)__float_as_uint(v[a]); const int mono = bits ^ ((bits >> 31) & 0x7fffffff); kk[a] = (mono & ~31) | (31 - ev[a]); rk[a] = 0; }
#pragma unroll
        for (int a = 0; a < 8; ++a)
#pragma unroll
            for (int b = 0; b < 8; ++b) if (b != a) rk[a] += (kk[b] > kk[a]) ? 1 : 0;
#pragma unroll
        for (int sg = 1; sg < 4; ++sg) {
#pragma unroll
            for (int b = 0; b < 8; ++b) { const int o = __shfl_xor(kk[b], 16 * sg);
#pragma unroll
                for (int a = 0; a < 8; ++a) rk[a] += (o > kk[a]) ? 1 : 0; } }
        float u[4]; int tsel[4];
#pragma unroll
        for (int k = 0; k < 4; ++k) { unsigned se = 0u, sv = 0u;
#pragma unroll
            for (int a = 0; a < 8; ++a) { const bool hit = rk[a] == k; se |= hit ? (unsigned)(ev[a] + 1) : 0u; sv |= hit ? __float_as_uint(v[a]) : 0u; }
            se |= (unsigned)__shfl_xor((int)se, 16); sv |= (unsigned)__shfl_xor((int)sv, 16); se |= (unsigned)__shfl_xor((int)se, 32); sv |= (unsigned)__shfl_xor((int)sv, 32);
            tsel[k] = (int)se - 1; u[k] = __uint_as_float(sv); }
        const float e1 = __builtin_amdgcn_exp2f(L2E * (u[1] - u[0])), e2 = __builtin_amdgcn_exp2f(L2E * (u[2] - u[0])), e3 = __builtin_amdgcn_exp2f(L2E * (u[3] - u[0])); const float inv = 1.0f / (1.0f + e1 + e2 + e3);
        const int my_e = grp == 0 ? tsel[0] : grp == 1 ? tsel[1] : grp == 2 ? tsel[2] : tsel[3]; const float my_g = (grp == 0 ? 1.0f : grp == 1 ? e1 : grp == 2 ? e2 : e3) * inv;
        const unsigned lrank = __hip_atomic_fetch_add((LAS unsigned*)lcnt + my_e, 1u, __ATOMIC_RELAXED, __HIP_MEMORY_SCOPE_WORKGROUP);
        __syncthreads();
        if (tid < 32) { const unsigned c = lcnt[tid]; lbase[tid] = c ? atomicAdd(cnt + tid * CNT_STRIDE, c) : 0u; }
        __syncthreads();
        { const unsigned rank = lbase[my_e] + lrank; const int m = row0 + rrow;
          tok[(size_t)my_e * NTOK + rank] = m; re[(size_t)m * 4 + grp] = my_e; rr[(size_t)m * 4 + grp] = (int)rank; rg[(size_t)m * 4 + grp] = my_g; }
        __syncthreads();
        if (tid < 32) lcnt[tid] = 0u;
        __syncthreads();
    }
}
__device__ __forceinline__ void rows2_phase(const bf16_t* x1b, const unsigned char* ym, const unsigned* cnt, const int* re, const int* rr, const float* rg, const float* g2, const float* b2,
                                            float* xout, bf16_t* xb, const float* w_in_next, const float* bf_next, float* logf, volatile LAS float* T, int gw, int NGW, int lane) {
    asm volatile("" : "+v"(lane));
    int pc = lane < 32 ? (int)((((const GAS unsigned*)cnt)[(lane & 31) * CNT_STRIDE] + 255u) & ~255u) : 0; int inc = pc;
#pragma unroll
    for (int o = 1; o < 32; o <<= 1) { const int t = __shfl_up(inc, o); if (lane >= o) inc += t; }
    const int poff = inc - pc;
    typedef int i32x4 __attribute__((ext_vector_type(4)));
    u32x2 nxa[4], nxb[4]; i32x4 ne0, nr0, ne1, nr1; f32x4 ng0, ng1;
#define R2_FETCH(M) do { _Pragma("unroll") for (int j = 0; j < 4; ++j) { nxa[j] = *(const GAS u32x2*)((const GAS bf16_t*)x1b + (size_t)(M) * D + 4 * (lane + 64 * j)); nxb[j] = *(const GAS u32x2*)((const GAS bf16_t*)x1b + (size_t)((M) + 1) * D + 4 * (lane + 64 * j)); } \
        ne0 = *(const GAS i32x4*)((const GAS int*)re + (size_t)(M) * 4); nr0 = *(const GAS i32x4*)((const GAS int*)rr + (size_t)(M) * 4); ng0 = *(const GAS f32x4*)((const GAS float*)rg + (size_t)(M) * 4); \
        ne1 = *(const GAS i32x4*)((const GAS int*)re + (size_t)((M) + 1) * 4); nr1 = *(const GAS i32x4*)((const GAS int*)rr + (size_t)((M) + 1) * 4); ng1 = *(const GAS f32x4*)((const GAS float*)rg + (size_t)((M) + 1) * 4); } while (0)
    if (2 * gw < NTOK) R2_FETCH(2 * gw);
    if (w_in_next) load_wt_lds(w_in_next + 1536, NIN, 8, T);
    for (int m = 2 * gw; m < NTOK; m += 2 * NGW) {
        f32x4 v0[4], v1[4]; const i32x4 e0 = ne0, r0 = nr0, e1 = ne1, r1 = nr1; const f32x4 g0 = ng0, g1 = ng1;
#pragma unroll
        for (int j = 0; j < 4; ++j) { const u32x2 wa = nxa[j], wb = nxb[j];
            v0[j].x = ALPHA * __uint_as_float(wa.x << 16); v0[j].y = ALPHA * __uint_as_float(wa.x & 0xffff0000u); v0[j].z = ALPHA * __uint_as_float(wa.y << 16); v0[j].w = ALPHA * __uint_as_float(wa.y & 0xffff0000u);
            v1[j].x = ALPHA * __uint_as_float(wb.x << 16); v1[j].y = ALPHA * __uint_as_float(wb.x & 0xffff0000u); v1[j].z = ALPHA * __uint_as_float(wb.y << 16); v1[j].w = ALPHA * __uint_as_float(wb.y & 0xffff0000u); }
        unsigned y0[4][4], y1[4][4];
#pragma unroll
        for (int k = 0; k < 4; ++k) { const int ra = __shfl(poff, e0[k]) + r0[k], rb = __shfl(poff, e1[k]) + r1[k]; const GAS unsigned char* ya = (const GAS unsigned char*)ym + (size_t)ra * 1024; const GAS unsigned char* yb_ = (const GAS unsigned char*)ym + (size_t)rb * 1024;
#pragma unroll
            for (int j = 0; j < 4; ++j) { y0[k][j] = *(const GAS unsigned*)(ya + 4 * (lane + 64 * j)); y1[k][j] = *(const GAS unsigned*)(yb_ + 4 * (lane + 64 * j)); } }
        { const int mn = m + 2 * NGW; if (mn < NTOK) R2_FETCH(mn); }
#pragma unroll
        for (int k = 0; k < 4; ++k)
#pragma unroll
            for (int j = 0; j < 4; ++j) { const int w = (int)y0[k][j], x = (int)y1[k][j]; const f32x2 ga = (f32x2){g0[k], g0[k]}, gb = (f32x2){g1[k], g1[k]};
                const f32x2 a01 = __builtin_elementwise_fma(__builtin_amdgcn_cvt_pk_f32_fp8(w, false), ga, (f32x2){v0[j].x, v0[j].y}), a23 = __builtin_elementwise_fma(__builtin_amdgcn_cvt_pk_f32_fp8(w, true), ga, (f32x2){v0[j].z, v0[j].w});
                const f32x2 b01 = __builtin_elementwise_fma(__builtin_amdgcn_cvt_pk_f32_fp8(x, false), gb, (f32x2){v1[j].x, v1[j].y}), b23 = __builtin_elementwise_fma(__builtin_amdgcn_cvt_pk_f32_fp8(x, true), gb, (f32x2){v1[j].z, v1[j].w});
                v0[j] = (f32x4){a01.x, a01.y, a23.x, a23.y}; v1[j] = (f32x4){b01.x, b01.y, b23.x, b23.y}; }
        row_ln2(v0, v1, g2, b2, lane);
        if (xout) { _Pragma("unroll") for (int j = 0; j < 4; ++j) { *(GAS f32x4*)((GAS float*)xout + (size_t)m * D + 4 * (lane + 64 * j)) = v0[j]; *(GAS f32x4*)((GAS float*)xout + (size_t)(m + 1) * D + 4 * (lane + 64 * j)) = v1[j]; } }
        if (w_in_next) { float a0[8], a1[8]; row_dot2_lds<8>(v0, v1, (const LAS float*)T, a0, a1, lane);
            row_store_bf16(v0, xb + (size_t)m * D, lane); row_logf_fin(a0, bf_next, logf, m, lane);
            row_store_bf16(v1, xb + (size_t)(m + 1) * D, lane); row_logf_fin(a1, bf_next, logf, m + 1, lane); }
    }
#undef R2_FETCH
    __syncthreads();
}
__device__ __forceinline__ void cumsum_block(const float* logf, float* cum, int bh, volatile LAS float* scr) {
    int tid = threadIdx.x; asm volatile("" : "+v"(tid)); const int lane = tid & 63, wv = tid >> 6;
    const float* src = logf + (size_t)bh * SEQ + tid * 8; float* dst = cum + (size_t)bh * SEQ + tid * 8;
    const f32x4 a = *(const f32x4*)src, b = *(const f32x4*)(src + 4);
    float v[8]; v[0] = a.x; v[1] = v[0] + a.y; v[2] = v[1] + a.z; v[3] = v[2] + a.w; v[4] = v[3] + b.x; v[5] = v[4] + b.y; v[6] = v[5] + b.z; v[7] = v[6] + b.w;
    const float s = v[7]; float inc = s;
#pragma unroll
    for (int o = 1; o < 64; o <<= 1) { const float t = __shfl_up(inc, o); if (lane >= o) inc += t; }
    if (lane == 63) scr[wv] = inc;
    __syncthreads();
    float base = inc - s;
    for (int i = 0; i < wv; ++i) base += scr[i];
    f32x4 o0, o1; o0.x = v[0] + base; o0.y = v[1] + base; o0.z = v[2] + base; o0.w = v[3] + base; o1.x = v[4] + base; o1.y = v[5] + base; o1.z = v[6] + base; o1.w = v[7] + base;
    *(f32x4*)dst = o0; *(f32x4*)(dst + 4) = o1;
    __syncthreads();
}

struct S5Order { const char* A; const char* B; size_t bstep; int G, c, ldb, nt;
    __device__ __forceinline__ bool next(int i, pg8::Unit& u) const {
        const int L = i * G + c; if (L >= 128) return false;
        const int g = L >> 3, pm = L & 7;
        u.A = A + ((size_t)g * 2048 + pm * 256) * 384 * 2; u.B = B + (size_t)g * bstep; u.e = g; u.pm = pm; u.pn = 0; u.valid = 256; u.lt = 0; u.lda = 384; u.ldb = ldb; u.nt = nt; u.seg = 0; return true; }
};
struct BranchOrder { pg8::StaticOrder T; const char *A0, *A1, *A2, *B0, *B1, *B2;
    __device__ __forceinline__ bool next(int i, pg8::Unit& u) const {
        const int ti = i / 3, seg = i - 3 * ti;
        if (!T.next(ti, u)) return false;
        u.seg = seg; u.lda = seg == 0 ? HP : 256; u.ldb = seg == 0 ? 512 : 256; u.nt = seg == 0 ? 8 : 4;
        const char *a0 = A0, *a1 = A1, *a2 = A2, *b0 = B0, *b1 = B1, *b2 = B2; asm volatile("" : "+s"(a0), "+s"(a1), "+s"(a2), "+s"(b0), "+s"(b1), "+s"(b2));
        u.A = (seg == 0 ? a0 : seg == 1 ? a1 : a2) + (size_t)u.pm * 256 * u.lda * 2; u.B = (seg == 0 ? b0 : seg == 1 ? b1 : b2) + (size_t)u.pn * 256 * u.ldb * 2; return true; }
};
namespace pg8 {
struct EpiS1 { float* S;
    static constexpr bool AFTER_DRAIN = false; __device__ __forceinline__ void pre(const Unit&, int, int, int, int) const {} __device__ __forceinline__ bool keep_acc(const Unit&) const { return false; }
    __device__ __forceinline__ void operator()(const Acc& acc, const Unit& u, int wr, int wc, int fr, int fq) const {
        const unsigned vo = (unsigned)(fr * 128 + 8 * fq) * 4u;
#pragma unroll
        for (int ai = 0; ai < 2; ++ai)
#pragma unroll
            for (int m = 0; m < 4; ++m) { float* ub = S + ((size_t)u.e * 2048 + u.pm * 256 + ai * 128 + wr * 64 + m * 16) * 128 + wc * 32;
                *(f32x4*)((char*)ub + vo) = acc[ai][0][m][0]; *(f32x4*)((char*)ub + vo + 16) = acc[ai][0][m][1]; }
    }
};
struct EpiS3 { bf16_t* ycp;
    static constexpr bool AFTER_DRAIN = false; __device__ __forceinline__ void pre(const Unit&, int, int, int, int) const {} __device__ __forceinline__ bool keep_acc(const Unit&) const { return false; }
    __device__ __forceinline__ void operator()(const Acc& acc, const Unit& u, int wr, int wc, int fr, int fq) const {
        const unsigned vo = (unsigned)((fr * 16 + (fq >> 1)) * 256 + (fq & 1) * 8) * 2u;
#pragma unroll
        for (int ai = 0; ai < 2; ++ai)
#pragma unroll
            for (int m = 0; m < 4; ++m)
#pragma unroll
                for (int bj = 0; bj < 2; ++bj) { f32x4 v[2] = {acc[ai][bj][m][0], acc[ai][bj][m][1]};
#pragma unroll
                    for (int n = 0; n < 2; ++n)
#pragma unroll
                        for (int i = 0; i < 4; ++i) { const float y = v[n][i]; v[n][i] = y * fsig(1.5957691216057308f * (y + 0.044715f * y * y * y)); }
                    st16(ycp + ((size_t)(u.pm * 256 + ai * 128 + wr * 64 + m * 16) * 16 + bj * 8 + wc * 2) * 256 + u.e * 16, vo, pack8(v[0], v[1])); }
    }
};
}

struct OneUnit { const char* A; const char* B; int pm, lda, ldb, nt;
    __device__ __forceinline__ bool next(int i, pg8::Unit& u) const {
        if (i) return false;
        u.A = A + (size_t)pm * 256 * lda * 2; u.B = B; u.e = 0; u.pm = pm; u.pn = 0; u.valid = 256; u.lt = 0; u.lda = lda; u.ldb = ldb; u.nt = nt; u.seg = 0; return true; }
};
__device__ __forceinline__ void wg_mem_sync() {
    asm volatile("s_waitcnt vmcnt(0)" ::: "memory");
    __syncthreads();
    if (threadIdx.x == 0) { __builtin_amdgcn_fence(__ATOMIC_ACQUIRE, "agent"); asm volatile("s_waitcnt vmcnt(0)" ::: "memory"); }
    __syncthreads();
}
__device__ __forceinline__ void count_in_and_wait(unsigned* ctr, unsigned n, unsigned* bar) {
    asm volatile("s_waitcnt vmcnt(0)" ::: "memory");
    __syncthreads();
    if (threadIdx.x == 0) {
        __builtin_amdgcn_fence(__ATOMIC_RELEASE, "agent");
        asm volatile("s_waitcnt vmcnt(0)" ::: "memory");
        (void)xb_add(ctr, 1u);
        XB_SPIN(xb_ld(ctr) < n, bar);
        __builtin_amdgcn_fence(__ATOMIC_ACQUIRE, "agent");
        asm volatile("s_waitcnt vmcnt(0)" ::: "memory");
    }
    __syncthreads();
}

#ifndef STEP_MASK
#define STEP_MASK 0x1fff
#endif
struct Args {
    const float* in[29]; float* out; unsigned char* ws;
    int step_lo, step_hi;
    int bar_region, pad;
};
constexpr int STEPS_PER_LAYER = 12, N_STEPS = 1 + NL * STEPS_PER_LAYER;

__global__ void __launch_bounds__(NWAVES * 64, 2) mk_fwd(Args a) {
    extern __shared__ __attribute__((aligned(16))) unsigned char lds_raw[];
    LAS unsigned char* lds0 = (LAS unsigned char*)lds_raw;
    LAS unsigned char* lds = lds0 + RING_OFF;
    volatile LAS unsigned* MISC = (volatile LAS unsigned*)lds0;
    const int tid = threadIdx.x, lane = tid & 63, wave = __builtin_amdgcn_readfirstlane(tid >> 6);
    const int G = gridDim.x;
    const int gw = (int)blockIdx.x * NWAVES + wave, NGW = G * NWAVES;
    unsigned char* ws = a.ws;
    for (int u = tid; u < LDSCTL_BYTES / 4; u += NWAVES * 64) ((LAS unsigned*)lds0)[u] = 0u;
    __syncthreads();
    XcdBarrier bar = xcd_barrier_post((unsigned*)(ws + WS_CTL) + CW_BAR + a.bar_region * XCD_BAR_WORDS, MISC + 8);
    const int lo = a.step_lo, hi = a.step_hi;
#define IN(k) (lo <= (k) && (k) < hi)
#define SEAM(k) do { if (IN(k) && IN((k) + 1)) xcd_barrier(bar); } while (0)
#define BX() ({ int b_ = (int)blockIdx.x; asm volatile("" : "+s"(b_)); b_; })
#define GWL() (BX() * NWAVES + wave)
#define WSP(T, off) ({ unsigned char* w_ = ws; asm volatile("" : "+s"(w_)); (T*)(__attribute__((address_space(1))) T*)(w_ + (off)); })
#define ARG_IN(i) ({ const __attribute__((address_space(4))) char* k_ = (const __attribute__((address_space(4))) char*)__builtin_amdgcn_kernarg_segment_ptr(); asm volatile("" : "+s"(k_)); (const float*)(const __attribute__((address_space(1))) float*)*(const float* const __attribute__((address_space(4)))*)(k_ + 8 * (i)); })

    if (IN(0) && (STEP_MASK & 1)) {
        PrepArgs pa; pa.w_in = ARG_IN(1); pa.w_ba = ARG_IN(15); pa.w_bb = ARG_IN(16); pa.w_bc = ARG_IN(17); pa.w_out = ARG_IN(18); pa.w_glu = ARG_IN(13); pa.w_up = ARG_IN(23); pa.w_dn = ARG_IN(25); pa.ws = ws;
        prep_items(pa, (float*)(lds_raw + RING_OFF + wave * 16640), (long)gw, (long)NGW, lane);
        S5In si; si.lam_re = ARG_IN(5); si.lam_im = ARG_IN(6); si.log_dt = ARG_IN(7); si.b_re = ARG_IN(8); si.b_im = ARG_IN(9); si.c_re = ARG_IN(10); si.c_im = ARG_IN(11); si.dsk = ARG_IN(12);
        for (int it = gw; it < NL * 16 * 48; it += NGW) { const int lg = it / 48, r = it % 48; s5_prep_item(si, ws, lg >> 4, lg & 15, r >> 4, r & 15, lane); }
        for (int it = gw; it < NL * 32; it += NGW) router_prep_item(ARG_IN(19), ARG_IN(20), ARG_IN(21), ARG_IN(22), ws, it >> 5, it & 31, lane);
        __syncthreads();
        rows0_phase(ARG_IN(0), ARG_IN(1), ARG_IN(2), WSP(bf16_t, WS_XB), WSP(float, WS_LOGF), (volatile LAS float*)lds, gw, NGW, lane);
    }
    SEAM(0);

    for (int l = 0; l < NL; ++l) {
        const int s0 = 1 + STEPS_PER_LAYER * l;
        unsigned* cnt = (unsigned*)(ws + WS_CTL) + CW_CNT + NE * CNT_STRIDE * l;
        if (IN(s0 + 0) && (STEP_MASK & (2 << 0))) {
            if (BX() < 64) cumsum_block(WSP(float, WS_LOGF), WSP(float, WS_CUM), BX(), (volatile LAS float*)lds);
            bf16_t* H = WSP(bf16_t, WS_H); bf16_t* A3 = WSP(bf16_t, WS_A3);
            pg8::StaticOrder S; S.init(WSP(bf16_t, WS_XB), 1024, WSP(bf16_t, WS_WIN) + (size_t)l * 5120 * 1024, 1024, 1024, NTOK, 5120, G, BX());
            pg8::EpiIn E{H, A3, WSP(unsigned char, WS_GQ)};
            pg8::gemm_phase<false>(lds, S, E);
        }
        SEAM(s0 + 0);
        if (IN(s0 + 1) && (STEP_MASK & (2 << 1))) {
            if (BX() < 128) {
                const int c = BX();
                { S5Order S{(const char*)WSP(bf16_t, WS_A3), (const char*)(WSP(bf16_t, WS_S5W1) + (size_t)l * 16 * 256 * 256), (size_t)256 * 256 * 2, G, c, 256, 4};
                  pg8::EpiS1 E{WSP(float, WS_S5S)};
                  pg8::gemm_phase<false>(lds, S, E); }
                wg_mem_sync();
                s5_scan_wg(WSP(float, WS_S5S), WSP(float, WS_S5A16) + (size_t)l * 16 * 64 * 2, WSP(bf16_t, WS_A3), c & 7, c >> 3, (LAS float*)lds);
                { S5Order S{(const char*)WSP(bf16_t, WS_A3), (const char*)(WSP(bf16_t, WS_S5W3) + (size_t)l * 16 * 256 * 384), (size_t)256 * 384 * 2, G, c, 384, 6};
                  pg8::EpiS3 E{WSP(bf16_t, WS_YCP)};
                  pg8::gemm_phase<false>(lds, S, E); }
                count_in_and_wait((unsigned*)(ws + WS_CTL) + CW_S5C + (l * 8 + (c & 7)) * 32, 16u, bar.bar);
                { bf16_t* YCP = WSP(bf16_t, WS_YCP); bf16_t* YC = WSP(bf16_t, WS_YC);
                  OneUnit S{(const char*)YCP, (const char*)(WSP(bf16_t, WS_WGLU) + (size_t)l * 65536), (c & 7) * 16 + (c >> 3), 256, 256, 4};
                  pg8::EpiGlu E{YCP, ARG_IN(14) + (size_t)l * 256, YC};
                  pg8::gemm_phase<false>(lds, S, E); }
                __syncthreads();
            }
            {
                bf16_t* H = WSP(bf16_t, WS_H); const float* CUM = WSP(float, WS_CUM);
                const attn_body::AttnTensors AT{(const attn_body::bf16*)(H + HC_Q), (const attn_body::bf16*)(H + HC_K), (const attn_body::bf16*)(H + HC_V), (attn_body::bf16*)WSP(bf16_t, WS_OB), CUM};
                const int vcu = (G % 8 == 0) ? (BX() % 8) * (G / 8) + BX() / 8 : BX(); const int batch = (vcu * 8 / G) & 7;
                attn_body::QueueOrder S{(unsigned*)(ws + WS_CTL) + CW_ATTQ + a.pad * 1024 + (l * 8 + batch) * 32, (volatile LAS int*)(MISC + 60)};
                attn_body::AttnTensors ATb = AT; ATb.Q += (size_t)batch * SEQ * HP; ATb.K += (size_t)batch * SEQ * HP; ATb.V += (size_t)batch * SEQ * HP; ATb.O += (size_t)batch * SEQ * HP; ATb.cum += (size_t)batch * 8 * SEQ;
                attn_body::attn_phase<attn_body::QueueOrder>((char*)lds_raw + RING_OFF, ATb, S);
            }
            __syncthreads();
            {
                const bf16_t* H = WSP(bf16_t, WS_H); const float* wpool = ARG_IN(3) + (size_t)l * 4 * 64 * 64; const float* pscale = ARG_IN(4) + (size_t)l * 256; bf16_t* YB = WSP(bf16_t, WS_YB);
                pool_phase(H, wpool, pscale, YB, BX(), G, lds);
            }
        }
        SEAM(s0 + 5);
        if (IN(s0 + 6) && (STEP_MASK & (2 << 6))) {
            bf16_t* H = WSP(bf16_t, WS_H); bf16_t* MERGED = WSP(bf16_t, WS_MERGED); bf16_t* YB = WSP(bf16_t, WS_YB); bf16_t* YC = WSP(bf16_t, WS_YC);
            BranchOrder S; S.T.init(nullptr, 0, nullptr, 0, 128, NTOK, 1024, G, BX());
            S.A0 = (const char*)WSP(bf16_t, WS_OB); S.A1 = (const char*)YB; S.A2 = (const char*)YC;
            S.B0 = (const char*)(WSP(bf16_t, WS_WBA) + (size_t)l * 1024 * 512); S.B1 = (const char*)(WSP(bf16_t, WS_WBB) + (size_t)l * 1024 * 256); S.B2 = (const char*)(WSP(bf16_t, WS_WBC) + (size_t)l * 1024 * 256);
            pg8::EpiBranchF E{WSP(unsigned char, WS_GQ), MERGED};
            pg8::gemm_phase<false>(lds, S, E);
        }
        SEAM(s0 + 6);
        if (IN(s0 + 7) && (STEP_MASK & (2 << 7))) {
            bf16_t* MERGED = WSP(bf16_t, WS_MERGED); bf16_t* MIX = WSP(bf16_t, WS_MIX);
            pg8::StaticOrder S; S.init(MERGED, 1024, WSP(bf16_t, WS_WOUT) + (size_t)l * 1024 * 1024, 1024, 1024, NTOK, 1024, G, BX());
            pg8::EpiPlain E{MIX, nullptr, 0};
            pg8::gemm_phase<false>(lds, S, E);
        }
        SEAM(s0 + 7);
        if (IN(s0 + 8) && (STEP_MASK & (2 << 8))) {
            const int dm = a.pad;
            rows1m_phase(WSP(bf16_t, WS_XB), WSP(bf16_t, WS_MIX), ARG_IN(19) + (size_t)l * D, ARG_IN(20) + (size_t)l * D, WSP(bf16_t, WS_WRT) + (size_t)l * 64 * PW1, WSP(float, WS_WRT + 768 * 1024) + l * 64,
                        WSP(bf16_t, WS_X1B), dm ? cnt + 4096 * dm : cnt, dm ? WSP(int, WS_OB) : WSP(int, WS_TOK), dm ? WSP(int, WS_OB + 8 * MiB) : WSP(int, WS_RE), dm ? WSP(int, WS_OB + 9 * MiB) : WSP(int, WS_RR), dm ? WSP(float, WS_OB + 10 * MiB) : WSP(float, WS_RG),
                        lds, MISC + 64, MISC + 96, (volatile LAS float*)(MISC + 256), BX(), G, wave, lane);
        }
        SEAM(s0 + 8);
        const bool fillok = (G == 256);
        if (IN(s0 + 9) && (STEP_MASK & (2 << 9))) {
            const int* TOK = WSP(int, WS_TOK); bf16_t* X1B = WSP(bf16_t, WS_X1B); bf16_t* ACT = WSP(bf16_t, WS_ACT);
            moe_prefix(cnt, (volatile LAS int*)(MISC + 16));
            { MoeOrder S{(const volatile LAS int*)(MISC + 16), cnt, TOK, (const char*)X1B, (const char*)(WSP(bf16_t, WS_WUP) + (size_t)l * NE * 2048 * 1024), (size_t)2048 * 1024 * 2, (size_t)256 * 1024 * 2, (size_t)256 * 1024 * 2, 8, G, BX(), 1024, true, -1};
              pg8::EpiUp E{ACT, ARG_IN(24) + (size_t)l * NE * 2048};
              pg8::gemm_phase<true>(lds, S, E); }
            if (fillok) {
                const int c = BX(), ga = 4 * (c & 7) + (c >> 6), p8 = (c >> 3) & 7, r0 = (((volatile LAS int*)(MISC + 16))[32] - 1) & 31;
                if (ga > r0) {
                    count_in_and_wait((unsigned*)(ws + WS_CTL) + CW_MOEF + (l * 32 + ga) * 32, 8u, bar.bar);
                    MoeOrder D{(const volatile LAS int*)(MISC + 16), cnt, TOK, (const char*)WSP(bf16_t, WS_ACT), (const char*)(WSP(bf16_t, WS_WDN) + (size_t)l * NE * 1024 * 1024), (size_t)1024 * 1024 * 2, (size_t)256 * 1024 * 2, (size_t)256 * 1024 * 2, 4, G, c, 1024, false, -1};
                    MoeOne S1{D, p8 < 4 ? ga : 32 + ga, p8 & 3};
                    pg8::EpiYm8 E2{(unsigned char*)WSP(bf16_t, WS_YM), ARG_IN(26) + (size_t)l * NE * 1024};
                    pg8::gemm_phase<false>(lds, S1, E2);
                }
            }
        }
        SEAM(s0 + 9);
        if (IN(s0 + 10) && (STEP_MASK & (2 << 10))) {
            const int* TOK = WSP(int, WS_TOK); bf16_t* ACT = WSP(bf16_t, WS_ACT); bf16_t* YM = WSP(bf16_t, WS_YM);
            if (!(IN(s0 + 9) && (STEP_MASK & (2 << 9)))) moe_prefix(cnt, (volatile LAS int*)(MISC + 16));
            const int r0 = fillok ? ((((volatile LAS int*)(MISC + 16))[32] - 1) & 31) : -1;
            MoeOrder S{(const volatile LAS int*)(MISC + 16), cnt, TOK, (const char*)ACT, (const char*)(WSP(bf16_t, WS_WDN) + (size_t)l * NE * 1024 * 1024), (size_t)1024 * 1024 * 2, (size_t)256 * 1024 * 2, (size_t)256 * 1024 * 2, 4, G, BX(), 1024, false, r0};
            pg8::EpiYm8 E{(unsigned char*)YM, ARG_IN(26) + (size_t)l * NE * 1024};
            pg8::gemm_phase<false>(lds, S, E);
        }
        SEAM(s0 + 10);
        if (IN(s0 + 11) && (STEP_MASK & (2 << 11))) {
            const bool last = (l == NL - 1);
            rows2_phase(WSP(bf16_t, WS_X1B), WSP(unsigned char, WS_YM), cnt, WSP(int, WS_RE), WSP(int, WS_RR), WSP(float, WS_RG), ARG_IN(27) + (size_t)l * D, ARG_IN(28) + (size_t)l * D,
                        last ? a.out : (float*)nullptr, WSP(bf16_t, WS_XB), last ? (const float*)nullptr : ARG_IN(1) + (size_t)(l + 1) * D * NIN, last ? (const float*)nullptr : ARG_IN(2) + (size_t)(l + 1) * 8,
                        WSP(float, WS_LOGF), (volatile LAS float*)lds, GWL(), NGW, lane);
        }
        SEAM(s0 + 11);
    }
#undef IN
#undef SEAM
}

#ifndef MK_MODE
#define MK_MODE 0
#endif
extern "C" void kernel_launch(void* const* d_in, const int* in_sizes, int n_in, void* d_out, int out_size, void* d_ws, size_t ws_size, hipStream_t stream) {
    if (n_in != 29 || out_size != NTOK * D || ws_size < WS_END2) { fprintf(stderr, "kernel_launch: unexpected shapes (n_in %d out %d ws %zu)\n", n_in, out_size, ws_size); return; }
    static int grid = 0;
    if (grid == 0) {
        int dev = 0, cus = 0;
        if (hipGetDevice(&dev) != hipSuccess || hipDeviceGetAttribute(&cus, hipDeviceAttributeMultiprocessorCount, dev) != hipSuccess) { fprintf(stderr, "kernel_launch: device query failed\n"); grid = -1; return; }
        if (hipFuncSetAttribute((const void*)mk_fwd, hipFuncAttributeMaxDynamicSharedMemorySize, LDS_BYTES) != hipSuccess) { fprintf(stderr, "kernel_launch: hipFuncSetAttribute failed\n"); grid = -1; return; }
        int per_cu = 0;
        if (hipOccupancyMaxActiveBlocksPerMultiprocessor(&per_cu, (const void*)mk_fwd, NWAVES * 64, LDS_BYTES) != hipSuccess || per_cu < 1) fprintf(stderr, "kernel_launch: occupancy query reports %d workgroups per CU\n", per_cu);
        (void)hipGetLastError();
        grid = cus;
    }
    if (grid < 0) return;
    unsigned char* ws = (unsigned char*)d_ws;
    (void)hipMemsetAsync(ws + WS_CTL, 0, 1 * MiB, stream);
    Args a{}; for (int i = 0; i < 29; ++i) a.in[i] = (const float*)d_in[i]; a.out = (float*)d_out; a.ws = ws;
#if MK_MODE == 0
    a.step_lo = 0; a.step_hi = N_STEPS; a.bar_region = 0;
    hipLaunchKernelGGL(mk_fwd, dim3(grid), dim3(NWAVES * 64), LDS_BYTES, stream, a);
#elif MK_MODE == 1
    for (int s = 0; s < N_STEPS; ++s) { Args b = a; b.step_lo = s; b.step_hi = s + 1; b.bar_region = s; hipLaunchKernelGGL(mk_fwd, dim3(grid), dim3(NWAVES * 64), LDS_BYTES, stream, b); }
#else
    for (int s = 0; s < N_STEPS; ++s) { const int bit = s == 0 ? 0 : 1 + (s - 1) % STEPS_PER_LAYER; const int rep = ((PROBE_MASK >> bit) & 1) ? PROBE_REP : 1;
        for (int r = 0; r < rep; ++r) { Args b = a; b.step_lo = s; b.step_hi = s + 1; b.bar_region = s; b.pad = (bit == 9 || bit == 2) ? r : 0; hipLaunchKernelGGL(mk_fwd, dim3(grid), dim3(NWAVES * 64), LDS_BYTES, stream, b); } }
#endif
}
```

```cpp
#include <hip/hip_runtime.h>
#include <cstdint>
#include <cstdio>
#include <cmath>

typedef unsigned short bf16_t;
typedef short bf16x8 __attribute__((ext_vector_type(8)));
typedef float f32x4 __attribute__((ext_vector_type(4)));
typedef float f32x2 __attribute__((ext_vector_type(2)));
typedef unsigned u32x4 __attribute__((ext_vector_type(4)));
typedef unsigned u32x2 __attribute__((ext_vector_type(2)));

constexpr int D = 1024, NB = 8, SEQ = 4096, NTOK = NB * SEQ, NL = 4;
constexpr int NIN = 5128, HP = 5120;
constexpr int NE = 32, TOPK = 4;
constexpr int MOE_ROWS = 139264;
constexpr float C2 = 0.125f * 1.4426950408889634f;
constexpr float L2E = 1.4426950408889634f;
constexpr float ALPHA = 1.681792830507429f;
constexpr float LN_EPS = 1e-5f;
constexpr int HC_Q = 0, HC_K = 512, HC_V = 1024, HC_POOL = 1536, HC_SSM = 1792, HC_G = 2048;

constexpr size_t MiB = 1u << 20;
constexpr size_t WS_CTL = 0;
constexpr size_t WS_WIN = 1 * MiB;
constexpr size_t WS_WBA = 41 * MiB;
constexpr size_t WS_WBB = 45 * MiB;
constexpr size_t WS_WBC = 47 * MiB;
constexpr size_t WS_WOUT = 49 * MiB;
constexpr size_t WS_WGLU = 57 * MiB;
constexpr size_t WS_WUP = 80 * MiB;
constexpr size_t WS_WDN = 592 * MiB;
constexpr size_t WS_XA = 848 * MiB;
constexpr size_t WS_X1 = 976 * MiB;
constexpr size_t WS_XB = 1104 * MiB;
constexpr size_t WS_X1B = 1168 * MiB;
constexpr size_t WS_H = 1232 * MiB;
constexpr size_t WS_A3 = 1552 * MiB;
constexpr size_t WS_MERGED = 1576 * MiB;
constexpr size_t WS_MIX = 1640 * MiB;
constexpr size_t WS_YB = 1704 * MiB;
constexpr size_t WS_YCP = 1720 * MiB;
constexpr size_t WS_YC = 1736 * MiB;
constexpr size_t WS_LOGF = 1752 * MiB;
constexpr size_t WS_CUM = 1753 * MiB;
constexpr size_t WS_TOK = 1754 * MiB;
constexpr size_t WS_RE = 1758 * MiB;
constexpr size_t WS_RR = WS_RE + 512 * 1024;
constexpr size_t WS_RG = WS_RR + 512 * 1024;
constexpr size_t WS_ACT = 1760 * MiB;
constexpr size_t WS_YM = 2032 * MiB;
constexpr size_t WS_END = 2304 * MiB;
constexpr int CW_MOEF = 238592;
constexpr int CW_S5C = 237568;
constexpr int CW_ATTQ = 229376;
constexpr int CW_CNT = 200704, CNT_STRIDE = 32;

__device__ __forceinline__ float bf2f(bf16_t b) { return __uint_as_float((unsigned)b << 16); }
__device__ __forceinline__ bf16_t f2bf(float f) { unsigned u = __float_as_uint(f); return (bf16_t)((u + 0x7fffu + ((u >> 16) & 1u)) >> 16); }
__device__ __forceinline__ unsigned pk2(float lo, float hi) { unsigned r; asm("v_cvt_pk_bf16_f32 %0, %1, %2" : "=v"(r) : "v"(lo), "v"(hi)); return r; }
__device__ __forceinline__ float sigmoidf_(float x) { return 1.0f / (1.0f + __expf(-x)); }
__device__ __forceinline__ float wave_sum(float v) {
#pragma unroll
    for (int o = 1; o < 64; o <<= 1) v += __shfl_xor(v, o);
    return v;
}
__device__ __forceinline__ float wave_max_f(float v) {
#pragma unroll
    for (int o = 32; o >= 1; o >>= 1) v = fmaxf(v, __shfl_xor(v, o));
    return v; }
__device__ __forceinline__ int wave_min_i(int v) {
#pragma unroll
    for (int o = 32; o >= 1; o >>= 1) { const int t = __shfl_xor(v, o); v = t < v ? t : v; }
    return v; }
template <int N> __device__ __forceinline__ void reduce_scatter(float (&v)[N], int lane) {
    int s = 32;
#pragma unroll
    for (int n = N / 2; n >= 1; n >>= 1) {
        const bool up = (lane & s) != 0;
#pragma unroll
        for (int i = 0; i < n; ++i) { float hi = v[i + n], lo = v[i]; asm volatile("" : "+v"(hi), "+v"(lo));
            const float keep = up ? hi : lo, send = up ? lo : hi; v[i] = keep + __shfl_xor(send, s); }
        s >>= 1;
    }
    for (; s >= 1; s >>= 1) v[0] += __shfl_xor(v[0], s);
}

__device__ __forceinline__ int dst_row(int mode, int c) {
    if (mode == 1) return c < 1536 ? c : (c < 1544 ? -1 : c - 8);
    if (mode == 2) { const int j = c >> 1, bj = c & 1; return (j >> 7) * 256 + bj * 128 + (j & 127); }
    return c;
}
__device__ __forceinline__ void transpose_item(const float* W, int Nsrc, int K, int Ndst, bf16_t* WT, int mode, float* scr, int item, int lane) {
    (void)Ndst;
    const int nkb = K / 64, nb = item / nkb, kb = item % nkb, k0 = 64 * kb, c0 = 64 * nb;
    const bool cin = (c0 + lane) < Nsrc;
    const float* src = W + (size_t)k0 * Nsrc + c0 + (cin ? lane : 0);
#pragma unroll 16
    for (int kk = 0; kk < 64; ++kk) scr[kk * 65 + lane] = __builtin_nontemporal_load(src + (size_t)kk * Nsrc);
    asm volatile("s_waitcnt lgkmcnt(0)" ::: "memory");
    const int c8 = lane & 7;
#pragma unroll
    for (int i = 0; i < 8; ++i) { const int col = (lane >> 3) + 8 * i; const int n = (c0 + col) < Nsrc ? dst_row(mode, c0 + col) : -1; const float* s = scr + (8 * c8) * 65 + col;
        const float sc = (mode == 1 && n >= 2048) ? -L2E : 1.0f;
        u32x4 o; o.x = pk2(s[0 * 65] * sc, s[1 * 65] * sc); o.y = pk2(s[2 * 65] * sc, s[3 * 65] * sc); o.z = pk2(s[4 * 65] * sc, s[5 * 65] * sc); o.w = pk2(s[6 * 65] * sc, s[7 * 65] * sc);
        if (n >= 0) __builtin_nontemporal_store(o, (u32x4*)(WT + (size_t)n * K + k0 + 8 * c8)); }
    asm volatile("s_waitcnt lgkmcnt(0)" ::: "memory");
}
struct PrepArgs { const float *w_in, *w_ba, *w_bb, *w_bc, *w_out, *w_glu, *w_up, *w_dn; unsigned char* ws; };
__device__ __forceinline__ void prep_items(const PrepArgs& a, float* scr, long gw, long NGW, int lane) {
    constexpr long I_IN = (1024 / 64) * ((NIN + 63) / 64), I_BA = (512 / 64) * (1024 / 64), I_BB = (256 / 64) * (1024 / 64), I_OUT = (1024 / 64) * (1024 / 64), I_GLU = (256 / 64) * (256 / 64);
    constexpr long I_UP = (1024 / 64) * (2048 / 64), I_DN = (1024 / 64) * (1024 / 64);
    constexpr long T_IN = NL * I_IN, T_BA = NL * I_BA, T_BB = NL * I_BB, T_OUT = NL * I_OUT, T_GLU = NL * I_GLU, T_UP = (long)NL * NE * I_UP, T_DN = (long)NL * NE * I_DN;
    constexpr long TOTAL = T_IN + T_BA + 2 * T_BB + T_OUT + T_GLU + T_UP + T_DN;
    for (long it = gw; it < TOTAL; it += NGW) {
        long r = it;
        if (r < T_UP) { const int inst = (int)(r / I_UP), item = (int)(r % I_UP); transpose_item(a.w_up + (size_t)inst * 1024 * 2048, 2048, 1024, 2048, (bf16_t*)(a.ws + WS_WUP) + (size_t)inst * 2048 * 1024, 2, scr, item, lane); continue; } r -= T_UP;
        if (r < T_DN) { const int inst = (int)(r / I_DN), item = (int)(r % I_DN); transpose_item(a.w_dn + (size_t)inst * 1024 * 1024, 1024, 1024, 1024, (bf16_t*)(a.ws + WS_WDN) + (size_t)inst * 1024 * 1024, 0, scr, item, lane); continue; } r -= T_DN;
        if (r < T_IN) { const int inst = (int)(r / I_IN), item = (int)(r % I_IN); transpose_item(a.w_in + (size_t)inst * 1024 * NIN, NIN, 1024, 5120, (bf16_t*)(a.ws + WS_WIN) + (size_t)inst * 5120 * 1024, 1, scr, item, lane); continue; } r -= T_IN;
        if (r < T_BA) { const int inst = (int)(r / I_BA), item = (int)(r % I_BA); transpose_item(a.w_ba + (size_t)inst * 512 * 1024, 1024, 512, 1024, (bf16_t*)(a.ws + WS_WBA) + (size_t)inst * 1024 * 512, 0, scr, item, lane); continue; } r -= T_BA;
        if (r < T_BB) { const int inst = (int)(r / I_BB), item = (int)(r % I_BB); transpose_item(a.w_bb + (size_t)inst * 256 * 1024, 1024, 256, 1024, (bf16_t*)(a.ws + WS_WBB) + (size_t)inst * 1024 * 256, 0, scr, item, lane); continue; } r -= T_BB;
        if (r < T_BB) { const int inst = (int)(r / I_BB), item = (int)(r % I_BB); transpose_item(a.w_bc + (size_t)inst * 256 * 1024, 1024, 256, 1024, (bf16_t*)(a.ws + WS_WBC) + (size_t)inst * 1024 * 256, 0, scr, item, lane); continue; } r -= T_BB;
        if (r < T_OUT) { const int inst = (int)(r / I_OUT), item = (int)(r % I_OUT); transpose_item(a.w_out + (size_t)inst * 1024 * 1024, 1024, 1024, 1024, (bf16_t*)(a.ws + WS_WOUT) + (size_t)inst * 1024 * 1024, 0, scr, item, lane); continue; } r -= T_OUT;
        { const int inst = (int)(r / I_GLU), item = (int)(r % I_GLU); transpose_item(a.w_glu + (size_t)inst * 256 * 256, 256, 256, 256, (bf16_t*)(a.ws + WS_WGLU) + (size_t)inst * 256 * 256, 0, scr, item, lane); }
    }
}

__device__ __forceinline__ void row_ln(f32x4 (&v)[4], const float* g, const float* bta, int lane) {
    float s = 0.f;
#pragma unroll
    for (int j = 0; j < 4; ++j) s += (v[j].x + v[j].y) + (v[j].z + v[j].w);
    const float mean = wave_sum(s) * (1.f / D); float s2 = 0.f;
#pragma unroll
    for (int j = 0; j < 4; ++j) { v[j] = v[j] - mean; s2 += (v[j].x * v[j].x + v[j].y * v[j].y) + (v[j].z * v[j].z + v[j].w * v[j].w); }
    const float rstd = 1.0f / sqrtf(wave_sum(s2) * (1.f / D) + LN_EPS);
#pragma unroll
    for (int j = 0; j < 4; ++j) { const f32x4 gg = *(const f32x4*)(g + 4 * (lane + 64 * j)), bb = *(const f32x4*)(bta + 4 * (lane + 64 * j)); v[j] = v[j] * rstd * gg + bb; }
}
#define GAS __attribute__((address_space(1)))
__device__ __forceinline__ void row_store_bf16(const f32x4 (&v)[4], bf16_t* orow, int lane) {
#pragma unroll
    for (int j = 0; j < 4; ++j) { u32x2 w; asm("v_cvt_pk_bf16_f32 %0, %1, %2" : "=v"(w.x) : "v"(v[j].x), "v"(v[j].y)); asm("v_cvt_pk_bf16_f32 %0, %1, %2" : "=v"(w.y) : "v"(v[j].z), "v"(v[j].w)); *(GAS u32x2*)((GAS bf16_t*)orow + 4 * (lane + 64 * j)) = w; }
}
#define LAS __attribute__((address_space(3)))
namespace pg8 {
constexpr int BM = 256, BK = 64, HALF = 128, HTB = HALF * BK * 2, STAGE_BYTES = 8 * HTB;
__device__ __forceinline__ int lds_byte(int r, int c) { const int st = (r >> 4) * 2 + (c >> 5), rr = r & 15, cc = c & 31, ob = rr * 64 + cc * 2; return st * 1024 + (ob ^ (((ob >> 9) & 1) << 5)); }
__device__ __forceinline__ void stage_rc(int b, int& R, int& C) { const int st = b / 1024, sb = b % 1024, swz = sb ^ (((sb >> 9) & 1) << 5); R = (st >> 1) * 16 + swz / 64; C = (st & 1) * 32 + (swz % 64) / 2; }
__device__ __forceinline__ int perm32(int rho) { const int n = rho >> 4, i = rho & 15; return 8 * (i >> 2) + 4 * n + (i & 3); }

struct Unit { const char* A; const char* B; int pm, pn, e, valid, lt; int lda, ldb, nt, seg; };

typedef f32x4 Acc[2][2][4][2];

template <bool GATHER, class Epi, class Sched>
__device__ __forceinline__ void gemm_phase(LAS unsigned char* lds, const Sched& S, const Epi& E) {
    int tid_ = threadIdx.x; asm volatile("" : "+v"(tid_));
    const int tid = tid_, wid = __builtin_amdgcn_readfirstlane(tid >> 6), lane = tid & 63, wr = wid >> 2, wc = wid & 3, fr = lane & 15, fq = lane >> 4;
    int R0, C0; stage_rc(tid * 16, R0, C0);
    const int Rb0 = (R0 & ~31) + perm32(R0 & 31);
    unsigned vB, vBn, vA = 0, vAn = 0; size_t sB, sBn, sA = 0, sAn = 0;
    unsigned offA[2][2], offN[2][2];
    const size_t kstep = (size_t)(BK * 2);
    const unsigned ldsw = (unsigned)wid * 1024u;
    const int aoff = lds_byte(wr * 64 + fr, fq * 8), boff = lds_byte(wc * 32 + fr, fq * 8);
#define PG8_SA(b, h) (((b) * 2 + (h)) * HTB)
#define PG8_SB(b, h) ((4 + (b) * 2 + (h)) * HTB)
#define PG8_STAGE_B(bufoff, gbase, h, vb, sb) do { _Pragma("unroll") for (int _i = 0; _i < 2; ++_i) \
        __builtin_amdgcn_global_load_lds((const unsigned*)((const char*)(gbase) + (size_t)(2 * (h) + _i) * (sb) + (vb)), (LAS unsigned*)(lds + (bufoff) + ldsw + _i * 8192), 16, 0, 0); } while (0)
#define PG8_STAGE_A(bufoff, gbase, h, va, sa, offs) do { _Pragma("unroll") for (int _i = 0; _i < 2; ++_i) { \
        const char* _p = GATHER ? (const char*)(gbase) + (offs)[h][_i] : (const char*)(gbase) + (size_t)(2 * (h) + _i) * (sa) + (va); \
        __builtin_amdgcn_global_load_lds((const unsigned*)_p, (LAS unsigned*)(lds + (bufoff) + ldsw + _i * 8192), 16, 0, 0); } } while (0)
#define PG8_LDA(dst, b, h) do { _Pragma("unroll") for (int m = 0; m < 4; ++m) _Pragma("unroll") for (int k = 0; k < 2; ++k) dst[m][k] = *(const LAS bf16x8*)(lds + PG8_SA(b, h) + aoff + m * 2048 + k * 1024); } while (0)
#define PG8_LDB(dst, b, h) do { _Pragma("unroll") for (int n = 0; n < 2; ++n) _Pragma("unroll") for (int k = 0; k < 2; ++k) dst[n][k] = *(const LAS bf16x8*)(lds + PG8_SB(b, h) + boff + n * 2048 + k * 1024); } while (0)
#define PG8_MMA(ai, bj, At, Bt) do { __builtin_amdgcn_s_setprio(1); _Pragma("unroll") for (int m = 0; m < 4; ++m) _Pragma("unroll") for (int n = 0; n < 2; ++n) _Pragma("unroll") for (int k = 0; k < 2; ++k) \
        acc[ai][bj][m][n] = __builtin_amdgcn_mfma_f32_16x16x32_bf16(Bt[n][k], At[m][k], acc[ai][bj][m][n], 0, 0, 0); __builtin_amdgcn_s_setprio(0); } while (0)
#define PG8_WAIT_V(n) asm volatile("s_waitcnt vmcnt(" #n ")" ::: "memory")
#define PG8_WAIT_L(n) asm volatile("s_waitcnt lgkmcnt(" #n ")" ::: "memory")
#define PG8_BAR __builtin_amdgcn_s_barrier()
#define PG8_SCHED __builtin_amdgcn_sched_barrier(0)
#define PG8_GEOM(u, oA, va, sa, vb, sb) do { if constexpr (GATHER) S.goff(u, R0, C0, oA); else { va = (unsigned)(R0 * (u).lda + C0) * 2u; sa = (size_t)64 * (u).lda * 2; } \
        vb = (unsigned)(Rb0 * (u).ldb + C0) * 2u; sb = (size_t)64 * (u).ldb * 2; } while (0)
    Unit cur, nxt; int ui = 0;
    if (!S.next(0, cur)) return;
    PG8_GEOM(cur, offA, vA, sA, vB, sB);
#pragma unroll
    for (int h = 0; h < 2; ++h)
#pragma unroll
        for (int i = 0; i < 2; ++i) offN[h][i] = offA[h][i];
    vAn = vA; sAn = sA; vBn = vB; sBn = sB; int nt = cur.nt;
    Acc acc;
#pragma unroll
    for (int a = 0; a < 2; ++a)
#pragma unroll
        for (int b = 0; b < 2; ++b)
#pragma unroll
            for (int m = 0; m < 4; ++m)
#pragma unroll
                for (int n = 0; n < 2; ++n) acc[a][b][m][n] = (f32x4){0.f, 0.f, 0.f, 0.f};
    bf16x8 At[4][2], B0[2][2], B1[2][2];
    const char* cA = cur.A; const char* cB = cur.B;
    E.pre(cur, wr, wc, fr, fq);
    PG8_STAGE_B(PG8_SB(0, 0), cB, 0, vB, sB); PG8_STAGE_B(PG8_SB(0, 1), cB, 1, vB, sB); PG8_STAGE_A(PG8_SA(0, 0), cA, 0, vA, sA, offA); PG8_STAGE_A(PG8_SA(0, 1), cA, 1, vA, sA, offA);
    if (wr == 1) PG8_BAR;
    PG8_WAIT_V(2); PG8_BAR;
    PG8_STAGE_B(PG8_SB(1, 0), cB + kstep, 0, vB, sB); PG8_STAGE_A(PG8_SA(1, 0), cA + kstep, 0, vA, sA, offA); PG8_STAGE_B(PG8_SB(1, 1), cB + kstep, 1, vB, sB);
    PG8_WAIT_V(6); PG8_BAR;
    for (;;) {
        const bool has_next = S.next(ui + 1, nxt);
        const char* nA = has_next ? nxt.A : cA; const char* nB = has_next ? nxt.B : cB;
        if (has_next) PG8_GEOM(nxt, offN, vAn, sAn, vBn, sBn);
#pragma unroll 1
        for (int t = 0; t < nt; t += 2) {
            const bool last = (t == nt - 2);
            const char* a1 = cA + (size_t)(t + 1) * kstep;
            const char* a2 = last ? nA : cA + (size_t)(t + 2) * kstep; const char* b2 = last ? nB : cB + (size_t)(t + 2) * kstep;
            const char* a3 = a2 + kstep; const char* b3 = b2 + kstep;
            unsigned o2[2][2];
            if constexpr (GATHER) {
#pragma unroll
                for (int h = 0; h < 2; ++h)
#pragma unroll
                    for (int i = 0; i < 2; ++i) o2[h][i] = last ? offN[h][i] : offA[h][i];
            }
            const unsigned va2 = last ? vAn : vA, vb2 = last ? vBn : vB; const size_t sa2 = last ? sAn : sA, sb2 = last ? sBn : sB;
            PG8_LDB(B0, 0, 0); PG8_LDB(B1, 0, 1); PG8_SCHED; PG8_LDA(At, 0, 0); PG8_STAGE_A(PG8_SA(1, 1), a1, 1, vA, sA, offA);
            PG8_WAIT_V(8); PG8_WAIT_L(0); PG8_BAR; PG8_MMA(0, 0, At, B0); PG8_MMA(0, 1, At, B1); PG8_BAR; PG8_SCHED;
            PG8_LDA(At, 0, 1); PG8_STAGE_B(PG8_SB(0, 0), b2, 0, vb2, sb2); PG8_STAGE_B(PG8_SB(0, 1), b2, 1, vb2, sb2); PG8_STAGE_A(PG8_SA(0, 0), a2, 0, va2, sa2, o2);
            PG8_WAIT_V(8); PG8_WAIT_L(0); PG8_BAR; PG8_MMA(1, 0, At, B0); PG8_MMA(1, 1, At, B1); PG8_BAR; PG8_SCHED;
            PG8_LDB(B0, 1, 0); PG8_LDB(B1, 1, 1); PG8_SCHED; PG8_LDA(At, 1, 0); PG8_STAGE_A(PG8_SA(0, 1), a2, 1, va2, sa2, o2);
            PG8_WAIT_V(8); PG8_WAIT_L(0); PG8_BAR; PG8_MMA(0, 0, At, B0); PG8_MMA(0, 1, At, B1); PG8_BAR; PG8_SCHED;
            PG8_LDA(At, 1, 1); PG8_STAGE_B(PG8_SB(1, 0), b3, 0, vb2, sb2); PG8_STAGE_B(PG8_SB(1, 1), b3, 1, vb2, sb2); PG8_STAGE_A(PG8_SA(1, 0), a3, 0, va2, sa2, o2);
            PG8_WAIT_V(8); PG8_WAIT_L(0); PG8_BAR; PG8_MMA(1, 0, At, B0); PG8_MMA(1, 1, At, B1); PG8_BAR; PG8_SCHED;
        }
        if (wr == 0) PG8_BAR;
        if constexpr (!Epi::AFTER_DRAIN) E(acc, cur, wr, wc, fr, fq);
        if (!has_next) break;
        if (!E.keep_acc(cur)) {
#pragma unroll
            for (int a = 0; a < 2; ++a)
#pragma unroll
                for (int b = 0; b < 2; ++b)
#pragma unroll
                    for (int m = 0; m < 4; ++m)
#pragma unroll
                        for (int n = 0; n < 2; ++n) acc[a][b][m][n] = (f32x4){0.f, 0.f, 0.f, 0.f};
        }
        cur = nxt; cA = nA; cB = nB; ++ui; nt = cur.nt; vA = vAn; sA = sAn; vB = vBn; sB = sBn;
        if constexpr (GATHER) {
#pragma unroll
            for (int h = 0; h < 2; ++h)
#pragma unroll
                for (int i = 0; i < 2; ++i) offA[h][i] = offN[h][i];
        }
        E.pre(cur, wr, wc, fr, fq);
        if (wr == 1) PG8_BAR;
    }
    PG8_WAIT_V(0);
    PG8_BAR;
    if constexpr (Epi::AFTER_DRAIN) E.after(acc, cur, wr, wc, fr, fq, lds);
#undef PG8_GEOM
#undef PG8_SA
#undef PG8_SB
#undef PG8_STAGE_A
#undef PG8_STAGE_B
#undef PG8_LDA
#undef PG8_LDB
#undef PG8_MMA
#undef PG8_WAIT_V
#undef PG8_WAIT_L
#undef PG8_BAR
#undef PG8_SCHED
}

struct StaticOrder {
    const char* A; const char* B; size_t tstepA, tstepB; int nM, nN, nwg, G, c, lda, ldb, nt;
    __device__ __forceinline__ void init(const void* A_, int lda_, const void* B_, int ldb_, int K, int M, int N, int G_, int c_) {
        A = (const char*)A_; B = (const char*)B_; lda = lda_; ldb = ldb_; nt = K / BK; tstepA = (size_t)BM * lda * 2; tstepB = (size_t)BM * ldb * 2; nM = M / BM; nN = N / BM; nwg = nM * nN; G = G_; c = c_; }
    __device__ __forceinline__ bool next(int i, Unit& u) const {
        const long L = (long)i * G + c; if (L >= nwg) return false;
        int wgid = (int)L; { const int q = nwg / 8, r = nwg % 8, xcd = wgid % 8, off = wgid / 8; wgid = (xcd < r ? xcd * (q + 1) : r * (q + 1) + (xcd - r) * q) + off; }
        const int nig = 8 * nN, gid = wgid / nig, fm = gid * 8, gsz = (nM - fm) < 8 ? (nM - fm) : 8;
        u.pm = fm + ((wgid % nig) % gsz); u.pn = (wgid % nig) / gsz; u.e = 0; u.valid = 256; u.lt = 0; u.lda = lda; u.ldb = ldb; u.nt = nt; u.seg = 0;
        u.A = A + (size_t)u.pm * tstepA; u.B = B + (size_t)u.pn * tstepB; return true;
    }
};
}
namespace pg8 {
__device__ __forceinline__ unsigned cvt_pk_bf16(float lo, float hi) { unsigned r; asm volatile("v_cvt_pk_bf16_f32 %0, %1, %2" : "=v"(r) : "v"(lo), "v"(hi)); return r; }
__device__ __forceinline__ float fsig(float x) { return __builtin_amdgcn_rcpf(1.0f + __builtin_amdgcn_exp2f(-L2E * x)); }
__device__ __forceinline__ u32x4 pack8(const f32x4 v0, const f32x4 v1) { u32x4 w; w.x = cvt_pk_bf16(v0[0], v0[1]); w.y = cvt_pk_bf16(v0[2], v0[3]); w.z = cvt_pk_bf16(v1[0], v1[1]); w.w = cvt_pk_bf16(v1[2], v1[3]); return w; }
__device__ __forceinline__ void unpack8(const u32x4 w, f32x4& v0, f32x4& v1) {
    v0[0] = __uint_as_float(w.x << 16); v0[1] = __uint_as_float(w.x & 0xffff0000u); v0[2] = __uint_as_float(w.y << 16); v0[3] = __uint_as_float(w.y & 0xffff0000u);
    v1[0] = __uint_as_float(w.z << 16); v1[1] = __uint_as_float(w.z & 0xffff0000u); v1[2] = __uint_as_float(w.w << 16); v1[3] = __uint_as_float(w.w & 0xffff0000u); }
__device__ __forceinline__ u32x4 ld16(const void* ubase, unsigned voff) { return *(const u32x4*)((const char*)ubase + voff); }
__device__ __forceinline__ void st16(void* ubase, unsigned voff, u32x4 v) { *(u32x4*)((char*)ubase + voff) = v; }
__device__ __forceinline__ f32x4 ldf4(const void* ubase, unsigned voff) { return *(const f32x4*)((const char*)ubase + voff); }

struct EpiIn { bf16_t* H; bf16_t* A3; unsigned char* GQ;
    static constexpr bool AFTER_DRAIN = false; __device__ __forceinline__ void pre(const Unit&, int, int, int, int) const {} __device__ __forceinline__ bool keep_acc(const Unit&) const { return false; }
    __device__ __forceinline__ void operator()(const Acc& acc, const Unit& u, int wr, int wc, int fr, int fq) const {
        const int pn = u.pn;
        const unsigned vH = (unsigned)(fr * HP + 8 * fq) * 2u, vS = (unsigned)((fq >> 1) * 2048 * 384 + fr * 16 + (fq & 1) * 8) * 2u, vG = (unsigned)(fr * 3072 + 8 * fq);
#pragma unroll
        for (int ai = 0; ai < 2; ++ai)
#pragma unroll
            for (int m = 0; m < 4; ++m) {
#pragma unroll
                for (int bj = 0; bj < 2; ++bj) { f32x4 v0 = acc[ai][bj][m][0], v1 = acc[ai][bj][m][1];
                    if (pn < 2) { v0 = v0 * C2; v1 = v1 * C2; }
                    if (pn >= 8) { unsigned q[8];
#pragma unroll
                        for (int i = 0; i < 4; i += 2) {
                            f32x2 ta = (f32x2){__builtin_amdgcn_exp2f(v0[i]), __builtin_amdgcn_exp2f(v0[i + 1])} + (f32x2){1.0f, 1.0f}, tb = (f32x2){__builtin_amdgcn_exp2f(v1[i]), __builtin_amdgcn_exp2f(v1[i + 1])} + (f32x2){1.0f, 1.0f};
                            f32x2 ya = (f32x2){__builtin_amdgcn_rcpf(ta.x), __builtin_amdgcn_rcpf(ta.y)} * (f32x2){255.0f, 255.0f} + (f32x2){0.5f, 0.5f}, yb = (f32x2){__builtin_amdgcn_rcpf(tb.x), __builtin_amdgcn_rcpf(tb.y)} * (f32x2){255.0f, 255.0f} + (f32x2){0.5f, 0.5f};
                            q[i] = (unsigned)fmaxf(ya.x, 1.0f); q[i + 1] = (unsigned)fmaxf(ya.y, 1.0f); q[4 + i] = (unsigned)fmaxf(yb.x, 1.0f); q[5 + i] = (unsigned)fmaxf(yb.y, 1.0f); }
                        u32x2 w; w.x = q[0] | (q[1] << 8) | (q[2] << 16) | (q[3] << 24); w.y = q[4] | (q[5] << 8) | (q[6] << 16) | (q[7] << 24);
                        *(u32x2*)(GQ + (size_t)(u.pm * 256 + ai * 128 + wr * 64 + m * 16) * 3072 + (pn - 8) * 256 + bj * 128 + wc * 32 + vG) = w; }
                    else if (pn == 7) st16(A3 + ((size_t)(bj * 8 + wc * 2) * 2048 + u.pm * 16 + ai * 8 + wr * 4 + m) * 384, vS, pack8(v0, v1));
                    else st16(H + (size_t)(u.pm * 256 + ai * 128 + wr * 64 + m * 16) * HP + pn * 256 + bj * 128 + wc * 32, vH, pack8(v0, v1)); } }
    }
};
struct EpiGlu { const bf16_t* ycp; const float* bias; bf16_t* yc;
    static constexpr bool AFTER_DRAIN = false; __device__ __forceinline__ void pre(const Unit&, int, int, int, int) const {} __device__ __forceinline__ bool keep_acc(const Unit&) const { return false; }
    __device__ __forceinline__ void operator()(const Acc& acc, const Unit& u, int wr, int wc, int fr, int fq) const {
        const unsigned vo = (unsigned)(fr * 256 + 8 * fq) * 2u;
        f32x4 bv[2][2];
#pragma unroll
        for (int bj = 0; bj < 2; ++bj)
#pragma unroll
            for (int n = 0; n < 2; ++n) bv[bj][n] = ldf4(bias + bj * 128 + wc * 32 + 4 * n, (unsigned)fq * 32u);
#define GL_UB(it) ((size_t)(u.pm * 256 + ((it) >> 3) * 128 + wr * 64 + (((it) >> 1) & 3) * 16) * 256 + ((it) & 1) * 128 + wc * 32)
        u32x4 yn = ld16(ycp + GL_UB(0), vo);
#pragma unroll
        for (int it = 0; it < 16; ++it) { const int ai = it >> 3, m = (it >> 1) & 3, bj = it & 1; const size_t ub = GL_UB(it); f32x4 y0, y1; unpack8(yn, y0, y1);
            if (it + 1 < 16) yn = ld16(ycp + GL_UB(it + 1), vo);
            f32x4 v0 = acc[ai][bj][m][0] + bv[bj][0], v1 = acc[ai][bj][m][1] + bv[bj][1];
#pragma unroll
            for (int i = 0; i < 4; ++i) { v0[i] = y0[i] * fsig(v0[i]); v1[i] = y1[i] * fsig(v1[i]); }
            st16(yc + ub, vo, pack8(v0, v1));
            asm volatile("" ::: "memory"); }
#undef GL_UB
    }
};
struct EpiBranch { const bf16_t* H; bf16_t* merged; int br;
    static constexpr bool AFTER_DRAIN = false; __device__ __forceinline__ void pre(const Unit&, int, int, int, int) const {} __device__ __forceinline__ bool keep_acc(const Unit&) const { return false; }
    __device__ __forceinline__ void operator()(const Acc& acc, const Unit& u, int wr, int wc, int fr, int fq) const {
        const unsigned vH = (unsigned)(fr * HP + 8 * fq) * 2u, vM = (unsigned)(fr * 1024 + 8 * fq) * 2u;
#pragma unroll
        for (int ai = 0; ai < 2; ++ai)
#pragma unroll
            for (int m = 0; m < 4; ++m) { const int rowu = u.pm * 256 + ai * 128 + wr * 64 + m * 16;
#pragma unroll
                for (int bj = 0; bj < 2; ++bj) { const int cu = u.pn * 256 + bj * 128 + wc * 32; f32x4 g0, g1; unpack8(ld16(H + (size_t)rowu * HP + HC_G + br * 1024 + cu, vH), g0, g1);
                    f32x4 v0 = acc[ai][bj][m][0] * g0, v1 = acc[ai][bj][m][1] * g1;
                    if (br > 0) { f32x4 p0, p1; unpack8(ld16(merged + (size_t)rowu * 1024 + cu, vM), p0, p1); v0 = v0 + p0; v1 = v1 + p1; }
                    st16(merged + (size_t)rowu * 1024 + cu, vM, pack8(v0, v1)); }
                asm volatile("" ::: "memory"); }
    }
};
struct EpiBranchF { const unsigned char* GQ; bf16_t* merged;
    static constexpr bool AFTER_DRAIN = false; __device__ __forceinline__ void pre(const Unit&, int, int, int, int) const {} __device__ __forceinline__ bool keep_acc(const Unit& u) const { return u.seg < 2; }
    __device__ __forceinline__ void operator()(Acc& acc, const Unit& u, int wr, int wc, int fr, int fq) const {
        const unsigned vG = (unsigned)(fr * 3072 + 8 * fq), vM = (unsigned)(fr * 1024 + 8 * fq) * 2u; const int seg = u.seg;
        const unsigned char* gbase = GQ + (size_t)(u.pm * 256 + wr * 64) * 3072 + seg * 1024 + u.pn * 256 + wc * 32;
        bf16_t* mbase = merged + (size_t)(u.pm * 256 + wr * 64) * 1024 + u.pn * 256 + wc * 32;
#define BF_LOAD(it, G, Hh) do { const size_t ro_ = (size_t)(((it) >> 3) * 128 + (((it) >> 1) & 3) * 16); const int bj_ = (it) & 1; \
            G = *(const u32x2*)(gbase + ro_ * 3072 + bj_ * 128 + vG); Hh = (u32x2){0xffffffffu, 0xffffffffu}; if (seg < 2) Hh = *(const u32x2*)(gbase + ro_ * 3072 + 1024 + bj_ * 128 + vG); } while (0)
        u32x2 gn, hn; BF_LOAD(0, gn, hn);
#pragma unroll
        for (int it = 0; it < 16; ++it) { const int ai = it >> 3, m = (it >> 1) & 3, bj = it & 1; const size_t ro = (size_t)(ai * 128 + m * 16);
            const u32x2 gw = gn, hw = hn;
            if (it + 1 < 16) BF_LOAD(it + 1, gn, hn);
            f32x4 g0, g1;
            if (seg < 2) {
#pragma unroll
                for (int i = 0; i < 4; ++i) { g0[i] = (float)((gw.x >> (8 * i)) & 255u) * __builtin_amdgcn_rcpf((float)((hw.x >> (8 * i)) & 255u));
                                              g1[i] = (float)((gw.y >> (8 * i)) & 255u) * __builtin_amdgcn_rcpf((float)((hw.y >> (8 * i)) & 255u)); }
            } else {
#pragma unroll
                for (int i = 0; i < 4; ++i) { g0[i] = (float)((gw.x >> (8 * i)) & 255u) * (1.0f / 255.0f); g1[i] = (float)((gw.y >> (8 * i)) & 255u) * (1.0f / 255.0f); }
            }
            acc[ai][bj][m][0] = acc[ai][bj][m][0] * g0; acc[ai][bj][m][1] = acc[ai][bj][m][1] * g1;
            if (seg == 2) st16(mbase + ro * 1024 + bj * 128, vM, pack8(acc[ai][bj][m][0], acc[ai][bj][m][1]));
            asm volatile("" ::: "memory"); }
#undef BF_LOAD
    }
};
struct EpiPlain { bf16_t* O; const float* bias; int bias_estride;
    static constexpr bool AFTER_DRAIN = false; __device__ __forceinline__ void pre(const Unit&, int, int, int, int) const {} __device__ __forceinline__ bool keep_acc(const Unit&) const { return false; }
    __device__ __forceinline__ void operator()(const Acc& acc, const Unit& u, int wr, int wc, int fr, int fq) const {
        const unsigned vo = (unsigned)(fr * 1024 + 8 * fq) * 2u;
        f32x4 bv[2][2];
#pragma unroll
        for (int bj = 0; bj < 2; ++bj)
#pragma unroll
            for (int n = 0; n < 2; ++n) bv[bj][n] = bias ? ldf4(bias + (size_t)u.e * bias_estride + u.pn * 256 + bj * 128 + wc * 32 + 4 * n, (unsigned)fq * 32u) : (f32x4){0.f, 0.f, 0.f, 0.f};
#pragma unroll
        for (int ai = 0; ai < 2; ++ai)
#pragma unroll
            for (int m = 0; m < 4; ++m) { const int rowu = u.pm * 256 + ai * 128 + wr * 64 + m * 16;
#pragma unroll
                for (int bj = 0; bj < 2; ++bj) st16(O + (size_t)rowu * 1024 + u.pn * 256 + bj * 128 + wc * 32, vo, pack8(acc[ai][bj][m][0] + bv[bj][0], acc[ai][bj][m][1] + bv[bj][1])); }
    }
};
struct EpiUp { bf16_t* act; const float* bup;
    static constexpr bool AFTER_DRAIN = false; __device__ __forceinline__ void pre(const Unit&, int, int, int, int) const {} __device__ __forceinline__ bool keep_acc(const Unit&) const { return false; }
    __device__ __forceinline__ void operator()(const Acc& acc, const Unit& u, int wr, int wc, int fr, int fq) const {
        const unsigned vo = (unsigned)(fr * 1024 + 8 * fq) * 2u;
        const int ju = u.pn * 128 + wc * 32;
        f32x4 bb[4];
#pragma unroll
        for (int q = 0; q < 4; ++q) { bb[q] = ldf4(bup + (size_t)u.e * 2048 + 2 * ju + 4 * q, (unsigned)fq * 64u); bb[q][1] += 1.0f; bb[q][3] += 1.0f; }
#pragma unroll
        for (int ai = 0; ai < 2; ++ai)
#pragma unroll
            for (int m = 0; m < 4; ++m) { const int rowu = u.pm * 256 + ai * 128 + wr * 64 + m * 16; f32x4 o[2];
#pragma unroll
                for (int n = 0; n < 2; ++n)
#pragma unroll
                    for (int i2 = 0; i2 < 2; ++i2) { const int q = 4 * n + 2 * i2;
                        f32x2 g = (f32x2){acc[ai][0][m][n][2 * i2], acc[ai][0][m][n][2 * i2 + 1]} + (f32x2){bb[q >> 1][0], bb[(q >> 1)][2]};
                        f32x2 l = (f32x2){acc[ai][1][m][n][2 * i2], acc[ai][1][m][n][2 * i2 + 1]} + (f32x2){bb[q >> 1][1], bb[(q >> 1)][3]};
                        g = __builtin_elementwise_min(g, (f32x2){7.0f, 7.0f}); l.x = __builtin_amdgcn_fmed3f(l.x, -6.0f, 8.0f); l.y = __builtin_amdgcn_fmed3f(l.y, -6.0f, 8.0f);
                        const f32x2 t = g * (-1.702f * L2E); const f32x2 d = (f32x2){__builtin_amdgcn_exp2f(t.x), __builtin_amdgcn_exp2f(t.y)} + (f32x2){1.0f, 1.0f};
                        const f32x2 s = (f32x2){__builtin_amdgcn_rcpf(d.x), __builtin_amdgcn_rcpf(d.y)};
                        const f32x2 r = (g * s) * l; o[n][2 * i2] = r.x; o[n][2 * i2 + 1] = r.y; }
                st16(act + (size_t)rowu * 1024 + ju, vo, pack8(o[0], o[1])); }
    }
};
struct EpiYm8 { unsigned char* O; const float* bias;
    mutable f32x4 bv[2][2];
    static constexpr bool AFTER_DRAIN = false;
    __device__ __forceinline__ void pre(const Unit& u, int, int wc, int, int fq) const {
#pragma unroll
        for (int bj = 0; bj < 2; ++bj)
#pragma unroll
            for (int n = 0; n < 2; ++n) bv[bj][n] = *(const GAS f32x4*)((const GAS char*)(bias + (size_t)u.e * 1024 + u.pn * 256 + bj * 128 + wc * 32 + 4 * n) + (unsigned)fq * 32u); }     __device__ __forceinline__ bool keep_acc(const Unit&) const { return false; }
    __device__ __forceinline__ void operator()(const Acc& acc, const Unit& u, int wr, int wc, int fr, int fq) const {
        const unsigned vo = (unsigned)(fr * 1024 + 8 * fq);
#pragma unroll
        for (int ai = 0; ai < 2; ++ai)
#pragma unroll
            for (int m = 0; m < 4; ++m) { const int rowu = u.pm * 256 + ai * 128 + wr * 64 + m * 16;
#pragma unroll
                for (int bj = 0; bj < 2; ++bj) { const f32x4 a = acc[ai][bj][m][0] + bv[bj][0], b = acc[ai][bj][m][1] + bv[bj][1]; u32x2 w;
                    int t = __builtin_amdgcn_cvt_pk_fp8_f32(a[0], a[1], 0, false); t = __builtin_amdgcn_cvt_pk_fp8_f32(a[2], a[3], t, true); w.x = (unsigned)t;
                    t = __builtin_amdgcn_cvt_pk_fp8_f32(b[0], b[1], 0, false); t = __builtin_amdgcn_cvt_pk_fp8_f32(b[2], b[3], t, true); w.y = (unsigned)t;
                    *(u32x2*)(O + (size_t)rowu * 1024 + u.pn * 256 + bj * 128 + wc * 32 + vo) = w; } }
    }
};
}
#include <hip/hip_bf16.h>
#include <cmath>
namespace attn_body {
using bf16=__hip_bfloat16;
using bf16x8=__attribute__((ext_vector_type(8)))short;
using s16x4=__attribute__((ext_vector_type(4)))short;
using f32x16=__attribute__((ext_vector_type(16)))float;
using u32x4=__attribute__((ext_vector_type(4)))unsigned;
constexpr int BATCH=8,NHEAD=8,SEQ=4096,D=64,DM=5120;
constexpr int NW=8,QBLK=32,QB=QBLK*NW,KVBLK=64,NQB=SEQ/QB;
constexpr int ATTN_PITCH=DM, ATTN_UNIT_ROWS=QB;
__device__ __forceinline__ int crow(int r,int hi){return (r&3)+8*(r>>2)+4*hi;}
#define SBAR() __builtin_amdgcn_sched_barrier(0)
__device__ __forceinline__ void cmask(f32x16&p0,f32x16&p1,int jb,int qrel,int hi){
  const float NEG=-INFINITY; int kb=64*jb+4*hi;
  #pragma unroll
  for(int r=0;r<16;++r){int kv=kb+(r&3)+8*(r>>2); if(kv>qrel)p0[r]=NEG; if(kv+32>qrel)p1[r]=NEG;}
}

constexpr int NSLOT=3, SLOTB=8192;
constexpr int LDS_K=0, LDS_V=NSLOT*SLOTB, LDS_WS=2*NSLOT*SLOTB, LDS_OST=LDS_WS+NW*64*4, LDS_BIAS=LDS_OST+NW*4096, LDS_BYTES=LDS_BIAS+SEQ*4;
constexpr float C2=0.125f*1.4426950408889634f;
__device__ __forceinline__ void glds16(const void*gsrc,unsigned lds_dst){unsigned keep;
  asm volatile("s_mov_b32 %0, m0\n\ts_mov_b32 m0, %2\n\ts_nop 0\n\tglobal_load_lds_dwordx4 %1, off\n\ts_mov_b32 m0, %0":"=&s"(keep):"v"(gsrc),"s"(lds_dst):"memory");}
__device__ __forceinline__ float max3f(float a,float b,float c){float r;asm("v_max3_f32 %0, %1, %2, %3":"=v"(r):"v"(a),"v"(b),"v"(c));return r;}
__device__ __forceinline__ float max2f(float a,float b){float r;asm("v_max_f32_e32 %0, %1, %2":"=v"(r):"v"(a),"v"(b));return r;}
__device__ __forceinline__ float fadd_s(float a,float b){float r;asm("v_add_f32_e32 %0, %1, %2":"=v"(r):"v"(a),"v"(b));return r;}
__device__ __forceinline__ float fsub_s(float a,float b){float r;asm("v_sub_f32_e32 %0, %1, %2":"=v"(r):"v"(a),"v"(b));return r;}
typedef float f32x2_t __attribute__((ext_vector_type(2))); typedef __bf16 bf16x2_t __attribute__((ext_vector_type(2)));
__device__ __forceinline__ unsigned cvtpk_s(float lo,float hi){f32x2_t v={lo,hi};bf16x2_t b=__builtin_convertvector(v,bf16x2_t);return __builtin_bit_cast(unsigned,b);}
#define WAIT_BAR(N) asm volatile("s_waitcnt vmcnt(" #N ") lgkmcnt(0)\n\ts_barrier":::"memory")

__device__ __forceinline__ void qkt(f32x16&p0,f32x16&p1,const char*Kslot,const bf16x8*qr,const f32x16&c0in,const f32x16&c1in,int r32,int hi){
  const char*kb=Kslot+hi*1024+r32*16;
  #pragma unroll
  for(int d0=0;d0<4;++d0){
    const bf16x8 b0=*reinterpret_cast<const bf16x8*>(kb+d0*2048);
    const bf16x8 b1=*reinterpret_cast<const bf16x8*>(kb+d0*2048+512);
    if(d0==0){p0=__builtin_amdgcn_mfma_f32_32x32x16_bf16(b0,qr[0],c0in,0,0,0);p1=__builtin_amdgcn_mfma_f32_32x32x16_bf16(b1,qr[0],c1in,0,0,0);}
    else{p0=__builtin_amdgcn_mfma_f32_32x32x16_bf16(b0,qr[d0],p0,0,0,0);p1=__builtin_amdgcn_mfma_f32_32x32x16_bf16(b1,qr[d0],p1,0,0,0);}}
}
typedef __attribute__((address_space(3))) const char* lds_cptr;
typedef short v4i16_t __attribute__((ext_vector_type(4)));
__device__ __forceinline__ void kload8(bf16x8*kf,lds_cptr kp){
  kf[0]=*(const __attribute__((address_space(3))) bf16x8*)(kp);      kf[1]=*(const __attribute__((address_space(3))) bf16x8*)(kp+512);
  kf[2]=*(const __attribute__((address_space(3))) bf16x8*)(kp+2048); kf[3]=*(const __attribute__((address_space(3))) bf16x8*)(kp+2560);
  kf[4]=*(const __attribute__((address_space(3))) bf16x8*)(kp+4096); kf[5]=*(const __attribute__((address_space(3))) bf16x8*)(kp+4608);
  kf[6]=*(const __attribute__((address_space(3))) bf16x8*)(kp+6144); kf[7]=*(const __attribute__((address_space(3))) bf16x8*)(kp+6656);
}
__device__ __forceinline__ void kload2(bf16x8*kf,lds_cptr kp,int j){ kf[2*j]=*(const __attribute__((address_space(3))) bf16x8*)(kp+j*2048); kf[2*j+1]=*(const __attribute__((address_space(3))) bf16x8*)(kp+j*2048+512); }
__device__ __forceinline__ s16x4 vtr(lds_cptr p){ return __builtin_bit_cast(s16x4,__builtin_amdgcn_ds_read_tr16_b64_v4i16((__attribute__((address_space(3))) v4i16_t*)p)); }
__device__ __forceinline__ float rowmax(const f32x16&p0,const f32x16&p1){
  float a=max3f(p0[0],p0[1],p1[0]),b=max3f(p0[2],p0[3],p1[1]);a=max3f(a,p1[2],p1[3]);
  #pragma unroll
  for(int r=4;r<16;r+=4){a=max3f(a,p0[r],p0[r+1]);b=max3f(b,p0[r+2],p0[r+3]);a=max3f(a,p1[r],p1[r+1]);b=max3f(b,p1[r+2],p1[r+3]);}
  const float m=max2f(a,b);
  auto rr=__builtin_amdgcn_permlane32_swap(__float_as_uint(m),__float_as_uint(m),false,false);
  return max2f(__uint_as_float(rr[0]),__uint_as_float(rr[1]));
}
__device__ __forceinline__ void pv(f32x16*o,int vb,bf16x8 pa0,bf16x8 pa1,bf16x8 pa2,bf16x8 pa3){
  #pragma unroll
  for(int d0=0;d0<2;++d0){s16x4 lo[4],hi[4];
    #pragma unroll
    for(int ks=0;ks<4;++ks){
      asm volatile("ds_read_b64_tr_b16 %0,%1 offset:%c2":"=&v"(lo[ks]):"v"(vb),"i"(d0*4096+ks*1024):"memory");
      asm volatile("ds_read_b64_tr_b16 %0,%1 offset:%c2":"=&v"(hi[ks]):"v"(vb),"i"(d0*4096+ks*1024+512):"memory");}
    asm volatile("s_waitcnt lgkmcnt(0)":::"memory");SBAR();
    #define PK(k) (bf16x8){lo[k][0],lo[k][1],lo[k][2],lo[k][3],hi[k][0],hi[k][1],hi[k][2],hi[k][3]}
    o[d0]=__builtin_amdgcn_mfma_f32_32x32x16_bf16(pa0,PK(0),o[d0],0,0,0);
    o[d0]=__builtin_amdgcn_mfma_f32_32x32x16_bf16(pa1,PK(1),o[d0],0,0,0);
    o[d0]=__builtin_amdgcn_mfma_f32_32x32x16_bf16(pa2,PK(2),o[d0],0,0,0);
    o[d0]=__builtin_amdgcn_mfma_f32_32x32x16_bf16(pa3,PK(3),o[d0],0,0,0);
    #undef PK
  }
}

#ifndef ATTN_STORE16
#define ATTN_STORE16(p,v) (*(u32x4*)(p)=(v))
#endif
typedef __attribute__((address_space(3))) const float* lds_fptr; typedef float f32x4_t __attribute__((ext_vector_type(4)));
__device__ __forceinline__ void bias_tuple(f32x16&c0,f32x16&c1,lds_fptr bp,float mhat){
  #pragma unroll
  for(int g=0;g<4;++g){ const f32x4_t x=*(const __attribute__((address_space(3))) f32x4_t*)(bp+8*g), y=*(const __attribute__((address_space(3))) f32x4_t*)(bp+32+8*g);
    #pragma unroll
    for(int i=0;i<4;++i){ c0[4*g+i]=x[i]-mhat; c1[4*g+i]=y[i]-mhat; } }
}
template<int THRL> __device__ __forceinline__ void attn_unit(int b,int h,int qb,const bf16*Q,const bf16*__restrict__ K,const bf16*__restrict__ V,bf16*O,const float*__restrict__ cum,char*shm){
  int tid_=threadIdx.x; asm volatile("":"+v"(tid_));
  const int tid=tid_,lane=tid&63,r32=lane&31,hi=lane>>5; const int wid=__builtin_amdgcn_readfirstlane(tid>>6);
  const long rowbase=(long)b*SEQ; const int q0=qb*QB;
  const bf16*Qw=Q+(rowbase+q0+wid*QBLK)*DM+h*D;
  const bf16*Kh=K+rowbase*DM+h*D,*Vh=V+rowbase*DM+h*D;
  const unsigned lds0=(unsigned)(uintptr_t)shm;
  float*wsf=(float*)(shm+LDS_WS)+wid*64;
  { const float*cb=cum+(long)(b*NHEAD+h)*SEQ; const float cref=cb[q0]; float*bt=(float*)(shm+LDS_BIAS);
    float cv[8];
    _Pragma("unroll") for(int u=0;u<8;++u){const int j=tid+u*NW*64; cv[u]=(j<q0+QB)?cb[j]:0.f;}
    _Pragma("unroll") for(int u=0;u<8;++u){const int j=tid+u*NW*64; if(j<q0+QB)bt[j]=-1.4426950408889634f*(cv[u]-cref);} }
  asm volatile("s_waitcnt lgkmcnt(0)\n\ts_barrier":::"memory");
  int tskip=0;
  { const int NT0=(q0+QB)/KVBLK; const lds_fptr bt0=(lds_fptr)((lds_cptr)shm+LDS_BIAS);
    const float bv=(lane<NT0)?bt0[64*lane+63]:0.f;
    const unsigned long long mk=__ballot(lane<NT0&&bv<-64.f);
    tskip=__builtin_amdgcn_readfirstlane((int)__popcll(mk))&~1; if(tskip>NT0-4)tskip=NT0-4; }
  const lds_fptr btl=(lds_fptr)((lds_cptr)shm+LDS_BIAS)+4*hi+64*tskip;
  const bf16*Khs=Kh+(long)tskip*KVBLK*DM,*Vhs=Vh+(long)tskip*KVBLK*DM;
  const bf16*ksrc=Khs+(long)lane*DM+wid*8;
  const bf16*vsrc=Vhs+(long)(16*(wid&3)+(lane>>2))*DM+(wid>>2)*32+(lane&3)*8;
  const unsigned kdst=lds0+LDS_K+wid*1024, vdst=lds0+LDS_V+wid*1024;
  #define DMA_K(t,slot) glds16(ksrc+(long)(t)*KVBLK*DM,(unsigned)__builtin_amdgcn_readfirstlane(kdst+(slot)))
  #define DMA_V(t,slot) glds16(vsrc+(long)(t)*KVBLK*DM,(unsigned)__builtin_amdgcn_readfirstlane(vdst+(slot)))
  const int vb0=(int)(lds0+LDS_V)+((lane>>4)&1)*32+(lane&3)*8+(4*hi+((lane&15)>>2))*64;
  const char*Kbase=shm+LDS_K; bf16x8 kf[8];
  const lds_cptr shm3=(lds_cptr)shm; const lds_cptr kp0=shm3+LDS_K+hi*1024+r32*16; const lds_cptr vp0=shm3+LDS_V+((lane>>4)&1)*32+(lane&3)*8+(4*hi+((lane&15)>>2))*64;
  const int NT=(q0+QB)/KVBLK-tskip;
  DMA_K(0,0);DMA_V(0,0);DMA_K(1,SLOTB);
  bf16x8 qr[4];
  #pragma unroll
  for(int d0=0;d0<4;++d0)qr[d0]=*reinterpret_cast<const bf16x8*>(&Qw[(long)r32*DM+d0*16+hi*8]);
  float mhat=0.f,l_reg=0.f;f32x16 o[2];o[0]=f32x16{};o[1]=f32x16{};
  const int qrel=wid*QBLK+r32;
  #define CMASK(P0,P1,t) do{int jb_=(t)-(NT-4); if(jb_>=0)cmask(P0,P1,jb_,qrel,hi);}while(0)
  bool resc=false;
  #define START(P0,P1) do{ const float rm=rowmax(P0,P1); resc=false; \
    { const float dl=rm; mhat=fadd_s(mhat,dl); \
      _Pragma("unroll") for(int r=0;r<16;++r){P0[r]=fsub_s(P0[r],dl);P1[r]=fsub_s(P1[r],dl);} \
      } \
    _Pragma("unroll") for(int r=0;r<16;++r)P0[r]=__builtin_amdgcn_exp2f(P0[r]); }while(0)
  #define RESC() do{ if(resc){ asm volatile("s_waitcnt lgkmcnt(0)":::"memory"); \
      _Pragma("unroll") for(int d_=0;d_<2;++d_) _Pragma("unroll") for(int r=0;r<16;++r)o[d_][r]*=wsf[crow(r,hi)]; } }while(0)
  f32x16 pA0,pA1,pB0,pB1;
  int sl_prev=0,sl_cur=0,sl_next=SLOTB;
  #define ROT() do{sl_prev=sl_cur;sl_cur=sl_next;sl_next=(sl_next==(NSLOT-1)*SLOTB)?0:sl_next+SLOTB;}while(0)
  DMA_K(2,2*SLOTB);
  WAIT_BAR(3);
  { f32x16 c0in,c1in; bias_tuple(c0in,c1in,btl,0.f); qkt(pA0,pA1,Kbase,qr,c0in,c1in,r32,hi); } asm volatile("s_nop 15\n\ts_nop 7":"+v"(pA0),"+v"(pA1));CMASK(pA0,pA1,0);
  START(pA0,pA1);
  _Pragma("unroll") for(int r=0;r<16;++r)pA1[r]=__builtin_amdgcn_exp2f(pA1[r]);
  WAIT_BAR(0);
  DMA_K(3,0);DMA_V(1,SLOTB);
  ROT();
  kload8(kf,kp0+sl_cur);
  WAIT_BAR(2);
  s16x4 vlo[8],vhi[8]; u32x4 pw0,pw1,pw2,pw3;
  #define PKW(P,B) cvtpk_s(P[B],P[B+1])
  #define PAF(k) __builtin_bit_cast(bf16x8,pw##k)
  #define VFR(i) (bf16x8){vlo[i][0],vlo[i][1],vlo[i][2],vlo[i][3],vhi[i][0],vhi[i][1],vhi[i][2],vhi[i][3]}
  #define PIN(x) asm volatile("":"+v"(x))
  #define MX3(a,b,c) __builtin_fmaxf(__builtin_fmaxf((a),(b)),(c))
  #define GAPA(MF,A0,A1,A2,A3,W0,W1,PW) do{ MF; sacc+=A0; sacc+=A1; sacc+=A2; sacc+=A3; PIN(sacc); W0; W1; PIN(PW); SBAR(); }while(0)
  #define EX(v) __builtin_amdgcn_exp2f(v)
  #define GAPB(MF,X,B) do{ MF; X[B]=EX(X[B]); X[B+1]=EX(X[B+1]); X[B+2]=EX(X[B+2]); X[B+3]=EX(X[B+3]); PIN(X); SBAR(); }while(0)
  #define VRD(i) do{ vlo[i]=vtr(vp_+(((i)>>2)*4096+((i)&3)*1024)); vhi[i]=vtr(vp_+(((i)>>2)*4096+((i)&3)*1024+512)); }while(0)
  #define KRD(G,j) do{ if(G){ kload2(kf,kp0+sl_next,j); SBAR(); } }while(0)
  #define STEP(C0,C1,P0,P1,t,GK,GV,GL) do{ SBAR(); \
    const lds_cptr vp_=vp0+sl_prev; bias_tuple(C0,C1,btl+(t)*64,mhat); SBAR(); \
    VRD(0); SBAR(); float sacc=(P0[0]+P0[1]); \
    GAPA(C0=__builtin_amdgcn_mfma_f32_32x32x16_bf16(kf[0],qr[0],C0,0,0,0), P0[2],P0[3],P0[4],P0[5],     pw0[0]=PKW(P0,0), pw0[1]=PKW(P0,2), pw0); \
    VRD(4); SBAR(); GAPA(C1=__builtin_amdgcn_mfma_f32_32x32x16_bf16(kf[1],qr[0],C1,0,0,0), P0[6],P0[7],P0[8],P0[9],     pw0[2]=PKW(P0,4), pw0[3]=PKW(P0,6), pw0); \
    VRD(1); SBAR(); GAPA(C0=__builtin_amdgcn_mfma_f32_32x32x16_bf16(kf[2],qr[1],C0,0,0,0),   P0[10],P0[11],P0[12],P0[13], pw1[0]=PKW(P0,8), pw1[1]=PKW(P0,10), pw1); \
    VRD(5); SBAR(); GAPA(C1=__builtin_amdgcn_mfma_f32_32x32x16_bf16(kf[3],qr[1],C1,0,0,0),   P0[14],P0[15],P1[0],P1[1],   pw1[2]=PKW(P0,12),pw1[3]=PKW(P0,14), pw1); \
    VRD(2); SBAR(); GAPA(C0=__builtin_amdgcn_mfma_f32_32x32x16_bf16(kf[4],qr[2],C0,0,0,0),   P1[2],P1[3],P1[4],P1[5],     pw2[0]=PKW(P1,0), pw2[1]=PKW(P1,2), pw2); \
    VRD(6); SBAR(); GAPA(C1=__builtin_amdgcn_mfma_f32_32x32x16_bf16(kf[5],qr[2],C1,0,0,0),   P1[6],P1[7],P1[8],P1[9],     pw2[2]=PKW(P1,4), pw2[3]=PKW(P1,6), pw2); \
    VRD(3); SBAR(); GAPA(C0=__builtin_amdgcn_mfma_f32_32x32x16_bf16(kf[6],qr[3],C0,0,0,0),   P1[10],P1[11],P1[12],P1[13], pw3[0]=PKW(P1,8), pw3[1]=PKW(P1,10), pw3); \
    VRD(7); SBAR(); GAPA(C1=__builtin_amdgcn_mfma_f32_32x32x16_bf16(kf[7],qr[3],C1,0,0,0),   P1[14],P1[15],0.f,0.f,       pw3[2]=PKW(P1,12),pw3[3]=PKW(P1,14), pw3); \
    l_reg+=sacc; \
    if(GK){DMA_K((t)+3,sl_cur);} if(GV){DMA_V((t)+1,sl_next);} \
    CMASK(C0,C1,t); \
    { float a=MX3(C0[0],C0[1],C1[0]),b=MX3(C0[2],C0[3],C1[1]); a=MX3(a,C1[2],C1[3]); \
      _Pragma("unroll") for(int r=4;r<16;r+=4){a=MX3(a,C0[r],C0[r+1]);b=MX3(b,C0[r+2],C0[r+3]);a=MX3(a,C1[r],C1[r+1]);b=MX3(b,C1[r+2],C1[r+3]);} \
      float rm=__builtin_fmaxf(a,b); { auto rr=__builtin_amdgcn_permlane32_swap(__float_as_uint(rm),__float_as_uint(rm),false,false); rm=__builtin_fmaxf(__uint_as_float(rr[0]),__uint_as_float(rr[1])); } \
      resc=false; \
      if(__builtin_expect(__any(rm>(float)THRL),0)){ const float dl=__builtin_fmaxf(rm,0.f); mhat+=dl; \
        _Pragma("unroll") for(int r=0;r<16;++r){C0[r]-=dl;C1[r]-=dl;} \
        const float f=__builtin_amdgcn_exp2f(-dl); l_reg*=f; if(hi==0)wsf[r32]=f; resc=true; } } \
    SBAR(); \
    GAPB(o[0]=__builtin_amdgcn_mfma_f32_32x32x16_bf16(PAF(0),VFR(0),o[0],0,0,0), C0,0); \
    GAPB(o[1]=__builtin_amdgcn_mfma_f32_32x32x16_bf16(PAF(0),VFR(4),o[1],0,0,0), C0,4); \
    KRD(GL,0); GAPB(o[0]=__builtin_amdgcn_mfma_f32_32x32x16_bf16(PAF(1),VFR(1),o[0],0,0,0), C0,8); \
    KRD(GL,1); GAPB(o[1]=__builtin_amdgcn_mfma_f32_32x32x16_bf16(PAF(1),VFR(5),o[1],0,0,0), C0,12); \
    KRD(GL,2); GAPB(o[0]=__builtin_amdgcn_mfma_f32_32x32x16_bf16(PAF(2),VFR(2),o[0],0,0,0), C1,0); \
    KRD(GL,3); GAPB(o[1]=__builtin_amdgcn_mfma_f32_32x32x16_bf16(PAF(2),VFR(6),o[1],0,0,0), C1,4); \
    GAPB(o[0]=__builtin_amdgcn_mfma_f32_32x32x16_bf16(PAF(3),VFR(3),o[0],0,0,0), C1,8); \
    GAPB(o[1]=__builtin_amdgcn_mfma_f32_32x32x16_bf16(PAF(3),VFR(7),o[1],0,0,0), C1,12); \
    }while(0)
  int t=1;
  #undef CMASK
  #define CMASK(P0,P1,t) do{}while(0)
  for(;t+5<NT;t+=2){
    STEP(pB0,pB1,pA0,pA1,t,true,true,true);     WAIT_BAR(2); RESC(); ROT();
    STEP(pA0,pA1,pB0,pB1,t+1,true,true,true);   WAIT_BAR(2); RESC(); ROT();
  }
  #undef CMASK
  #define CMASK(P0,P1,t) do{int jb_=(t)-(NT-4); if(jb_>=0)cmask(P0,P1,jb_,qrel,hi);}while(0)
  #define ENDW(tt) do{ if((tt)+3<NT){WAIT_BAR(2);} else if((tt)+2<NT){WAIT_BAR(1);} else {WAIT_BAR(0);} }while(0)
  for(;t+1<NT;t+=2){
    STEP(pB0,pB1,pA0,pA1,t,(t+3<NT),(t+1<NT),(t+1<NT));       ENDW(t);   RESC(); ROT();
    STEP(pA0,pA1,pB0,pB1,t+1,(t+4<NT),(t+2<NT),(t+2<NT));     ENDW(t+1); RESC(); ROT();
  }
  STEP(pB0,pB1,pA0,pA1,NT-1,false,false,false); RESC();
  { float sacc=pB0[0]+pB0[1]; _Pragma("unroll") for(int r=2;r<16;++r)sacc+=pB0[r]; _Pragma("unroll") for(int r=0;r<16;++r)sacc+=pB1[r]; l_reg+=sacc;
    pw0=(u32x4){PKW(pB0,0),PKW(pB0,2),PKW(pB0,4),PKW(pB0,6)};pw1=(u32x4){PKW(pB0,8),PKW(pB0,10),PKW(pB0,12),PKW(pB0,14)};pw2=(u32x4){PKW(pB1,0),PKW(pB1,2),PKW(pB1,4),PKW(pB1,6)};pw3=(u32x4){PKW(pB1,8),PKW(pB1,10),PKW(pB1,12),PKW(pB1,14)};
    SBAR(); pv(o,vb0+sl_cur,PAF(0),PAF(1),PAF(2),PAF(3)); }
  #undef PKW
  #undef PAF
  #undef VFR
  #undef PIN
  #undef MX3
  #undef GAPA
  #undef GAPB
  #undef EX
  #undef VRD
  #undef KRD
  #undef STEP
  #undef ENDW
  {auto rr=__builtin_amdgcn_permlane32_swap(__float_as_uint(l_reg),__float_as_uint(l_reg),false,false);l_reg=__uint_as_float(rr[0])+__uint_as_float(rr[1]);}
  if(hi==0)wsf[32+r32]=l_reg;asm volatile("s_waitcnt lgkmcnt(0)":::"memory");
  float rli[16];
  #pragma unroll
  for(int r=0;r<16;++r)rli[r]=__builtin_amdgcn_rcpf(wsf[32+crow(r,hi)]);
  bf16*Ow=O+(rowbase+q0+wid*QBLK)*DM+h*D;
  { bf16*stg=(bf16*)(shm+LDS_OST)+wid*2048;
    #pragma unroll
    for(int r=0;r<16;++r){const int orow=crow(r,hi);
      #pragma unroll
      for(int d0=0;d0<2;++d0)stg[orow*64+d0*32+r32]=__float2bfloat16(o[d0][r]*rli[r]);}
    asm volatile("s_waitcnt lgkmcnt(0)":::"memory");
    #pragma unroll
    for(int i=0;i<4;++i){const int row=i*8+(lane>>3),ch=lane&7; const u32x4 v=*(const u32x4*)(stg+row*64+ch*8); ATTN_STORE16(Ow+(long)row*DM+ch*8,v);} }
  asm volatile("s_waitcnt lgkmcnt(0)\n\ts_barrier":::"memory");
  #undef DMA_K
  #undef DMA_V
  #undef CMASK
  #undef START
  #undef RESC
  #undef ROT
}
constexpr int ATTN_LDS_BYTES=LDS_BYTES;
struct AttnTensors { const bf16* Q; const bf16* K; const bf16* V; bf16* O; const float* cum; };
struct AttnUnit { int bh; int qb; };
struct StaticOrder {
  int vcu;
  __device__ __forceinline__ explicit StaticOrder(int grid,int block):vcu((block%8)*(grid/8)+block/8){}
  __device__ __forceinline__ bool next(int i,AttnUnit&u)const{ if(i>=4||vcu>=256)return false; const int s=vcu&3; u.bh=(vcu>>5)*NHEAD+((((vcu>>2)&7)+2*i)&7); u.qb=(i==0)?s:(i==1)?7-s:(i==2)?8+s:15-s; return true; }
  __device__ __forceinline__ void a_ready(const AttnUnit&)const{}
  __device__ __forceinline__ void done(const AttnUnit&)const{}
};
struct QueueOrder {
  unsigned* q; volatile __attribute__((address_space(3))) int* slot;
  __device__ __forceinline__ bool next(int,AttnUnit&u)const{
    if(threadIdx.x==0)slot[0]=(int)__hip_atomic_fetch_add(q,1u,__ATOMIC_RELAXED,__HIP_MEMORY_SCOPE_AGENT);
    asm volatile("s_waitcnt vmcnt(0) lgkmcnt(0)\n\ts_barrier":::"memory");
    const int v=__builtin_amdgcn_readfirstlane(slot[0]);
    asm volatile("s_waitcnt lgkmcnt(0)\n\ts_barrier":::"memory");
    if(v>=128)return false; u.qb=15-(v>>3); u.bh=7-(v&7); return true; }
  __device__ __forceinline__ void a_ready(const AttnUnit&)const{}
  __device__ __forceinline__ void done(const AttnUnit&)const{}
};
template<class Sched,int THRL=8> __device__ __forceinline__ void attn_phase(char*lds,const AttnTensors&T,const Sched&S){
  AttnUnit u;
  for(int i=0;S.next(i,u);++i){ S.a_ready(u); attn_unit<THRL>(u.bh/NHEAD,u.bh%NHEAD,u.qb,T.Q,T.K,T.V,T.O,T.cum,lds); S.done(u); }
}
#undef SBAR
#undef WAIT_BAR
}
constexpr int NWAVES = 8;
constexpr int RING_BYTES = 131072;
constexpr int LDSCTL_BYTES = 4096, RING_OFF = LDSCTL_BYTES;
constexpr int LDS_BYTES = 147456;
constexpr int CW_BAR = 4096;
typedef __attribute__((address_space(1))) unsigned gu32;

#define XB_TMO      128
#define XB_XCNT(j)  (256  + 64 * (j))
#define XB_XSUB(j)  (1280 + 64 * (j))
#define XB_XGEN(j)  (2304 + 64 * (j))
#define XB_TOP      3328
#define XB_TOPGEN   3392
#define XCD_BAR_WORDS 3456
#define XB_SPIN_CAP (1u << 18)
__device__ __forceinline__ unsigned xb_ld(unsigned* p)              { return __hip_atomic_load(p, __ATOMIC_RELAXED, __HIP_MEMORY_SCOPE_AGENT); }
__device__ __forceinline__ unsigned xb_add(unsigned* p, unsigned v) { return __hip_atomic_fetch_add(p, v, __ATOMIC_RELAXED, __HIP_MEMORY_SCOPE_AGENT); }
__device__ __forceinline__ unsigned xb_xcc_id() { return (unsigned)__builtin_amdgcn_s_getreg((3 << 11) | 20) & 0xFu; }
#define XB_SPIN(cond, bar) do { unsigned _sp = 0; while (cond) { __builtin_amdgcn_s_sleep(1); \
    if ((++_sp & 255u) == 0u) { if (xb_ld(&(bar)[XB_TMO])) break; if (_sp > XB_SPIN_CAP) { atomicAdd(&(bar)[XB_TMO], 1u); break; } } } } while (0)
struct XcdBarrier { unsigned* bar; unsigned x; volatile LAS unsigned* st; };
__device__ __forceinline__ XcdBarrier xcd_barrier_post(unsigned* bar, volatile LAS unsigned* st) {
    XcdBarrier b; b.bar = bar; b.x = xb_xcc_id(); b.st = st;
    if (threadIdx.x == 0) (void)xb_add(&bar[XB_XCNT(b.x)], 1u);
    return b;
}
__device__ __forceinline__ void xcd_barrier_complete(unsigned* bar, unsigned x, unsigned& nloc, unsigned& nx) {
    const unsigned G = gridDim.x * gridDim.y * gridDim.z;
    unsigned sum, cnt, mine, sp = 0u;
    for (;;) {
        sum = 0u; cnt = 0u; mine = 0u;
#pragma unroll
        for (unsigned j = 0; j < 16; ++j) { const unsigned c = xb_ld(&bar[XB_XCNT(j)]); sum += c; cnt += (c > 0u) ? 1u : 0u; mine = (j == x) ? c : mine; }
        if (sum == G) break;
        __builtin_amdgcn_s_sleep(1);
        if ((++sp & 255u) == 0u) { if (xb_ld(&bar[XB_TMO])) break; if (sp > XB_SPIN_CAP) { atomicAdd(&bar[XB_TMO], 1u); break; } }
    }
    nloc = mine > 0u ? mine : 1u; nx = cnt > 0u ? cnt : 1u;
}
__device__ __forceinline__ void xcd_barrier(const XcdBarrier& b) {
    asm volatile("s_waitcnt vmcnt(0)" ::: "memory");
    __syncthreads();
    if (threadIdx.x == 0) {
        unsigned* bar = b.bar;
        __builtin_amdgcn_s_waitcnt(0);
        unsigned nloc = b.st[0], nx = b.st[1];
        if (nloc == 0u) { xcd_barrier_complete(bar, b.x, nloc, nx); b.st[0] = nloc; b.st[1] = nx; }
        const unsigned old = xb_add(&bar[XB_XSUB(b.x)], 1u);
        const unsigned gen = old / nloc;
        if (old + 1u == (gen + 1u) * nloc) {
            __builtin_amdgcn_fence(__ATOMIC_RELEASE, "agent");
            asm volatile("s_waitcnt vmcnt(0)" ::: "memory");
            const unsigned og = xb_add(&bar[XB_TOP], 1u);
            const unsigned tg = og / nx;
            if (og + 1u == (tg + 1u) * nx) xb_add(&bar[XB_TOPGEN], 1u);
            else XB_SPIN(xb_ld(&bar[XB_TOPGEN]) == tg, bar);
            __builtin_amdgcn_fence(__ATOMIC_ACQUIRE, "agent");
            xb_add(&bar[XB_XGEN(b.x)], 1u);
            asm volatile("s_waitcnt vmcnt(0)" ::: "memory");
        } else {
            XB_SPIN(xb_ld(&bar[XB_XGEN(b.x)]) == gen, bar);
            __builtin_amdgcn_fence(__ATOMIC_ACQUIRE, "agent");
            asm volatile("s_waitcnt vmcnt(0)" ::: "memory");
        }
    }
    __syncthreads();
}

struct MoeOrder {
    const volatile LAS int* tpre; const unsigned* cnt; const int* tok; const char* A; const char* B; size_t estepB, tstepB, tstepA; int nN, G, c, lda; bool gather;
    int r0x;
    __device__ __forceinline__ bool unit_at(int mt, int pn, pg8::Unit& u) const {
        if (mt >= tpre[32]) return false;
        const int e = __builtin_amdgcn_readfirstlane((int)((volatile LAS unsigned char*)(tpre + 96))[mt]);
        const int lt = __builtin_amdgcn_readfirstlane(mt - tpre[e]);
        const int rem = tpre[33 + e] - lt * 256;
        u.e = e; u.pm = mt; u.pn = pn; u.valid = rem < 256 ? rem : 256; u.lt = lt; u.lda = 1024; u.ldb = 1024; u.nt = 16; u.seg = 0;
        u.B = B + (size_t)e * estepB + (size_t)pn * tstepB;
        u.A = gather ? A : A + (size_t)mt * tstepA;
        return true;
    }
    __device__ __forceinline__ bool next(int i, pg8::Unit& u) const {
        const int x = c & 7, j = c >> 3, per = (G >> 3) / nN, pn = j % nN; int mt = (i * 8 + x) * per + j / nN;
        if (r0x >= 0) { const int k = r0x + 1; mt = mt < k ? mt : (mt < 2 * k ? 32 + (mt - k) : 64 + (mt - 2 * k)); }
        return unit_at(mt, pn, u);
    }
    __device__ __forceinline__ void goff(const pg8::Unit& u, int R0, int C0, unsigned (&off)[2][2]) const {
#pragma unroll
        for (int h = 0; h < 2; ++h)
#pragma unroll
            for (int i = 0; i < 2; ++i) { const int r = h * 128 + R0 + 64 * i; const int t = r < u.valid ? ((const __attribute__((address_space(1))) int*)tok)[(size_t)u.e * NTOK + u.lt * 256 + r] : 0;     off[h][i] = (unsigned)(t * lda + C0) * 2u; }
    }
};
struct MoeOne { MoeOrder M; int mt, pn;
    __device__ __forceinline__ bool next(int i, pg8::Unit& u) const { if (i) return false; return M.unit_at(mt, pn, u); }
    __device__ __forceinline__ void goff(const pg8::Unit& u, int R0, int C0, unsigned (&off)[2][2]) const { M.goff(u, R0, C0, off); }
};
__device__ __forceinline__ void moe_prefix(const unsigned* cnt, volatile LAS int* tpre) {
    int tid = threadIdx.x; asm volatile("" : "+v"(tid));
    if (tid < 64) { const int c = tid < 32 ? (int)cnt[tid * CNT_STRIDE] : 0; const int tl = (c + 255) >> 8; int inc = tl;
#pragma unroll
        for (int o = 1; o < 32; o <<= 1) { const int t = __shfl_up(inc, o); if (tid >= o) inc += t; }
        if (tid < 32) { tpre[tid] = inc - tl; tpre[33 + tid] = c; if (tid == 31) tpre[32] = inc; } }
    __syncthreads();
    { volatile LAS unsigned char* tmap = (volatile LAS unsigned char*)(tpre + 96);
      const int tot = tpre[32];
      for (int mt = tid; mt < tot; mt += NWAVES * 64) { int e = 0;
#pragma unroll
          for (int k = 1; k < 32; ++k) e += (tpre[k] <= mt) ? 1 : 0;
          tmap[mt] = (unsigned char)e; } }
    __syncthreads();
}

constexpr size_t WS_S5W1 = 58 * MiB;
constexpr size_t WS_S5W3 = 66 * MiB;
constexpr size_t WS_S5A16 = 78 * MiB;
constexpr size_t WS_S5S = 2304 * MiB;
constexpr size_t WS_OB = 2320 * MiB;
constexpr size_t WS_GQ = 2640 * MiB;
constexpr size_t WS_END2 = 2736 * MiB;

struct S5Disc { float lr, li, dt, zr, zi; };
__device__ __forceinline__ S5Disc s5_disc(const float* lam_re, const float* lam_im, const float* log_dt, int g, int p) {
    S5Disc d; d.dt = expf(log_dt[g]); d.lr = lam_re[g * 64 + p]; d.li = lam_im[g * 64 + p];
    const float mag = expf(d.lr * d.dt), ar = mag * cosf(d.li * d.dt), ai = mag * sinf(d.li * d.dt), den = d.lr * d.lr + d.li * d.li, nr = ar - 1.0f;
    d.zr = (nr * d.lr + ai * d.li) / den; d.zi = (ai * d.lr - nr * d.li) / den; return d;
}
__device__ __forceinline__ void s5_apow(const S5Disc& d, float n, float& pr, float& pi) { const float mag = expf(d.lr * d.dt * n); pr = mag * cosf(d.li * d.dt * n); pi = mag * sinf(d.li * d.dt * n); }

struct S5In { const float *lam_re, *lam_im, *log_dt, *b_re, *b_im, *c_re, *c_im, *dsk; };
__device__ __forceinline__ void s5_prep_item(const S5In& in, unsigned char* ws, int l, int g, int kind, int q, int lane) {
    const float* lam_re = in.lam_re + (size_t)l * 1024; const float* lam_im = in.lam_im + (size_t)l * 1024; const float* log_dt = in.log_dt + (size_t)l * 16;
    const float* b_re = in.b_re + (size_t)l * 16384; const float* b_im = in.b_im + (size_t)l * 16384; const float* c_re = in.c_re + (size_t)l * 16384; const float* c_im = in.c_im + (size_t)l * 16384;
    const float* dsk = in.dsk + (size_t)l * 256;
    bf16_t* W1 = (bf16_t*)(ws + WS_S5W1) + ((size_t)l * 16 + g) * 256 * 256;
    bf16_t* W3 = (bf16_t*)(ws + WS_S5W3) + ((size_t)l * 16 + g) * 256 * 384;
    const int p = lane;
    const S5Disc d = s5_disc(lam_re, lam_im, log_dt, g, p);
    if (kind == 0) {
        float pr, pi; s5_apow(d, (float)q, pr, pi);
        float mr[16], mi[16];
#pragma unroll
        for (int h = 0; h < 16; ++h) { const float br = b_re[(g * 64 + p) * 16 + h], bi = b_im[(g * 64 + p) * 16 + h]; const float bbr = d.zr * br - d.zi * bi, bbi = d.zr * bi + d.zi * br;
            mr[h] = pr * bbr - pi * bbi; mi[h] = pr * bbi + pi * bbr; }
        float crv[16], civ[16];
#pragma unroll
        for (int hp = 0; hp < 16; ++hp) { crv[hp] = c_re[(g * 16 + hp) * 64 + p]; civ[hp] = c_im[(g * 16 + hp) * 64 + p]; }
#pragma unroll
        for (int hp = 0; hp < 16; ++hp) {
            const float cr = crv[hp], ci = civ[hp];
            float v[16];
#pragma unroll
            for (int h = 0; h < 16; ++h) v[h] = cr * mr[h] - ci * mi[h];
            reduce_scatter<16>(v, lane);
            const int h = (lane >> 2) & 15;
            float kv = v[0]; if (q == 0 && h == hp) kv += dsk[g * 16 + hp];
            const bf16_t kb = f2bf(kv);
            for (int s = (lane & 3); s + q < 16; s += 4) { const int t = s + q;
                W3[(size_t)(t * 16 + hp) * 384 + s * 16 + h] = kb;
                if (q > 0) W3[(size_t)(s * 16 + hp) * 384 + t * 16 + h] = 0; }
        }
    } else if (kind == 1) {
        float pr, pi; s5_apow(d, (float)(15 - q), pr, pi);
        u32x4 wr0, wr1, wi0, wi1; unsigned wr_[8], wi_[8];
#pragma unroll
        for (int h2 = 0; h2 < 8; ++h2) { float re[2], im[2];
#pragma unroll
            for (int e = 0; e < 2; ++e) { const int h = 2 * h2 + e; const float br = b_re[(g * 64 + p) * 16 + h], bi = b_im[(g * 64 + p) * 16 + h]; const float bbr = d.zr * br - d.zi * bi, bbi = d.zr * bi + d.zi * br;
                re[e] = pr * bbr - pi * bbi; im[e] = pr * bbi + pi * bbr; }
            wr_[h2] = pk2(re[0], re[1]); wi_[h2] = pk2(im[0], im[1]); }
        wr0 = (u32x4){wr_[0], wr_[1], wr_[2], wr_[3]}; wr1 = (u32x4){wr_[4], wr_[5], wr_[6], wr_[7]}; wi0 = (u32x4){wi_[0], wi_[1], wi_[2], wi_[3]}; wi1 = (u32x4){wi_[4], wi_[5], wi_[6], wi_[7]};
        *(u32x4*)(W1 + (size_t)p * 256 + q * 16) = wr0; *(u32x4*)(W1 + (size_t)p * 256 + q * 16 + 8) = wr1;
        *(u32x4*)(W1 + (size_t)(64 + p) * 256 + q * 16) = wi0; *(u32x4*)(W1 + (size_t)(64 + p) * 256 + q * 16 + 8) = wi1;
        const u32x4 z = (u32x4){0u, 0u, 0u, 0u};
        *(u32x4*)(W1 + (size_t)(128 + p) * 256 + q * 16) = z; *(u32x4*)(W1 + (size_t)(128 + p) * 256 + q * 16 + 8) = z;
        *(u32x4*)(W1 + (size_t)(192 + p) * 256 + q * 16) = z; *(u32x4*)(W1 + (size_t)(192 + p) * 256 + q * 16 + 8) = z;
    } else {
        float pr, pi; s5_apow(d, (float)(q + 1), pr, pi);
#pragma unroll
        for (int hp = 0; hp < 16; ++hp) { const float cr = c_re[(g * 16 + hp) * 64 + p], ci = c_im[(g * 16 + hp) * 64 + p];
            W3[(size_t)(q * 16 + hp) * 384 + 256 + p] = f2bf(cr * pr - ci * pi);
            W3[(size_t)(q * 16 + hp) * 384 + 320 + p] = f2bf(-(cr * pi + ci * pr)); }
        if (q == 0) { float ar, ai; s5_apow(d, 16.0f, ar, ai); float* A16 = (float*)(ws + WS_S5A16) + (((size_t)l * 16 + g) * 64 + p) * 2; A16[0] = ar; A16[1] = ai; }
    }
}

__device__ __forceinline__ void s5_scan_wg(const float* S, const float* a16, bf16_t* A3, int b, int g, LAS float* sl) {
    int tid = threadIdx.x; asm volatile("" : "+v"(tid));
    const f32x4* src = (const f32x4*)(S + ((size_t)g * 2048 + b * 256) * 128);
#pragma unroll 1
    for (int i0 = tid; i0 < 8192; i0 += 8 * NWAVES * 64) { f32x4 w[8];
#pragma unroll
        for (int u = 0; u < 8; ++u) w[u] = src[i0 + u * NWAVES * 64];
#pragma unroll
        for (int u = 0; u < 8; ++u) *(LAS f32x4*)(sl + 4 * (i0 + u * NWAVES * 64)) = w[u]; }
    __syncthreads();
    if (tid < 64) {
        const int lane = tid; const float ar = a16[(g * 64 + lane) * 2], ai = a16[(g * 64 + lane) * 2 + 1];
        bf16_t* hp = A3 + ((size_t)g * 2048 + b * 256) * 384 + 256 + lane;
        float hr = 0.f, hi = 0.f;
#pragma unroll 8
        for (int c = 0; c < 256; ++c) { const float sr = sl[c * 128 + lane], si = sl[c * 128 + 64 + lane];
            hp[(size_t)c * 384] = f2bf(hr); hp[(size_t)c * 384 + 64] = f2bf(hi);
            const float nr = ar * hr - ai * hi + sr, ni = ar * hi + ai * hr + si; hr = nr; hi = ni; }
        asm volatile("s_waitcnt vmcnt(0)" ::: "memory");
        __builtin_amdgcn_fence(__ATOMIC_ACQUIRE, "agent");
        asm volatile("s_waitcnt vmcnt(0)" ::: "memory");
    }
    __syncthreads();
}

typedef float f32x16p __attribute__((ext_vector_type(16)));
__device__ __forceinline__ void pool_phase(const bf16_t* H, const float* wpool, const float* pscale, bf16_t* yb, int bx, int G, LAS unsigned char* lds) {
    int tid = threadIdx.x; asm volatile("" : "+v"(tid));
    const int lane = tid & 63, w8 = tid >> 6, g = w8 >> 1, tb = (w8 & 1) * 32, r = lane & 31, hi = lane >> 5;
    LAS bf16_t* ut = (LAS bf16_t*)lds; LAS bf16_t* mxb = (LAS bf16_t*)(lds + 79 * 512);
    bf16x8 wf[4][2]; float ps[2];
#pragma unroll
    for (int ks = 0; ks < 4; ++ks)
#pragma unroll
        for (int cb = 0; cb < 2; ++cb) { unsigned pk[4];
#pragma unroll
            for (int j2 = 0; j2 < 4; ++j2) { const float a = wpool[(g * 64 + 16 * ks + 8 * hi + 2 * j2) * 64 + 32 * cb + r], b = wpool[(g * 64 + 16 * ks + 8 * hi + 2 * j2 + 1) * 64 + 32 * cb + r]; pk[j2] = pk2(a, b); }
            wf[ks][cb] = __builtin_bit_cast(bf16x8, (u32x4){pk[0], pk[1], pk[2], pk[3]}); }
    ps[0] = pscale[g * 64 + r]; ps[1] = pscale[g * 64 + 32 + r];
    u32x4 wn[5];
#pragma unroll
    for (int u = 0; u < 5; ++u) { const int c = tid + u * NWAVES * 64; const int rr = c >> 5, ch8 = (c & 31) * 8; const int tok = bx * 64 - 15 + rr; wn[u] = (u32x4){0u, 0u, 0u, 0u}; if (bx < NTOK / 64 && c < 79 * 32 && tok >= 0) wn[u] = *(const GAS u32x4*)((const GAS bf16_t*)H + (size_t)tok * HP + HC_POOL + ch8); }
    for (int item = bx; item < NTOK / 64; item += G) {
        const int t0 = item * 64;
        {
#pragma unroll
          for (int u = 0; u < 5; ++u) { const int c = tid + u * NWAVES * 64; if (c < 79 * 32) *(LAS u32x4*)(ut + (c >> 5) * 256 + (c & 31) * 8) = wn[u]; }
          const int t1 = (item + G) * 64;
#pragma unroll
          for (int u = 0; u < 5; ++u) { const int c = tid + u * NWAVES * 64; const int rr = c >> 5, ch8 = (c & 31) * 8; const int tok = t1 - 15 + rr; wn[u] = (u32x4){0u, 0u, 0u, 0u}; if (item + G < NTOK / 64 && c < 79 * 32 && tok >= 0) wn[u] = *(const GAS u32x4*)((const GAS bf16_t*)H + (size_t)tok * HP + HC_POOL + ch8); } }
        __syncthreads();
        { const int ch = tid & 255, half = tid >> 8, gg = ch >> 6, w = 2 << gg, l0 = half * 32, tf = (t0 + l0) & (SEQ - 1);
          float s = 0.f;
          for (int k = 1; k < w; ++k) if (tf - k >= 0) s += bf2f(ut[(15 + l0 - k) * 256 + ch]);
#pragma unroll 4
          for (int q = 0; q < 32; ++q) { const int lt = l0 + q, t = tf + q; const float u = bf2f(ut[(15 + lt) * 256 + ch]);
              s += u; if (q > 0 && t >= w) s -= bf2f(ut[(15 + lt - w) * 256 + ch]);
              const int cnt = (t + 1 < w) ? t + 1 : w;
              mxb[lt * 264 + ch] = f2bf(s * __builtin_amdgcn_rcpf((float)cnt) - u); } }
        __syncthreads();
        f32x16p acc[2];
#pragma unroll
        for (int cb = 0; cb < 2; ++cb)
#pragma unroll
            for (int q = 0; q < 16; ++q) acc[cb][q] = 0.f;
#pragma unroll
        for (int ks = 0; ks < 4; ++ks) { const bf16x8 a = *(const LAS bf16x8*)(mxb + (tb + r) * 264 + g * 64 + 16 * ks + 8 * hi);
            acc[0] = __builtin_amdgcn_mfma_f32_32x32x16_bf16(a, wf[ks][0], acc[0], 0, 0, 0); acc[1] = __builtin_amdgcn_mfma_f32_32x32x16_bf16(a, wf[ks][1], acc[1], 0, 0, 0); }
#pragma unroll
        for (int cb = 0; cb < 2; ++cb)
#pragma unroll
            for (int q = 0; q < 16; ++q) { const int tok = t0 + tb + (q & 3) + 8 * (q >> 2) + 4 * hi; yb[(size_t)tok * 256 + g * 64 + 32 * cb + r] = f2bf(acc[cb][q] * ps[cb]); }
        __syncthreads();
    }
}

constexpr int WT_PITCH = 1028;
__device__ __forceinline__ void load_wt_lds(const float* W, int ldw, int ne, volatile LAS float* Tv) {
    int tid0 = threadIdx.x; asm volatile("" : "+v"(tid0));
    LAS float* T = (LAS float*)Tv; const int q = ne >> 2, tot = 1024 * q;
    for (int base = tid0; base < tot; base += 8 * NWAVES * 64) {
        f32x4 w[8];
#pragma unroll
        for (int u = 0; u < 8; ++u) { const int idx = base + u * NWAVES * 64; if (idx < tot) { const int k = idx / q, e4 = (idx - k * q) * 4; w[u] = *(const f32x4*)(W + (size_t)k * ldw + e4); } }
#pragma unroll
        for (int u = 0; u < 8; ++u) { const int idx = base + u * NWAVES * 64; if (idx < tot) { const int k = idx / q, e4 = (idx - k * q) * 4;
            T[(e4 + 0) * WT_PITCH + k] = w[u].x; T[(e4 + 1) * WT_PITCH + k] = w[u].y; T[(e4 + 2) * WT_PITCH + k] = w[u].z; T[(e4 + 3) * WT_PITCH + k] = w[u].w; } }
    }
    __syncthreads();
}
__device__ __forceinline__ void wave_sum2(float& a, float& b) {
#pragma unroll
    for (int o = 1; o < 64; o <<= 1) { const float ta = __shfl_xor(a, o), tb = __shfl_xor(b, o); a += ta; b += tb; } }
__device__ __forceinline__ void wave_max2(float a, float b, float& ra, float& rb) {
#pragma unroll
    for (int o = 32; o >= 1; o >>= 1) { const float ta = __shfl_xor(a, o), tb = __shfl_xor(b, o); a = fmaxf(a, ta); b = fmaxf(b, tb); }
    ra = a; rb = b; }
__device__ __forceinline__ void wave_min2(int a, int b, int& ra, int& rb) {
#pragma unroll
    for (int o = 32; o >= 1; o >>= 1) { const int ta = __shfl_xor(a, o), tb = __shfl_xor(b, o); a = ta < a ? ta : a; b = tb < b ? tb : b; }
    ra = a; rb = b; }
__device__ __forceinline__ void row_ln2(f32x4 (&v)[4], f32x4 (&w)[4], const float* g, const float* bta, int lane) {
    f32x4 gg[4], bb[4];
#pragma unroll
    for (int j = 0; j < 4; ++j) { gg[j] = *(const GAS f32x4*)((const GAS float*)g + 4 * (lane + 64 * j)); bb[j] = *(const GAS f32x4*)((const GAS float*)bta + 4 * (lane + 64 * j)); }
    float s = 0.f, t = 0.f;
#pragma unroll
    for (int j = 0; j < 4; ++j) { s += (v[j].x + v[j].y) + (v[j].z + v[j].w); t += (w[j].x + w[j].y) + (w[j].z + w[j].w); }
    wave_sum2(s, t); const float mv = s * (1.f / D), mw = t * (1.f / D); float s2 = 0.f, t2 = 0.f;
#pragma unroll
    for (int j = 0; j < 4; ++j) { v[j] = v[j] - mv; w[j] = w[j] - mw; s2 += (v[j].x * v[j].x + v[j].y * v[j].y) + (v[j].z * v[j].z + v[j].w * v[j].w); t2 += (w[j].x * w[j].x + w[j].y * w[j].y) + (w[j].z * w[j].z + w[j].w * w[j].w); }
    wave_sum2(s2, t2); const float rv = __builtin_amdgcn_rsqf(s2 * (1.f / D) + LN_EPS), rw = __builtin_amdgcn_rsqf(t2 * (1.f / D) + LN_EPS);
#pragma unroll
    for (int j = 0; j < 4; ++j) { v[j] = v[j] * rv * gg[j] + bb[j]; w[j] = w[j] * rw * gg[j] + bb[j]; }
}
__device__ __forceinline__ void row_ln2s(f32x4 (&v)[4], f32x4 (&w)[4], const float* g, const float* bta, int lane, float& mv, float& rv, float& mw, float& rw) {
    f32x4 gg[4], bb[4];
#pragma unroll
    for (int j = 0; j < 4; ++j) { gg[j] = *(const GAS f32x4*)((const GAS float*)g + 4 * (lane + 64 * j)); bb[j] = *(const GAS f32x4*)((const GAS float*)bta + 4 * (lane + 64 * j)); }
    float s = 0.f, t = 0.f;
#pragma unroll
    for (int j = 0; j < 4; ++j) { s += (v[j].x + v[j].y) + (v[j].z + v[j].w); t += (w[j].x + w[j].y) + (w[j].z + w[j].w); }
    wave_sum2(s, t); mv = s * (1.f / D); mw = t * (1.f / D); float s2 = 0.f, t2 = 0.f;
#pragma unroll
    for (int j = 0; j < 4; ++j) { v[j] = v[j] - mv; w[j] = w[j] - mw; s2 += (v[j].x * v[j].x + v[j].y * v[j].y) + (v[j].z * v[j].z + v[j].w * v[j].w); t2 += (w[j].x * w[j].x + w[j].y * w[j].y) + (w[j].z * w[j].z + w[j].w * w[j].w); }
    wave_sum2(s2, t2); rv = __builtin_amdgcn_rsqf(s2 * (1.f / D) + LN_EPS); rw = __builtin_amdgcn_rsqf(t2 * (1.f / D) + LN_EPS);
#pragma unroll
    for (int j = 0; j < 4; ++j) { v[j] = v[j] * rv * gg[j] + bb[j]; w[j] = w[j] * rw * gg[j] + bb[j]; }
}
template <int N> __device__ __forceinline__ void reduce_scatter2(float (&v)[N], float (&w)[N], int lane) {
    int s = 32;
#pragma unroll
    for (int n = N / 2; n >= 1; n >>= 1) {
        const bool up = (lane & s) != 0;
#pragma unroll
        for (int i = 0; i < n; ++i) { float hi = v[i + n], lo = v[i], hj = w[i + n], lj = w[i]; asm volatile("" : "+v"(hi), "+v"(lo), "+v"(hj), "+v"(lj));
            const float kv = up ? hi : lo, sv = up ? lo : hi, kw = up ? hj : lj, sw = up ? lj : hj; v[i] = kv + __shfl_xor(sv, s); w[i] = kw + __shfl_xor(sw, s); }
        s >>= 1;
    }
    for (; s >= 1; s >>= 1) { const float ta = __shfl_xor(v[0], s), tb = __shfl_xor(w[0], s); v[0] += ta; w[0] += tb; }
}
template <int NEX> __device__ __forceinline__ void row_dot2_lds(const f32x4 (&v0)[4], const f32x4 (&v1)[4], const LAS float* T, float (&a0)[NEX], float (&a1)[NEX], int lane) {
#pragma unroll
    for (int e = 0; e < NEX; ++e) { f32x2 p0 = (f32x2){0.f, 0.f}, p1 = (f32x2){0.f, 0.f};
#pragma unroll
        for (int j = 0; j < 4; ++j) { const f32x4 w = *(const LAS f32x4*)(T + e * WT_PITCH + 4 * (lane + 64 * j));
            p0 = __builtin_elementwise_fma((f32x2){v0[j].x, v0[j].y}, (f32x2){w.x, w.y}, p0); p0 = __builtin_elementwise_fma((f32x2){v0[j].z, v0[j].w}, (f32x2){w.z, w.w}, p0);
            p1 = __builtin_elementwise_fma((f32x2){v1[j].x, v1[j].y}, (f32x2){w.x, w.y}, p1); p1 = __builtin_elementwise_fma((f32x2){v1[j].z, v1[j].w}, (f32x2){w.z, w.w}, p1); }
        a0[e] = p0.x + p0.y; a1[e] = p1.x + p1.y;
        if ((e & 3) == 3) { asm volatile("" ::: "memory"); __builtin_amdgcn_sched_barrier(0); } }
}
__device__ __forceinline__ void row_logf_fin(float (&a)[8], const float* bf_l, float* logf, int m, int lane) {
    reduce_scatter<8>(a, lane);
    if ((lane & 7) == 0) { const int h = lane >> 3; const float z = a[0] + ((const GAS float*)bf_l)[h]; const float ls = fminf(z, 0.f) - 0.6931471805599453f * __builtin_amdgcn_logf(1.0f + __builtin_amdgcn_exp2f(-L2E * fabsf(z)));
        const int b = m / SEQ, t = m % SEQ; ((GAS float*)logf)[((size_t)b * 8 + h) * SEQ + t] = ls; }
}
__device__ __forceinline__ void rows0_phase(const float* x, const float* w_in0, const float* bf0, bf16_t* xb, float* logf, volatile LAS float* T, int gw, int NGW, int lane) {
    asm volatile("" : "+v"(lane));
    load_wt_lds(w_in0 + 1536, NIN, 8, T);
    f32x4 n0[4], n1[4];
    if (2 * gw < NTOK) {
#pragma unroll
        for (int j = 0; j < 4; ++j) { n0[j] = *(const GAS f32x4*)((const GAS float*)x + (size_t)(2 * gw) * D + 4 * (lane + 64 * j)); n1[j] = *(const GAS f32x4*)((const GAS float*)x + (size_t)(2 * gw + 1) * D + 4 * (lane + 64 * j)); } }
    for (int m = 2 * gw; m < NTOK; m += 2 * NGW) {
        f32x4 v0[4], v1[4];
#pragma unroll
        for (int j = 0; j < 4; ++j) { v0[j] = n0[j]; v1[j] = n1[j]; }
        { const int mn = m + 2 * NGW; if (mn < NTOK) {
#pragma unroll
            for (int j = 0; j < 4; ++j) { n0[j] = *(const GAS f32x4*)((const GAS float*)x + (size_t)mn * D + 4 * (lane + 64 * j)); n1[j] = *(const GAS f32x4*)((const GAS float*)x + (size_t)(mn + 1) * D + 4 * (lane + 64 * j)); } } }
        float a0[8], a1[8]; row_dot2_lds<8>(v0, v1, (const LAS float*)T, a0, a1, lane);
        row_store_bf16(v0, xb + (size_t)m * D, lane); row_logf_fin(a0, bf0, logf, m, lane);
        row_store_bf16(v1, xb + (size_t)(m + 1) * D, lane); row_logf_fin(a1, bf0, logf, m + 1, lane);
    }
    __syncthreads();
}
__device__ __forceinline__ void rows1_phase(const bf16_t* xinb, const bf16_t* mix, const float* g1, const float* b1, const float* wr, const float* br, bf16_t* x1b, unsigned* cnt, int* tok, int* re, int* rr, float* rg,
                                            volatile LAS float* T, volatile LAS unsigned* lcnt, volatile LAS unsigned* lbase, volatile LAS float* wscr_all, int bx, int G, int wave, int lane) {
    asm volatile("" : "+v"(lane));
    volatile LAS float* wscr = wscr_all + wave * 32;
    const int tid = wave * 64 + lane;
    if (tid < 32) lcnt[tid] = 0u;
    load_wt_lds(wr, 32, 32, T);
    for (int blk = bx; blk < NTOK / 128; blk += G) {
        const int row0 = blk * 128 + wave * 16;
        int my_e = 0; float my_g = 0.f;
#pragma unroll 1
        for (int i = 0; i < 16; i += 2) {
            const int m = row0 + i; f32x4 v0[4], v1[4];
#pragma unroll
            for (int j = 0; j < 4; ++j) { f32x4 xa, xb_; { const u32x2 wa = *(const u32x2*)(xinb + (size_t)m * D + 4 * (lane + 64 * j)), wb = *(const u32x2*)(xinb + (size_t)(m + 1) * D + 4 * (lane + 64 * j));
                    xa.x = __uint_as_float(wa.x << 16); xa.y = __uint_as_float(wa.x & 0xffff0000u); xa.z = __uint_as_float(wa.y << 16); xa.w = __uint_as_float(wa.y & 0xffff0000u); xb_.x = __uint_as_float(wb.x << 16); xb_.y = __uint_as_float(wb.x & 0xffff0000u); xb_.z = __uint_as_float(wb.y << 16); xb_.w = __uint_as_float(wb.y & 0xffff0000u); }
                const u32x2 ma = *(const u32x2*)(mix + (size_t)m * D + 4 * (lane + 64 * j)), mb = *(const u32x2*)(mix + (size_t)(m + 1) * D + 4 * (lane + 64 * j));
                v0[j].x = ALPHA * xa.x + __uint_as_float(ma.x << 16); v0[j].y = ALPHA * xa.y + __uint_as_float(ma.x & 0xffff0000u); v0[j].z = ALPHA * xa.z + __uint_as_float(ma.y << 16); v0[j].w = ALPHA * xa.w + __uint_as_float(ma.y & 0xffff0000u);
                v1[j].x = ALPHA * xb_.x + __uint_as_float(mb.x << 16); v1[j].y = ALPHA * xb_.y + __uint_as_float(mb.x & 0xffff0000u); v1[j].z = ALPHA * xb_.z + __uint_as_float(mb.y << 16); v1[j].w = ALPHA * xb_.w + __uint_as_float(mb.y & 0xffff0000u); }
            row_ln2(v0, v1, g1, b1, lane);
            row_store_bf16(v0, x1b + (size_t)m * D, lane); row_store_bf16(v1, x1b + (size_t)(m + 1) * D, lane);
            float a0[32], a1[32]; row_dot2_lds<32>(v0, v1, (const LAS float*)T, a0, a1, lane);
            reduce_scatter2<32>(a0, a1, lane);
            const int myexp = (lane >> 1) & 31; const float bre = br[myexp]; const float va = a0[0] + bre, vb = a1[0] + bre;
            int ra = 0, rb = 0;
#pragma unroll
            for (int k = 1; k < 32; ++k) { const int oe = (myexp + k) & 31; const float oa = __shfl(va, 2 * oe), ob = __shfl(vb, 2 * oe);
                ra += (oa > va || (oa == va && oe < myexp)) ? 1 : 0; rb += (ob > vb || (ob == vb && oe < myexp)) ? 1 : 0; }
            float ua[4], ub[4]; int ta[4], tb[4];
#pragma unroll
            for (int k = 0; k < 4; ++k) { const unsigned long long ma = __ballot(ra == k), mb = __ballot(rb == k); const int la = __ffsll((long long)ma) - 1, lb = __ffsll((long long)mb) - 1;
                ta[k] = la >> 1; tb[k] = lb >> 1; ua[k] = __shfl(va, la); ub[k] = __shfl(vb, lb); }
            { const float e1 = __builtin_amdgcn_exp2f(L2E * (ua[1] - ua[0])), e2 = __builtin_amdgcn_exp2f(L2E * (ua[2] - ua[0])), e3 = __builtin_amdgcn_exp2f(L2E * (ua[3] - ua[0])); const float inv = 1.0f / (1.0f + e1 + e2 + e3);
              if ((lane >> 2) == i) { const int k = lane & 3; my_e = k == 0 ? ta[0] : k == 1 ? ta[1] : k == 2 ? ta[2] : ta[3]; my_g = (k == 0 ? 1.0f : k == 1 ? e1 : k == 2 ? e2 : e3) * inv; } }
            { const float e1 = __builtin_amdgcn_exp2f(L2E * (ub[1] - ub[0])), e2 = __builtin_amdgcn_exp2f(L2E * (ub[2] - ub[0])), e3 = __builtin_amdgcn_exp2f(L2E * (ub[3] - ub[0])); const float inv = 1.0f / (1.0f + e1 + e2 + e3);
              if ((lane >> 2) == i + 1) { const int k = lane & 3; my_e = k == 0 ? tb[0] : k == 1 ? tb[1] : k == 2 ? tb[2] : tb[3]; my_g = (k == 0 ? 1.0f : k == 1 ? e1 : k == 2 ? e2 : e3) * inv; } }
        }
        const unsigned lrank = __hip_atomic_fetch_add((LAS unsigned*)lcnt + my_e, 1u, __ATOMIC_RELAXED, __HIP_MEMORY_SCOPE_WORKGROUP);
        __syncthreads();
        if (tid < 32) { const unsigned c = lcnt[tid]; lbase[tid] = c ? atomicAdd(cnt + tid * CNT_STRIDE, c) : 0u; }
        __syncthreads();
        { const unsigned rank = lbase[my_e] + lrank; const int m = row0 + (lane >> 2);
          tok[(size_t)my_e * NTOK + rank] = m; re[(size_t)row0 * 4 + lane] = my_e; rr[(size_t)row0 * 4 + lane] = (int)rank; rg[(size_t)row0 * 4 + lane] = my_g; }
        __syncthreads();
        if (tid < 32) lcnt[tid] = 0u;
        __syncthreads();
    }
}
constexpr size_t WS_WRT = 79 * MiB;
constexpr int PW1 = 1032;
__device__ __forceinline__ void router_prep_item(const float* g1, const float* b1, const float* wr, const float* br, unsigned char* ws, int l, int e, int lane) {
    bf16_t* WT = (bf16_t*)(ws + WS_WRT) + (size_t)l * 64 * PW1; float* GB = (float*)(ws + WS_WRT + 768 * 1024) + l * 64;
    float sg = 0.f, sb = 0.f;
#pragma unroll
    for (int j = 0; j < 16; ++j) { const int k = lane + 64 * j; const float w0 = wr[(size_t)l * 1024 * 32 + k * 32 + e], gk = g1[l * 1024 + k], bk = b1[l * 1024 + k]; const float w = w0 * gk;
        const bf16_t hi = f2bf(w); WT[e * PW1 + k] = hi; WT[(32 + e) * PW1 + k] = f2bf(w - bf2f(hi)); sg += w; sb += bk * w0; }
    sg = wave_sum(sg); sb = wave_sum(sb);
    if (lane == 0) { GB[e] = sg; GB[32 + e] = sb + br[l * 32 + e]; }
}
__device__ __forceinline__ void rows1m_phase(const bf16_t* xinb, const bf16_t* mix, const float* g1, const float* b1, const bf16_t* wtg, const float* gbg, bf16_t* x1b, unsigned* cnt, int* tok, int* re, int* rr, float* rg,
                                             LAS unsigned char* ring, volatile LAS unsigned* lcnt, volatile LAS unsigned* lbase, volatile LAS float* gb  , int bx, int G, int wave, int lane) {
    asm volatile("" : "+v"(lane));
    const int tid = wave * 64 + lane;
    LAS bf16_t* WT = (LAS bf16_t*)ring;
    if (tid < 32) lcnt[tid] = 0u;
    { const GAS u32x4* src = (const GAS u32x4*)wtg; constexpr int NV = 64 * PW1 * 2 / 16;
#pragma unroll 1
      for (int i0 = tid; i0 < NV; i0 += 9 * NWAVES * 64) { u32x4 w[9];
#pragma unroll
          for (int u = 0; u < 9; ++u) { const int i = i0 + u * NWAVES * 64; if (i < NV) w[u] = src[i]; }
#pragma unroll
          for (int u = 0; u < 9; ++u) { const int i = i0 + u * NWAVES * 64; if (i < NV) *(LAS u32x4*)(ring + 16 * i) = w[u]; } }
      if (tid < 64) gb[tid] = ((const GAS float*)gbg)[tid]; }
    __syncthreads();
    const int rrow = lane & 15, grp = lane >> 4;
    for (int blk = bx; blk < NTOK / 128; blk += G) {
        const int row0 = blk * 128 + wave * 16;
        float mu_l = 0.f, rs_l = 0.f;
        u32x2 nxa[4], nxb[4], nma[4], nmb[4];
#pragma unroll
        for (int j = 0; j < 4; ++j) { nxa[j] = *(const GAS u32x2*)((const GAS bf16_t*)xinb + (size_t)row0 * D + 4 * (lane + 64 * j)); nxb[j] = *(const GAS u32x2*)((const GAS bf16_t*)xinb + (size_t)(row0 + 1) * D + 4 * (lane + 64 * j));
                                      nma[j] = *(const GAS u32x2*)((const GAS bf16_t*)mix + (size_t)row0 * D + 4 * (lane + 64 * j)); nmb[j] = *(const GAS u32x2*)((const GAS bf16_t*)mix + (size_t)(row0 + 1) * D + 4 * (lane + 64 * j)); }
#pragma unroll 1
        for (int i = 0; i < 16; i += 2) {
            const int m = row0 + i; f32x4 v0[4], v1[4];
            u32x2 cxa[4], cxb[4], cma[4], cmb[4];
#pragma unroll
            for (int j = 0; j < 4; ++j) { cxa[j] = nxa[j]; cxb[j] = nxb[j]; cma[j] = nma[j]; cmb[j] = nmb[j]; }
            if (i + 2 < 16) {
#pragma unroll
                for (int j = 0; j < 4; ++j) { nxa[j] = *(const GAS u32x2*)((const GAS bf16_t*)xinb + (size_t)(m + 2) * D + 4 * (lane + 64 * j)); nxb[j] = *(const GAS u32x2*)((const GAS bf16_t*)xinb + (size_t)(m + 3) * D + 4 * (lane + 64 * j));
                                              nma[j] = *(const GAS u32x2*)((const GAS bf16_t*)mix + (size_t)(m + 2) * D + 4 * (lane + 64 * j)); nmb[j] = *(const GAS u32x2*)((const GAS bf16_t*)mix + (size_t)(m + 3) * D + 4 * (lane + 64 * j)); }
            }
#pragma unroll
            for (int j = 0; j < 4; ++j) { f32x4 xa, xb_; { const u32x2 wa = cxa[j], wb = cxb[j];
                    xa.x = __uint_as_float(wa.x << 16); xa.y = __uint_as_float(wa.x & 0xffff0000u); xa.z = __uint_as_float(wa.y << 16); xa.w = __uint_as_float(wa.y & 0xffff0000u); xb_.x = __uint_as_float(wb.x << 16); xb_.y = __uint_as_float(wb.x & 0xffff0000u); xb_.z = __uint_as_float(wb.y << 16); xb_.w = __uint_as_float(wb.y & 0xffff0000u); }
                const u32x2 ma = cma[j], mb = cmb[j];
                v0[j].x = ALPHA * xa.x + __uint_as_float(ma.x << 16); v0[j].y = ALPHA * xa.y + __uint_as_float(ma.x & 0xffff0000u); v0[j].z = ALPHA * xa.z + __uint_as_float(ma.y << 16); v0[j].w = ALPHA * xa.w + __uint_as_float(ma.y & 0xffff0000u);
                v1[j].x = ALPHA * xb_.x + __uint_as_float(mb.x << 16); v1[j].y = ALPHA * xb_.y + __uint_as_float(mb.x & 0xffff0000u); v1[j].z = ALPHA * xb_.z + __uint_as_float(mb.y << 16); v1[j].w = ALPHA * xb_.w + __uint_as_float(mb.y & 0xffff0000u); }
            float ma_, ra_, mb_, rb_; row_ln2s(v0, v1, g1, b1, lane, ma_, ra_, mb_, rb_);
            row_store_bf16(v0, x1b + (size_t)m * D, lane); row_store_bf16(v1, x1b + (size_t)(m + 1) * D, lane);
            if (rrow == i) { mu_l = ma_; rs_l = ra_; } if (rrow == i + 1) { mu_l = mb_; rs_l = rb_; }
        }
        f32x4 ax[4], am[4];
#pragma unroll
        for (int t = 0; t < 4; ++t) { ax[t] = (f32x4){0.f, 0.f, 0.f, 0.f}; am[t] = (f32x4){0.f, 0.f, 0.f, 0.f}; }
        { const GAS bf16_t* xp = (const GAS bf16_t*)xinb + (size_t)(row0 + rrow) * D + 8 * grp; const GAS bf16_t* mp = (const GAS bf16_t*)mix + (size_t)(row0 + rrow) * D + 8 * grp; const LAS bf16_t* wp = WT + rrow * PW1 + 8 * grp;
#pragma unroll 8
          for (int ks = 0; ks < 32; ++ks) { const bf16x8 fx = *(const GAS bf16x8*)(xp + 32 * ks), fm = *(const GAS bf16x8*)(mp + 32 * ks);
#pragma unroll
              for (int t = 0; t < 4; ++t) { const bf16x8 fw = *(const LAS bf16x8*)(wp + 16 * t * PW1 + 32 * ks);
                  ax[t] = __builtin_amdgcn_mfma_f32_16x16x32_bf16(fw, fx, ax[t], 0, 0, 0); am[t] = __builtin_amdgcn_mfma_f32_16x16x32_bf16(fw, fm, am[t], 0, 0, 0); } } }
        float v[8]; int ev[8];
#pragma unroll
        for (int t = 0; t < 2; ++t)
#pragma unroll
            for (int r = 0; r < 4; ++r) { const int e = 16 * t + 4 * grp + r; const float P = ALPHA * (ax[t][r] + ax[t + 2][r]) + (am[t][r] + am[t + 2][r]);
                v[4 * t + r] = rs_l * (P - mu_l * gb[e]) + gb[32 + e]; ev[4 * t + r] = e; }
        int kk[8], rk[8];
#pragma unroll
        for (int a = 0; a < 8; ++a) { const int bits = (int)__float_as_uint(v[a]); const int mono = bits ^ ((bits >> 31) & 0x7fffffff); kk[a] = (mono & ~31) | (31 - ev[a]); rk[a] = 0; }
#pragma unroll
        for (int a = 0; a < 8; ++a)
#pragma unroll
            for (int b = 0; b < 8; ++b) if (b != a) rk[a] += (kk[b] > kk[a]) ? 1 : 0;
#pragma unroll
        for (int sg = 1; sg < 4; ++sg) {
#pragma unroll
            for (int b = 0; b < 8; ++b) { const int o = __shfl_xor(kk[b], 16 * sg);
#pragma unroll
                for (int a = 0; a < 8; ++a) rk[a] += (o > kk[a]) ? 1 : 0; } }
        float u[4]; int tsel[4];
#pragma unroll
        for (int k = 0; k < 4; ++k) { unsigned se = 0u, sv = 0u;
#pragma unroll
            for (int a = 0; a < 8; ++a) { const bool hit = rk[a] == k; se |= hit ? (unsigned)(ev[a] + 1) : 0u; sv |= hit ? __float_as_uint(v[a]) : 0u; }
            se |= (unsigned)__shfl_xor((int)se, 16); sv |= (unsigned)__shfl_xor((int)sv, 16); se |= (unsigned)__shfl_xor((int)se, 32); sv |= (unsigned)__shfl_xor((int)sv, 32);
            tsel[k] = (int)se - 1; u[k] = __uint_as_float(sv); }
        const float e1 = __builtin_amdgcn_exp2f(L2E * (u[1] - u[0])), e2 = __builtin_amdgcn_exp2f(L2E * (u[2] - u[0])), e3 = __builtin_amdgcn_exp2f(L2E * (u[3] - u[0])); const float inv = 1.0f / (1.0f + e1 + e2 + e3);
        const int my_e = grp == 0 ? tsel[0] : grp == 1 ? tsel[1] : grp == 2 ? tsel[2] : tsel[3]; const float my_g = (grp == 0 ? 1.0f : grp == 1 ? e1 : grp == 2 ? e2 : e3) * inv;
        const unsigned lrank = __hip_atomic_fetch_add((LAS unsigned*)lcnt + my_e, 1u, __ATOMIC_RELAXED, __HIP_MEMORY_SCOPE_WORKGROUP);
        __syncthreads();
        if (tid < 32) { const unsigned c = lcnt[tid]; lbase[tid] = c ? atomicAdd(cnt + tid * CNT_STRIDE, c) : 0u; }
        __syncthreads();
        { const unsigned rank = lbase[my_e] + lrank; const int m = row0 + rrow;
          tok[(size_t)my_e * NTOK + rank] = m; re[(size_t)m * 4 + grp] = my_e; rr[(size_t)m * 4 + grp] = (int)rank; rg[(size_t)m * 4 + grp] = my_g; }
        __syncthreads();
        if (tid < 32) lcnt[tid] = 0u;
        __syncthreads();
    }
}
__device__ __forceinline__ void rows2_phase(const bf16_t* x1b, const unsigned char* ym, const unsigned* cnt, const int* re, const int* rr, const float* rg, const float* g2, const float* b2,
                                            float* xout, bf16_t* xb, const float* w_in_next, const float* bf_next, float* logf, volatile LAS float* T, int gw, int NGW, int lane) {
    asm volatile("" : "+v"(lane));
    int pc = lane < 32 ? (int)((((const GAS unsigned*)cnt)[(lane & 31) * CNT_STRIDE] + 255u) & ~255u) : 0; int inc = pc;
#pragma unroll
    for (int o = 1; o < 32; o <<= 1) { const int t = __shfl_up(inc, o); if (lane >= o) inc += t; }
    const int poff = inc - pc;
    typedef int i32x4 __attribute__((ext_vector_type(4)));
    u32x2 nxa[4], nxb[4]; i32x4 ne0, nr0, ne1, nr1; f32x4 ng0, ng1;
#define R2_FETCH(M) do { _Pragma("unroll") for (int j = 0; j < 4; ++j) { nxa[j] = *(const GAS u32x2*)((const GAS bf16_t*)x1b + (size_t)(M) * D + 4 * (lane + 64 * j)); nxb[j] = *(const GAS u32x2*)((const GAS bf16_t*)x1b + (size_t)((M) + 1) * D + 4 * (lane + 64 * j)); } \
        ne0 = *(const GAS i32x4*)((const GAS int*)re + (size_t)(M) * 4); nr0 = *(const GAS i32x4*)((const GAS int*)rr + (size_t)(M) * 4); ng0 = *(const GAS f32x4*)((const GAS float*)rg + (size_t)(M) * 4); \
        ne1 = *(const GAS i32x4*)((const GAS int*)re + (size_t)((M) + 1) * 4); nr1 = *(const GAS i32x4*)((const GAS int*)rr + (size_t)((M) + 1) * 4); ng1 = *(const GAS f32x4*)((const GAS float*)rg + (size_t)((M) + 1) * 4); } while (0)
    if (2 * gw < NTOK) R2_FETCH(2 * gw);
    if (w_in_next) load_wt_lds(w_in_next + 1536, NIN, 8, T);
    for (int m = 2 * gw; m < NTOK; m += 2 * NGW) {
        f32x4 v0[4], v1[4]; const i32x4 e0 = ne0, r0 = nr0, e1 = ne1, r1 = nr1; const f32x4 g0 = ng0, g1 = ng1;
#pragma unroll
        for (int j = 0; j < 4; ++j) { const u32x2 wa = nxa[j], wb = nxb[j];
            v0[j].x = ALPHA * __uint_as_float(wa.x << 16); v0[j].y = ALPHA * __uint_as_float(wa.x & 0xffff0000u); v0[j].z = ALPHA * __uint_as_float(wa.y << 16); v0[j].w = ALPHA * __uint_as_float(wa.y & 0xffff0000u);
            v1[j].x = ALPHA * __uint_as_float(wb.x << 16); v1[j].y = ALPHA * __uint_as_float(wb.x & 0xffff0000u); v1[j].z = ALPHA * __uint_as_float(wb.y << 16); v1[j].w = ALPHA * __uint_as_float(wb.y & 0xffff0000u); }
        unsigned y0[4][4], y1[4][4];
#pragma unroll
        for (int k = 0; k < 4; ++k) { const int ra = __shfl(poff, e0[k]) + r0[k], rb = __shfl(poff, e1[k]) + r1[k]; const GAS unsigned char* ya = (const GAS unsigned char*)ym + (size_t)ra * 1024; const GAS unsigned char* yb_ = (const GAS unsigned char*)ym + (size_t)rb * 1024;
#pragma unroll
            for (int j = 0; j < 4; ++j) { y0[k][j] = *(const GAS unsigned*)(ya + 4 * (lane + 64 * j)); y1[k][j] = *(const GAS unsigned*)(yb_ + 4 * (lane + 64 * j)); } }
        { const int mn = m + 2 * NGW; if (mn < NTOK) R2_FETCH(mn); }
#pragma unroll
        for (int k = 0; k < 4; ++k)
#pragma unroll
            for (int j = 0; j < 4; ++j) { const int w = (int)y0[k][j], x = (int)y1[k][j]; const f32x2 ga = (f32x2){g0[k], g0[k]}, gb = (f32x2){g1[k], g1[k]};
                const f32x2 a01 = __builtin_elementwise_fma(__builtin_amdgcn_cvt_pk_f32_fp8(w, false), ga, (f32x2){v0[j].x, v0[j].y}), a23 = __builtin_elementwise_fma(__builtin_amdgcn_cvt_pk_f32_fp8(w, true), ga, (f32x2){v0[j].z, v0[j].w});
                const f32x2 b01 = __builtin_elementwise_fma(__builtin_amdgcn_cvt_pk_f32_fp8(x, false), gb, (f32x2){v1[j].x, v1[j].y}), b23 = __builtin_elementwise_fma(__builtin_amdgcn_cvt_pk_f32_fp8(x, true), gb, (f32x2){v1[j].z, v1[j].w});
                v0[j] = (f32x4){a01.x, a01.y, a23.x, a23.y}; v1[j] = (f32x4){b01.x, b01.y, b23.x, b23.y}; }
        row_ln2(v0, v1, g2, b2, lane);
        if (xout) { _Pragma("unroll") for (int j = 0; j < 4; ++j) { *(GAS f32x4*)((GAS float*)xout + (size_t)m * D + 4 * (lane + 64 * j)) = v0[j]; *(GAS f32x4*)((GAS float*)xout + (size_t)(m + 1) * D + 4 * (lane + 64 * j)) = v1[j]; } }
        if (w_in_next) { float a0[8], a1[8]; row_dot2_lds<8>(v0, v1, (const LAS float*)T, a0, a1, lane);
            row_store_bf16(v0, xb + (size_t)m * D, lane); row_logf_fin(a0, bf_next, logf, m, lane);
            row_store_bf16(v1, xb + (size_t)(m + 1) * D, lane); row_logf_fin(a1, bf_next, logf, m + 1, lane); }
    }
#undef R2_FETCH
    __syncthreads();
}
__device__ __forceinline__ void cumsum_block(const float* logf, float* cum, int bh, volatile LAS float* scr) {
    int tid = threadIdx.x; asm volatile("" : "+v"(tid)); const int lane = tid & 63, wv = tid >> 6;
    const float* src = logf + (size_t)bh * SEQ + tid * 8; float* dst = cum + (size_t)bh * SEQ + tid * 8;
    const f32x4 a = *(const f32x4*)src, b = *(const f32x4*)(src + 4);
    float v[8]; v[0] = a.x; v[1] = v[0] + a.y; v[2] = v[1] + a.z; v[3] = v[2] + a.w; v[4] = v[3] + b.x; v[5] = v[4] + b.y; v[6] = v[5] + b.z; v[7] = v[6] + b.w;
    const float s = v[7]; float inc = s;
#pragma unroll
    for (int o = 1; o < 64; o <<= 1) { const float t = __shfl_up(inc, o); if (lane >= o) inc += t; }
    if (lane == 63) scr[wv] = inc;
    __syncthreads();
    float base = inc - s;
    for (int i = 0; i < wv; ++i) base += scr[i];
    f32x4 o0, o1; o0.x = v[0] + base; o0.y = v[1] + base; o0.z = v[2] + base; o0.w = v[3] + base; o1.x = v[4] + base; o1.y = v[5] + base; o1.z = v[6] + base; o1.w = v[7] + base;
    *(f32x4*)dst = o0; *(f32x4*)(dst + 4) = o1;
    __syncthreads();
}

struct S5Order { const char* A; const char* B; size_t bstep; int G, c, ldb, nt;
    __device__ __forceinline__ bool next(int i, pg8::Unit& u) const {
        const int L = i * G + c; if (L >= 128) return false;
        const int g = L >> 3, pm = L & 7;
        u.A = A + ((size_t)g * 2048 + pm * 256) * 384 * 2; u.B = B + (size_t)g * bstep; u.e = g; u.pm = pm; u.pn = 0; u.valid = 256; u.lt = 0; u.lda = 384; u.ldb = ldb; u.nt = nt; u.seg = 0; return true; }
};
struct BranchOrder { pg8::StaticOrder T; const char *A0, *A1, *A2, *B0, *B1, *B2;
    __device__ __forceinline__ bool next(int i, pg8::Unit& u) const {
        const int ti = i / 3, seg = i - 3 * ti;
        if (!T.next(ti, u)) return false;
        u.seg = seg; u.lda = seg == 0 ? HP : 256; u.ldb = seg == 0 ? 512 : 256; u.nt = seg == 0 ? 8 : 4;
        const char *a0 = A0, *a1 = A1, *a2 = A2, *b0 = B0, *b1 = B1, *b2 = B2; asm volatile("" : "+s"(a0), "+s"(a1), "+s"(a2), "+s"(b0), "+s"(b1), "+s"(b2));
        u.A = (seg == 0 ? a0 : seg == 1 ? a1 : a2) + (size_t)u.pm * 256 * u.lda * 2; u.B = (seg == 0 ? b0 : seg == 1 ? b1 : b2) + (size_t)u.pn * 256 * u.ldb * 2; return true; }
};
namespace pg8 {
struct EpiS1 { float* S;
    static constexpr bool AFTER_DRAIN = false; __device__ __forceinline__ void pre(const Unit&, int, int, int, int) const {} __device__ __forceinline__ bool keep_acc(const Unit&) const { return false; }
    __device__ __forceinline__ void operator()(const Acc& acc, const Unit& u, int wr, int wc, int fr, int fq) const {
        const unsigned vo = (unsigned)(fr * 128 + 8 * fq) * 4u;
#pragma unroll
        for (int ai = 0; ai < 2; ++ai)
#pragma unroll
            for (int m = 0; m < 4; ++m) { float* ub = S + ((size_t)u.e * 2048 + u.pm * 256 + ai * 128 + wr * 64 + m * 16) * 128 + wc * 32;
                *(f32x4*)((char*)ub + vo) = acc[ai][0][m][0]; *(f32x4*)((char*)ub + vo + 16) = acc[ai][0][m][1]; }
    }
};
struct EpiS3 { bf16_t* ycp;
    static constexpr bool AFTER_DRAIN = false; __device__ __forceinline__ void pre(const Unit&, int, int, int, int) const {} __device__ __forceinline__ bool keep_acc(const Unit&) const { return false; }
    __device__ __forceinline__ void operator()(const Acc& acc, const Unit& u, int wr, int wc, int fr, int fq) const {
        const unsigned vo = (unsigned)((fr * 16 + (fq >> 1)) * 256 + (fq & 1) * 8) * 2u;
#pragma unroll
        for (int ai = 0; ai < 2; ++ai)
#pragma unroll
            for (int m = 0; m < 4; ++m)
#pragma unroll
                for (int bj = 0; bj < 2; ++bj) { f32x4 v[2] = {acc[ai][bj][m][0], acc[ai][bj][m][1]};
#pragma unroll
                    for (int n = 0; n < 2; ++n)
#pragma unroll
                        for (int i = 0; i < 4; ++i) { const float y = v[n][i]; v[n][i] = y * fsig(1.5957691216057308f * (y + 0.044715f * y * y * y)); }
                    st16(ycp + ((size_t)(u.pm * 256 + ai * 128 + wr * 64 + m * 16) * 16 + bj * 8 + wc * 2) * 256 + u.e * 16, vo, pack8(v[0], v[1])); }
    }
};
}

struct OneUnit { const char* A; const char* B; int pm, lda, ldb, nt;
    __device__ __forceinline__ bool next(int i, pg8::Unit& u) const {
        if (i) return false;
        u.A = A + (size_t)pm * 256 * lda * 2; u.B = B; u.e = 0; u.pm = pm; u.pn = 0; u.valid = 256; u.lt = 0; u.lda = lda; u.ldb = ldb; u.nt = nt; u.seg = 0; return true; }
};
__device__ __forceinline__ void wg_mem_sync() {
    asm volatile("s_waitcnt vmcnt(0)" ::: "memory");
    __syncthreads();
    if (threadIdx.x == 0) { __builtin_amdgcn_fence(__ATOMIC_ACQUIRE, "agent"); asm volatile("s_waitcnt vmcnt(0)" ::: "memory"); }
    __syncthreads();
}
__device__ __forceinline__ void count_in_and_wait(unsigned* ctr, unsigned n, unsigned* bar) {
    asm volatile("s_waitcnt vmcnt(0)" ::: "memory");
    __syncthreads();
    if (threadIdx.x == 0) {
        __builtin_amdgcn_fence(__ATOMIC_RELEASE, "agent");
        asm volatile("s_waitcnt vmcnt(0)" ::: "memory");
        (void)xb_add(ctr, 1u);
        XB_SPIN(xb_ld(ctr) < n, bar);
        __builtin_amdgcn_fence(__ATOMIC_ACQUIRE, "agent");
        asm volatile("s_waitcnt vmcnt(0)" ::: "memory");
    }
    __syncthreads();
}

#ifndef STEP_MASK
#define STEP_MASK 0x1fff
#endif
struct Args {
    const float* in[29]; float* out; unsigned char* ws;
    int step_lo, step_hi;
    int bar_region, pad;
};
constexpr int STEPS_PER_LAYER = 12, N_STEPS = 1 + NL * STEPS_PER_LAYER;

__global__ void __launch_bounds__(NWAVES * 64, 2) mk_fwd(Args a) {
    extern __shared__ __attribute__((aligned(16))) unsigned char lds_raw[];
    LAS unsigned char* lds0 = (LAS unsigned char*)lds_raw;
    LAS unsigned char* lds = lds0 + RING_OFF;
    volatile LAS unsigned* MISC = (volatile LAS unsigned*)lds0;
    const int tid = threadIdx.x, lane = tid & 63, wave = __builtin_amdgcn_readfirstlane(tid >> 6);
    const int G = gridDim.x;
    const int gw = (int)blockIdx.x * NWAVES + wave, NGW = G * NWAVES;
    unsigned char* ws = a.ws;
    for (int u = tid; u < LDSCTL_BYTES / 4; u += NWAVES * 64) ((LAS unsigned*)lds0)[u] = 0u;
    __syncthreads();
    XcdBarrier bar = xcd_barrier_post((unsigned*)(ws + WS_CTL) + CW_BAR + a.bar_region * XCD_BAR_WORDS, MISC + 8);
    const int lo = a.step_lo, hi = a.step_hi;
#define IN(k) (lo <= (k) && (k) < hi)
#define SEAM(k) do { if (IN(k) && IN((k) + 1)) xcd_barrier(bar); } while (0)
#define BX() ({ int b_ = (int)blockIdx.x; asm volatile("" : "+s"(b_)); b_; })
#define GWL() (BX() * NWAVES + wave)
#define WSP(T, off) ({ unsigned char* w_ = ws; asm volatile("" : "+s"(w_)); (T*)(__attribute__((address_space(1))) T*)(w_ + (off)); })
#define ARG_IN(i) ({ const __attribute__((address_space(4))) char* k_ = (const __attribute__((address_space(4))) char*)__builtin_amdgcn_kernarg_segment_ptr(); asm volatile("" : "+s"(k_)); (const float*)(const __attribute__((address_space(1))) float*)*(const float* const __attribute__((address_space(4)))*)(k_ + 8 * (i)); })

    if (IN(0) && (STEP_MASK & 1)) {
        PrepArgs pa; pa.w_in = ARG_IN(1); pa.w_ba = ARG_IN(15); pa.w_bb = ARG_IN(16); pa.w_bc = ARG_IN(17); pa.w_out = ARG_IN(18); pa.w_glu = ARG_IN(13); pa.w_up = ARG_IN(23); pa.w_dn = ARG_IN(25); pa.ws = ws;
        prep_items(pa, (float*)(lds_raw + RING_OFF + wave * 16640), (long)gw, (long)NGW, lane);
        S5In si; si.lam_re = ARG_IN(5); si.lam_im = ARG_IN(6); si.log_dt = ARG_IN(7); si.b_re = ARG_IN(8); si.b_im = ARG_IN(9); si.c_re = ARG_IN(10); si.c_im = ARG_IN(11); si.dsk = ARG_IN(12);
        for (int it = gw; it < NL * 16 * 48; it += NGW) { const int lg = it / 48, r = it % 48; s5_prep_item(si, ws, lg >> 4, lg & 15, r >> 4, r & 15, lane); }
        for (int it = gw; it < NL * 32; it += NGW) router_prep_item(ARG_IN(19), ARG_IN(20), ARG_IN(21), ARG_IN(22), ws, it >> 5, it & 31, lane);
        __syncthreads();
        rows0_phase(ARG_IN(0), ARG_IN(1), ARG_IN(2), WSP(bf16_t, WS_XB), WSP(float, WS_LOGF), (volatile LAS float*)lds, gw, NGW, lane);
    }
    SEAM(0);

    for (int l = 0; l < NL; ++l) {
        const int s0 = 1 + STEPS_PER_LAYER * l;
        unsigned* cnt = (unsigned*)(ws + WS_CTL) + CW_CNT + NE * CNT_STRIDE * l;
        if (IN(s0 + 0) && (STEP_MASK & (2 << 0))) {
            if (BX() < 64) cumsum_block(WSP(float, WS_LOGF), WSP(float, WS_CUM), BX(), (volatile LAS float*)lds);
            bf16_t* H = WSP(bf16_t, WS_H); bf16_t* A3 = WSP(bf16_t, WS_A3);
            pg8::StaticOrder S; S.init(WSP(bf16_t, WS_XB), 1024, WSP(bf16_t, WS_WIN) + (size_t)l * 5120 * 1024, 1024, 1024, NTOK, 5120, G, BX());
            pg8::EpiIn E{H, A3, WSP(unsigned char, WS_GQ)};
            pg8::gemm_phase<false>(lds, S, E);
        }
        SEAM(s0 + 0);
        if (IN(s0 + 1) && (STEP_MASK & (2 << 1))) {
            if (BX() < 128) {
                const int c = BX();
                { S5Order S{(const char*)WSP(bf16_t, WS_A3), (const char*)(WSP(bf16_t, WS_S5W1) + (size_t)l * 16 * 256 * 256), (size_t)256 * 256 * 2, G, c, 256, 4};
                  pg8::EpiS1 E{WSP(float, WS_S5S)};
                  pg8::gemm_phase<false>(lds, S, E); }
                wg_mem_sync();
                s5_scan_wg(WSP(float, WS_S5S), WSP(float, WS_S5A16) + (size_t)l * 16 * 64 * 2, WSP(bf16_t, WS_A3), c & 7, c >> 3, (LAS float*)lds);
                { S5Order S{(const char*)WSP(bf16_t, WS_A3), (const char*)(WSP(bf16_t, WS_S5W3) + (size_t)l * 16 * 256 * 384), (size_t)256 * 384 * 2, G, c, 384, 6};
                  pg8::EpiS3 E{WSP(bf16_t, WS_YCP)};
                  pg8::gemm_phase<false>(lds, S, E); }
                count_in_and_wait((unsigned*)(ws + WS_CTL) + CW_S5C + (l * 8 + (c & 7)) * 32, 16u, bar.bar);
                { bf16_t* YCP = WSP(bf16_t, WS_YCP); bf16_t* YC = WSP(bf16_t, WS_YC);
                  OneUnit S{(const char*)YCP, (const char*)(WSP(bf16_t, WS_WGLU) + (size_t)l * 65536), (c & 7) * 16 + (c >> 3), 256, 256, 4};
                  pg8::EpiGlu E{YCP, ARG_IN(14) + (size_t)l * 256, YC};
                  pg8::gemm_phase<false>(lds, S, E); }
                __syncthreads();
            }
            {
                bf16_t* H = WSP(bf16_t, WS_H); const float* CUM = WSP(float, WS_CUM);
                const attn_body::AttnTensors AT{(const attn_body::bf16*)(H + HC_Q), (const attn_body::bf16*)(H + HC_K), (const attn_body::bf16*)(H + HC_V), (attn_body::bf16*)WSP(bf16_t, WS_OB), CUM};
                const int vcu = (G % 8 == 0) ? (BX() % 8) * (G / 8) + BX() / 8 : BX(); const int batch = (vcu * 8 / G) & 7;
                attn_body::QueueOrder S{(unsigned*)(ws + WS_CTL) + CW_ATTQ + a.pad * 1024 + (l * 8 + batch) * 32, (volatile LAS int*)(MISC + 60)};
                attn_body::AttnTensors ATb = AT; ATb.Q += (size_t)batch * SEQ * HP; ATb.K += (size_t)batch * SEQ * HP; ATb.V += (size_t)batch * SEQ * HP; ATb.O += (size_t)batch * SEQ * HP; ATb.cum += (size_t)batch * 8 * SEQ;
                attn_body::attn_phase<attn_body::QueueOrder>((char*)lds_raw + RING_OFF, ATb, S);
            }
            __syncthreads();
            {
                const bf16_t* H = WSP(bf16_t, WS_H); const float* wpool = ARG_IN(3) + (size_t)l * 4 * 64 * 64; const float* pscale = ARG_IN(4) + (size_t)l * 256; bf16_t* YB = WSP(bf16_t, WS_YB);
                pool_phase(H, wpool, pscale, YB, BX(), G, lds);
            }
        }
        SEAM(s0 + 5);
        if (IN(s0 + 6) && (STEP_MASK & (2 << 6))) {
            bf16_t* H = WSP(bf16_t, WS_H); bf16_t* MERGED = WSP(bf16_t, WS_MERGED); bf16_t* YB = WSP(bf16_t, WS_YB); bf16_t* YC = WSP(bf16_t, WS_YC);
            BranchOrder S; S.T.init(nullptr, 0, nullptr, 0, 128, NTOK, 1024, G, BX());
            S.A0 = (const char*)WSP(bf16_t, WS_OB); S.A1 = (const char*)YB; S.A2 = (const char*)YC;
            S.B0 = (const char*)(WSP(bf16_t, WS_WBA) + (size_t)l * 1024 * 512); S.B1 = (const char*)(WSP(bf16_t, WS_WBB) + (size_t)l * 1024 * 256); S.B2 = (const char*)(WSP(bf16_t, WS_WBC) + (size_t)l * 1024 * 256);
            pg8::EpiBranchF E{WSP(unsigned char, WS_GQ), MERGED};
            pg8::gemm_phase<false>(lds, S, E);
        }
        SEAM(s0 + 6);
        if (IN(s0 + 7) && (STEP_MASK & (2 << 7))) {
            bf16_t* MERGED = WSP(bf16_t, WS_MERGED); bf16_t* MIX = WSP(bf16_t, WS_MIX);
            pg8::StaticOrder S; S.init(MERGED, 1024, WSP(bf16_t, WS_WOUT) + (size_t)l * 1024 * 1024, 1024, 1024, NTOK, 1024, G, BX());
            pg8::EpiPlain E{MIX, nullptr, 0};
            pg8::gemm_phase<false>(lds, S, E);
        }
        SEAM(s0 + 7);
        if (IN(s0 + 8) && (STEP_MASK & (2 << 8))) {
            const int dm = a.pad;
            rows1m_phase(WSP(bf16_t, WS_XB), WSP(bf16_t, WS_MIX), ARG_IN(19) + (size_t)l * D, ARG_IN(20) + (size_t)l * D, WSP(bf16_t, WS_WRT) + (size_t)l * 64 * PW1, WSP(float, WS_WRT + 768 * 1024) + l * 64,
                        WSP(bf16_t, WS_X1B), dm ? cnt + 4096 * dm : cnt, dm ? WSP(int, WS_OB) : WSP(int, WS_TOK), dm ? WSP(int, WS_OB + 8 * MiB) : WSP(int, WS_RE), dm ? WSP(int, WS_OB + 9 * MiB) : WSP(int, WS_RR), dm ? WSP(float, WS_OB + 10 * MiB) : WSP(float, WS_RG),
                        lds, MISC + 64, MISC + 96, (volatile LAS float*)(MISC + 256), BX(), G, wave, lane);
        }
        SEAM(s0 + 8);
        const bool fillok = (G == 256);
        if (IN(s0 + 9) && (STEP_MASK & (2 << 9))) {
            const int* TOK = WSP(int, WS_TOK); bf16_t* X1B = WSP(bf16_t, WS_X1B); bf16_t* ACT = WSP(bf16_t, WS_ACT);
            moe_prefix(cnt, (volatile LAS int*)(MISC + 16));
            { MoeOrder S{(const volatile LAS int*)(MISC + 16), cnt, TOK, (const char*)X1B, (const char*)(WSP(bf16_t, WS_WUP) + (size_t)l * NE * 2048 * 1024), (size_t)2048 * 1024 * 2, (size_t)256 * 1024 * 2, (size_t)256 * 1024 * 2, 8, G, BX(), 1024, true, -1};
              pg8::EpiUp E{ACT, ARG_IN(24) + (size_t)l * NE * 2048};
              pg8::gemm_phase<true>(lds, S, E); }
            if (fillok) {
                const int c = BX(), ga = 4 * (c & 7) + (c >> 6), p8 = (c >> 3) & 7, r0 = (((volatile LAS int*)(MISC + 16))[32] - 1) & 31;
                if (ga > r0) {
                    count_in_and_wait((unsigned*)(ws + WS_CTL) + CW_MOEF + (l * 32 + ga) * 32, 8u, bar.bar);
                    MoeOrder D{(const volatile LAS int*)(MISC + 16), cnt, TOK, (const char*)WSP(bf16_t, WS_ACT), (const char*)(WSP(bf16_t, WS_WDN) + (size_t)l * NE * 1024 * 1024), (size_t)1024 * 1024 * 2, (size_t)256 * 1024 * 2, (size_t)256 * 1024 * 2, 4, G, c, 1024, false, -1};
                    MoeOne S1{D, p8 < 4 ? ga : 32 + ga, p8 & 3};
                    pg8::EpiYm8 E2{(unsigned char*)WSP(bf16_t, WS_YM), ARG_IN(26) + (size_t)l * NE * 1024};
                    pg8::gemm_phase<false>(lds, S1, E2);
                }
            }
        }
        SEAM(s0 + 9);
        if (IN(s0 + 10) && (STEP_MASK & (2 << 10))) {
            const int* TOK = WSP(int, WS_TOK); bf16_t* ACT = WSP(bf16_t, WS_ACT); bf16_t* YM = WSP(bf16_t, WS_YM);
            if (!(IN(s0 + 9) && (STEP_MASK & (2 << 9)))) moe_prefix(cnt, (volatile LAS int*)(MISC + 16));
            const int r0 = fillok ? ((((volatile LAS int*)(MISC + 16))[32] - 1) & 31) : -1;
            MoeOrder S{(const volatile LAS int*)(MISC + 16), cnt, TOK, (const char*)ACT, (const char*)(WSP(bf16_t, WS_WDN) + (size_t)l * NE * 1024 * 1024), (size_t)1024 * 1024 * 2, (size_t)256 * 1024 * 2, (size_t)256 * 1024 * 2, 4, G, BX(), 1024, false, r0};
            pg8::EpiYm8 E{(unsigned char*)YM, ARG_IN(26) + (size_t)l * NE * 1024};
            pg8::gemm_phase<false>(lds, S, E);
        }
        SEAM(s0 + 10);
        if (IN(s0 + 11) && (STEP_MASK & (2 << 11))) {
            const bool last = (l == NL - 1);
            rows2_phase(WSP(bf16_t, WS_X1B), WSP(unsigned char, WS_YM), cnt, WSP(int, WS_RE), WSP(int, WS_RR), WSP(float, WS_RG), ARG_IN(27) + (size_t)l * D, ARG_IN(28) + (size_t)l * D,
                        last ? a.out : (float*)nullptr, WSP(bf16_t, WS_XB), last ? (const float*)nullptr : ARG_IN(1) + (size_t)(l + 1) * D * NIN, last ? (const float*)nullptr : ARG_IN(2) + (size_t)(l + 1) * 8,
                        WSP(float, WS_LOGF), (volatile LAS float*)lds, GWL(), NGW, lane);
        }
        SEAM(s0 + 11);
    }
#undef IN
#undef SEAM
}

#ifndef MK_MODE
#define MK_MODE 0
#endif
extern "C" void kernel_launch(void* const* d_in, const int* in_sizes, int n_in, void* d_out, int out_size, void* d_ws, size_t ws_size, hipStream_t stream) {
    if (n_in != 29 || out_size != NTOK * D || ws_size < WS_END2) { fprintf(stderr, "kernel_launch: unexpected shapes (n_in %d out %d ws %zu)\n", n_in, out_size, ws_size); return; }
    static int grid = 0;
    if (grid == 0) {
        int dev = 0, cus = 0;
        if (hipGetDevice(&dev) != hipSuccess || hipDeviceGetAttribute(&cus, hipDeviceAttributeMultiprocessorCount, dev) != hipSuccess) { fprintf(stderr, "kernel_launch: device query failed\n"); grid = -1; return; }
        if (hipFuncSetAttribute((const void*)mk_fwd, hipFuncAttributeMaxDynamicSharedMemorySize, LDS_BYTES) != hipSuccess) { fprintf(stderr, "kernel_launch: hipFuncSetAttribute failed\n"); grid = -1; return; }
        int per_cu = 0;
        if (hipOccupancyMaxActiveBlocksPerMultiprocessor(&per_cu, (const void*)mk_fwd, NWAVES * 64, LDS_BYTES) != hipSuccess || per_cu < 1) fprintf(stderr, "kernel_launch: occupancy query reports %d workgroups per CU\n", per_cu);
        (void)hipGetLastError();
        grid = cus;
    }
    if (grid < 0) return;
    unsigned char* ws = (unsigned char*)d_ws;
    (void)hipMemsetAsync(ws + WS_CTL, 0, 1 * MiB, stream);
    Args a{}; for (int i = 0; i < 29; ++i) a.in[i] = (const float*)d_in[i]; a.out = (float*)d_out; a.ws = ws;
#if MK_MODE == 0
    a.step_lo = 0; a.step_hi = N_STEPS; a.bar_region = 0;
    hipLaunchKernelGGL(mk_fwd, dim3(grid), dim3(NWAVES * 64), LDS_BYTES, stream, a);
#elif MK_MODE == 1
    for (int s = 0; s < N_STEPS; ++s) { Args b = a; b.step_lo = s; b.step_hi = s + 1; b.bar_region = s; hipLaunchKernelGGL(mk_fwd, dim3(grid), dim3(NWAVES * 64), LDS_BYTES, stream, b); }
#else
    for (int s = 0; s < N_STEPS; ++s) { const int bit = s == 0 ? 0 : 1 + (s - 1) % STEPS_PER_LAYER; const int rep = ((PROBE_MASK >> bit) & 1) ? PROBE_REP : 1;
        for (int r = 0; r < rep; ++r) { Args b = a; b.step_lo = s; b.step_hi = s + 1; b.bar_region = s; b.pad = (bit == 9 || bit == 2) ? r : 0; hipLaunchKernelGGL(mk_fwd, dim3(grid), dim3(NWAVES * 64), LDS_BYTES, stream, b); } }
#endif
}
```
